# Optimizing an MI355X kernel written in HIP

```python
import math
import jax
import jax.numpy as jnp
from jax import lax
import numpy as np

D_MODEL = 1024
BATCH = 1
SEQ = 16384
DEPTH = 4

CTX_LEN = 256
GRID_W = 64
EPS = 1e-6
ROPE_BASE = 10000.0

RET_HEADS = 4
RET_DK = 128
RET_DV = 256
RET_CHUNK = 128
RET_QK = RET_HEADS * RET_DK
RET_V = RET_HEADS * RET_DV

HY_WIDTH = 512
HY_ORDER = 2
HY_BANDS = 16
HY_EMB = 2 * HY_BANDS + 1
HY_FFN = 64
HY_DECAY_TARGET = 1e-2
HY_FAST_DECAY = 0.3
HY_SLOW_DECAY = 1.5

AB_SPLITS = (RET_QK, 2 * RET_QK, 2 * RET_QK + RET_V, 2 * RET_QK + 2 * RET_V)
AB_IN = 2 * RET_QK + 2 * RET_V + (HY_ORDER + 1) * HY_WIDTH
AB_CAT = RET_V + HY_WIDTH

DA_HEADS = 8
DA_HEAD_DIM = 64
DA_WIDTH = DA_HEADS * 2 * DA_HEAD_DIM
Q_BLOCK = 128

N_EXPERTS = 64
TOP_K = 8
N_GROUPS = 8
TOPK_GROUPS = 4
EXPERT_DIM = 256
SHARED_DIM = 256
ROUTED_SCALE = 2.5
MOE_BLOCK = 128

kernel_name = "hybrid_retention_hyena_diffattn_moe_dit"

F32 = jnp.float32


def rmsnorm(x, g, eps=EPS):
    xf = x.astype(F32)
    y = xf * lax.rsqrt(jnp.mean(xf * xf, axis=-1, keepdims=True) + eps)
    return (y * g.astype(F32)).astype(x.dtype)


def head_norm(r, eps=EPS):
    mu = jnp.mean(r, axis=-1, keepdims=True)
    var = jnp.mean(jnp.square(r - mu), axis=-1, keepdims=True)
    return (r - mu) * lax.rsqrt(var + eps)


def swiglu(x, wg, wu, wd):
    return (jax.nn.silu(x @ wg) * (x @ wu)) @ wd


def axial_rope(rows, head_dim):
    n_freq = head_dim // 4
    inv = ROPE_BASE ** (-jnp.arange(n_freq, dtype=F32) / n_freq)
    row = jnp.repeat(jnp.arange(rows, dtype=F32), GRID_W)
    col = jnp.tile(jnp.arange(GRID_W, dtype=F32), rows)
    ang = jnp.concatenate([row[:, None] * inv, col[:, None] * inv], axis=-1)
    return jnp.cos(ang), jnp.sin(ang)


def apply_rope(x, cos, sin):
    shape = (1, x.shape[1]) + (1,) * (x.ndim - 3) + (cos.shape[-1],)
    cos = cos.reshape(shape).astype(x.dtype)
    sin = sin.reshape(shape).astype(x.dtype)
    x1, x2 = jnp.split(x, 2, axis=-1)
    return jnp.concatenate([x1 * cos - x2 * sin, x2 * cos + x1 * sin], axis=-1)


def retention_scan(q, k, v, log_g, s0):
    B, L, H, dk = q.shape
    dv = v.shape[-1]
    n = L // RET_CHUNK
    qc = q.reshape(B, n, RET_CHUNK, H, dk)
    kc = k.reshape(B, n, RET_CHUNK, H, dk)
    vc = v.reshape(B, n, RET_CHUNK, H, dv)
    i = jnp.arange(RET_CHUNK, dtype=F32)
    rel = i[:, None] - i[None, :]
    dec_in = jnp.where(rel[..., None] >= 0, jnp.exp(jnp.maximum(rel, 0.0)[..., None] * log_g), 0.0)
    s = jnp.einsum('bnihd,bnjhd->bnhij', qc, kc) * dec_in.transpose(2, 0, 1)
    inner = jnp.einsum('bnhij,bnjhe->bnihe', s, vc)
    q_dec = jnp.exp((i + 1.0)[:, None] * log_g)
    k_dec = jnp.exp((RET_CHUNK - 1.0 - i)[:, None] * log_g)
    upd = jnp.einsum('bnjhd,bnjhe->nbhde', kc * k_dec[:, :, None], vc)
    g_chunk = jnp.exp(RET_CHUNK * log_g)[None, :, None, None]

    def step(state, u):
        return g_chunk * state + u, state

    s_final, s_prev = lax.scan(step, s0, upd)
    cross = jnp.einsum('bnihd,nbhde->bnihe', qc * q_dec[:, :, None], s_prev)
    return (inner + cross).reshape(B, L, H, dv), s_final


def bidir_retention(qc, kc, vc, qx, kx, vx, log_g):
    B = qc.shape[0]
    z = jnp.zeros((B, RET_HEADS, RET_DK, RET_DV), F32)
    flip = lambda a: a[:, ::-1]
    yc_f, sc_f = retention_scan(qc, kc, vc, log_g[0], z)
    yx_f, _ = retention_scan(qx, kx, vx, log_g[0], sc_f)
    yc_b, sc_b = retention_scan(flip(qc), flip(kc), flip(vc), log_g[1], z)
    yx_b, _ = retention_scan(flip(qx), flip(kx), flip(vx), log_g[1], sc_b)
    return yc_f + flip(yc_b), yx_f + flip(yx_b)


def short_conv(u, w, b):
    up = jnp.pad(u, ((0, 0), (1, 1), (0, 0)))
    return up[:, :-2] * w[0] + up[:, 1:-1] * w[1] + up[:, 2:] * w[2] + b


def hyena_filters(L, w1, b1, f1, w2, b2, f2, w3):
    t = jnp.arange(L, dtype=F32)
    t_norm = t / max(L - 1, 1)
    bands = jnp.linspace(1e-4, HY_BANDS - 1, HY_BANDS, dtype=F32)
    ang = (2.0 * math.pi / L) * t[:, None] * bands[None, :]
    z = jnp.concatenate([t_norm[:, None], jnp.cos(ang), -jnp.sin(ang)], axis=-1)
    h = jnp.sin(f1 * (z @ w1 + b1))
    h = jnp.sin(f2 * (h @ w2 + b2))
    h = (h @ w3).astype(F32)
    deltas = jnp.abs(jnp.linspace(math.log(HY_DECAY_TARGET) / HY_SLOW_DECAY,
                                  math.log(HY_DECAY_TARGET) / HY_FAST_DECAY, HY_WIDTH, dtype=F32))
    window = jnp.exp(-t_norm[:, None] * deltas[None, :])
    return h.reshape(L, HY_ORDER, 2, HY_WIDTH) * window[:, None, None, :]


def bidir_long_conv(u, h_fwd, h_bwd, skip):
    L, C = h_fwd.shape
    hc = jnp.concatenate([h_fwd, jnp.zeros((1, C), F32), h_bwd[1:][::-1]], axis=0)
    uf = u.astype(F32)
    U = jnp.fft.rfft(uf, n=2 * L, axis=1)
    Hf = jnp.fft.rfft(hc, axis=0)
    y = jnp.fft.irfft(U * Hf[None], n=2 * L, axis=1)[:, :L]
    return (y + uf * skip.astype(F32)).astype(u.dtype)


def hyena(u3, conv_w, conv_b, filt, skip):
    u3 = short_conv(u3, conv_w, conv_b)
    v, x1, x2 = jnp.split(u3, 3, axis=-1)
    y = x1 * bidir_long_conv(v, filt[:, 0, 0], filt[:, 0, 1], skip[0])
    y = x2 * bidir_long_conv(y, filt[:, 1, 0], filt[:, 1, 1], skip[1])
    return y


def mixer_ab(hc, hx, w_in, w_out, decay_logit, conv_w, conv_b, w1, b1, f1, w2, b2, f2, w3, skip, rope, with_ctx):
    qc, kc, vc, gc, uc = jnp.split(hc @ w_in, AB_SPLITS, axis=-1)
    qx, kx, vx, gx, ux = jnp.split(hx @ w_in, AB_SPLITS, axis=-1)

    def heads(q, k, v):
        B, L, _ = q.shape
        return (q.reshape(B, L, RET_HEADS, RET_DK).astype(F32),
                k.reshape(B, L, RET_HEADS, RET_DK).astype(F32) * RET_DK ** -0.5,
                v.reshape(B, L, RET_HEADS, RET_DV).astype(F32))

    qc, kc, vc = heads(qc, kc, vc)
    qx, kx, vx = heads(qx, kx, vx)
    cos, sin = rope
    qx, kx = apply_rope(qx, cos, sin), apply_rope(kx, cos, sin)
    log_g = jax.nn.log_sigmoid(decay_logit.astype(F32))
    rc, rx = bidir_retention(qc, kc, vc, qx, kx, vx, log_g)

    def merge(r, g, u):
        B, L = r.shape[:2]
        ret = head_norm(r).reshape(B, L, RET_V).astype(g.dtype) * jax.nn.silu(g)
        hy = hyena(u, conv_w, conv_b, hyena_filters(L, w1, b1, f1, w2, b2, f2, w3), skip)
        return jnp.concatenate([ret, hy], axis=-1) @ w_out

    yx = merge(rx, gx, ux)
    yc = merge(rc, gc, uc) if with_ctx else None
    return yc, yx


def mixer_da(hc, hx, w_in, w_out, lam, subln, lambda_init, rope, with_ctx):
    def heads(p):
        B, L, _ = p.shape
        q, k, v = jnp.split(p, 3, axis=-1)
        return (q.reshape(B, L, DA_HEADS, 2, DA_HEAD_DIM), k.reshape(B, L, DA_HEADS, 2, DA_HEAD_DIM),
                v.reshape(B, L, DA_HEADS, 2 * DA_HEAD_DIM))

    qc, kc, vc = heads(hc @ w_in)
    qx, kx, vx = heads(hx @ w_in)
    cos, sin = rope
    qx, kx = apply_rope(qx, cos, sin), apply_rope(kx, cos, sin)
    lam_f = lam.astype(F32)
    lam_full = jnp.exp(jnp.sum(lam_f[0] * lam_f[1])) - jnp.exp(jnp.sum(lam_f[2] * lam_f[3])) + lambda_init
    k_all = jnp.concatenate([kc, kx], axis=1)
    v_all = jnp.concatenate([vc, vx], axis=1)

    def attend(q, k, v):
        s = jnp.einsum('bqhcd,bkhcd->bhcqk', q, k).astype(F32) * DA_HEAD_DIM ** -0.5
        p = jax.nn.softmax(s, axis=-1)
        a = p[:, :, 0] - lam_full * p[:, :, 1]
        return jnp.einsum('bhqk,bkhe->bqhe', a.astype(v.dtype), v)

    def finish(o):
        B, L = o.shape[:2]
        o = rmsnorm(o, subln, eps=1e-5) * (1.0 - lambda_init)
        return o.reshape(B, L, DA_WIDTH) @ w_out

    B, Lx = qx.shape[:2]
    nb = Lx // Q_BLOCK
    qb = qx.reshape(B, nb, Q_BLOCK, DA_HEADS, 2, DA_HEAD_DIM).transpose(1, 0, 2, 3, 4, 5)
    ox = lax.map(lambda qq: attend(qq, k_all, v_all), qb)
    ox = ox.transpose(1, 0, 2, 3, 4).reshape(B, Lx, DA_HEADS, 2 * DA_HEAD_DIM)
    yx = finish(ox)
    yc = finish(attend(qc, kc, vc)) if with_ctx else None
    return yc, yx


def route(xf, w_r, bias):
    N = xf.shape[0]
    scores = jax.nn.sigmoid((xf @ w_r).astype(F32))
    choice = scores + bias.astype(F32)
    grp = choice.reshape(N, N_GROUPS, N_EXPERTS // N_GROUPS)
    gscore = jnp.sum(lax.top_k(grp, 2)[0], axis=-1)
    _, gidx = lax.top_k(gscore, TOPK_GROUPS)
    gmask = jnp.any(gidx[:, :, None] == jnp.arange(N_GROUPS)[None, None, :], axis=1)
    emask = jnp.repeat(gmask, N_EXPERTS // N_GROUPS, axis=1)
    _, eidx = lax.top_k(jnp.where(emask, choice, -jnp.inf), TOP_K)
    w = jnp.take_along_axis(scores, eidx, axis=-1)
    w = w / (jnp.sum(w, axis=-1, keepdims=True) + 1e-20) * ROUTED_SCALE
    return eidx, w


def routed_experts(xf, eidx, w, wg, wu, wd):
    N, D = xf.shape
    A = N * TOP_K
    e_flat = eidx.reshape(A)
    tok_flat = jnp.repeat(jnp.arange(N, dtype=jnp.int32), TOP_K)
    w_flat = w.reshape(A)
    order = jnp.argsort(e_flat)
    e_sorted = e_flat[order]
    counts = jnp.bincount(e_flat, length=N_EXPERTS)
    padded = (counts + MOE_BLOCK - 1) // MOE_BLOCK * MOE_BLOCK
    pad_end = jnp.cumsum(padded)
    pad_start = pad_end - padded
    start = jnp.cumsum(counts) - counts
    dest = pad_start[e_sorted] + jnp.arange(A, dtype=jnp.int32) - start[e_sorted]
    n_blocks = -(-(A + N_EXPERTS * (MOE_BLOCK - 1)) // MOE_BLOCK)
    P = n_blocks * MOE_BLOCK
    slot_tok = jnp.full((P,), N, jnp.int32).at[dest].set(tok_flat[order])
    slot_w = jnp.zeros((P,), F32).at[dest].set(w_flat[order])
    block_expert = jnp.minimum(jnp.searchsorted(pad_end, jnp.arange(n_blocks, dtype=jnp.int32) * MOE_BLOCK,
                                                side='right'), N_EXPERTS - 1)
    x_pad = jnp.concatenate([xf, jnp.zeros((1, D), xf.dtype)], axis=0)

    def step(acc, blk):
        toks, ws, e = blk
        yb = swiglu(x_pad[toks], wg[e], wu[e], wd[e]) * ws[:, None].astype(xf.dtype)
        return acc.at[toks].add(yb), None

    acc, _ = lax.scan(step, jnp.zeros((N + 1, D), xf.dtype),
                      (slot_tok.reshape(n_blocks, MOE_BLOCK), slot_w.reshape(n_blocks, MOE_BLOCK), block_expert))
    return acc[:N]


def moe(h, w_r, b_r, wg, wu, wd, swg, swu, swd):
    eidx, w = route(h, w_r, b_r)
    return swiglu(h, swg, swu, swd) + routed_experts(h, eidx, w, wg, wu, wd)


def setup_inputs(seed: int = 0) -> dict:
    key = jax.random.key(seed)
    ks = iter(jax.random.split(key, 40))
    nrm = lambda shape, scale: jax.random.normal(next(ks), shape, jnp.float32) * scale
    D = D_MODEL
    ne, no = (DEPTH + 1) // 2, DEPTH // 2
    ret_base = jnp.log(2.0 ** (5.0 + 2.0 * jnp.arange(RET_HEADS, dtype=jnp.float32)) - 1.0)
    return {
        "x": nrm((BATCH, SEQ, D), 1.0),
        "c": nrm((BATCH, D), 1.0),
        "ctx": nrm((BATCH, CTX_LEN, D), 1.0),
        "c_ctx": nrm((D,), 1.0),
        "w_ada": nrm((DEPTH, D, 6 * D), 0.5 * D ** -0.5),
        "b_ada": nrm((DEPTH, 6 * D), 0.02),
        "norm_mix": 1.0 + nrm((DEPTH, D), 0.05),
        "norm_ffn": 1.0 + nrm((DEPTH, D), 0.05),
        "ab_w_in": nrm((ne, D, AB_IN), D ** -0.5),
        "ab_w_out": nrm((ne, AB_CAT, D), AB_CAT ** -0.5),
        "ret_decay_logit": ret_base + nrm((ne, 2, RET_HEADS), 0.1),
        "hy_conv_w": nrm((ne, 3, (HY_ORDER + 1) * HY_WIDTH), 0.5),
        "hy_conv_b": nrm((ne, (HY_ORDER + 1) * HY_WIDTH), 0.02),
        "hy_w1": nrm((ne, HY_EMB, HY_FFN), HY_EMB ** -0.5),
        "hy_b1": nrm((ne, HY_FFN), 0.1),
        "hy_freq1": 1.0 + nrm((ne, HY_FFN), 0.1),
        "hy_w2": nrm((ne, HY_FFN, HY_FFN), HY_FFN ** -0.5),
        "hy_b2": nrm((ne, HY_FFN), 0.1),
        "hy_freq2": 1.0 + nrm((ne, HY_FFN), 0.1),
        "hy_w3": nrm((ne, HY_FFN, HY_ORDER * 2 * HY_WIDTH), 0.005),
        "hy_skip": nrm((ne, HY_ORDER, HY_WIDTH), 0.5),
        "da_w_in": nrm((no, D, 3 * DA_WIDTH), D ** -0.5),
        "da_w_out": nrm((no, DA_WIDTH, D), DA_WIDTH ** -0.5),
        "da_lambda": nrm((no, 4, DA_HEAD_DIM), 0.1),
        "da_subln": 1.0 + nrm((no, 2 * DA_HEAD_DIM), 0.05),
        "router_w": nrm((DEPTH, D, N_EXPERTS), D ** -0.5),
        "router_b": nrm((DEPTH, N_EXPERTS), 0.01),
        "exp_w_gate": nrm((DEPTH, N_EXPERTS, D, EXPERT_DIM), D ** -0.5),
        "exp_w_up": nrm((DEPTH, N_EXPERTS, D, EXPERT_DIM), D ** -0.5),
        "exp_w_down": nrm((DEPTH, N_EXPERTS, EXPERT_DIM, D), EXPERT_DIM ** -0.5),
        "sh_w_gate": nrm((DEPTH, D, SHARED_DIM), D ** -0.5),
        "sh_w_up": nrm((DEPTH, D, SHARED_DIM), D ** -0.5),
        "sh_w_down": nrm((DEPTH, SHARED_DIM, D), SHARED_DIM ** -0.5),
        "norm_final": 1.0 + nrm((D,), 0.05),
    }


def reference(x, c, ctx, c_ctx, w_ada, b_ada, norm_mix, norm_ffn, ab_w_in, ab_w_out, ret_decay_logit,
              hy_conv_w, hy_conv_b, hy_w1, hy_b1, hy_freq1, hy_w2, hy_b2, hy_freq2, hy_w3, hy_skip,
              da_w_in, da_w_out, da_lambda, da_subln, router_w, router_b, exp_w_gate, exp_w_up, exp_w_down,
              sh_w_gate, sh_w_up, sh_w_down, norm_final):
    B, L, D = x.shape
    Lc = ctx.shape[1]
    rows = L // GRID_W
    rope_ret = axial_rope(rows, RET_DK)
    rope_da = axial_rope(rows, DA_HEAD_DIM)
    for i in range(DEPTH):
        with_ctx = i < DEPTH - 1
        j = i // 2
        mod_x = jax.nn.silu(c) @ w_ada[i] + b_ada[i]
        mod_c = jax.nn.silu(c_ctx) @ w_ada[i] + b_ada[i]
        sx = jnp.split(mod_x[:, None, :], 6, axis=-1)
        sc = jnp.split(mod_c, 6, axis=-1)
        hx = rmsnorm(x, norm_mix[i]) * (1.0 + sx[1]) + sx[0]
        hc = rmsnorm(ctx, norm_mix[i]) * (1.0 + sc[1]) + sc[0]
        if i % 2 == 0:
            yc, yx = mixer_ab(hc, hx, ab_w_in[j], ab_w_out[j], ret_decay_logit[j], hy_conv_w[j], hy_conv_b[j],
                              hy_w1[j], hy_b1[j], hy_freq1[j], hy_w2[j], hy_b2[j], hy_freq2[j], hy_w3[j], hy_skip[j],
                              rope_ret, with_ctx)
        else:
            lambda_init = 0.8 - 0.6 * math.exp(-0.3 * i)
            yc, yx = mixer_da(hc, hx, da_w_in[j], da_w_out[j], da_lambda[j], da_subln[j], lambda_init,
                              rope_da, with_ctx)
        x = x + sx[2] * yx
        hx = rmsnorm(x, norm_ffn[i]) * (1.0 + sx[4]) + sx[3]
        moe_w = (router_w[i], router_b[i], exp_w_gate[i], exp_w_up[i], exp_w_down[i],
                 sh_w_gate[i], sh_w_up[i], sh_w_down[i])
        if with_ctx:
            ctx = ctx + sc[2] * yc
            hc = rmsnorm(ctx, norm_ffn[i]) * (1.0 + sc[4]) + sc[3]
            h_all = jnp.concatenate([hc.reshape(B * Lc, D), hx.reshape(B * L, D)], axis=0)
            y_all = moe(h_all, *moe_w)
            ctx = ctx + sc[5] * y_all[:B * Lc].reshape(B, Lc, D)
            x = x + sx[5] * y_all[B * Lc:].reshape(B, L, D)
        else:
            x = x + sx[5] * moe(hx.reshape(B * L, D), *moe_w).reshape(B, L, D)
    return rmsnorm(x, norm_final)
```

```cpp
#include <hip/hip_runtime.h>
#include <cstdio>
#include <cstdint>
#include <cmath>

#define LAS __attribute__((address_space(3)))
typedef unsigned short bf16_t;
typedef short bf16x8 __attribute__((ext_vector_type(8)));
typedef short s16x4 __attribute__((ext_vector_type(4)));
typedef float f32x2 __attribute__((ext_vector_type(2)));
typedef float f32x4 __attribute__((ext_vector_type(4)));
typedef float f32x16 __attribute__((ext_vector_type(16)));
typedef unsigned u32x2 __attribute__((ext_vector_type(2)));
typedef unsigned u32x4 __attribute__((ext_vector_type(4)));
typedef __bf16 bf16x2_t __attribute__((ext_vector_type(2)));

constexpr int D = 1024, NC = 256, NX = 16384, NTOK = NC + NX, DEPTH = 4;
constexpr int AB_IN = 4608, AB_CAT = 1536, DA_IN = 3072, DA_W = 1024;
constexpr int NEXP = 64, TOPK = 8, EDIM = 256;
constexpr int FFT_M = 16384;
constexpr int HSPEC_LD = 16400;
constexpr float EPS = 1e-6f;

__device__ __forceinline__ unsigned cvtpk(float lo, float hi) { f32x2 v = {lo, hi}; bf16x2_t b = __builtin_convertvector(v, bf16x2_t); return __builtin_bit_cast(unsigned, b); }
__device__ __forceinline__ bf16_t f2bf(float x) { return (bf16_t)(cvtpk(x, 0.f) & 0xffffu); }
__device__ __forceinline__ float bf2f(bf16_t b) { return __uint_as_float(((unsigned)b) << 16); }
__device__ __forceinline__ float bflo(unsigned w) { return __uint_as_float(w << 16); }
__device__ __forceinline__ float bfhi(unsigned w) { return __uint_as_float(w & 0xffff0000u); }
__device__ __forceinline__ float siluf(float x) { return x / (1.0f + __expf(-x)); }
__device__ __forceinline__ float sigmoidf_(float x) { return 1.0f / (1.0f + __expf(-x)); }
__device__ __forceinline__ int opaque(int x) { asm volatile("" : "+v"(x)); return x; }
__device__ __forceinline__ float wave_sum(float v) {
#pragma unroll
    for (int o = 32; o >= 1; o >>= 1) v += __shfl_xor(v, o);
    return v;
}

#define XB_TMO      128
#define XB_XCNT(j)  (256  + 64 * (j))
#define XB_XSUB(j)  (1280 + 64 * (j))
#define XB_XGEN(j)  (2304 + 64 * (j))
#define XB_TOP      3328
#define XB_TOPGEN   3392
#define XCD_BAR_WORDS 3456
#define XB_SPIN_CAP (1u << 18)

__device__ __forceinline__ unsigned xb_ld(unsigned* p)              { return __hip_atomic_load(p, __ATOMIC_RELAXED, __HIP_MEMORY_SCOPE_AGENT); }
__device__ __forceinline__ unsigned xb_add(unsigned* p, unsigned v) { return __hip_atomic_fetch_add(p, v, __ATOMIC_RELAXED, __HIP_MEMORY_SCOPE_AGENT); }
__device__ __forceinline__ unsigned xb_xcc_id() { return (unsigned)__builtin_amdgcn_s_getreg((3 << 11) | 20) & 0xFu; }
#define XB_SPIN(cond, bar) do { unsigned _sp = 0; while (cond) { __builtin_amdgcn_s_sleep(1); \
    if ((++_sp & 255u) == 0u) { if (xb_ld(&(bar)[XB_TMO])) break; if (_sp > XB_SPIN_CAP) { atomicAdd(&(bar)[XB_TMO], 1u); break; } } } } while (0)

struct XcdBarrier { unsigned* bar; unsigned x; volatile LAS unsigned* st; };

__device__ __forceinline__ XcdBarrier xcd_barrier_post(unsigned* bar, volatile LAS unsigned* st) {
    XcdBarrier b; b.bar = bar; b.x = xb_xcc_id(); b.st = st;
    if (threadIdx.x == 0) (void)xb_add(&bar[XB_XCNT(b.x)], 1u);
    return b;
}
__device__ __forceinline__ void xcd_barrier_complete(unsigned* bar, unsigned x, unsigned& nloc, unsigned& nx) {
    const unsigned G = gridDim.x * gridDim.y * gridDim.z;
    unsigned sum, cnt, mine, sp = 0u;
    for (;;) {
        sum = 0u; cnt = 0u; mine = 0u;
#pragma unroll
        for (unsigned j = 0; j < 16; ++j) { const unsigned c = xb_ld(&bar[XB_XCNT(j)]); sum += c; cnt += (c > 0u) ? 1u : 0u; mine = (j == x) ? c : mine; }
        if (sum == G) break;
        __builtin_amdgcn_s_sleep(1);
        if ((++sp & 255u) == 0u) { if (xb_ld(&bar[XB_TMO])) break; if (sp > XB_SPIN_CAP) { atomicAdd(&bar[XB_TMO], 1u); break; } }
    }
    nloc = mine > 0u ? mine : 1u; nx = cnt > 0u ? cnt : 1u;
}
__device__ __forceinline__ void xcd_barrier(const XcdBarrier& b) {
    asm volatile("s_waitcnt vmcnt(0)" ::: "memory");
    __syncthreads();
    if (threadIdx.x == 0) {
        unsigned* bar = b.bar;
        __builtin_amdgcn_s_waitcnt(0);
        unsigned nloc = b.st[0], nx = b.st[1];
        if (nloc == 0u) { xcd_barrier_complete(bar, b.x, nloc, nx); b.st[0] = nloc; b.st[1] = nx; }
        const unsigned old = xb_add(&bar[XB_XSUB(b.x)], 1u);
        const unsigned gen = old / nloc;
        if (old + 1u == (gen + 1u) * nloc) {
            __builtin_amdgcn_fence(__ATOMIC_RELEASE, "agent");
            asm volatile("s_waitcnt vmcnt(0)" ::: "memory");
            const unsigned og = xb_add(&bar[XB_TOP], 1u);
            const unsigned tg = og / nx;
            if (og + 1u == (tg + 1u) * nx) xb_add(&bar[XB_TOPGEN], 1u);
            else XB_SPIN(xb_ld(&bar[XB_TOPGEN]) == tg, bar);
            __builtin_amdgcn_fence(__ATOMIC_ACQUIRE, "agent");
            xb_add(&bar[XB_XGEN(b.x)], 1u);
            asm volatile("s_waitcnt vmcnt(0)" ::: "memory");
        } else {
            XB_SPIN(xb_ld(&bar[XB_XGEN(b.x)]) == gen, bar);
            __builtin_amdgcn_fence(__ATOMIC_ACQUIRE, "agent");
            asm volatile("s_waitcnt vmcnt(0)" ::: "memory");
        }
    }
    __syncthreads();
}

namespace pg8 {
constexpr int BM = 256, BK = 64, HALF = 128, HTB = HALF * BK * 2, STAGE_BYTES = 8 * HTB;
__host__ __device__ __forceinline__ int lds_byte(int r, int c) { const int st = (r >> 4) * 2 + (c >> 5), rr = r & 15, cc = c & 31, ob = rr * 64 + cc * 2; return st * 1024 + (ob ^ (((ob >> 9) & 1) << 5)); }
__host__ __device__ __forceinline__ void stage_rc(int b, int& R, int& C) { const int st = b / 1024, sb = b % 1024, swz = sb ^ (((sb >> 9) & 1) << 5); R = (st >> 1) * 16 + swz / 64; C = (st & 1) * 32 + (swz % 64) / 2; }
__host__ __device__ __forceinline__ int perm32(int rho) { const int n = rho >> 4, i = rho & 15; return 8 * (i >> 2) + 4 * n + (i & 3); }

struct Unit { const char* A; const char* B; int pm, pn, e, aux; };

template <class Epi, class Sched, bool GATHER>
__device__ __forceinline__ void gemm_phase(LAS unsigned char* lds, const int K_, const Sched& S, const Epi& E) {
    int K = K_; asm volatile("" : "+s"(K));
    const int tid = opaque((int)threadIdx.x), wid = __builtin_amdgcn_readfirstlane(tid >> 6), lane = tid & 63, wr = wid >> 2, wc = wid & 3, fr = lane & 15, fq = lane >> 4;
    const int nt = K / BK;
    int Rr[2], Cc[2];
    unsigned voffB[2], vAc[2][2], vAn[2][2];
    const size_t kstep = (size_t)(BK * 2);
    const size_t hstep = (size_t)HALF * K * 2;
#pragma unroll
    for (int i = 0; i < 2; ++i) { int R, C; stage_rc(tid * 16 + i * 8192, R, C); Rr[i] = R; Cc[i] = C; const int Rb = Epi::PERM ? ((R & ~31) + perm32(R & 31)) : R;
        voffB[i] = (unsigned)(Rb * K + C) * 2u; vAc[0][i] = (unsigned)(R * K + C) * 2u; vAc[1][i] = vAc[0][i] + (unsigned)hstep; vAn[0][i] = vAc[0][i]; vAn[1][i] = vAc[1][i]; }
    const unsigned ldsw = (unsigned)wid * 1024u;
    const int aoff = lds_byte(wr * 64 + fr, fq * 8), boff = lds_byte(wc * 32 + fr, fq * 8);
#define PG8_SA(b, h) (((b) * 2 + (h)) * HTB)
#define PG8_SB(b, h) ((4 + (b) * 2 + (h)) * HTB)
#define PG8_STAGE(bufoff, gbase, voff) do { _Pragma("unroll") for (int _i = 0; _i < 2; ++_i) \
        __builtin_amdgcn_global_load_lds((const unsigned*)((const char*)(gbase) + (voff)[_i]), (LAS unsigned*)(lds + (bufoff) + ldsw + _i * 8192), 16, 0, 0); } while (0)
#define PG8_LDA(dst, b, h) do { _Pragma("unroll") for (int m = 0; m < 4; ++m) _Pragma("unroll") for (int k = 0; k < 2; ++k) dst[m][k] = *(const LAS bf16x8*)(lds + PG8_SA(b, h) + aoff + m * 2048 + k * 1024); } while (0)
#define PG8_LDB(dst, b, h) do { _Pragma("unroll") for (int n = 0; n < 2; ++n) _Pragma("unroll") for (int k = 0; k < 2; ++k) dst[n][k] = *(const LAS bf16x8*)(lds + PG8_SB(b, h) + boff + n * 2048 + k * 1024); } while (0)
#define PG8_MMA(ai, bj, At, Bt) do { __builtin_amdgcn_s_setprio(1); _Pragma("unroll") for (int m = 0; m < 4; ++m) _Pragma("unroll") for (int n = 0; n < 2; ++n) _Pragma("unroll") for (int k = 0; k < 2; ++k) \
        acc[ai][bj][m][n] = __builtin_amdgcn_mfma_f32_16x16x32_bf16(Bt[n][k], At[m][k], acc[ai][bj][m][n], 0, 0, 0); __builtin_amdgcn_s_setprio(0); } while (0)
#define PG8_WAIT_V(n) asm volatile("s_waitcnt vmcnt(" #n ")" ::: "memory")
#define PG8_WAIT_L(n) asm volatile("s_waitcnt lgkmcnt(" #n ")" ::: "memory")
#define PG8_BAR __builtin_amdgcn_s_barrier()
#define PG8_SCHED __builtin_amdgcn_sched_barrier(0)
    Unit cur, nxt; int ui = 0;
    if (!S.next(0, cur)) return;
    if (GATHER) { S.offsets(cur, Rr, Cc, vAc); }
    f32x4 acc[2][2][4][2];
#pragma unroll
    for (int a = 0; a < 2; ++a)
#pragma unroll
        for (int b = 0; b < 2; ++b)
#pragma unroll
            for (int m = 0; m < 4; ++m)
#pragma unroll
                for (int n = 0; n < 2; ++n) acc[a][b][m][n] = (f32x4){0.f, 0.f, 0.f, 0.f};
    bf16x8 At[4][2], B0[2][2], B1[2][2];
    const char* cA = cur.A; const char* cB = cur.B;
    PG8_STAGE(PG8_SB(0, 0), cB, voffB); PG8_STAGE(PG8_SA(0, 0), cA, vAc[0]); PG8_STAGE(PG8_SB(0, 1), cB + hstep, voffB); PG8_STAGE(PG8_SA(0, 1), cA, vAc[1]);
    if (wr == 1) PG8_BAR;
    PG8_WAIT_V(4); PG8_BAR;
    PG8_STAGE(PG8_SB(1, 0), cB + kstep, voffB); PG8_STAGE(PG8_SA(1, 0), cA + kstep, vAc[0]); PG8_STAGE(PG8_SB(1, 1), cB + hstep + kstep, voffB);
    PG8_WAIT_V(6); PG8_BAR;
    for (;;) {
        const bool has_next = S.next(ui + 1, nxt);
        const char* nA = has_next ? nxt.A : cA; const char* nB = has_next ? nxt.B : cB;
        if (GATHER) { if (has_next) S.offsets(nxt, Rr, Cc, vAn); else { vAn[0][0] = vAc[0][0]; vAn[0][1] = vAc[0][1]; vAn[1][0] = vAc[1][0]; vAn[1][1] = vAc[1][1]; } }
        for (int t = 0; t < nt; t += 2) {
            const bool last = (t == nt - 2);
            const char* a1 = cA + (size_t)(t + 1) * kstep;
            const char* a2 = last ? nA : cA + (size_t)(t + 2) * kstep; const char* b2 = last ? nB : cB + (size_t)(t + 2) * kstep;
            const char* a3 = a2 + kstep; const char* b3 = b2 + kstep;
            unsigned v2[2][2];
            if (GATHER) { v2[0][0] = last ? vAn[0][0] : vAc[0][0]; v2[0][1] = last ? vAn[0][1] : vAc[0][1]; v2[1][0] = last ? vAn[1][0] : vAc[1][0]; v2[1][1] = last ? vAn[1][1] : vAc[1][1]; }
            else { v2[0][0] = vAc[0][0]; v2[0][1] = vAc[0][1]; v2[1][0] = vAc[1][0]; v2[1][1] = vAc[1][1]; }
            PG8_LDB(B0, 0, 0); PG8_SCHED; PG8_LDA(At, 0, 0); PG8_STAGE(PG8_SA(1, 1), a1, vAc[1]);
            PG8_WAIT_L(8); PG8_BAR; PG8_WAIT_L(0); PG8_MMA(0, 0, At, B0); PG8_BAR; PG8_SCHED;
            PG8_LDB(B1, 0, 1); PG8_STAGE(PG8_SB(0, 0), b2, voffB);
            PG8_BAR; PG8_WAIT_L(0); PG8_MMA(0, 1, At, B1); PG8_BAR;
            PG8_LDA(At, 0, 1); PG8_STAGE(PG8_SA(0, 0), a2, v2[0]);
            PG8_BAR; PG8_WAIT_L(0); PG8_MMA(1, 0, At, B0); PG8_BAR; PG8_SCHED;
            PG8_STAGE(PG8_SB(0, 1), b2 + hstep, voffB);
            PG8_WAIT_V(6); PG8_BAR; PG8_MMA(1, 1, At, B1); PG8_BAR;
            PG8_LDB(B0, 1, 0); PG8_SCHED; PG8_LDA(At, 1, 0); PG8_STAGE(PG8_SA(0, 1), a2, v2[1]);
            PG8_WAIT_L(8); PG8_BAR; PG8_WAIT_L(0); PG8_MMA(0, 0, At, B0); PG8_BAR; PG8_SCHED;
            PG8_LDB(B1, 1, 1); PG8_STAGE(PG8_SB(1, 0), b3, voffB);
            PG8_BAR; PG8_WAIT_L(0); PG8_MMA(0, 1, At, B1); PG8_BAR;
            PG8_LDA(At, 1, 1); PG8_STAGE(PG8_SA(1, 0), a3, v2[0]);
            PG8_BAR; PG8_WAIT_L(0); PG8_MMA(1, 0, At, B0); PG8_BAR; PG8_SCHED;
            PG8_STAGE(PG8_SB(1, 1), b3 + hstep, voffB);
            PG8_WAIT_V(6); PG8_BAR; PG8_MMA(1, 1, At, B1); PG8_BAR;
        }
        E(acc, cur, wr, wc, fr, fq);
        if (!has_next) break;
#pragma unroll
        for (int a = 0; a < 2; ++a)
#pragma unroll
            for (int b = 0; b < 2; ++b)
#pragma unroll
                for (int m = 0; m < 4; ++m)
#pragma unroll
                    for (int n = 0; n < 2; ++n) acc[a][b][m][n] = (f32x4){0.f, 0.f, 0.f, 0.f};
        cur = nxt; cA = nA; cB = nB; ++ui;
        if (GATHER) { vAc[0][0] = vAn[0][0]; vAc[0][1] = vAn[0][1]; vAc[1][0] = vAn[1][0]; vAc[1][1] = vAn[1][1]; }
    }
    PG8_WAIT_V(0);
    if (wr == 0) PG8_BAR;
    PG8_BAR;
#undef PG8_SA
#undef PG8_SB
#undef PG8_STAGE
#undef PG8_LDA
#undef PG8_LDB
#undef PG8_MMA
#undef PG8_WAIT_V
#undef PG8_WAIT_L
#undef PG8_BAR
#undef PG8_SCHED
}
}
constexpr size_t MiB = 1u << 20;
constexpr size_t WS_CTL = 0, CTL_ZERO_BYTES = 1 * MiB;
constexpr size_t WS_MOD = 1 * MiB;
constexpr size_t WS_ROPE = WS_MOD + 256 * 1024;
constexpr size_t WS_MISC = WS_ROPE + 256 * 1024;
constexpr size_t WS_WAB_IN = 2 * MiB;
constexpr size_t WS_WAB_OUT = 20 * MiB;
constexpr size_t WS_WDA_IN = 26 * MiB;
constexpr size_t WS_WDA_OUT = 38 * MiB;
constexpr size_t WS_WR = 42 * MiB;
constexpr size_t WS_W3T = 43 * MiB;
constexpr size_t WS_HID2C = WS_W3T + 512 * 1024;
constexpr size_t WS_WGU = 44 * MiB;
constexpr size_t WS_WD = 109 * MiB;
constexpr size_t WS_XRES = 142 * MiB;
constexpr size_t WS_H = 207 * MiB;
constexpr size_t WS_LTOK = 240 * MiB;
constexpr size_t WS_LW = WS_LTOK + 5 * MiB;
constexpr size_t WS_SLOT = WS_LW + 5 * MiB;
constexpr size_t WS_SLOTW = WS_SLOT + 1 * MiB;
constexpr size_t WS_U = 252 * MiB;
constexpr size_t WS_PROJ = WS_U;
constexpr size_t WS_TAPS = WS_U;
constexpr size_t WS_CAT = WS_U + 147 * MiB;
constexpr size_t WS_UPD = WS_U + 196 * MiB;
constexpr size_t WS_SPREV = WS_U + 261 * MiB;
constexpr size_t WS_UT = WS_U + 326 * MiB;
constexpr size_t WS_YT = WS_U + 374 * MiB;
constexpr size_t WS_HSPEC = WS_U + 390 * MiB;
constexpr size_t WS_Y1 = WS_U + 519 * MiB;
constexpr size_t WS_MIX_END = WS_U + 551 * MiB;
constexpr int MAX_TILES = 649;
constexpr size_t WS_ACT = WS_U;
constexpr size_t WS_YSLOT = WS_U + 82 * MiB;
constexpr size_t WS_END = WS_U + 551 * MiB;
static_assert(WS_YSLOT + (size_t)MAX_TILES * 256 * 1024 * 2 <= WS_END, "moe view");
static_assert(WS_HSPEC + (size_t)2 * 512 * HSPEC_LD * 8 <= WS_MIX_END, "mixer view");

constexpr int CW_BAR = 1024;
constexpr int CW_CNT = 8192;
constexpr int CW_ERR = 16;

constexpr int LDS_BIG = 139264;
constexpr int LDS_MISC = LDS_BIG;
constexpr int LDS_BYTES = LDS_BIG + 16384;
constexpr int NTHREADS = 512;

struct Params {
    const float* in[34];
    float* out;
    unsigned char* ws;
    int ph_lo, ph_hi;
};

struct Ctx {
    const Params* p;
    LAS unsigned char* lds;
    int tid, lane, wid, G, bid;
    unsigned char* ws;
};

template <class RowMap>
__device__ __forceinline__ void cvt_tile(const Ctx& c, const float* src, int ldn, int k0, int n0, bf16_t* dst, int ldk, const RowMap& rm) {
    LAS float* t = (LAS float*)c.lds;
    const int tid = c.tid;
    {   const int kr = tid >> 4, nc = (tid & 15) * 4;
#pragma unroll
        for (int h = 0; h < 2; ++h) { const f32x4 v = *(const f32x4*)(src + (size_t)(k0 + kr + 32 * h) * ldn + n0 + nc);
            t[(kr + 32 * h) * 65 + nc + 0] = v[0]; t[(kr + 32 * h) * 65 + nc + 1] = v[1]; t[(kr + 32 * h) * 65 + nc + 2] = v[2]; t[(kr + 32 * h) * 65 + nc + 3] = v[3]; } }
    __syncthreads();
    {   const int n = tid >> 3, k8 = (tid & 7) * 8; float f[8];
#pragma unroll
        for (int j = 0; j < 8; ++j) f[j] = t[(k8 + j) * 65 + n];
        u32x4 w; w.x = cvtpk(f[0], f[1]); w.y = cvtpk(f[2], f[3]); w.z = cvtpk(f[4], f[5]); w.w = cvtpk(f[6], f[7]);
        *(u32x4*)(dst + (size_t)rm(n0 + n) * ldk + k0 + k8) = w; }
    __syncthreads();
}
struct RowId { __device__ __forceinline__ int operator()(int n) const { return n; } };
struct RowAbIn { __device__ __forceinline__ int operator()(int n) const { if (n >= 1024) return n; const int d = n & 127; return (n & ~127) + ((d < 64) ? 2 * d : 2 * (d - 64) + 1); } };
struct RowDaIn { __device__ __forceinline__ int operator()(int n) const { if (n >= 2048) return n; const int d = n & 63; return (n & ~63) + ((d < 32) ? 2 * d : 2 * (d - 32) + 1); } };
struct RowGate { __device__ __forceinline__ int operator()(int n) const { return (n >> 7) * 256 + (n & 127); } };
struct RowUp   { __device__ __forceinline__ int operator()(int n) const { return (n >> 7) * 256 + 128 + (n & 127); } };

__device__ __forceinline__ void cvt_router_tile(const Ctx& c, const float* src, int k0, bf16_t* dhi, bf16_t* dlo) {
    LAS float* t = (LAS float*)c.lds; const int tid = c.tid;
    {   const int kr = tid >> 4, nc = (tid & 15) * 4;
#pragma unroll
        for (int h = 0; h < 2; ++h) { const f32x4 v = *(const f32x4*)(src + (size_t)(k0 + kr + 32 * h) * 64 + nc);
            t[(kr + 32 * h) * 65 + nc + 0] = v[0]; t[(kr + 32 * h) * 65 + nc + 1] = v[1]; t[(kr + 32 * h) * 65 + nc + 2] = v[2]; t[(kr + 32 * h) * 65 + nc + 3] = v[3]; } }
    __syncthreads();
    {   const int n = tid >> 3, k8 = (tid & 7) * 8; float f[8], g[8];
#pragma unroll
        for (int j = 0; j < 8; ++j) { f[j] = t[(k8 + j) * 65 + n]; const float h = bf2f(f2bf(f[j])); g[j] = f[j] - h; f[j] = h; }
        u32x4 w; w.x = cvtpk(f[0], f[1]); w.y = cvtpk(f[2], f[3]); w.z = cvtpk(f[4], f[5]); w.w = cvtpk(f[6], f[7]);
        *(u32x4*)(dhi + (size_t)n * 1024 + k0 + k8) = w;
        w.x = cvtpk(g[0], g[1]); w.y = cvtpk(g[2], g[3]); w.z = cvtpk(g[4], g[5]); w.w = cvtpk(g[6], g[7]);
        *(u32x4*)(dlo + (size_t)n * 1024 + k0 + k8) = w; }
    __syncthreads();
}

__device__ __forceinline__ void phase_pr0(const Ctx& c) {
    const Params& P = *c.p; unsigned char* ws = c.ws;
    const int T_ABIN = 2 * 16 * 72, T_ABOUT = 2 * 24 * 16, T_DAIN = 2 * 16 * 48, T_DAOUT = 2 * 16 * 16, T_R = 4 * 16, T_W3 = 2 * 1 * 32;
    const int T_ALL = T_ABIN + T_ABOUT + T_DAIN + T_DAOUT + T_R + T_W3;
    for (int u = c.bid; u < T_ALL; u += c.G) {
        int v = u;
        if (v < T_ABIN) { const int j = v / (16 * 72), r = v % (16 * 72), kt = r / 72, ntile = r % 72;
            cvt_tile(c, P.in[8] + (size_t)j * 1024 * AB_IN, AB_IN, kt * 64, ntile * 64, (bf16_t*)(ws + WS_WAB_IN) + (size_t)j * AB_IN * 1024, 1024, RowAbIn()); continue; }
        v -= T_ABIN;
        if (v < T_ABOUT) { const int j = v / (24 * 16), r = v % (24 * 16), kt = r / 16, ntile = r % 16;
            cvt_tile(c, P.in[9] + (size_t)j * AB_CAT * 1024, 1024, kt * 64, ntile * 64, (bf16_t*)(ws + WS_WAB_OUT) + (size_t)j * 1024 * AB_CAT, AB_CAT, RowId()); continue; }
        v -= T_ABOUT;
        if (v < T_DAIN) { const int j = v / (16 * 48), r = v % (16 * 48), kt = r / 48, ntile = r % 48;
            cvt_tile(c, P.in[21] + (size_t)j * 1024 * DA_IN, DA_IN, kt * 64, ntile * 64, (bf16_t*)(ws + WS_WDA_IN) + (size_t)j * DA_IN * 1024, 1024, RowDaIn()); continue; }
        v -= T_DAIN;
        if (v < T_DAOUT) { const int j = v / (16 * 16), r = v % (16 * 16), kt = r / 16, ntile = r % 16;
            cvt_tile(c, P.in[22] + (size_t)j * 1024 * 1024, 1024, kt * 64, ntile * 64, (bf16_t*)(ws + WS_WDA_OUT) + (size_t)j * 1024 * 1024, 1024, RowId()); continue; }
        v -= T_DAOUT;
        if (v < T_R) { const int i = v / 16, kt = v % 16;
            cvt_router_tile(c, P.in[25] + (size_t)i * 1024 * 64, kt * 64, (bf16_t*)(ws + WS_WR) + (size_t)(i * 2 + 0) * 64 * 1024, (bf16_t*)(ws + WS_WR) + (size_t)(i * 2 + 1) * 64 * 1024); continue; }
        v -= T_R;
        { const int j = v / 32, ntile = v % 32;
            cvt_tile(c, P.in[19] + (size_t)j * 64 * 2048, 2048, 0, ntile * 64, (bf16_t*)(ws + WS_W3T) + (size_t)j * 2048 * 64, 64, RowId()); }
    }
    {
        LAS float* red = (LAS float*)c.lds;
        for (int u = c.bid; u < 192; u += c.G) {
            const int i = u / 48, j0 = (u % 48) * 128, col = c.tid & 127, kg = c.tid >> 7;
            const float* w = P.in[4] + (size_t)i * 1024 * 6144 + j0 + col;
            float a0 = 0.f, a1 = 0.f;
#pragma unroll 8
            for (int k = kg * 256; k < kg * 256 + 256; ++k) { const float wv = w[(size_t)k * 6144]; a0 += siluf(P.in[1][k]) * wv; a1 += siluf(P.in[3][k]) * wv; }
            red[(kg * 2 + 0) * 128 + col] = a0; red[(kg * 2 + 1) * 128 + col] = a1;
            __syncthreads();
            if (c.tid < 256) { const int s = c.tid >> 7; float v = 0.f;
#pragma unroll
                for (int g = 0; g < 4; ++g) v += red[(g * 2 + s) * 128 + col];
                ((float*)(ws + WS_MOD))[(size_t)(i * 2 + s) * 6144 + j0 + col] = v + P.in[5][(size_t)i * 6144 + j0 + col]; }
            __syncthreads();
        }
    }
    {
        f32x2* rt = (f32x2*)(ws + WS_ROPE);
        const int NRR = 256 * 32, NRC = 64 * 32, NDR = 256 * 16, NDC = 64 * 16;
        for (int idx = c.bid * NTHREADS + c.tid; idx < NRR + NRC + NDR + NDC; idx += c.G * NTHREADS) {
            int v = idx; float pos, inv;
            if (v < NRR) { pos = (float)(v >> 5); inv = powf(10000.f, -(float)(v & 31) / 32.f); }
            else if ((v -= NRR) < NRC) { pos = (float)(v >> 5); inv = powf(10000.f, -(float)(v & 31) / 32.f); }
            else if ((v -= NRC) < NDR) { pos = (float)(v >> 4); inv = powf(10000.f, -(float)(v & 15) / 16.f); }
            else { v -= NDR; pos = (float)(v >> 4); inv = powf(10000.f, -(float)(v & 15) / 16.f); }
            const float ang = pos * inv;
            rt[idx] = (f32x2){cosf(ang), sinf(ang)};
        }
    }
    if (c.bid == 0 && c.wid < 2) {
        const int j = c.wid; const float* lam = P.in[23] + (size_t)j * 4 * 64;
        float a = lam[c.lane] * lam[64 + c.lane], b = lam[128 + c.lane] * lam[192 + c.lane];
        a = wave_sum(a); b = wave_sum(b);
        const float linit = 0.8f - 0.6f * expf(-0.3f * (float)(2 * j + 1));
        if (c.lane == 0) { ((float*)(ws + WS_MISC))[j * 2 + 0] = expf(a) - expf(b) + linit; ((float*)(ws + WS_MISC))[j * 2 + 1] = linit; }
    }
}

__device__ __forceinline__ void norm_rows(const Ctx& c, int layer, int which  , const float* gain, int row_lo, int row_hi, const float* xsrc_lat, const float* xsrc_ctx, bf16_t* dst) {
    const float* mod = (const float*)(c.ws + WS_MOD) + (size_t)layer * 2 * 6144;
    const int sh_off = which ? 3 * 1024 : 0, sc_off = which ? 4 * 1024 : 1024;
    for (int row = row_lo + c.bid * 8 + c.wid; row < row_hi; row += c.G * 8) {
        const float* x = (row < NC) ? (xsrc_ctx + (size_t)row * D) : (xsrc_lat + (size_t)(row - NC) * D);
        const float* m = mod + ((row < NC) ? 6144 : 0);
        f32x4 v[4]; float ss = 0.f;
#pragma unroll
        for (int q = 0; q < 4; ++q) { v[q] = *(const f32x4*)(x + q * 256 + c.lane * 4); ss += v[q][0] * v[q][0] + v[q][1] * v[q][1] + v[q][2] * v[q][2] + v[q][3] * v[q][3]; }
        ss = wave_sum(ss);
        const float rstd = rsqrtf(ss * (1.0f / 1024.f) + EPS);
#pragma unroll
        for (int q = 0; q < 4; ++q) { const int col = q * 256 + c.lane * 4;
            const f32x4 g = *(const f32x4*)(gain + col), sc = *(const f32x4*)(m + sc_off + col), sh = *(const f32x4*)(m + sh_off + col);
            float o[4];
#pragma unroll
            for (int j = 0; j < 4; ++j) o[j] = v[q][j] * rstd * g[j] * (1.0f + sc[j]) + sh[j];
            u32x2 w; w.x = cvtpk(o[0], o[1]); w.y = cvtpk(o[2], o[3]);
            *(u32x2*)(dst + (size_t)row * D + col) = w; }
    }
}

__device__ __forceinline__ void phase_pr1(const Ctx& c) {
    const Params& P = *c.p;
    float* xres = (float*)(c.ws + WS_XRES);
    for (size_t i = (size_t)c.bid * NTHREADS + c.tid; i < (size_t)NTOK * D / 4; i += (size_t)c.G * NTHREADS) {
        const size_t e = i * 4; const f32x4 v = (e < (size_t)NC * D) ? *(const f32x4*)(P.in[2] + e) : *(const f32x4*)(P.in[0] + (e - (size_t)NC * D));
        *(f32x4*)(xres + e) = v; }
    norm_rows(c, 0, 0, P.in[6], 0, NTOK, P.in[0], P.in[2], (bf16_t*)(c.ws + WS_H));
}
__device__ __forceinline__ int xcd_remap(int L, int n) { const int q = n / 8, r = n % 8, x = L % 8, off = L / 8; return (x < r ? x * (q + 1) : r * (q + 1) + (x - r) * q) + off; }

struct DenseSched {
    const char* A; const char* Bt; int K, nM, nN, pm0, G, c, nwg;
    __device__ __forceinline__ void init(const void* A_, const void* Bt_, int K_, int nM_, int nN_, int pm0_, int G_, int c_) { A = (const char*)A_; Bt = (const char*)Bt_; K = K_; nM = nM_ - pm0_; nN = nN_; pm0 = pm0_; G = G_; c = c_; nwg = nM * nN; }
    __device__ __forceinline__ bool next(int i, pg8::Unit& u) const {
        const long L = (long)i * G + c; if (L >= nwg) return false;
        const int wgid = xcd_remap((int)L, nwg);
        const int WGM = 8, nig = WGM * nN, gid = wgid / nig, fm = gid * WGM, gsz = (nM - fm) < WGM ? (nM - fm) : WGM;
        u.pm = pm0 + fm + ((wgid % nig) % gsz); u.pn = (wgid % nig) / gsz; u.e = 0; u.aux = 0;
        u.A = A + (size_t)u.pm * 256 * K * 2; u.B = Bt + (size_t)u.pn * 256 * K * 2; return true;
    }
    __device__ __forceinline__ void offsets(const pg8::Unit&, const int (&)[2], const int (&)[2], unsigned (&)[2][2]) const {}
};

struct MoeTable { const LAS int* tb; const LAS int* cn; };
__device__ __forceinline__ int moe_find(const MoeTable& t, int T) { int e = 0;
#pragma unroll 1
    for (int s = 64; s >= 1; s >>= 1) { if (e + s <= 64 && t.tb[e + s] <= T) e += s; } return e; }

struct MoeUpSched {
    MoeTable t; const char* H; const char* W; const int* ltok; int tok0, G, c, nwg;
    __device__ __forceinline__ bool next(int i, pg8::Unit& u) const {
        const long L = (long)i * G + c; if (L >= nwg) return false;
        const int id = xcd_remap((int)L, nwg); const int T = id >> 1; u.pn = id & 1; u.pm = T; u.e = moe_find(t, T); u.aux = T - t.tb[u.e];
        u.A = H; u.B = W + ((size_t)u.e * 512 + (size_t)u.pn * 256) * 1024 * 2; return true;
    }
    __device__ __forceinline__ void offsets(const pg8::Unit& u, const int (&Rr)[2], const int (&Cc)[2], unsigned (&vo)[2][2]) const {
        const int cnt = t.cn[u.e];
#pragma unroll
        for (int h = 0; h < 2; ++h)
#pragma unroll
            for (int i = 0; i < 2; ++i) { const int pos = u.aux * 256 + h * 128 + Rr[i]; int tok;
                if (u.e == 64) tok = tok0 + (pos < cnt ? pos : 0); else tok = (pos < cnt) ? ltok[(size_t)u.e * NTOK + pos] : tok0;
                vo[h][i] = (unsigned)(tok * 1024 + Cc[i]) * 2u; }
    }
};
struct MoeDownSched {
    MoeTable t; const char* ACT; const char* W; int G, c, nwg;
    __device__ __forceinline__ bool next(int i, pg8::Unit& u) const {
        const long L = (long)i * G + c; if (L >= nwg) return false;
        const int id = xcd_remap((int)L, nwg); const int T = id >> 2; u.pn = id & 3; u.pm = T; u.e = moe_find(t, T); u.aux = T - t.tb[u.e];
        u.A = ACT + (size_t)T * 256 * 256 * 2; u.B = W + ((size_t)u.e * 1024 + (size_t)u.pn * 256) * 256 * 2; return true;
    }
    __device__ __forceinline__ void offsets(const pg8::Unit&, const int (&)[2], const int (&)[2], unsigned (&)[2][2]) const {}
};

__device__ __forceinline__ void rope8(f32x4& v0, f32x4& v1, const f32x2* cs) {
    const f32x4 t0 = *(const f32x4*)(cs), t1 = *(const f32x4*)(cs + 2);
    float a, b;
    a = v0[0]; b = v0[1]; v0[0] = a * t0[0] - b * t0[1]; v0[1] = b * t0[0] + a * t0[1];
    a = v0[2]; b = v0[3]; v0[2] = a * t0[2] - b * t0[3]; v0[3] = b * t0[2] + a * t0[3];
    a = v1[0]; b = v1[1]; v1[0] = a * t1[0] - b * t1[1]; v1[1] = b * t1[0] + a * t1[1];
    a = v1[2]; b = v1[3]; v1[2] = a * t1[2] - b * t1[3]; v1[3] = b * t1[2] + a * t1[3];
}
struct EpiAbIn {
    static constexpr bool PERM = true;
    bf16_t* O; const f32x2* rope;
    __device__ __forceinline__ void operator()(const f32x4 (&acc)[2][2][4][2], const pg8::Unit& u, int wr, int wc, int fr, int fq) const {
        const int row0 = u.pm * 256 + wr * 64 + fr, colt = u.pn * 256 + wc * 32 + 8 * fq;
        const bool qk = u.pn < 4, lat = u.pm >= 1; const float ksc = (u.pn >= 2 && u.pn < 4) ? 0.08838834764831845f : 1.0f;
#pragma unroll
        for (int ai = 0; ai < 2; ++ai)
#pragma unroll
            for (int m = 0; m < 4; ++m) { const int row = row0 + ai * 128 + m * 16; bf16_t* rowp = O + (size_t)row * AB_IN + colt; const int t = row - NC;
#pragma unroll
                for (int bj = 0; bj < 2; ++bj) { f32x4 v0 = acc[ai][bj][m][0], v1 = acc[ai][bj][m][1];
                    if (qk) { if (lat) { const int p0 = ((colt + bj * 128) & 127) >> 1;
                            const f32x2* cs = (p0 < 32) ? rope + (size_t)(t >> 6) * 32 + p0 : rope + 256 * 32 + (size_t)(t & 63) * 32 + (p0 - 32);
                            rope8(v0, v1, cs); }
                        v0 *= ksc; v1 *= ksc; }
                    u32x4 w; w.x = cvtpk(v0[0], v0[1]); w.y = cvtpk(v0[2], v0[3]); w.z = cvtpk(v1[0], v1[1]); w.w = cvtpk(v1[2], v1[3]);
                    *(u32x4*)(rowp + bj * 128) = w; } }
    }
};
struct EpiDaIn {
    static constexpr bool PERM = true;
    bf16_t* O; const f32x2* rope;
    __device__ __forceinline__ void operator()(const f32x4 (&acc)[2][2][4][2], const pg8::Unit& u, int wr, int wc, int fr, int fq) const {
        const int row0 = u.pm * 256 + wr * 64 + fr, colt = u.pn * 256 + wc * 32 + 8 * fq;
        const bool qk = u.pn < 8, lat = u.pm >= 1; const float qsc = (u.pn < 4) ? 0.125f * 1.4426950408889634f : 1.0f;
#pragma unroll
        for (int ai = 0; ai < 2; ++ai)
#pragma unroll
            for (int m = 0; m < 4; ++m) { const int row = row0 + ai * 128 + m * 16; bf16_t* rowp = O + (size_t)row * DA_IN + colt; const int t = row - NC;
#pragma unroll
                for (int bj = 0; bj < 2; ++bj) { f32x4 v0 = acc[ai][bj][m][0], v1 = acc[ai][bj][m][1];
                    if (qk) { if (lat) { const int p0 = ((colt + bj * 128) & 63) >> 1;
                            const f32x2* cs = (p0 < 16) ? rope + (size_t)(t >> 6) * 16 + p0 : rope + 256 * 16 + (size_t)(t & 63) * 16 + (p0 - 16);
                            rope8(v0, v1, cs); }
                        v0 *= qsc; v1 *= qsc; }
                    u32x4 w; w.x = cvtpk(v0[0], v0[1]); w.y = cvtpk(v0[2], v0[3]); w.z = cvtpk(v1[0], v1[1]); w.w = cvtpk(v1[2], v1[3]);
                    *(u32x4*)(rowp + bj * 128) = w; } }
    }
};
struct EpiResid {
    static constexpr bool PERM = false;
    float* X; const float* mod;
    __device__ __forceinline__ void operator()(const f32x4 (&acc)[2][2][4][2], const pg8::Unit& u, int wr, int wc, int fr, int fq) const {
        const int row0 = u.pm * 256 + wr * 64 + fr, col0 = u.pn * 256 + wc * 32 + 4 * fq;
        const float* g = mod + ((u.pm == 0) ? 6144 : 0) + 2 * 1024;
        f32x4 gv[2][2];
#pragma unroll
        for (int bj = 0; bj < 2; ++bj)
#pragma unroll
            for (int n = 0; n < 2; ++n) gv[bj][n] = *(const f32x4*)(g + col0 + bj * 128 + n * 16);
#pragma unroll
        for (int ai = 0; ai < 2; ++ai)
#pragma unroll
            for (int m = 0; m < 4; ++m) { float* rowp = X + (size_t)(row0 + ai * 128 + m * 16) * D + col0;
#pragma unroll
                for (int bj = 0; bj < 2; ++bj)
#pragma unroll
                    for (int n = 0; n < 2; ++n) { f32x4* p = (f32x4*)(rowp + bj * 128 + n * 16); *p = *p + gv[bj][n] * acc[ai][bj][m][n]; } }
    }
};
struct EpiSwiglu {
    static constexpr bool PERM = true;
    bf16_t* ACT;
    __device__ __forceinline__ void operator()(const f32x4 (&acc)[2][2][4][2], const pg8::Unit& u, int wr, int wc, int fr, int fq) const {
        const int row0 = u.pm * 256 + wr * 64 + fr, col0 = u.pn * 128 + wc * 32 + 8 * fq;
#pragma unroll
        for (int ai = 0; ai < 2; ++ai)
#pragma unroll
            for (int m = 0; m < 4; ++m) { bf16_t* rowp = ACT + (size_t)(row0 + ai * 128 + m * 16) * 256 + col0; float o[8];
#pragma unroll
                for (int n = 0; n < 2; ++n)
#pragma unroll
                    for (int j = 0; j < 4; ++j) { const float g = acc[ai][0][m][n][j], up = acc[ai][1][m][n][j]; o[n * 4 + j] = siluf(g) * up; }
                u32x4 w; w.x = cvtpk(o[0], o[1]); w.y = cvtpk(o[2], o[3]); w.z = cvtpk(o[4], o[5]); w.w = cvtpk(o[6], o[7]);
                *(u32x4*)rowp = w; }
    }
};
struct EpiDown {
    static constexpr bool PERM = true;
    bf16_t* Y; const float* lw; MoeTable t;
    __device__ __forceinline__ void operator()(const f32x4 (&acc)[2][2][4][2], const pg8::Unit& u, int wr, int wc, int fr, int fq) const {
        const int r0 = wr * 64 + fr, col0 = u.pn * 256 + wc * 32 + 8 * fq; const int cnt = t.cn[u.e];
#pragma unroll
        for (int ai = 0; ai < 2; ++ai)
#pragma unroll
            for (int m = 0; m < 4; ++m) { const int r = r0 + ai * 128 + m * 16, pos = u.aux * 256 + r;
                const float wv = (u.e == 64) ? 1.0f : ((pos < cnt) ? lw[(size_t)u.e * NTOK + pos] : 0.0f);
                bf16_t* rowp = Y + (size_t)(u.pm * 256 + r) * 1024 + col0;
#pragma unroll
                for (int bj = 0; bj < 2; ++bj) { const f32x4 v0 = acc[ai][bj][m][0] * wv, v1 = acc[ai][bj][m][1] * wv;
                    u32x4 w; w.x = cvtpk(v0[0], v0[1]); w.y = cvtpk(v0[2], v0[3]); w.z = cvtpk(v1[0], v1[1]); w.w = cvtpk(v1[2], v1[3]);
                    *(u32x4*)(rowp + bj * 128) = w; }
                asm volatile("" ::: "memory"); }
    }
};
__device__ __forceinline__ int fphys(int i) { return i + ((i >> 6) << 2); }
__device__ __forceinline__ int brev14(int x) { return (int)(__brev((unsigned)x) >> 18); }
__device__ __forceinline__ int brevK(int s, int K) { return (int)(__brev((unsigned)s) >> (32 - K)); }
__device__ __forceinline__ void cmul(float& ar, float& ai, float br, float bi) { const float r = ar * br - ai * bi, i = ar * bi + ai * br; ar = r; ai = i; }
__device__ __forceinline__ constexpr float tw16c(int k) { return (k & 15) == 0 ? 1.f : (k & 15) == 1 ? 0.9238795325112867f : (k & 15) == 2 ? 0.7071067811865476f : (k & 15) == 3 ? 0.3826834323650898f : (k & 15) == 4 ? 0.f :
    (k & 15) == 5 ? -0.3826834323650898f : (k & 15) == 6 ? -0.7071067811865476f : (k & 15) == 7 ? -0.9238795325112867f : (k & 15) == 8 ? -1.f : (k & 15) == 9 ? -0.9238795325112867f : (k & 15) == 10 ? -0.7071067811865476f :
    (k & 15) == 11 ? -0.3826834323650898f : (k & 15) == 12 ? 0.f : (k & 15) == 13 ? 0.3826834323650898f : (k & 15) == 14 ? 0.7071067811865476f : 0.9238795325112867f; }
__device__ __forceinline__ constexpr float tw16s(int k) { return tw16c(k + 12); }

template <int LOGN, int K, bool INV>
__device__ __forceinline__ void fft_pass(LAS f32x2* z, int tid) {
    constexpr int R = 1 << K, LOGST = LOGN - K, ST = 1 << LOGST;
#pragma unroll 1
    for (int g = tid; g < FFT_M / R; g += NTHREADS) {
        const int b = g >> LOGST, j = g & (ST - 1), base = (b << LOGN) + j;
        float xr[R], xi[R];
#pragma unroll
        for (int q = 0; q < R; ++q) { const f32x2 v = z[fphys(base + (q << LOGST))]; xr[q] = v[0]; xi[q] = v[1]; }
        float wr_[R], wi_[R];
        if (LOGST > 0) {
            const float fr = (float)j * (1.0f / (float)(1 << LOGN));
            wr_[0] = 1.f; wi_[0] = 0.f;
#pragma unroll
            for (int bit = 1; bit < R; bit <<= 1) { const float a = fr * (float)bit; wr_[bit] = __builtin_amdgcn_cosf(a); wi_[bit] = INV ? __builtin_amdgcn_sinf(a) : -__builtin_amdgcn_sinf(a); }
#pragma unroll
            for (int r = 3; r < R; ++r) { if ((r & (r - 1)) != 0) { const int hb = 1 << (31 - __builtin_clz(r)); wr_[r] = wr_[hb]; wi_[r] = wi_[hb]; cmul(wr_[r], wi_[r], wr_[r - hb], wi_[r - hb]); } }
        }
        if (!INV) {
#pragma unroll
            for (int s = 0; s < K; ++s) { const int half = R >> (s + 1);
#pragma unroll
                for (int a = 0; a < R; ++a) if ((a & half) == 0) {
                    const int o = a & (half - 1); const int ti = o * (8 / half);
                    const float ur = xr[a], ui = xi[a], vr = xr[a + half], vi = xi[a + half];
                    xr[a] = ur + vr; xi[a] = ui + vi;
                    float dr = ur - vr, di = ui - vi;
                    if (half >= 1 && o != 0) cmul(dr, di, tw16c(ti), -tw16s(ti));
                    xr[a + half] = dr; xi[a + half] = di; } }
            if (LOGST > 0) {
#pragma unroll
                for (int s = 1; s < R; ++s) { const int r = brevK(s, K); cmul(xr[s], xi[s], wr_[r], wi_[r]); } }
        } else {
            if (LOGST > 0) {
#pragma unroll
                for (int s = 1; s < R; ++s) { const int r = brevK(s, K); cmul(xr[s], xi[s], wr_[r], wi_[r]); } }
#pragma unroll
            for (int s = K - 1; s >= 0; --s) { const int half = R >> (s + 1);
#pragma unroll
                for (int a = 0; a < R; ++a) if ((a & half) == 0) {
                    const int o = a & (half - 1); const int ti = o * (8 / half);
                    const float ur = xr[a], ui = xi[a]; float vr = xr[a + half], vi = xi[a + half];
                    if (o != 0) cmul(vr, vi, tw16c(ti), tw16s(ti));
                    xr[a] = ur + vr; xi[a] = ui + vi; xr[a + half] = ur - vr; xi[a + half] = ui - vi; } }
        }
#pragma unroll
        for (int q = 0; q < R; ++q) z[fphys(base + (q << LOGST))] = (f32x2){xr[q], xi[q]};
    }
}
__device__ __forceinline__ void fft_fwd(LAS f32x2* z, int tid) {
    fft_pass<14, 4, false>(z, tid); __syncthreads();
    fft_pass<10, 4, false>(z, tid); __syncthreads();
    fft_pass<6, 4, false>(z, tid);  __syncthreads();
    fft_pass<2, 2, false>(z, tid);  __syncthreads();
}
__device__ __forceinline__ void fft_inv(LAS f32x2* z, int tid) {
    fft_pass<2, 2, true>(z, tid);  __syncthreads();
    fft_pass<6, 4, true>(z, tid);  __syncthreads();
    fft_pass<10, 4, true>(z, tid); __syncthreads();
    fft_pass<14, 4, true>(z, tid); __syncthreads();
}
__device__ __forceinline__ void fft_pair_mul(LAS f32x2* z, const f32x2* Hs, int tid) {
    constexpr int M = FFT_M;
#pragma unroll 1
    for (int k = tid; k <= M / 2; k += NTHREADS) {
        if (k == 0) {
            const f32x2 z0 = z[0]; const float X0 = z0[0] + z0[1], XM = z0[0] - z0[1];
            const float Y0 = X0 * Hs[0][0], YM = XM * Hs[M][0];
            z[0] = (f32x2){0.5f * (Y0 + YM), 0.5f * (Y0 - YM)};
        } else {
            const int p1 = fphys(brev14(k)), p2 = fphys(brev14(M - k));
            const f32x2 zk = z[p1], zm = z[p2]; const f32x2 hk = Hs[k], hm = Hs[M - k];
            const float Er = 0.5f * (zk[0] + zm[0]), Ei = 0.5f * (zk[1] - zm[1]);
            const float Dr = 0.5f * (zk[0] - zm[0]), Di = 0.5f * (zk[1] + zm[1]);
            const float Or = Di, Oi = -Dr;
            const float a = (float)k * (1.0f / (float)(2 * M));
            const float wr = __builtin_amdgcn_cosf(a), wi = -__builtin_amdgcn_sinf(a);
            const float wOr = wr * Or - wi * Oi, wOi = wr * Oi + wi * Or;
            const float Xkr = Er + wOr, Xki = Ei + wOi;
            const float Xmr = Er - wOr, Xmi = -(Ei - wOi);
            const float Ykr = Xkr * hk[0] - Xki * hk[1], Yki = Xkr * hk[1] + Xki * hk[0];
            const float Ymr = Xmr * hm[0] - Xmi * hm[1], Ymi = Xmr * hm[1] + Xmi * hm[0];
            const float Yer = 0.5f * (Ykr + Ymr), Yei = 0.5f * (Yki - Ymi);
            const float Fr = 0.5f * (Ykr - Ymr), Fi = 0.5f * (Yki + Ymi);
            const float Yor = Fr * wr + Fi * wi, Yoi = Fi * wr - Fr * wi;
            z[p1] = (f32x2){Yer - Yoi, Yei + Yor};
            if (p2 != p1) z[p2] = (f32x2){Yer + Yoi, -Yei + Yor};
        }
    }
}
__device__ __forceinline__ void fft_unpack_store(const LAS f32x2* z, f32x2* Hs, float sc, int tid) {
    constexpr int M = FFT_M;
#pragma unroll 1
    for (int k = tid; k <= M / 2; k += NTHREADS) {
        if (k == 0) { const f32x2 z0 = z[0]; Hs[0] = (f32x2){(z0[0] + z0[1]) * sc, 0.f}; Hs[M] = (f32x2){(z0[0] - z0[1]) * sc, 0.f}; }
        else {
            const f32x2 zk = z[fphys(brev14(k))], zm = z[fphys(brev14(M - k))];
            const float Er = 0.5f * (zk[0] + zm[0]), Ei = 0.5f * (zk[1] - zm[1]);
            const float Dr = 0.5f * (zk[0] - zm[0]), Di = 0.5f * (zk[1] + zm[1]);
            const float Or = Di, Oi = -Dr;
            const float a = (float)k * (1.0f / (float)(2 * M));
            const float wr = __builtin_amdgcn_cosf(a), wi = -__builtin_amdgcn_sinf(a);
            const float wOr = wr * Or - wi * Oi, wOi = wr * Oi + wi * Or;
            Hs[k] = (f32x2){(Er + wOr) * sc, (Ei + wOi) * sc};
            if (k != M - k) Hs[M - k] = (f32x2){(Er - wOr) * sc, -(Ei - wOi) * sc};
        }
    }
}
__device__ __forceinline__ int crow(int r, int hi) { return (r & 3) + 8 * (r >> 2) + 4 * hi; }
__device__ __forceinline__ bf16x8 ldfrag(const LAS unsigned char* base, int pitch, int row, int kbyte) { return *(const LAS bf16x8*)(base + row * pitch + kbyte); }
constexpr int P136 = 272;

__device__ __forceinline__ float ret_log2g(const float* decay_logit, int dir, int h) { const float x = decay_logit[dir * 4 + h]; return -log1pf(expf(-x)) * 1.4426950408889634f; }

__device__ __forceinline__ void phase_f1(const Ctx& c, int j) {
    const Params& P = *c.p;
    const float* w1 = P.in[13] + (size_t)j * 33 * 64; const float* b1 = P.in[14] + j * 64; const float* f1 = P.in[15] + j * 64;
    const float* w2 = P.in[16] + (size_t)j * 64 * 64; const float* b2 = P.in[17] + j * 64; const float* f2 = P.in[18] + j * 64;
    const bf16_t* w3t = (const bf16_t*)(c.ws + WS_W3T) + (size_t)j * 2048 * 64;
    float* taps = (float*)(c.ws + WS_TAPS); float* hid2c = (float*)(c.ws + WS_HID2C);
    LAS float* zs = (LAS float*)c.lds;
    LAS float* h1s = (LAS float*)(c.lds + 18432);
    LAS float* w1s = (LAS float*)(c.lds + 51712);
    LAS float* w2s = (LAS float*)(c.lds + 60160);
    LAS unsigned char* hb = c.lds + 76544;
    LAS unsigned char* as = c.lds + 94976;
    for (int u = c.bid; u < 130; u += c.G) {
        const int tid = opaque(c.tid);
        const bool isctx = u >= 128; const int L = isctx ? 256 : 16384; const int t0 = isctx ? (u - 128) * 128 : u * 128;
        for (int i = tid; i < 33 * 64; i += NTHREADS) w1s[i] = w1[i];
        for (int i = tid; i < 64 * 64; i += NTHREADS) w2s[i] = w2[i];
        {
            const int tl = tid >> 2, part = tid & 3; const float t = (float)(t0 + tl);
            if (part == 0) zs[tl * 36 + 0] = t / (float)(L - 1);
#pragma unroll
            for (int q = 0; q < 4; ++q) { const int b = part * 4 + q; const float band = 1e-4f + (float)b * ((15.0f - 1e-4f) / 15.0f);
                const float ang = (6.283185307179586f / (float)L) * t * band;
                zs[tl * 36 + 1 + b] = __cosf(ang); zs[tl * 36 + 17 + b] = -__sinf(ang); }
        }
        __syncthreads();
        {   const int tl = tid >> 2, og = (tid & 3) * 16; float a[16];
#pragma unroll
            for (int o = 0; o < 16; ++o) a[o] = b1[og + o];
#pragma unroll 1
            for (int f = 0; f < 33; ++f) { const float zv = zs[tl * 36 + f];
#pragma unroll
                for (int o = 0; o < 16; ++o) a[o] += zv * w1s[f * 64 + og + o]; }
#pragma unroll
            for (int o = 0; o < 16; ++o) h1s[tl * 65 + og + o] = __sinf(f1[og + o] * a[o]);
        }
        __syncthreads();
        {   const int tl = tid >> 2, og = (tid & 3) * 16; float a[16];
#pragma unroll
            for (int o = 0; o < 16; ++o) a[o] = b2[og + o];
#pragma unroll 1
            for (int k = 0; k < 64; ++k) { const float hv = h1s[tl * 65 + k];
#pragma unroll
                for (int o = 0; o < 16; ++o) a[o] += hv * w2s[k * 64 + og + o]; }
#pragma unroll
            for (int o = 0; o < 16; ++o) a[o] = __sinf(f2[og + o] * a[o]);
            if (isctx) {
#pragma unroll
                for (int o = 0; o < 16; ++o) hid2c[(size_t)(t0 + tl) * 64 + og + o] = a[o];
            } else {
#pragma unroll
                for (int o = 0; o < 16; o += 2) *(LAS unsigned*)(hb + tl * 144 + (og + o) * 2) = cvtpk(a[o], a[o + 1]);
            }
        }
        __syncthreads();
        if (!isctx) {
            const int lane = tid & 63, r32 = lane & 31, hi = lane >> 5, w = __builtin_amdgcn_readfirstlane(tid >> 6);
#pragma unroll 1
            for (int cc = 0; cc < 8; ++cc) {
                {   const int row = tid >> 1, hf = tid & 1; const u32x4* src = (const u32x4*)(w3t + (size_t)(cc * 256 + row) * 64 + hf * 32);
#pragma unroll
                    for (int q = 0; q < 4; ++q) *(LAS u32x4*)(as + row * 144 + hf * 64 + q * 16) = src[q]; }
                __syncthreads();
                f32x16 acc[4];
#pragma unroll
                for (int ni = 0; ni < 4; ++ni) acc[ni] = (f32x16){};
#pragma unroll
                for (int ks = 0; ks < 4; ++ks) { const bf16x8 a = ldfrag(as, 144, 32 * w + r32, ks * 32 + hi * 16);
#pragma unroll
                    for (int ni = 0; ni < 4; ++ni) { const bf16x8 b = ldfrag(hb, 144, 32 * ni + r32, ks * 32 + hi * 16); acc[ni] = __builtin_amdgcn_mfma_f32_32x32x16_bf16(a, b, acc[ni], 0, 0, 0); } }
#pragma unroll
                for (int ni = 0; ni < 4; ++ni) { const int t = t0 + 32 * ni + r32; const float tn = (float)t * (1.0f / 16383.0f);
#pragma unroll
                    for (int r = 0; r < 16; ++r) { const int fc = cc * 256 + 32 * w + crow(r, hi); const int ch = fc & 511;
                        const float delta = 3.0701134573253945f + (15.350567286626972f - 3.0701134573253945f) * ((float)ch * (1.0f / 511.0f));
                        taps[(size_t)fc * 16384 + t] = acc[ni][r] * __expf(-tn * delta); } }
                __syncthreads();
            }
        }
        __syncthreads();
    }
}

__device__ __forceinline__ void phase_f2(const Ctx& c) {
    const float* taps = (const float*)(c.ws + WS_TAPS); f32x2* hs = (f32x2*)(c.ws + WS_HSPEC);
    LAS f32x2* z = (LAS f32x2*)c.lds;
    for (int u = c.bid; u < 1024; u += c.G) {
        const int tid = opaque(c.tid);
        const int o = u >> 9, ch = u & 511;
        const float* hf = taps + (size_t)(o * 1024 + ch) * 16384; const float* hbk = taps + (size_t)(o * 1024 + 512 + ch) * 16384;
#pragma unroll 4
        for (int i = 0; i < 32; ++i) { const int m = tid + i * NTHREADS; f32x2 v;
            if (m < 8192) v = *(const f32x2*)(hf + 2 * m);
            else if (m == 8192) v = (f32x2){0.f, hbk[16383]};
            else { const int s = 32768 - 2 * m; v = (f32x2){hbk[s], hbk[s - 1]}; }
            z[fphys(m)] = v; }
        __syncthreads();
        fft_fwd(z, tid);
        fft_unpack_store(z, hs + (size_t)u * HSPEC_LD, 1.0f / (float)FFT_M, tid);
        __syncthreads();
    }
}

__device__ __forceinline__ void stage_T(const int tid, LAS unsigned char* dstT, const bf16_t* src, int ld, int ncols, const float* rowscale  ) {
    const int j = tid >> 2;
    for (int c8 = (tid & 3) * 8; c8 < ncols; c8 += 32) {
        const u32x4 v = *(const u32x4*)(src + (size_t)j * ld + c8); const unsigned w[4] = {v.x, v.y, v.z, v.w};
#pragma unroll
        for (int q = 0; q < 4; ++q) { *(LAS bf16_t*)(dstT + (c8 + 2 * q) * P136 + j * 2) = (bf16_t)(w[q] & 0xffffu); *(LAS bf16_t*)(dstT + (c8 + 2 * q + 1) * P136 + j * 2) = (bf16_t)(w[q] >> 16); }
    }
}
__device__ __forceinline__ void phase_r1(const Ctx& c, int j) {
    const Params& P = *c.p; const bf16_t* proj = (const bf16_t*)(c.ws + WS_PROJ); bf16_t* upd = (bf16_t*)(c.ws + WS_UPD);
    LAS unsigned char* VT = c.lds; LAS unsigned char* KF = c.lds + 69632; LAS unsigned char* KB = c.lds + 104448;
    for (int u = c.bid; u < 130 * 4; u += c.G) {
        const int tid = opaque(c.tid), lane = tid & 63, r32 = lane & 31, hi = lane >> 5, w = __builtin_amdgcn_readfirstlane(tid >> 6);
        const int m = u >> 2, h = u & 3; const size_t row0 = (size_t)m * 128;
        const float lgf = ret_log2g(P.in[10] + j * 8, 0, h), lgb = ret_log2g(P.in[10] + j * 8, 1, h);
        stage_T(tid, VT, proj + row0 * AB_IN + 1024 + h * 256, AB_IN, 256, nullptr);
        {   const int jj = tid >> 2; const float sf = exp2f((float)(127 - jj) * lgf), sb = exp2f((float)jj * lgb);
            for (int c8 = (tid & 3) * 8; c8 < 128; c8 += 32) {
                const u32x4 v = *(const u32x4*)(proj + (row0 + jj) * AB_IN + 512 + h * 128 + c8); const unsigned wv[4] = {v.x, v.y, v.z, v.w};
#pragma unroll
                for (int q = 0; q < 4; ++q) { const float lo = bflo(wv[q]), hi_ = bfhi(wv[q]);
                    *(LAS bf16_t*)(KF + (c8 + 2 * q) * P136 + jj * 2) = f2bf(lo * sf); *(LAS bf16_t*)(KF + (c8 + 2 * q + 1) * P136 + jj * 2) = f2bf(hi_ * sf);
                    *(LAS bf16_t*)(KB + (c8 + 2 * q) * P136 + jj * 2) = f2bf(lo * sb); *(LAS bf16_t*)(KB + (c8 + 2 * q + 1) * P136 + jj * 2) = f2bf(hi_ * sb); } } }
        __syncthreads();
#pragma unroll 1
        for (int dir = 0; dir < 2; ++dir) {
            const LAS unsigned char* KX = dir ? KB : KF;
            f32x16 af[4];
#pragma unroll
            for (int n = 0; n < 4; ++n) af[n] = (f32x16){};
#pragma unroll
            for (int ks = 0; ks < 8; ++ks) { const bf16x8 a = ldfrag(VT, P136, 32 * w + r32, ks * 32 + hi * 16);
#pragma unroll
                for (int n = 0; n < 4; ++n) { const bf16x8 bf_ = ldfrag(KX, P136, 32 * n + r32, ks * 32 + hi * 16); af[n] = __builtin_amdgcn_mfma_f32_32x32x16_bf16(a, bf_, af[n], 0, 0, 0); } }
            bf16_t* of = upd + ((size_t)(m * 4 + h) * 2 + dir) * 32768;
#pragma unroll
            for (int n = 0; n < 4; ++n)
#pragma unroll
                for (int r = 0; r < 16; ++r) { const int e = 32 * w + crow(r, hi), d = 32 * n + r32; of[e * 128 + d] = f2bf(af[n][r]); }
        }
        __syncthreads();
    }
}

__device__ __forceinline__ void phase_hyprep(const Ctx& c, int j) {
    const Params& P = *c.p; const bf16_t* proj = (const bf16_t*)(c.ws + WS_PROJ); bf16_t* uT = (bf16_t*)(c.ws + WS_UT);
    const float* cw = P.in[11] + (size_t)j * 3 * 1536; const float* cb = P.in[12] + (size_t)j * 1536;
    LAS float* t = (LAS float*)c.lds;
    const int tid = c.tid;
    for (int u = c.bid; u < 256 * 24; u += c.G) {
        const int tt = u / 24, ct = u % 24, t0 = tt * 64, ch0 = ct * 64;
        for (int idx = tid; idx < 66 * 8; idx += NTHREADS) { const int r = idx >> 3, c8 = (idx & 7) * 8; const int tg = t0 - 1 + r;
            u32x4 v = (u32x4){0u, 0u, 0u, 0u};
            if (tg >= 0 && tg < NX) v = *(const u32x4*)(proj + (size_t)(NC + tg) * AB_IN + 3072 + ch0 + c8);
            const unsigned wv[4] = {v.x, v.y, v.z, v.w};
#pragma unroll
            for (int q = 0; q < 4; ++q) { t[r * 65 + c8 + 2 * q] = bflo(wv[q]); t[r * 65 + c8 + 2 * q + 1] = bfhi(wv[q]); } }
        __syncthreads();
        {   const int ch = tid >> 3, t8 = (tid & 7) * 8; const int chg = ch0 + ch;
            const float w0 = cw[chg], w1 = cw[1536 + chg], w2 = cw[3072 + chg], bb = cb[chg]; float o[8];
#pragma unroll
            for (int q = 0; q < 8; ++q) o[q] = t[(t8 + q) * 65 + ch] * w0 + t[(t8 + q + 1) * 65 + ch] * w1 + t[(t8 + q + 2) * 65 + ch] * w2 + bb;
            u32x4 wv; wv.x = cvtpk(o[0], o[1]); wv.y = cvtpk(o[2], o[3]); wv.z = cvtpk(o[4], o[5]); wv.w = cvtpk(o[6], o[7]);
            *(u32x4*)(uT + (size_t)chg * NX + t0 + t8) = wv; }
        __syncthreads();
    }
}

__device__ __forceinline__ void phase_scan(const Ctx& c, int j) {
    const Params& P = *c.p; const unsigned* upd = (const unsigned*)(c.ws + WS_UPD); unsigned* sp = (unsigned*)(c.ws + WS_SPREV);
    for (int idx = c.bid * NTHREADS + c.tid; idx < 4 * 2 * 16384; idx += c.G * NTHREADS) {
        const int h = idx >> 15, dir = (idx >> 14) & 1, pr = idx & 16383;
        const float g = exp2f(128.0f * ret_log2g(P.in[10] + j * 8, dir, h));
        float s0 = 0.f, s1 = 0.f;
        const size_t base = (size_t)(h * 2 + dir) * 16384 + pr, mstride = (size_t)4 * 2 * 16384;
#pragma unroll 1
        for (int it = 0; it < 130; it += 10) {
            unsigned uv[10]; int mm[10];
#pragma unroll
            for (int q = 0; q < 10; ++q) { const int s = it + q; mm[q] = (dir == 0) ? s : (s < 2 ? 1 - s : 131 - s); uv[q] = upd[base + (size_t)mm[q] * mstride]; }
#pragma unroll
            for (int q = 0; q < 10; ++q) { sp[base + (size_t)mm[q] * mstride] = cvtpk(s0, s1); s0 = g * s0 + bflo(uv[q]); s1 = g * s1 + bfhi(uv[q]); }
        }
    }
}
__device__ __forceinline__ void phase_hyconv(const Ctx& c, int j) {
    const Params& P = *c.p; const unsigned* uT = (const unsigned*)(c.ws + WS_UT); unsigned* yT = (unsigned*)(c.ws + WS_YT);
    const f32x2* hs = (const f32x2*)(c.ws + WS_HSPEC); const float* skip = P.in[20] + (size_t)j * 2 * 512;
    LAS f32x2* z = (LAS f32x2*)c.lds;
    for (int ch = c.bid; ch < 512; ch += c.G) {
        const int tid = opaque(c.tid);
        const unsigned* vp = uT + (size_t)ch * (NX / 2); const unsigned* x1p = uT + (size_t)(512 + ch) * (NX / 2); const unsigned* x2p = uT + (size_t)(1024 + ch) * (NX / 2);
        const float sk0 = skip[ch], sk1 = skip[512 + ch];
#pragma unroll 4
        for (int i = 0; i < 16; ++i) { const int m = tid + i * NTHREADS; const unsigned w = vp[m]; z[fphys(m)] = (f32x2){bflo(w), bfhi(w)}; }
#pragma unroll 4
        for (int i = 16; i < 32; ++i) z[fphys(tid + i * NTHREADS)] = (f32x2){0.f, 0.f};
        __syncthreads();
        fft_fwd(z, tid); fft_pair_mul(z, hs + (size_t)ch * HSPEC_LD, tid); __syncthreads(); fft_inv(z, tid);
        f32x2* y1g = (f32x2*)(c.ws + WS_Y1) + (size_t)ch * (NX / 2);
#pragma unroll 4
        for (int i = 0; i < 16; ++i) { const int m = tid + i * NTHREADS; const f32x2 cv = z[fphys(m)]; const unsigned w = x1p[m], wv = vp[m];
            const f32x2 y = (f32x2){bflo(w) * (cv[0] + sk0 * bflo(wv)), bfhi(w) * (cv[1] + sk0 * bfhi(wv))};
            z[fphys(m)] = y; y1g[m] = y; }
#pragma unroll 4
        for (int i = 16; i < 32; ++i) z[fphys(tid + i * NTHREADS)] = (f32x2){0.f, 0.f};
        __syncthreads();
        fft_fwd(z, tid); fft_pair_mul(z, hs + (size_t)(512 + ch) * HSPEC_LD, tid); __syncthreads(); fft_inv(z, tid);
#pragma unroll 4
        for (int i = 0; i < 16; ++i) { const int m = tid + i * NTHREADS; const f32x2 cv = z[fphys(m)]; const unsigned w = x2p[m]; const f32x2 y1 = y1g[m];
            yT[(size_t)ch * (NX / 2) + m] = cvtpk(bflo(w) * (cv[0] + sk1 * y1[0]), bfhi(w) * (cv[1] + sk1 * y1[1])); }
        __syncthreads();
    }
}

__device__ __forceinline__ void phase_r3(const Ctx& c, int j) {
    const Params& P = *c.p; const bf16_t* proj = (const bf16_t*)(c.ws + WS_PROJ); const bf16_t* spv = (const bf16_t*)(c.ws + WS_SPREV); bf16_t* cat = (bf16_t*)(c.ws + WS_CAT);
    LAS unsigned char* R0 = c.lds; LAS unsigned char* R1 = c.lds + 34816; LAS unsigned char* R2 = c.lds + 69632;
    for (int u = c.bid; u < 130 * 4; u += c.G) {
        const int tid = opaque(c.tid), lane = tid & 63, r32 = lane & 31, hi = lane >> 5, w = __builtin_amdgcn_readfirstlane(tid >> 6), wr2 = w >> 2, wc = w & 3;
        const int m = u >> 2, h = u & 3; const size_t row0 = (size_t)m * 128;
        const float lgf = ret_log2g(P.in[10] + j * 8, 0, h), lgb = ret_log2g(P.in[10] + j * 8, 1, h);
        {   const int jj = tid >> 2;
            for (int c8 = (tid & 3) * 8; c8 < 128; c8 += 32) {
                *(LAS u32x4*)(R0 + jj * P136 + c8 * 2) = *(const u32x4*)(proj + (row0 + jj) * AB_IN + h * 128 + c8);
                *(LAS u32x4*)(R1 + jj * P136 + c8 * 2) = *(const u32x4*)(proj + (row0 + jj) * AB_IN + 512 + h * 128 + c8); } }
        stage_T(tid, R2, proj + row0 * AB_IN + 1024 + h * 256, AB_IN, 256, nullptr);
        __syncthreads();
        f32x16 s[2] = {(f32x16){}, (f32x16){}};
#pragma unroll
        for (int ks = 0; ks < 8; ++ks) { const bf16x8 b = ldfrag(R1, P136, 32 * wc + r32, ks * 32 + hi * 16);
#pragma unroll
            for (int mi = 0; mi < 2; ++mi) { const bf16x8 a = ldfrag(R0, P136, 64 * wr2 + 32 * mi + r32, ks * 32 + hi * 16); s[mi] = __builtin_amdgcn_mfma_f32_32x32x16_bf16(a, b, s[mi], 0, 0, 0); } }
        __syncthreads();
#pragma unroll
        for (int mi = 0; mi < 2; ++mi)
#pragma unroll
            for (int r = 0; r < 16; ++r) { const int i = 64 * wr2 + 32 * mi + crow(r, hi), jc = 32 * wc + r32, rel = i - jc;
                const float dcy = (rel > 0) ? exp2f((float)rel * lgf) : ((rel < 0) ? exp2f((float)(-rel) * lgb) : 2.0f);
                *(LAS bf16_t*)(R1 + i * P136 + jc * 2) = f2bf(s[mi][r] * dcy); }
        __syncthreads();
        f32x16 o[2][2];
#pragma unroll
        for (int mi = 0; mi < 2; ++mi)
#pragma unroll
            for (int ni = 0; ni < 2; ++ni) o[mi][ni] = (f32x16){};
#pragma unroll
        for (int ks = 0; ks < 8; ++ks) { bf16x8 a[2], b[2];
#pragma unroll
            for (int q = 0; q < 2; ++q) { a[q] = ldfrag(R1, P136, 64 * wr2 + 32 * q + r32, ks * 32 + hi * 16); b[q] = ldfrag(R2, P136, 64 * wc + 32 * q + r32, ks * 32 + hi * 16); }
#pragma unroll
            for (int mi = 0; mi < 2; ++mi)
#pragma unroll
                for (int ni = 0; ni < 2; ++ni) o[mi][ni] = __builtin_amdgcn_mfma_f32_32x32x16_bf16(a[mi], b[ni], o[mi][ni], 0, 0, 0); }
        __syncthreads();
#pragma unroll 1
        for (int dir = 0; dir < 2; ++dir) {
            {   const int jj = tid >> 2; const float qd = (dir == 0) ? exp2f((float)(jj + 1) * lgf) : exp2f((float)(128 - jj) * lgb);
                for (int c8 = (tid & 3) * 8; c8 < 128; c8 += 32) { const u32x4 v = *(const LAS u32x4*)(R0 + jj * P136 + c8 * 2); u32x4 wv;
                    wv.x = cvtpk(bflo(v.x) * qd, bfhi(v.x) * qd); wv.y = cvtpk(bflo(v.y) * qd, bfhi(v.y) * qd); wv.z = cvtpk(bflo(v.z) * qd, bfhi(v.z) * qd); wv.w = cvtpk(bflo(v.w) * qd, bfhi(v.w) * qd);
                    *(LAS u32x4*)(R1 + jj * P136 + c8 * 2) = wv; } }
            {   const bf16_t* sp = spv + ((size_t)(m * 4 + h) * 2 + dir) * 32768;
                for (int idx = tid; idx < 256 * 16; idx += NTHREADS) { const int e = idx >> 4, c8 = (idx & 15) * 8; *(LAS u32x4*)(R2 + e * P136 + c8 * 2) = *(const u32x4*)(sp + e * 128 + c8); } }
            __syncthreads();
#pragma unroll
            for (int ks = 0; ks < 8; ++ks) { bf16x8 a[2], b[2];
#pragma unroll
                for (int q = 0; q < 2; ++q) { a[q] = ldfrag(R1, P136, 64 * wr2 + 32 * q + r32, ks * 32 + hi * 16); b[q] = ldfrag(R2, P136, 64 * wc + 32 * q + r32, ks * 32 + hi * 16); }
#pragma unroll
                for (int mi = 0; mi < 2; ++mi)
#pragma unroll
                    for (int ni = 0; ni < 2; ++ni) o[mi][ni] = __builtin_amdgcn_mfma_f32_32x32x16_bf16(a[mi], b[ni], o[mi][ni], 0, 0, 0); }
            __syncthreads();
        }
        for (int idx = tid; idx < 128 * 32; idx += NTHREADS) { const int i = idx >> 5, c8 = (idx & 31) * 8; *(LAS u32x4*)(R2 + i * 528 + c8 * 2) = *(const u32x4*)(proj + (row0 + i) * AB_IN + 2048 + h * 256 + c8); }
        LAS float* st = (LAS float*)R0;
#pragma unroll
        for (int mi = 0; mi < 2; ++mi)
#pragma unroll
            for (int r = 0; r < 16; ++r) { float sm = o[mi][0][r] + o[mi][1][r], sq = o[mi][0][r] * o[mi][0][r] + o[mi][1][r] * o[mi][1][r];
#pragma unroll
                for (int off = 16; off >= 1; off >>= 1) { sm += __shfl_xor(sm, off); sq += __shfl_xor(sq, off); }
                if (r32 == 0) { const int i = 64 * wr2 + 32 * mi + crow(r, hi); st[(i * 4 + wc) * 2 + 0] = sm; st[(i * 4 + wc) * 2 + 1] = sq; } }
        __syncthreads();
#pragma unroll
        for (int mi = 0; mi < 2; ++mi)
#pragma unroll
            for (int r = 0; r < 16; ++r) { const int i = 64 * wr2 + 32 * mi + crow(r, hi); float sm = 0.f, sq = 0.f;
#pragma unroll
                for (int q = 0; q < 4; ++q) { sm += st[(i * 4 + q) * 2 + 0]; sq += st[(i * 4 + q) * 2 + 1]; }
                const float mu = sm * (1.0f / 256.f), var = fmaxf(sq * (1.0f / 256.f) - mu * mu, 0.f), rstd = rsqrtf(var + EPS);
#pragma unroll
                for (int ni = 0; ni < 2; ++ni) { const int e = 64 * wc + 32 * ni + r32; LAS bf16_t* pg = (LAS bf16_t*)(R2 + i * 528 + e * 2); const float g = bf2f(*pg);
                    *pg = f2bf((o[mi][ni][r] - mu) * rstd * siluf(g)); } }
        __syncthreads();
        for (int idx = tid; idx < 128 * 32; idx += NTHREADS) { const int i = idx >> 5, c8 = (idx & 31) * 8; *(u32x4*)(cat + (row0 + i) * AB_CAT + h * 256 + c8) = *(const LAS u32x4*)(R2 + i * 528 + c8 * 2); }
        __syncthreads();
    }
}

__device__ __forceinline__ void phase_hytrans(const Ctx& c) {
    const bf16_t* yT = (const bf16_t*)(c.ws + WS_YT); bf16_t* cat = (bf16_t*)(c.ws + WS_CAT);
    LAS bf16_t* t = (LAS bf16_t*)c.lds;
    const int tid = c.tid;
    for (int u = c.bid; u < 256 * 8; u += c.G) {
        const int t0 = (u >> 3) * 64, ch0 = (u & 7) * 64;
        {   const int ch = tid >> 3, t8 = (tid & 7) * 8; const u32x4 v = *(const u32x4*)(yT + (size_t)(ch0 + ch) * NX + t0 + t8); const unsigned wv[4] = {v.x, v.y, v.z, v.w};
#pragma unroll
            for (int q = 0; q < 4; ++q) { t[ch * 66 + t8 + 2 * q] = (bf16_t)(wv[q] & 0xffffu); t[ch * 66 + t8 + 2 * q + 1] = (bf16_t)(wv[q] >> 16); } }
        __syncthreads();
        {   const int tt = tid >> 3, c8 = (tid & 7) * 8; unsigned short e[8];
#pragma unroll
            for (int q = 0; q < 8; ++q) e[q] = t[(c8 + q) * 66 + tt];
            u32x4 wv; wv.x = e[0] | ((unsigned)e[1] << 16); wv.y = e[2] | ((unsigned)e[3] << 16); wv.z = e[4] | ((unsigned)e[5] << 16); wv.w = e[6] | ((unsigned)e[7] << 16);
            *(u32x4*)(cat + (size_t)(NC + t0 + tt) * AB_CAT + 1024 + ch0 + c8) = wv; }
        __syncthreads();
    }
}

__device__ __forceinline__ void phase_hyctx(const Ctx& c, int j) {
    const Params& P = *c.p; const bf16_t* proj = (const bf16_t*)(c.ws + WS_PROJ); bf16_t* cat = (bf16_t*)(c.ws + WS_CAT);
    const float* hid2c = (const float*)(c.ws + WS_HID2C); const float* w3 = P.in[19] + (size_t)j * 64 * 2048;
    const float* cw = P.in[11] + (size_t)j * 3 * 1536; const float* cb = P.in[12] + (size_t)j * 1536; const float* skip = P.in[20] + (size_t)j * 2 * 512;
    LAS float* raw = (LAS float*)c.lds;
    LAS float* ser = raw + 3 * 258;
    LAS float* flt = ser + 3 * 256;
    LAS float* yy = flt + 4 * 256;
    const int tid = c.tid;
    for (int ch = c.bid; ch < 512; ch += c.G) {
        for (int idx = tid; idx < 3 * 258; idx += NTHREADS) { const int s = idx / 258, r = idx % 258, t = r - 1; raw[idx] = (t >= 0 && t < 256) ? bf2f(proj[(size_t)t * AB_IN + 3072 + s * 512 + ch]) : 0.f; }
        {
            const int t = tid & 255, hf = tid >> 8; const float tn = (float)t * (1.0f / 255.0f);
            const float delta = 3.0701134573253945f + (15.350567286626972f - 3.0701134573253945f) * ((float)ch * (1.0f / 511.0f)); const float win = __expf(-tn * delta);
            float a0 = 0.f, a1 = 0.f; const int col0 = (2 * hf) * 512 + ch, col1 = (2 * hf + 1) * 512 + ch;
            for (int k = 0; k < 64; ++k) { const float hv = hid2c[t * 64 + k]; a0 += hv * w3[(size_t)k * 2048 + col0]; a1 += hv * w3[(size_t)k * 2048 + col1]; }
            flt[(2 * hf) * 256 + t] = a0 * win; flt[(2 * hf + 1) * 256 + t] = a1 * win; }
        __syncthreads();
        for (int idx = tid; idx < 3 * 256; idx += NTHREADS) { const int s = idx >> 8, t = idx & 255, cg = s * 512 + ch;
            ser[idx] = raw[s * 258 + t] * cw[cg] + raw[s * 258 + t + 1] * cw[1536 + cg] + raw[s * 258 + t + 2] * cw[3072 + cg] + cb[cg]; }
        __syncthreads();
        if (tid < 256) { const int t = tid; float a = 0.f;
            for (int s = 0; s <= t; ++s) a += flt[0 * 256 + (t - s)] * ser[s];
            for (int s = t + 1; s < 256; ++s) a += flt[1 * 256 + (s - t)] * ser[s];
            yy[t] = ser[256 + t] * (a + skip[ch] * ser[t]); }
        __syncthreads();
        if (tid < 256) { const int t = tid; float a = 0.f;
            for (int s = 0; s <= t; ++s) a += flt[2 * 256 + (t - s)] * yy[s];
            for (int s = t + 1; s < 256; ++s) a += flt[3 * 256 + (s - t)] * yy[s];
            cat[(size_t)t * AB_CAT + 1024 + ch] = f2bf(ser[512 + t] * (a + skip[512 + ch] * yy[t])); }
        __syncthreads();
    }
}
namespace da {
constexpr int KVBLK = 64;
constexpr int SHM_V = KVBLK * 128 * 2, SHM_K = KVBLK * 128 * 2;
constexpr float THR2 = 11.5f;
#define DA_KSWZ(row, colB) ((row) * 256 + ((colB) ^ (((row) & 7) << 4)))
#define DA_SBAR() __builtin_amdgcn_sched_barrier(0)
__device__ __forceinline__ unsigned cvtpk_a(float lo, float hi) { unsigned r; asm volatile("v_cvt_pk_bf16_f32 %0, %1, %2" : "=v"(r) : "v"(lo), "v"(hi)); return r; }
__device__ __forceinline__ void partialSM(f32x16& p0, f32x16& p1, float& m_reg, float& alpha) {
    float pmax = p0[0];
#pragma unroll
    for (int r = 1; r < 16; ++r) pmax = fmaxf(pmax, p0[r]);
#pragma unroll
    for (int r = 0; r < 16; ++r) pmax = fmaxf(pmax, p1[r]);
    { auto rr = __builtin_amdgcn_permlane32_swap(__float_as_uint(pmax), __float_as_uint(pmax), false, false); pmax = fmaxf(__uint_as_float(rr[0]), __uint_as_float(rr[1])); }
    float mn;
    if (__builtin_expect(__all(pmax - m_reg <= THR2), 1)) { mn = m_reg; alpha = 1.f; }
    else { mn = fmaxf(m_reg, pmax); alpha = __builtin_amdgcn_exp2f(m_reg - mn); m_reg = mn; }
#pragma unroll
    for (int r = 0; r < 16; ++r) { p0[r] -= mn; p1[r] -= mn; }
#pragma unroll
    for (int r = 0; r < 16; ++r) p0[r] = __builtin_amdgcn_exp2f(p0[r]);
}
__device__ __forceinline__ void finishSM(f32x16& p0, f32x16& p1, float alpha, float& l_reg, bf16x8& pa0, bf16x8& pa1, bf16x8& pa2, bf16x8& pa3) {
#pragma unroll
    for (int r = 0; r < 16; ++r) p1[r] = __builtin_amdgcn_exp2f(p1[r]);
    float ps = 0;
#pragma unroll
    for (int r = 0; r < 16; ++r) ps += p0[r];
#pragma unroll
    for (int r = 0; r < 16; ++r) ps += p1[r];
    { auto rr = __builtin_amdgcn_permlane32_swap(__float_as_uint(ps), __float_as_uint(ps), false, false); ps = __uint_as_float(rr[0]) + __uint_as_float(rr[1]); }
    l_reg = l_reg * alpha + ps;
#define DA_PK4(P, BASE, OUT) do { unsigned a0 = cvtpk_a(P[BASE + 0], P[BASE + 1]), a1 = cvtpk_a(P[BASE + 2], P[BASE + 3]);   \
    unsigned b0 = cvtpk_a(P[BASE + 4], P[BASE + 5]), b1 = cvtpk_a(P[BASE + 6], P[BASE + 7]);                              \
    auto r0 = __builtin_amdgcn_permlane32_swap(a0, b0, false, false); auto r1 = __builtin_amdgcn_permlane32_swap(a1, b1, false, false); \
    u32x4 w = {r0[0], r1[0], r0[1], r1[1]}; OUT = *reinterpret_cast<bf16x8*>(&w); } while (0)
    DA_PK4(p0, 0, pa0); DA_PK4(p0, 8, pa1); DA_PK4(p1, 0, pa2); DA_PK4(p1, 8, pa3);
#undef DA_PK4
}
__device__ __forceinline__ void qkt(f32x16& p0, f32x16& p1, const LAS char* Ks, const bf16x8* qr, int r32, int hi, int comp) {
    p0 = f32x16{}; p1 = f32x16{};
#pragma unroll
    for (int d0 = 0; d0 < 4; ++d0) { const int cb = (comp * 64 + d0 * 16 + hi * 8) * 2;
        const bf16x8 b0 = *(const LAS bf16x8*)(Ks + DA_KSWZ(r32, cb));
        const bf16x8 b1 = *(const LAS bf16x8*)(Ks + DA_KSWZ(32 + r32, cb));
        p0 = __builtin_amdgcn_mfma_f32_32x32x16_bf16(b0, qr[d0], p0, 0, 0, 0);
        p1 = __builtin_amdgcn_mfma_f32_32x32x16_bf16(b1, qr[d0], p1, 0, 0, 0); }
}
__device__ __forceinline__ int v_st(int k, int c) { const int kk = (k & ~0xC) | ((k & 4) << 1) | ((k & 8) >> 1); return ((kk >> 3) * 4 + (c >> 5)) * 512 + ((kk & 7) * 32 + (c & 31)) * 2; }
__device__ __forceinline__ int v_rd_base(int lane) { return ((lane & 3) << 3) | (((lane >> 2) & 3) << 6) | (((lane >> 4) & 1) << 5) | (((lane >> 5) & 1) << 8); }
constexpr int v_rd_off(int d0, int ks, int half) { return d0 * 512 + ks * 4096 + half * 2048; }
template <int OFF> __device__ __forceinline__ s16x4 tr_read(int vb) { s16x4 r; asm volatile("ds_read_b64_tr_b16 %0, %1 offset:%2" : "=&v"(r) : "v"(vb), "i"(OFF) : "memory"); return r; }
template <int D0> __device__ __forceinline__ void pv_one(f32x16& od, int vb, bf16x8 pa0, bf16x8 pa1, bf16x8 pa2, bf16x8 pa3) {
    const s16x4 l0 = tr_read<v_rd_off(D0, 0, 0)>(vb), h0 = tr_read<v_rd_off(D0, 0, 1)>(vb), l1 = tr_read<v_rd_off(D0, 1, 0)>(vb), h1 = tr_read<v_rd_off(D0, 1, 1)>(vb);
    const s16x4 l2 = tr_read<v_rd_off(D0, 2, 0)>(vb), h2 = tr_read<v_rd_off(D0, 2, 1)>(vb), l3 = tr_read<v_rd_off(D0, 3, 0)>(vb), h3 = tr_read<v_rd_off(D0, 3, 1)>(vb);
    asm volatile("s_waitcnt lgkmcnt(0)" ::: "memory"); DA_SBAR();
#define DA_PK(L, H) (bf16x8){L[0], L[1], L[2], L[3], H[0], H[1], H[2], H[3]}
    od = __builtin_amdgcn_mfma_f32_32x32x16_bf16(pa0, DA_PK(l0, h0), od, 0, 0, 0);
    od = __builtin_amdgcn_mfma_f32_32x32x16_bf16(pa1, DA_PK(l1, h1), od, 0, 0, 0);
    od = __builtin_amdgcn_mfma_f32_32x32x16_bf16(pa2, DA_PK(l2, h2), od, 0, 0, 0);
    od = __builtin_amdgcn_mfma_f32_32x32x16_bf16(pa3, DA_PK(l3, h3), od, 0, 0, 0);
#undef DA_PK
}
__device__ __forceinline__ void pv_d0(f32x16* o, int vb, bf16x8 pa0, bf16x8 pa1, bf16x8 pa2, bf16x8 pa3) {
    pv_one<0>(o[0], vb, pa0, pa1, pa2, pa3); pv_one<1>(o[1], vb, pa0, pa1, pa2, pa3); pv_one<2>(o[2], vb, pa0, pa1, pa2, pa3); pv_one<3>(o[3], vb, pa0, pa1, pa2, pa3);
}

__device__ __forceinline__ void attn_unit(LAS char* lds, const bf16_t* proj, bf16_t* cat, int h, int qrow0, int nkeys, float lam, float oscale, const float* subln) {
    constexpr int LD = DA_IN;
    const int tid = opaque((int)threadIdx.x), wid = __builtin_amdgcn_readfirstlane(tid >> 6), lane = tid & 63, r32 = lane & 31, hi = lane >> 5, comp = wid >> 2, qw = wid & 3;
    LAS char* V_lds = lds; LAS char* K_lds = lds + 2 * SHM_V;
    LAS float* ws = (LAS float*)(lds + 2 * SHM_V + 2 * SHM_K) + wid * 64; LAS float* li_l = ws; LAS float* al_l = ws + 32;
    float m_reg = -1e30f, l_reg = 0; f32x16 o[4] = {}; bf16x8 qr[4];
    const bf16_t* Qw = proj + (size_t)(qrow0 + qw * 32 + r32) * LD + h * 128 + comp * 64 + hi * 8;
#pragma unroll
    for (int d0 = 0; d0 < 4; ++d0) qr[d0] = *reinterpret_cast<const bf16x8*>(Qw + d0 * 16);
    const bf16_t* Kh = proj + 1024 + h * 128; const bf16_t* Vh = proj + 2048 + h * 128;
    const int sr = tid >> 4, sc = (tid & 15) * 8, vst0 = v_st(sr, sc), vst1 = v_st(32 + sr, sc);
    const int vb0 = (int)(unsigned)(uintptr_t)V_lds + v_rd_base(lane);
    struct { bf16x8 vs0, vs1, ks0, ks1; } sr_[2];
#define DA_SLOAD(i, k0) do { sr_[i].vs0 = *(const bf16x8*)(&Vh[(size_t)((k0) + sr) * LD + sc]); sr_[i].vs1 = *(const bf16x8*)(&Vh[(size_t)((k0) + 32 + sr) * LD + sc]); \
    sr_[i].ks0 = *(const bf16x8*)(&Kh[(size_t)((k0) + sr) * LD + sc]); sr_[i].ks1 = *(const bf16x8*)(&Kh[(size_t)((k0) + 32 + sr) * LD + sc]); } while (0)
#define DA_SWRITE(b, i) do { *(LAS bf16x8*)(V_lds + (b) * SHM_V + vst0) = sr_[i].vs0; *(LAS bf16x8*)(V_lds + (b) * SHM_V + vst1) = sr_[i].vs1; const int kc = sc * 2; \
    *(LAS bf16x8*)(K_lds + (b) * SHM_K + DA_KSWZ(sr, kc)) = sr_[i].ks0; *(LAS bf16x8*)(K_lds + (b) * SHM_K + DA_KSWZ(32 + sr, kc)) = sr_[i].ks1; } while (0)
#define DA_SWAIT() asm volatile("s_waitcnt vmcnt(4)" ::: "memory")
#define DA_RESC(a) do { if (__any((a) < 1.f)) { if (hi == 0) al_l[r32] = (a); asm volatile("s_waitcnt lgkmcnt(0)" ::: "memory"); \
    _Pragma("unroll") for (int d = 0; d < 4; ++d) _Pragma("unroll") for (int r = 0; r < 16; ++r) o[d][r] *= al_l[crow(r, hi)]; } } while (0)
    f32x16 pA0, pA1, pB0, pB1; float alA, alB; bf16x8 pa0, pa1, pa2, pa3; const int NT = nkeys / KVBLK;
    DA_SLOAD(0, 0); asm volatile("s_waitcnt vmcnt(0)" ::: "memory"); DA_SWRITE(0, 0); __syncthreads();
    qkt(pA0, pA1, K_lds, qr, r32, hi, comp); partialSM(pA0, pA1, m_reg, alA);
    DA_SLOAD(1, KVBLK); if (2 < NT) DA_SLOAD(0, 2 * KVBLK);
    DA_SWAIT(); DA_SWRITE(1, 1); __syncthreads();
    for (int j = 1; j + 1 < NT; j += 2) {
        DA_SBAR(); qkt(pB0, pB1, K_lds + SHM_K, qr, r32, hi, comp);
        finishSM(pA0, pA1, alA, l_reg, pa0, pa1, pa2, pa3); DA_SBAR();
        DA_SLOAD(1, (j + 2) * KVBLK); DA_SBAR();
        pv_d0(o, vb0, pa0, pa1, pa2, pa3); partialSM(pB0, pB1, m_reg, alB);
        __syncthreads(); DA_SWAIT(); DA_SWRITE(0, 0);
        DA_RESC(alB); __syncthreads();
        DA_SBAR(); qkt(pA0, pA1, K_lds, qr, r32, hi, comp);
        finishSM(pB0, pB1, alB, l_reg, pa0, pa1, pa2, pa3); DA_SBAR();
        if (j + 3 < NT) DA_SLOAD(0, (j + 3) * KVBLK); DA_SBAR();
        pv_d0(o, vb0 + SHM_V, pa0, pa1, pa2, pa3); partialSM(pA0, pA1, m_reg, alA);
        __syncthreads(); DA_SWAIT(); DA_SWRITE(1, 1);
        DA_RESC(alA); __syncthreads();
    }
    DA_SBAR(); qkt(pB0, pB1, K_lds + SHM_K, qr, r32, hi, comp);
    finishSM(pA0, pA1, alA, l_reg, pa0, pa1, pa2, pa3); DA_SBAR();
    pv_d0(o, vb0, pa0, pa1, pa2, pa3); partialSM(pB0, pB1, m_reg, alB);
    __syncthreads(); DA_RESC(alB);
    finishSM(pB0, pB1, alB, l_reg, pa0, pa1, pa2, pa3); DA_SBAR();
    pv_d0(o, vb0 + SHM_V, pa0, pa1, pa2, pa3);
    if (hi == 0) li_l[r32] = l_reg; asm volatile("s_waitcnt lgkmcnt(0)" ::: "memory");
    float rli[16];
#pragma unroll
    for (int r = 0; r < 16; ++r) rli[r] = __builtin_amdgcn_rcpf(li_l[crow(r, hi)]);
#pragma unroll
    for (int d0 = 0; d0 < 4; ++d0)
#pragma unroll
        for (int r = 0; r < 16; ++r) o[d0][r] *= rli[r];
    __syncthreads();
    LAS float* xb = (LAS float*)lds;
    if (comp == 1) {
#pragma unroll
        for (int d0 = 0; d0 < 4; ++d0)
#pragma unroll
            for (int r = 0; r < 16; ++r) xb[((qw * 64) + d0 * 16 + r) * 64 + lane] = o[d0][r];
    }
    __syncthreads();
    if (comp == 0) {
        float ssq[16];
#pragma unroll
        for (int r = 0; r < 16; ++r) ssq[r] = 0.f;
#pragma unroll
        for (int d0 = 0; d0 < 4; ++d0)
#pragma unroll
            for (int r = 0; r < 16; ++r) { const float x = o[d0][r] - lam * xb[((qw * 64) + d0 * 16 + r) * 64 + lane]; o[d0][r] = x; ssq[r] += x * x; }
#pragma unroll
        for (int r = 0; r < 16; ++r) {
#pragma unroll
            for (int off = 16; off >= 1; off >>= 1) ssq[r] += __shfl_xor(ssq[r], off);
            ssq[r] = rsqrtf(ssq[r] * (1.0f / 128.f) + 1e-5f) * oscale; }
        asm volatile("" ::: "memory");
        LAS char* stg = lds + qw * 16384;
#pragma unroll
        for (int d0 = 0; d0 < 4; ++d0) { const float g = subln[d0 * 32 + r32];
#pragma unroll
            for (int r = 0; r < 16; ++r) *(LAS bf16_t*)(stg + crow(r, hi) * 272 + (d0 * 32 + r32) * 2) = f2bf(o[d0][r] * ssq[r] * g); }
        asm volatile("s_waitcnt lgkmcnt(0)" ::: "memory");
        bf16_t* Ow = cat + (size_t)(qrow0 + qw * 32) * DA_W + h * 128;
#pragma unroll
        for (int q = 0; q < 8; ++q) { const int id = q * 64 + lane, row = id >> 4, c16 = id & 15; *(u32x4*)(Ow + (size_t)row * DA_W + c16 * 8) = *(const LAS u32x4*)(stg + row * 272 + c16 * 16); }
    }
    __syncthreads();
#undef DA_SLOAD
#undef DA_SWRITE
#undef DA_SWAIT
#undef DA_RESC
}
}

__device__ __forceinline__ void phase_attn(const Ctx& c, int jj, bool with_ctx) {
    const Params& P = *c.p; const bf16_t* proj = (const bf16_t*)(c.ws + WS_PROJ); bf16_t* cat = (bf16_t*)(c.ws + WS_CAT);
    const float lam = ((const float*)(c.ws + WS_MISC))[jj * 2 + 0], linit = ((const float*)(c.ws + WS_MISC))[jj * 2 + 1];
    const float* subln = P.in[24] + (size_t)jj * 128;
    const int nunits = 1024 + (with_ctx ? 16 : 0);
    for (int L = c.bid; L < nunits; L += c.G) {
        if (L < 1024) da::attn_unit((LAS char*)c.lds, proj, cat, L & 7, NC + (L >> 3) * 128, NTOK, lam, 1.0f - linit, subln);
        else { const int i = L - 1024; da::attn_unit((LAS char*)c.lds, proj, cat, i & 7, (i >> 3) * 128, NC, lam, 1.0f - linit, subln); }
    }
}
__device__ __forceinline__ MoeTable moe_table(const Ctx& c, int layer, int ntok_l) {
    LAS int* tb = (LAS int*)(c.lds + LDS_MISC + 64); LAS int* cn = (LAS int*)(c.lds + LDS_MISC + 512);
    const unsigned* cg = (const unsigned*)(c.ws + WS_CTL) + CW_CNT + layer * 64;
    __syncthreads();
    if (c.tid == 0) { int t = 0;
        for (int e = 0; e < 65; ++e) { const int n = (e < 64) ? (int)cg[e] : ntok_l; cn[e] = n; tb[e] = t; t += (n + 255) >> 8; }
        tb[65] = t; }
    __syncthreads();
    MoeTable r; r.tb = tb; r.cn = cn; return r;
}

__device__ __forceinline__ void phase_p6(const Ctx& c, int layer, int tok0) {
    const Params& P = *c.p; unsigned char* ws = c.ws; const int tid = c.tid, lane = c.lane, w = c.wid;
    {
        const float* wg = P.in[27] + (size_t)layer * 64 * 1024 * 256; const float* wu = P.in[28] + (size_t)layer * 64 * 1024 * 256; const float* wd = P.in[29] + (size_t)layer * 64 * 256 * 1024;
        const float* sg = P.in[30] + (size_t)layer * 1024 * 256; const float* su = P.in[31] + (size_t)layer * 1024 * 256; const float* sd = P.in[32] + (size_t)layer * 256 * 1024;
        bf16_t* WGU = (bf16_t*)(ws + WS_WGU); bf16_t* WD = (bf16_t*)(ws + WS_WD);
        const int NT_ = 65 * 192;
        for (int u = c.bid; u < NT_; u += c.G) {
            const int e = u / 192, r = u % 192, kind = r >> 6, q = r & 63;
            if (kind == 0) { const float* src = (e < 64) ? wg + (size_t)e * 1024 * 256 : sg; cvt_tile(c, src, 256, (q >> 2) * 64, (q & 3) * 64, WGU + (size_t)e * 512 * 1024, 1024, RowGate()); }
            else if (kind == 1) { const float* src = (e < 64) ? wu + (size_t)e * 1024 * 256 : su; cvt_tile(c, src, 256, (q >> 2) * 64, (q & 3) * 64, WGU + (size_t)e * 512 * 1024, 1024, RowUp()); }
            else { const float* src = (e < 64) ? wd + (size_t)e * 256 * 1024 : sd; cvt_tile(c, src, 1024, (q >> 4) * 64, (q & 15) * 64, WD + (size_t)e * 1024 * 256, 256, RowId()); }
        }
    }
    __syncthreads();
    const int ntok_l = NTOK - tok0, tpb = (ntok_l + c.G - 1) / c.G;
    const int tb0 = tok0 + c.bid * tpb, tb1 = (tb0 + tpb < NTOK) ? tb0 + tpb : NTOK; const int nloc = (tb1 > tb0) ? tb1 - tb0 : 0;
    LAS unsigned char* hsh = c.lds; LAS unsigned char* hsl = c.lds + 33024;
    LAS float* lg = (LAS float*)(c.lds + 66048);
    LAS int* che = (LAS int*)(c.lds + 74240); LAS float* chw = (LAS float*)(c.lds + 79360);
    LAS int* cntl = (LAS int*)(c.lds + 84480); LAS int* basel = (LAS int*)(c.lds + 84736);
    if (tid < 64) cntl[tid] = 0;
    const float* xres = (const float*)(ws + WS_XRES); bf16_t* hB = (bf16_t*)(ws + WS_H);
    const float* gain = P.in[7] + (size_t)layer * D; const float* modl = (const float*)(ws + WS_MOD) + (size_t)layer * 2 * 6144;
    const bf16_t* wrh = (const bf16_t*)(ws + WS_WR) + (size_t)(layer * 2 + 0) * 64 * 1024; const bf16_t* wrl = wrh + 64 * 1024;
    const float* rbias = P.in[26] + (size_t)layer * 64;
    const int nsub = (nloc + 15) >> 4;
    for (int st = 0; st < nsub; ++st) {
#pragma unroll 1
        for (int q2 = 0; q2 < 2; ++q2) { const int tl = st * 16 + w * 2 + q2, row = tb0 + tl; LAS unsigned char* ph = hsh + (w * 2 + q2) * 2064; LAS unsigned char* pl = hsl + (w * 2 + q2) * 2064;
            if (tl < nloc) {
                const float* x = xres + (size_t)row * D; const float* m = modl + ((row < NC) ? 6144 : 0);
                f32x4 v[4]; float ss = 0.f;
#pragma unroll
                for (int q = 0; q < 4; ++q) { v[q] = *(const f32x4*)(x + q * 256 + lane * 4); ss += v[q][0] * v[q][0] + v[q][1] * v[q][1] + v[q][2] * v[q][2] + v[q][3] * v[q][3]; }
                ss = wave_sum(ss); const float rstd = rsqrtf(ss * (1.0f / 1024.f) + EPS);
#pragma unroll
                for (int q = 0; q < 4; ++q) { const int col = q * 256 + lane * 4;
                    const f32x4 g = *(const f32x4*)(gain + col), sc = *(const f32x4*)(m + 4 * 1024 + col), sh = *(const f32x4*)(m + 3 * 1024 + col);
                    float o[4], hi_[4], lo_[4];
#pragma unroll
                    for (int k = 0; k < 4; ++k) { o[k] = v[q][k] * rstd * g[k] * (1.0f + sc[k]) + sh[k]; hi_[k] = bf2f(f2bf(o[k])); lo_[k] = o[k] - hi_[k]; }
                    u32x2 wv; wv.x = cvtpk(o[0], o[1]); wv.y = cvtpk(o[2], o[3]);
                    *(u32x2*)(hB + (size_t)row * D + col) = wv;
                    *(LAS u32x2*)(ph + col * 2) = wv;
                    u32x2 wl; wl.x = cvtpk(lo_[0], lo_[1]); wl.y = cvtpk(lo_[2], lo_[3]);
                    *(LAS u32x2*)(pl + col * 2) = wl; }
            } else {
#pragma unroll
                for (int q = 0; q < 4; ++q) { *(LAS u32x2*)(ph + (q * 256 + lane * 4) * 2) = (u32x2){0u, 0u}; *(LAS u32x2*)(pl + (q * 256 + lane * 4) * 2) = (u32x2){0u, 0u}; }
            } }
        __syncthreads();
        {   const int et = w & 3, kh = w >> 2, fr = lane & 15, fq = lane >> 4; f32x4 acc = (f32x4){0.f, 0.f, 0.f, 0.f};
            const bf16_t* bh = wrh + (size_t)(et * 16 + fr) * 1024 + kh * 512 + fq * 8; const bf16_t* bl = wrl + (size_t)(et * 16 + fr) * 1024 + kh * 512 + fq * 8;
#pragma unroll 4
            for (int ks = 0; ks < 16; ++ks) {
                const bf16x8 ah = *(const LAS bf16x8*)(hsh + fr * 2064 + (kh * 512 + ks * 32 + fq * 8) * 2), al = *(const LAS bf16x8*)(hsl + fr * 2064 + (kh * 512 + ks * 32 + fq * 8) * 2);
                const bf16x8 vbh = *(const bf16x8*)(bh + ks * 32), vbl = *(const bf16x8*)(bl + ks * 32);
                acc = __builtin_amdgcn_mfma_f32_16x16x32_bf16(ah, vbh, acc, 0, 0, 0);
                acc = __builtin_amdgcn_mfma_f32_16x16x32_bf16(ah, vbl, acc, 0, 0, 0);
                acc = __builtin_amdgcn_mfma_f32_16x16x32_bf16(al, vbh, acc, 0, 0, 0); }
#pragma unroll
            for (int r = 0; r < 4; ++r) lg[(kh * 16 + fq * 4 + r) * 64 + et * 16 + fr] = acc[r];
        }
        __syncthreads();
#pragma unroll 1
        for (int q2 = 0; q2 < 2; ++q2) { const int ts = w * 2 + q2, tl = st * 16 + ts;
            if (tl < nloc) {
                const float logit = lg[ts * 64 + lane] + lg[(16 + ts) * 64 + lane];
                const float score = sigmoidf_(logit), choice = score + rbias[lane];
                float m1 = choice;
#pragma unroll
                for (int off = 1; off <= 4; off <<= 1) m1 = fmaxf(m1, __shfl_xor(m1, off));
                const unsigned long long bm = __ballot(choice == m1); const unsigned gb = (unsigned)(bm >> (lane & 56)) & 0xffu;
                const bool isfirst = ((lane & 7) == (__builtin_ctz(gb) & 7));
                float m2 = isfirst ? -INFINITY : choice;
#pragma unroll
                for (int off = 1; off <= 4; off <<= 1) m2 = fmaxf(m2, __shfl_xor(m2, off));
                const float gs = m1 + m2; const int g = lane >> 3; int grank = 0;
#pragma unroll
                for (int g2 = 0; g2 < 8; ++g2) { const float o = __shfl(gs, g2 * 8); grank += (o > gs || (o == gs && g2 < g)) ? 1 : 0; }
                const bool gsel = grank < 4; const float mc = gsel ? choice : -INFINITY; int erank = 0;
#pragma unroll 8
                for (int e2 = 0; e2 < 64; ++e2) { const float o = __shfl(mc, e2); erank += (o > mc || (o == mc && e2 < lane)) ? 1 : 0; }
                const bool sel = gsel && erank < 8;
                const float sw = wave_sum(sel ? score : 0.f);
                if (sel) { che[tl * 8 + erank] = lane; chw[tl * 8 + erank] = score / (sw + 1e-20f) * 2.5f; atomicAdd((int*)&cntl[lane], 1); }
            } }
        __syncthreads();
    }
    if (tid < 64) { const int n = cntl[tid]; unsigned* cg = (unsigned*)(ws + WS_CTL) + CW_CNT + layer * 64;
        basel[tid] = n ? (int)__hip_atomic_fetch_add(cg + tid, (unsigned)n, __ATOMIC_RELAXED, __HIP_MEMORY_SCOPE_AGENT) : 0; cntl[tid] = 0; }
    __syncthreads();
    int* ltok = (int*)(ws + WS_LTOK); float* lw = (float*)(ws + WS_LW); int* slot = (int*)(ws + WS_SLOT);
    for (int idx = tid; idx < nloc * 8; idx += NTHREADS) { const int tl = idx >> 3, e = che[idx]; const int pos = basel[e] + atomicAdd((int*)&cntl[e], 1);
        ltok[(size_t)e * NTOK + pos] = tb0 + tl; lw[(size_t)e * NTOK + pos] = chw[idx]; slot[(size_t)(tb0 + tl) * 8 + (idx & 7)] = (e << 20) | pos; }
    __syncthreads();
}

__device__ __forceinline__ void phase_p9(const Ctx& c, int layer, int tok0, const MoeTable& t) {
    const Params& P = *c.p; unsigned char* ws = c.ws; const int lane = c.lane;
    float* xres = (float*)(ws + WS_XRES); const bf16_t* Y = (const bf16_t*)(ws + WS_YSLOT); const int* slot = (const int*)(ws + WS_SLOT);
    const float* modl = (const float*)(ws + WS_MOD) + (size_t)layer * 2 * 6144;
    const bool fin = (layer == DEPTH - 1);
    const float* gain = fin ? P.in[33] : P.in[6] + (size_t)(layer + 1) * D; const float* modn = (const float*)(ws + WS_MOD) + (size_t)(layer + 1) * 2 * 6144;
    bf16_t* hA = (bf16_t*)(ws + WS_H);
    const size_t shrow0 = (size_t)t.tb[64] * 256;
    for (int row = tok0 + c.bid * 8 + c.wid; row < NTOK; row += c.G * 8) {
        const int sl = (lane < 8) ? slot[(size_t)row * 8 + lane] : 0;
        float acc[16];
#pragma unroll
        for (int k = 0; k < 16; ++k) acc[k] = 0.f;
#pragma unroll
        for (int k = 0; k < 9; ++k) { size_t yr;
            if (k < 8) { const int s = __shfl(sl, k); yr = (size_t)t.tb[s >> 20] * 256 + (s & 0xfffff); } else yr = shrow0 + (size_t)(row - tok0);
#pragma unroll
            for (int q = 0; q < 2; ++q) { const u32x4 v = *(const u32x4*)(Y + yr * 1024 + q * 512 + lane * 8);
                acc[q * 8 + 0] += bflo(v.x); acc[q * 8 + 1] += bfhi(v.x); acc[q * 8 + 2] += bflo(v.y); acc[q * 8 + 3] += bfhi(v.y);
                acc[q * 8 + 4] += bflo(v.z); acc[q * 8 + 5] += bfhi(v.z); acc[q * 8 + 6] += bflo(v.w); acc[q * 8 + 7] += bfhi(v.w); } }
        const float* m = modl + ((row < NC) ? 6144 : 0) + 5 * 1024; float* x = xres + (size_t)row * D; float xn[16]; float ss = 0.f;
#pragma unroll
        for (int q = 0; q < 2; ++q)
#pragma unroll
            for (int hh = 0; hh < 2; ++hh) { const int col = q * 512 + lane * 8 + hh * 4; const f32x4 xv = *(const f32x4*)(x + col), g = *(const f32x4*)(m + col); f32x4 o;
#pragma unroll
                for (int k = 0; k < 4; ++k) { o[k] = xv[k] + g[k] * acc[q * 8 + hh * 4 + k]; xn[q * 8 + hh * 4 + k] = o[k]; ss += o[k] * o[k]; }
                *(f32x4*)(x + col) = o; }
        ss = wave_sum(ss); const float rstd = rsqrtf(ss * (1.0f / 1024.f) + EPS);
        if (fin) {
            float* out = P.out + (size_t)(row - NC) * D;
#pragma unroll
            for (int q = 0; q < 2; ++q)
#pragma unroll
                for (int hh = 0; hh < 2; ++hh) { const int col = q * 512 + lane * 8 + hh * 4; const f32x4 g = *(const f32x4*)(gain + col); f32x4 o;
#pragma unroll
                    for (int k = 0; k < 4; ++k) o[k] = xn[q * 8 + hh * 4 + k] * rstd * g[k];
                    *(f32x4*)(out + col) = o; }
        } else {
            const float* mn = modn + ((row < NC) ? 6144 : 0);
#pragma unroll
            for (int q = 0; q < 2; ++q) { const int col = q * 512 + lane * 8; float o[8];
#pragma unroll
                for (int hh = 0; hh < 2; ++hh) { const f32x4 g = *(const f32x4*)(gain + col + hh * 4), sc = *(const f32x4*)(mn + 1024 + col + hh * 4), sh = *(const f32x4*)(mn + col + hh * 4);
#pragma unroll
                    for (int k = 0; k < 4; ++k) o[hh * 4 + k] = xn[q * 8 + hh * 4 + k] * rstd * g[k] * (1.0f + sc[k]) + sh[k]; }
                u32x4 wv; wv.x = cvtpk(o[0], o[1]); wv.y = cvtpk(o[2], o[3]); wv.z = cvtpk(o[4], o[5]); wv.w = cvtpk(o[6], o[7]);
                *(u32x4*)(hA + (size_t)row * D + col) = wv; }
        }
    }
}
constexpr int NPHASE = 38;
__global__ void __launch_bounds__(NTHREADS, 2) fwd_kernel(Params prm) {
    extern __shared__ __attribute__((aligned(16))) unsigned char lds_raw[];
    Ctx c; c.p = &prm; c.lds = (LAS unsigned char*)lds_raw; c.tid = threadIdx.x; c.lane = c.tid & 63; c.wid = __builtin_amdgcn_readfirstlane(c.tid >> 6); c.G = gridDim.x; c.bid = blockIdx.x; c.ws = prm.ws;
    volatile LAS unsigned* misc = (volatile LAS unsigned*)(c.lds + LDS_MISC);
    if (c.tid < 4) misc[c.tid] = 0u;
    __syncthreads();
    const int lo = prm.ph_lo, hi = prm.ph_hi;
    XcdBarrier bar; bar.bar = (unsigned*)(c.ws + WS_CTL) + CW_BAR; bar.x = 0; bar.st = misc;
    if (hi - lo > 1) bar = xcd_barrier_post((unsigned*)(c.ws + WS_CTL) + CW_BAR, misc);
#define IN(k) ((lo <= (k) && (k) < hi) && ((c.tid = opaque((int)threadIdx.x)), (c.lane = c.tid & 63), (c.wid = __builtin_amdgcn_readfirstlane(c.tid >> 6)), true))
#define SEAM(k) do { if ((lo <= (k)) && ((k) + 1 < hi)) xcd_barrier(bar); } while (0)
    unsigned char* ws = c.ws; const Params& P = prm;
    if (IN(0)) { phase_pr0(c); } SEAM(0);
    if (IN(1)) { phase_pr1(c); } SEAM(1);
#pragma unroll 1
    for (int jj = 0; jj < 2; ++jj) {
        const int pb = 2 + jj * 18;
        { const int layer = 2 * jj;
        if (IN(pb + 0)) { phase_f1(c, jj); } SEAM(pb + 0);
        if (IN(pb + 1)) { phase_f2(c); } SEAM(pb + 1);
        if (IN(pb + 2)) {
            DenseSched S; S.init(ws + WS_H, (const bf16_t*)(ws + WS_WAB_IN) + (size_t)jj * AB_IN * 1024, 1024, 65, 18, 0, c.G, c.bid);
            EpiAbIn E{(bf16_t*)(ws + WS_PROJ), (const f32x2*)(ws + WS_ROPE)};
            pg8::gemm_phase<EpiAbIn, DenseSched, false>(c.lds, 1024, S, E); } SEAM(pb + 2);
        if (IN(pb + 3)) { phase_r1(c, jj); phase_hyprep(c, jj); } SEAM(pb + 3);
        if (IN(pb + 4)) { phase_hyconv(c, jj); phase_scan(c, jj); } SEAM(pb + 4);
        if (IN(pb + 5)) { phase_r3(c, jj); phase_hytrans(c); phase_hyctx(c, jj); } SEAM(pb + 5);
        if (IN(pb + 6)) {
            DenseSched S; S.init(ws + WS_CAT, (const bf16_t*)(ws + WS_WAB_OUT) + (size_t)jj * 1024 * AB_CAT, AB_CAT, 65, 4, 0, c.G, c.bid);
            EpiResid E{(float*)(ws + WS_XRES), (const float*)(ws + WS_MOD) + (size_t)layer * 2 * 6144};
            pg8::gemm_phase<EpiResid, DenseSched, false>(c.lds, AB_CAT, S, E); } SEAM(pb + 6);
        if (IN(pb + 7)) { phase_p6(c, layer, 0); } SEAM(pb + 7);
        if (IN(pb + 8)) { const MoeTable t = moe_table(c, layer, NTOK);
            MoeUpSched S; S.t = t; S.H = (const char*)(ws + WS_H); S.W = (const char*)(ws + WS_WGU); S.ltok = (const int*)(ws + WS_LTOK); S.tok0 = 0; S.G = c.G; S.c = c.bid; S.nwg = t.tb[65] * 2;
            EpiSwiglu E{(bf16_t*)(ws + WS_ACT)};
            pg8::gemm_phase<EpiSwiglu, MoeUpSched, true>(c.lds, 1024, S, E); } SEAM(pb + 8);
        if (IN(pb + 9)) { const MoeTable t = moe_table(c, layer, NTOK);
            MoeDownSched S; S.t = t; S.ACT = (const char*)(ws + WS_ACT); S.W = (const char*)(ws + WS_WD); S.G = c.G; S.c = c.bid; S.nwg = t.tb[65] * 4;
            EpiDown E{(bf16_t*)(ws + WS_YSLOT), (const float*)(ws + WS_LW), t};
            pg8::gemm_phase<EpiDown, MoeDownSched, false>(c.lds, 256, S, E); } SEAM(pb + 9);
        if (IN(pb + 10)) { const MoeTable t = moe_table(c, layer, NTOK); phase_p9(c, layer, 0, t); } SEAM(pb + 10);
        }
        { const int layer = 2 * jj + 1; const bool with_ctx = layer < DEPTH - 1; const int tok0 = with_ctx ? 0 : NC; const int pm0 = with_ctx ? 0 : 1;
        if (IN(pb + 11)) {
            DenseSched S; S.init(ws + WS_H, (const bf16_t*)(ws + WS_WDA_IN) + (size_t)jj * DA_IN * 1024, 1024, 65, 12, 0, c.G, c.bid);
            EpiDaIn E{(bf16_t*)(ws + WS_PROJ), (const f32x2*)(ws + WS_ROPE) + (256 * 32 + 64 * 32)};
            pg8::gemm_phase<EpiDaIn, DenseSched, false>(c.lds, 1024, S, E); } SEAM(pb + 11);
        if (IN(pb + 12)) { phase_attn(c, jj, with_ctx); } SEAM(pb + 12);
        if (IN(pb + 13)) {
            DenseSched S; S.init(ws + WS_CAT, (const bf16_t*)(ws + WS_WDA_OUT) + (size_t)jj * 1024 * 1024, 1024, 65, 4, pm0, c.G, c.bid);
            EpiResid E{(float*)(ws + WS_XRES), (const float*)(ws + WS_MOD) + (size_t)layer * 2 * 6144};
            pg8::gemm_phase<EpiResid, DenseSched, false>(c.lds, 1024, S, E); } SEAM(pb + 13);
        if (IN(pb + 14)) { phase_p6(c, layer, tok0); } SEAM(pb + 14);
        if (IN(pb + 15)) { const MoeTable t = moe_table(c, layer, NTOK - tok0);
            MoeUpSched S; S.t = t; S.H = (const char*)(ws + WS_H); S.W = (const char*)(ws + WS_WGU); S.ltok = (const int*)(ws + WS_LTOK); S.tok0 = tok0; S.G = c.G; S.c = c.bid; S.nwg = t.tb[65] * 2;
            EpiSwiglu E{(bf16_t*)(ws + WS_ACT)};
            pg8::gemm_phase<EpiSwiglu, MoeUpSched, true>(c.lds, 1024, S, E); } SEAM(pb + 15);
        if (IN(pb + 16)) { const MoeTable t = moe_table(c, layer, NTOK - tok0);
            MoeDownSched S; S.t = t; S.ACT = (const char*)(ws + WS_ACT); S.W = (const char*)(ws + WS_WD); S.G = c.G; S.c = c.bid; S.nwg = t.tb[65] * 4;
            EpiDown E{(bf16_t*)(ws + WS_YSLOT), (const float*)(ws + WS_LW), t};
            pg8::gemm_phase<EpiDown, MoeDownSched, false>(c.lds, 256, S, E); } SEAM(pb + 16);
        if (IN(pb + 17)) { const MoeTable t = moe_table(c, layer, NTOK - tok0); phase_p9(c, layer, tok0, t); } SEAM(pb + 17);
        }
    }
#undef IN
#undef SEAM
}

#ifdef DBG_K
__global__ void dbg_dump(const unsigned* w, size_t nwords, float* out, int nout) {
    for (int i = blockIdx.x * blockDim.x + threadIdx.x; i < nout; i += gridDim.x * blockDim.x) { unsigned h = 0;
        for (size_t q = i; q < nwords; q += (size_t)nout) { unsigned x = w[q]; x ^= x >> 16; x *= 0x7feb352du; x ^= x >> 15; x *= 0x846ca68bu; x ^= x >> 16; h += x; }
        out[i] = (float)(h & 0xFFFFFu); }
}
#endif
#ifndef MK_SPLIT
#define MK_SPLIT 0
#endif
extern "C" void kernel_launch(void* const* d_in, const int* in_sizes, int n_in, void* d_out, int out_size, void* d_ws, size_t ws_size, hipStream_t stream) {
    static int grid = 0;
    if (grid == 0) {
        if (n_in != 34 || out_size != NX * D || ws_size < WS_END) { fprintf(stderr, "kernel_launch: unexpected shapes: n_in %d out %d ws %zu (need %zu)\n", n_in, out_size, ws_size, (size_t)WS_END); grid = -1; return; }
        int dev = 0, cus = 0, per_cu = 0;
        if (hipGetDevice(&dev) != hipSuccess || hipDeviceGetAttribute(&cus, hipDeviceAttributeMultiprocessorCount, dev) != hipSuccess) { grid = -1; return; }
        if (hipFuncSetAttribute((const void*)fwd_kernel, hipFuncAttributeMaxDynamicSharedMemorySize, LDS_BYTES) != hipSuccess) { fprintf(stderr, "kernel_launch: hipFuncSetAttribute failed\n"); grid = -1; return; }
        if (hipOccupancyMaxActiveBlocksPerMultiprocessor(&per_cu, (const void*)fwd_kernel, NTHREADS, LDS_BYTES) != hipSuccess || per_cu < 1) { fprintf(stderr, "kernel_launch: occupancy query says %d\n", per_cu); grid = -1; return; }
        grid = cus;
        if (grid > 256) grid = 256;
        grid &= ~7;
    }
    if (grid <= 0) return;
    (void)hipMemsetAsync((char*)d_ws + WS_CTL, 0, CTL_ZERO_BYTES, stream);
    Params p{};
    for (int i = 0; i < 34; ++i) p.in[i] = (const float*)d_in[i];
    p.out = (float*)d_out; p.ws = (unsigned char*)d_ws;
#ifdef DBG_K
    for (int k = 0; k <= DBG_K; ++k) { p.ph_lo = k; p.ph_hi = k + 1; hipLaunchKernelGGL(fwd_kernel, dim3(grid), dim3(NTHREADS), LDS_BYTES, stream, p); }
    hipLaunchKernelGGL(dbg_dump, dim3(1024), dim3(256), 0, stream, (const unsigned*)((const char*)d_ws + (size_t)(DBG_OFF)), (size_t)(DBG_BYTES) / 4, (float*)d_out, out_size);
#elif MK_SPLIT
    for (int k = 0; k < NPHASE; ++k) { p.ph_lo = k; p.ph_hi = k + 1; hipLaunchKernelGGL(fwd_kernel, dim3(grid), dim3(NTHREADS), LDS_BYTES, stream, p); }
#else
    p.ph_lo = 0; p.ph_hi = NPHASE;
    hipLaunchKernelGGL(fwd_kernel, dim3(grid), dim3(NTHREADS), LDS_BYTES, stream, p);
#endif
    const hipError_t le = hipPeekAtLastError();
    if (le != hipSuccess) fprintf(stderr, "kernel_launch: launch failed: %s\n", hipGetErrorName(le));
}
```

```cpp
#include <hip/hip_runtime.h>
#include <cstdio>
#include <cstdint>
#include <cmath>

#define LAS __attribute__((address_space(3)))
typedef unsigned short bf16_t;
typedef short bf16x8 __attribute__((ext_vector_type(8)));
typedef short s16x4 __attribute__((ext_vector_type(4)));
typedef float f32x2 __attribute__((ext_vector_type(2)));
typedef float f32x4 __attribute__((ext_vector_type(4)));
typedef float f32x16 __attribute__((ext_vector_type(16)));
typedef unsigned u32x2 __attribute__((ext_vector_type(2)));
typedef unsigned u32x4 __attribute__((ext_vector_type(4)));
typedef __bf16 bf16x2_t __attribute__((ext_vector_type(2)));

constexpr int D = 1024, NC = 256, NX = 16384, NTOK = NC + NX, DEPTH = 4;
constexpr int AB_IN = 4608, AB_CAT = 1536, DA_IN = 3072, DA_W = 1024;
constexpr int NEXP = 64, TOPK = 8, EDIM = 256;
constexpr int FFT_M = 16384;
constexpr int HSPEC_LD = 16400;
constexpr float EPS = 1e-6f;

__device__ __forceinline__ unsigned cvtpk(float lo, float hi) { f32x2 v = {lo, hi}; bf16x2_t b = __builtin_convertvector(v, bf16x2_t); return __builtin_bit_cast(unsigned, b); }
__device__ __forceinline__ bf16_t f2bf(float x) { return (bf16_t)(cvtpk(x, 0.f) & 0xffffu); }
__device__ __forceinline__ float bf2f(bf16_t b) { return __uint_as_float(((unsigned)b) << 16); }
__device__ __forceinline__ float bflo(unsigned w) { return __uint_as_float(w << 16); }
__device__ __forceinline__ float bfhi(unsigned w) { return __uint_as_float(w & 0xffff0000u); }
__device__ __forceinline__ float siluf(float x) { return x / (1.0f + __expf(-x)); }
__device__ __forceinline__ float sigmoidf_(float x) { return 1.0f / (1.0f + __expf(-x)); }
__device__ __forceinline__ int opaque(int x) { asm volatile("" : "+v"(x)); return x; }
__device__ __forceinline__ int opaque_s(int x) { asm volatile("" : "+s"(x)); return x; }
template <class T> __device__ __forceinline__ T* opaque_p(T* p) { asm volatile("" : "+s"(p)); return p; }
__device__ __forceinline__ float wave_sum(float v) {
#pragma unroll
    for (int o = 32; o >= 1; o >>= 1) v += __shfl_xor(v, o);
    return v;
}

#define XB_TMO      128
#define XB_XCNT(j)  (256  + 64 * (j))
#define XB_XSUB(j)  (1280 + 64 * (j))
#define XB_XGEN(j)  (2304 + 64 * (j))
#define XB_TOP      3328
#define XB_TOPGEN   3392
#define XCD_BAR_WORDS 3456
#define XB_SPIN_CAP (1u << 18)

__device__ __forceinline__ unsigned xb_ld(unsigned* p)              { return __hip_atomic_load(p, __ATOMIC_RELAXED, __HIP_MEMORY_SCOPE_AGENT); }
__device__ __forceinline__ unsigned xb_add(unsigned* p, unsigned v) { return __hip_atomic_fetch_add(p, v, __ATOMIC_RELAXED, __HIP_MEMORY_SCOPE_AGENT); }
__device__ __forceinline__ unsigned xb_xcc_id() { return (unsigned)__builtin_amdgcn_s_getreg((3 << 11) | 20) & 0xFu; }
#define XB_SPIN(cond, bar) do { unsigned _sp = 0; while (cond) { __builtin_amdgcn_s_sleep(1); \
    if ((++_sp & 255u) == 0u) { if (xb_ld(&(bar)[XB_TMO])) break; if (_sp > XB_SPIN_CAP) { atomicAdd(&(bar)[XB_TMO], 1u); break; } } } } while (0)

struct XcdBarrier { unsigned* bar; unsigned x; volatile LAS unsigned* st; };

__device__ __forceinline__ XcdBarrier xcd_barrier_post(unsigned* bar, volatile LAS unsigned* st) {
    XcdBarrier b; b.bar = bar; b.x = xb_xcc_id(); b.st = st;
    if (threadIdx.x == 0) (void)xb_add(&bar[XB_XCNT(b.x)], 1u);
    return b;
}
__device__ __forceinline__ void xcd_barrier_complete(unsigned* bar, unsigned x, unsigned& nloc, unsigned& nx) {
    const unsigned G = gridDim.x * gridDim.y * gridDim.z;
    unsigned sum, cnt, mine, sp = 0u;
    for (;;) {
        sum = 0u; cnt = 0u; mine = 0u;
#pragma unroll
        for (unsigned j = 0; j < 16; ++j) { const unsigned c = xb_ld(&bar[XB_XCNT(j)]); sum += c; cnt += (c > 0u) ? 1u : 0u; mine = (j == x) ? c : mine; }
        if (sum == G) break;
        __builtin_amdgcn_s_sleep(1);
        if ((++sp & 255u) == 0u) { if (xb_ld(&bar[XB_TMO])) break; if (sp > XB_SPIN_CAP) { atomicAdd(&bar[XB_TMO], 1u); break; } }
    }
    nloc = mine > 0u ? mine : 1u; nx = cnt > 0u ? cnt : 1u;
}
__device__ __forceinline__ void xcd_barrier(const XcdBarrier& b) {
    asm volatile("s_waitcnt vmcnt(0)" ::: "memory");
    __syncthreads();
    if (threadIdx.x == 0) {
        unsigned* bar = b.bar;
        __builtin_amdgcn_s_waitcnt(0);
        unsigned nloc = b.st[0], nx = b.st[1];
        if (nloc == 0u) { xcd_barrier_complete(bar, b.x, nloc, nx); b.st[0] = nloc; b.st[1] = nx; }
        const unsigned old = xb_add(&bar[XB_XSUB(b.x)], 1u);
        const unsigned gen = old / nloc;
        if (old + 1u == (gen + 1u) * nloc) {
            __builtin_amdgcn_fence(__ATOMIC_RELEASE, "agent");
            asm volatile("s_waitcnt vmcnt(0)" ::: "memory");
            const unsigned og = xb_add(&bar[XB_TOP], 1u);
            const unsigned tg = og / nx;
            if (og + 1u == (tg + 1u) * nx) xb_add(&bar[XB_TOPGEN], 1u);
            else XB_SPIN(xb_ld(&bar[XB_TOPGEN]) == tg, bar);
            __builtin_amdgcn_fence(__ATOMIC_ACQUIRE, "agent");
            xb_add(&bar[XB_XGEN(b.x)], 1u);
            asm volatile("s_waitcnt vmcnt(0)" ::: "memory");
        } else {
            XB_SPIN(xb_ld(&bar[XB_XGEN(b.x)]) == gen, bar);
            __builtin_amdgcn_fence(__ATOMIC_ACQUIRE, "agent");
            asm volatile("s_waitcnt vmcnt(0)" ::: "memory");
        }
    }
    __syncthreads();
}

namespace pg8 {
constexpr int BM = 256, BK = 64, HALF = 128, HTB = HALF * BK * 2, STAGE_BYTES = 8 * HTB;
__host__ __device__ __forceinline__ int lds_byte(int r, int c) { const int st = (r >> 4) * 2 + (c >> 5), rr = r & 15, cc = c & 31, ob = rr * 64 + cc * 2; return st * 1024 + (ob ^ (((ob >> 9) & 1) << 5)); }
__host__ __device__ __forceinline__ void stage_rc(int b, int& R, int& C) { const int st = b / 1024, sb = b % 1024, swz = sb ^ (((sb >> 9) & 1) << 5); R = (st >> 1) * 16 + swz / 64; C = (st & 1) * 32 + (swz % 64) / 2; }
__host__ __device__ __forceinline__ int perm32(int rho) { const int n = rho >> 4, i = rho & 15; return 8 * (i >> 2) + 4 * n + (i & 3); }

struct Unit { const char* A; const char* B; int pm, pn, e, aux; };

template <class Epi, class Sched, bool GATHER>
__device__ __forceinline__ void gemm_phase(LAS unsigned char* lds, const int K_, const Sched& S, const Epi& E) {
    int K = K_; asm volatile("" : "+s"(K));
    const int tid = opaque((int)threadIdx.x), wid = __builtin_amdgcn_readfirstlane(tid >> 6), lane = tid & 63, wr = wid >> 2, wc = wid & 3, fr = lane & 15, fq = lane >> 4;
    const int nt = K / BK;
    int Rr[2], Cc[2];
    unsigned voffB[2], vAc[2][2], vAn[2][2];
    const size_t kstep = (size_t)(BK * 2);
    const size_t hstep = (size_t)HALF * K * 2;
#pragma unroll
    for (int i = 0; i < 2; ++i) { int R, C; stage_rc(tid * 16 + i * 8192, R, C); Rr[i] = R; Cc[i] = C; const int Rb = Epi::PERM ? ((R & ~31) + perm32(R & 31)) : R;
        voffB[i] = (unsigned)(Rb * K + C) * 2u; vAc[0][i] = (unsigned)(R * K + C) * 2u; vAc[1][i] = vAc[0][i] + (unsigned)hstep; vAn[0][i] = vAc[0][i]; vAn[1][i] = vAc[1][i]; }
    const unsigned ldsw = (unsigned)wid * 1024u;
    const int aoff = lds_byte(wr * 64 + fr, fq * 8), boff = lds_byte(wc * 32 + fr, fq * 8);
#define PG8_SA(b, h) (((b) * 2 + (h)) * HTB)
#define PG8_SB(b, h) ((4 + (b) * 2 + (h)) * HTB)
#define PG8_STAGE(bufoff, gbase, voff) do { _Pragma("unroll") for (int _i = 0; _i < 2; ++_i) \
        __builtin_amdgcn_global_load_lds((const unsigned*)((const char*)(gbase) + (voff)[_i]), (LAS unsigned*)(lds + (bufoff) + ldsw + _i * 8192), 16, 0, 0); } while (0)
#define PG8_LDA(dst, b, h) do { _Pragma("unroll") for (int m = 0; m < 4; ++m) _Pragma("unroll") for (int k = 0; k < 2; ++k) dst[m][k] = *(const LAS bf16x8*)(lds + PG8_SA(b, h) + aoff + m * 2048 + k * 1024); } while (0)
#define PG8_LDB(dst, b, h) do { _Pragma("unroll") for (int n = 0; n < 2; ++n) _Pragma("unroll") for (int k = 0; k < 2; ++k) dst[n][k] = *(const LAS bf16x8*)(lds + PG8_SB(b, h) + boff + n * 2048 + k * 1024); } while (0)
#define PG8_MMA(ai, bj, At, Bt) do { __builtin_amdgcn_s_setprio(1); _Pragma("unroll") for (int m = 0; m < 4; ++m) _Pragma("unroll") for (int n = 0; n < 2; ++n) _Pragma("unroll") for (int k = 0; k < 2; ++k) \
        acc[ai][bj][m][n] = __builtin_amdgcn_mfma_f32_16x16x32_bf16(Bt[n][k], At[m][k], acc[ai][bj][m][n], 0, 0, 0); __builtin_amdgcn_s_setprio(0); } while (0)
#define PG8_WAIT_V(n) asm volatile("s_waitcnt vmcnt(" #n ")" ::: "memory")
#define PG8_WAIT_L(n) asm volatile("s_waitcnt lgkmcnt(" #n ")" ::: "memory")
#define PG8_BAR __builtin_amdgcn_s_barrier()
#define PG8_SCHED __builtin_amdgcn_sched_barrier(0)
    Unit cur, nxt; int ui = 0;
    if (!S.next(0, cur)) return;
    if (GATHER) { S.offsets(cur, Rr, Cc, vAc); }
    f32x4 acc[2][2][4][2];
#pragma unroll
    for (int a = 0; a < 2; ++a)
#pragma unroll
        for (int b = 0; b < 2; ++b)
#pragma unroll
            for (int m = 0; m < 4; ++m)
#pragma unroll
                for (int n = 0; n < 2; ++n) acc[a][b][m][n] = (f32x4){0.f, 0.f, 0.f, 0.f};
    bf16x8 At[4][2], B0[2][2], B1[2][2];
    const char* cA = cur.A; const char* cB = cur.B;
    PG8_STAGE(PG8_SB(0, 0), cB, voffB); PG8_STAGE(PG8_SA(0, 0), cA, vAc[0]); PG8_STAGE(PG8_SB(0, 1), cB + hstep, voffB); PG8_STAGE(PG8_SA(0, 1), cA, vAc[1]);
    if (wr == 1) PG8_BAR;
    PG8_WAIT_V(4); PG8_BAR;
    PG8_STAGE(PG8_SB(1, 0), cB + kstep, voffB); PG8_STAGE(PG8_SA(1, 0), cA + kstep, vAc[0]); PG8_STAGE(PG8_SB(1, 1), cB + hstep + kstep, voffB);
    PG8_WAIT_V(6); PG8_BAR;
    for (;;) {
        const bool has_next = S.next(ui + 1, nxt);
        const char* nA = has_next ? nxt.A : cA; const char* nB = has_next ? nxt.B : cB;
        if (GATHER) { if (has_next) S.offsets(nxt, Rr, Cc, vAn); else { vAn[0][0] = vAc[0][0]; vAn[0][1] = vAc[0][1]; vAn[1][0] = vAc[1][0]; vAn[1][1] = vAc[1][1]; } }
        for (int t = 0; t < nt; t += 2) {
            const bool last = (t == nt - 2);
            const char* a1 = cA + (size_t)(t + 1) * kstep;
            const char* a2 = last ? nA : cA + (size_t)(t + 2) * kstep; const char* b2 = last ? nB : cB + (size_t)(t + 2) * kstep;
            const char* a3 = a2 + kstep; const char* b3 = b2 + kstep;
            unsigned v2[2][2];
            if (GATHER) { v2[0][0] = last ? vAn[0][0] : vAc[0][0]; v2[0][1] = last ? vAn[0][1] : vAc[0][1]; v2[1][0] = last ? vAn[1][0] : vAc[1][0]; v2[1][1] = last ? vAn[1][1] : vAc[1][1]; }
            else { v2[0][0] = vAc[0][0]; v2[0][1] = vAc[0][1]; v2[1][0] = vAc[1][0]; v2[1][1] = vAc[1][1]; }
            PG8_LDB(B0, 0, 0); PG8_SCHED; PG8_LDA(At, 0, 0); PG8_STAGE(PG8_SA(1, 1), a1, vAc[1]);
            PG8_WAIT_L(8); PG8_BAR; PG8_WAIT_L(0); PG8_MMA(0, 0, At, B0); PG8_BAR; PG8_SCHED;
            PG8_LDB(B1, 0, 1); PG8_STAGE(PG8_SB(0, 0), b2, voffB);
            PG8_BAR; PG8_WAIT_L(0); PG8_MMA(0, 1, At, B1); PG8_BAR;
            PG8_LDA(At, 0, 1); PG8_STAGE(PG8_SA(0, 0), a2, v2[0]);
            PG8_BAR; PG8_WAIT_L(0); PG8_MMA(1, 0, At, B0); PG8_BAR; PG8_SCHED;
            PG8_STAGE(PG8_SB(0, 1), b2 + hstep, voffB);
            PG8_WAIT_V(6); PG8_BAR; PG8_MMA(1, 1, At, B1); PG8_BAR;
            PG8_LDB(B0, 1, 0); PG8_SCHED; PG8_LDA(At, 1, 0); PG8_STAGE(PG8_SA(0, 1), a2, v2[1]);
            PG8_WAIT_L(8); PG8_BAR; PG8_WAIT_L(0); PG8_MMA(0, 0, At, B0); PG8_BAR; PG8_SCHED;
            PG8_LDB(B1, 1, 1); PG8_STAGE(PG8_SB(1, 0), b3, voffB);
            PG8_BAR; PG8_WAIT_L(0); PG8_MMA(0, 1, At, B1); PG8_BAR;
            PG8_LDA(At, 1, 1); PG8_STAGE(PG8_SA(1, 0), a3, v2[0]);
            PG8_BAR; PG8_WAIT_L(0); PG8_MMA(1, 0, At, B0); PG8_BAR; PG8_SCHED;
            PG8_STAGE(PG8_SB(1, 1), b3 + hstep, voffB);
            PG8_WAIT_V(6); PG8_BAR; PG8_MMA(1, 1, At, B1); PG8_BAR;
        }
        E(acc, cur, wr, wc, fr, fq);
        if (!has_next) break;
#pragma unroll
        for (int a = 0; a < 2; ++a)
#pragma unroll
            for (int b = 0; b < 2; ++b)
#pragma unroll
                for (int m = 0; m < 4; ++m)
#pragma unroll
                    for (int n = 0; n < 2; ++n) acc[a][b][m][n] = (f32x4){0.f, 0.f, 0.f, 0.f};
        cur = nxt; cA = nA; cB = nB; ++ui;
        if (GATHER) { vAc[0][0] = vAn[0][0]; vAc[0][1] = vAn[0][1]; vAc[1][0] = vAn[1][0]; vAc[1][1] = vAn[1][1]; }
    }
    PG8_WAIT_V(0);
    if (wr == 0) PG8_BAR;
    PG8_BAR;
#undef PG8_SA
#undef PG8_SB
#undef PG8_STAGE
#undef PG8_LDA
#undef PG8_LDB
#undef PG8_MMA
#undef PG8_WAIT_V
#undef PG8_WAIT_L
#undef PG8_BAR
#undef PG8_SCHED
}
}
constexpr size_t MiB = 1u << 20;
constexpr size_t WS_CTL = 0, CTL_ZERO_BYTES = 1 * MiB;
constexpr size_t WS_MOD = 1 * MiB;
constexpr size_t WS_ROPE = WS_MOD + 256 * 1024;
constexpr size_t WS_MISC = WS_ROPE + 256 * 1024;
constexpr size_t WS_WAB_IN = 2 * MiB;
constexpr size_t WS_WAB_OUT = 20 * MiB;
constexpr size_t WS_WDA_IN = 26 * MiB;
constexpr size_t WS_WDA_OUT = 38 * MiB;
constexpr size_t WS_WR = 42 * MiB;
constexpr size_t WS_W3T = 43 * MiB;
constexpr size_t WS_HID2C = WS_W3T + 512 * 1024;
constexpr size_t WS_WGU = 44 * MiB;
constexpr size_t WS_WD = 109 * MiB;
constexpr size_t WS_XRES = 142 * MiB;
constexpr size_t WS_H = 207 * MiB;
constexpr size_t WS_LTOK = 240 * MiB;
constexpr size_t WS_LW = WS_LTOK + 5 * MiB;
constexpr size_t WS_SLOT = WS_LW + 5 * MiB;
constexpr size_t WS_SLOTW = WS_SLOT + 1 * MiB;
constexpr size_t WS_U = 252 * MiB;
constexpr size_t WS_PROJ = WS_U;
constexpr size_t WS_TAPS = WS_U;
constexpr size_t WS_CAT = WS_U + 147 * MiB;
constexpr size_t WS_UPD = WS_U + 196 * MiB;
constexpr size_t WS_SPREV = WS_U + 261 * MiB;
constexpr size_t WS_UT = WS_U + 326 * MiB;
constexpr size_t WS_YT = WS_U + 374 * MiB;
constexpr size_t WS_HSPEC = WS_U + 390 * MiB;
constexpr size_t WS_Y1 = WS_U + 519 * MiB;
constexpr size_t WS_MIX_END = WS_U + 551 * MiB;
constexpr int MAX_TILES = 649;
constexpr size_t WS_ACT = WS_U;
constexpr size_t WS_YSLOT = WS_U + 82 * MiB;
constexpr size_t WS_HLO = WS_YSLOT;
constexpr size_t WS_END = WS_U + 551 * MiB;
static_assert(WS_YSLOT + (size_t)MAX_TILES * 256 * 1024 * 2 <= WS_END, "moe view");
static_assert(WS_HSPEC + (size_t)2 * 512 * HSPEC_LD * 8 <= WS_MIX_END, "mixer view");

constexpr int CW_BAR = 1024;
constexpr int CW_CNT = 8192;
constexpr int CW_ERR = 16;

constexpr int LDS_BIG = 139264;
constexpr int LDS_MISC = LDS_BIG;
constexpr int LDS_BYTES = LDS_BIG + 16384;
constexpr int NTHREADS = 512;

struct Params {
    const float* in[34];
    float* out;
    unsigned char* ws;
    int ph_lo, ph_hi;
};

typedef const __attribute__((address_space(4))) Params* KParams;
#define PREF const __attribute__((address_space(4))) Params&
__device__ __forceinline__ KParams opaque_kp(KParams p) { asm volatile("" : "+s"(p)); return p; }
struct Ctx {
    KParams p;
    LAS unsigned char* lds;
    int tid, lane, wid, G, bid, cnt_off, pass;
    unsigned char* ws;
};

template <class RowMap>
__device__ __forceinline__ void cvt_tile(const Ctx& c, const float* src, int ldn, int k0, int n0, bf16_t* dst, int ldk, const RowMap& rm) {
    LAS float* t = (LAS float*)c.lds;
    const int tid = c.tid;
    {   const int kr = tid >> 4, nc = (tid & 15) * 4;
#pragma unroll
        for (int h = 0; h < 2; ++h) { const f32x4 v = *(const f32x4*)(src + (size_t)(k0 + kr + 32 * h) * ldn + n0 + nc);
            t[(kr + 32 * h) * 65 + nc + 0] = v[0]; t[(kr + 32 * h) * 65 + nc + 1] = v[1]; t[(kr + 32 * h) * 65 + nc + 2] = v[2]; t[(kr + 32 * h) * 65 + nc + 3] = v[3]; } }
    __syncthreads();
    {   const int n = tid >> 3, k8 = (tid & 7) * 8; float f[8];
#pragma unroll
        for (int j = 0; j < 8; ++j) f[j] = t[(k8 + j) * 65 + n];
        u32x4 w; w.x = cvtpk(f[0], f[1]); w.y = cvtpk(f[2], f[3]); w.z = cvtpk(f[4], f[5]); w.w = cvtpk(f[6], f[7]);
        *(u32x4*)(dst + (size_t)rm(n0 + n) * ldk + k0 + k8) = w; }
    __syncthreads();
}
struct RowId { __device__ __forceinline__ int operator()(int n) const { return n; } };
struct RowAbIn { __device__ __forceinline__ int operator()(int n) const { if (n >= 1024) return n; const int d = n & 127; return (n & ~127) + ((d < 64) ? 2 * d : 2 * (d - 64) + 1); } };
struct RowDaIn { __device__ __forceinline__ int operator()(int n) const { if (n >= 2048) return n; const int d = n & 63; return (n & ~63) + ((d < 32) ? 2 * d : 2 * (d - 32) + 1); } };
struct RowGate { __device__ __forceinline__ int operator()(int n) const { return (n >> 7) * 256 + (n & 127); } };
struct RowUp   { __device__ __forceinline__ int operator()(int n) const { return (n >> 7) * 256 + 128 + (n & 127); } };

__device__ __forceinline__ void cvt_router_tile(const Ctx& c, const float* src, int k0, bf16_t* dhi, bf16_t* dlo) {
    LAS float* t = (LAS float*)c.lds; const int tid = c.tid;
    {   const int kr = tid >> 4, nc = (tid & 15) * 4;
#pragma unroll
        for (int h = 0; h < 2; ++h) { const f32x4 v = *(const f32x4*)(src + (size_t)(k0 + kr + 32 * h) * 64 + nc);
            t[(kr + 32 * h) * 65 + nc + 0] = v[0]; t[(kr + 32 * h) * 65 + nc + 1] = v[1]; t[(kr + 32 * h) * 65 + nc + 2] = v[2]; t[(kr + 32 * h) * 65 + nc + 3] = v[3]; } }
    __syncthreads();
    {   const int n = tid >> 3, k8 = (tid & 7) * 8; float f[8], g[8];
#pragma unroll
        for (int j = 0; j < 8; ++j) { f[j] = t[(k8 + j) * 65 + n]; const float h = bf2f(f2bf(f[j])); g[j] = f[j] - h; f[j] = h; }
        u32x4 w; w.x = cvtpk(f[0], f[1]); w.y = cvtpk(f[2], f[3]); w.z = cvtpk(f[4], f[5]); w.w = cvtpk(f[6], f[7]);
        *(u32x4*)(dhi + (size_t)n * 1024 + k0 + k8) = w;
        w.x = cvtpk(g[0], g[1]); w.y = cvtpk(g[2], g[3]); w.z = cvtpk(g[4], g[5]); w.w = cvtpk(g[6], g[7]);
        *(u32x4*)(dlo + (size_t)n * 1024 + k0 + k8) = w; }
    __syncthreads();
}

__device__ __forceinline__ void phase_pr0(const Ctx& c) {
    PREF P = *c.p; unsigned char* ws = c.ws;
    const int T_ABIN = 2 * 16 * 72, T_ABOUT = 2 * 24 * 16, T_DAIN = 2 * 16 * 48, T_DAOUT = 2 * 16 * 16, T_R = 4 * 16, T_W3 = 2 * 1 * 32;
    const int T_ALL = T_ABIN + T_ABOUT + T_DAIN + T_DAOUT + T_R + T_W3;
    for (int u = c.bid; u < T_ALL; u += c.G) {
        int v = u;
        if (v < T_ABIN) { const int j = v / (16 * 72), r = v % (16 * 72), kt = r / 72, ntile = r % 72;
            cvt_tile(c, P.in[8] + (size_t)j * 1024 * AB_IN, AB_IN, kt * 64, ntile * 64, (bf16_t*)(ws + WS_WAB_IN) + (size_t)j * AB_IN * 1024, 1024, RowAbIn()); continue; }
        v -= T_ABIN;
        if (v < T_ABOUT) { const int j = v / (24 * 16), r = v % (24 * 16), kt = r / 16, ntile = r % 16;
            cvt_tile(c, P.in[9] + (size_t)j * AB_CAT * 1024, 1024, kt * 64, ntile * 64, (bf16_t*)(ws + WS_WAB_OUT) + (size_t)j * 1024 * AB_CAT, AB_CAT, RowId()); continue; }
        v -= T_ABOUT;
        if (v < T_DAIN) { const int j = v / (16 * 48), r = v % (16 * 48), kt = r / 48, ntile = r % 48;
            cvt_tile(c, P.in[21] + (size_t)j * 1024 * DA_IN, DA_IN, kt * 64, ntile * 64, (bf16_t*)(ws + WS_WDA_IN) + (size_t)j * DA_IN * 1024, 1024, RowDaIn()); continue; }
        v -= T_DAIN;
        if (v < T_DAOUT) { const int j = v / (16 * 16), r = v % (16 * 16), kt = r / 16, ntile = r % 16;
            cvt_tile(c, P.in[22] + (size_t)j * 1024 * 1024, 1024, kt * 64, ntile * 64, (bf16_t*)(ws + WS_WDA_OUT) + (size_t)j * 1024 * 1024, 1024, RowId()); continue; }
        v -= T_DAOUT;
        if (v < T_R) { const int i = v / 16, kt = v % 16;
            cvt_router_tile(c, P.in[25] + (size_t)i * 1024 * 64, kt * 64, (bf16_t*)(ws + WS_WR) + (size_t)(i * 2 + 0) * 64 * 1024, (bf16_t*)(ws + WS_WR) + (size_t)(i * 2 + 1) * 64 * 1024); continue; }
        v -= T_R;
        { const int j = v / 32, ntile = v % 32;
            cvt_tile(c, P.in[19] + (size_t)j * 64 * 2048, 2048, 0, ntile * 64, (bf16_t*)(ws + WS_W3T) + (size_t)j * 2048 * 64, 64, RowId()); }
    }
    {
        LAS float* red = (LAS float*)c.lds;
        for (int u = c.bid; u < 192; u += c.G) {
            const int i = u / 48, j0 = (u % 48) * 128, col = c.tid & 127, kg = c.tid >> 7;
            const float* w = P.in[4] + (size_t)i * 1024 * 6144 + j0 + col;
            float a0 = 0.f, a1 = 0.f;
#pragma unroll 8
            for (int k = kg * 256; k < kg * 256 + 256; ++k) { const float wv = w[(size_t)k * 6144]; a0 += siluf(P.in[1][k]) * wv; a1 += siluf(P.in[3][k]) * wv; }
            red[(kg * 2 + 0) * 128 + col] = a0; red[(kg * 2 + 1) * 128 + col] = a1;
            __syncthreads();
            if (c.tid < 256) { const int s = c.tid >> 7; float v = 0.f;
#pragma unroll
                for (int g = 0; g < 4; ++g) v += red[(g * 2 + s) * 128 + col];
                ((float*)(ws + WS_MOD))[(size_t)(i * 2 + s) * 6144 + j0 + col] = v + P.in[5][(size_t)i * 6144 + j0 + col]; }
            __syncthreads();
        }
    }
    {
        f32x2* rt = (f32x2*)(ws + WS_ROPE);
        const int NRR = 256 * 32, NRC = 64 * 32, NDR = 256 * 16, NDC = 64 * 16;
        for (int idx = c.bid * NTHREADS + c.tid; idx < NRR + NRC + NDR + NDC; idx += c.G * NTHREADS) {
            int v = idx; float pos, inv;
            if (v < NRR) { pos = (float)(v >> 5); inv = powf(10000.f, -(float)(v & 31) / 32.f); }
            else if ((v -= NRR) < NRC) { pos = (float)(v >> 5); inv = powf(10000.f, -(float)(v & 31) / 32.f); }
            else if ((v -= NRC) < NDR) { pos = (float)(v >> 4); inv = powf(10000.f, -(float)(v & 15) / 16.f); }
            else { v -= NDR; pos = (float)(v >> 4); inv = powf(10000.f, -(float)(v & 15) / 16.f); }
            const float ang = pos * inv;
            rt[idx] = (f32x2){cosf(ang), sinf(ang)};
        }
    }
    if (c.bid == 0 && c.wid < 2) {
        const int j = c.wid; const float* lam = P.in[23] + (size_t)j * 4 * 64;
        float a = lam[c.lane] * lam[64 + c.lane], b = lam[128 + c.lane] * lam[192 + c.lane];
        a = wave_sum(a); b = wave_sum(b);
        const float linit = 0.8f - 0.6f * expf(-0.3f * (float)(2 * j + 1));
        if (c.lane == 0) { ((float*)(ws + WS_MISC))[j * 2 + 0] = expf(a) - expf(b) + linit; ((float*)(ws + WS_MISC))[j * 2 + 1] = linit; }
    }
}

__device__ __forceinline__ void norm_rows(const Ctx& c, int layer, int which  , const float* gain, int row_lo, int row_hi, const float* xsrc_lat, const float* xsrc_ctx, bf16_t* dst) {
    const float* mod = (const float*)(c.ws + WS_MOD) + (size_t)layer * 2 * 6144;
    const int sh_off = which ? 3 * 1024 : 0, sc_off = which ? 4 * 1024 : 1024;
    for (int row = row_lo + c.bid * 8 + c.wid; row < row_hi; row += c.G * 8) {
        const float* x = (row < NC) ? (xsrc_ctx + (size_t)row * D) : (xsrc_lat + (size_t)(row - NC) * D);
        const float* m = mod + ((row < NC) ? 6144 : 0);
        f32x4 v[4]; float ss = 0.f;
#pragma unroll
        for (int q = 0; q < 4; ++q) { v[q] = *(const f32x4*)(x + q * 256 + c.lane * 4); ss += v[q][0] * v[q][0] + v[q][1] * v[q][1] + v[q][2] * v[q][2] + v[q][3] * v[q][3]; }
        ss = wave_sum(ss);
        const float rstd = rsqrtf(ss * (1.0f / 1024.f) + EPS);
#pragma unroll
        for (int q = 0; q < 4; ++q) { const int col = q * 256 + c.lane * 4;
            const f32x4 g = *(const f32x4*)(gain + col), sc = *(const f32x4*)(m + sc_off + col), sh = *(const f32x4*)(m + sh_off + col);
            float o[4];
#pragma unroll
            for (int j = 0; j < 4; ++j) o[j] = v[q][j] * rstd * g[j] * (1.0f + sc[j]) + sh[j];
            u32x2 w; w.x = cvtpk(o[0], o[1]); w.y = cvtpk(o[2], o[3]);
            *(u32x2*)(dst + (size_t)row * D + col) = w; }
    }
}

__device__ __forceinline__ void phase_pr1(const Ctx& c) {
    PREF P = *c.p;
    float* xres = (float*)(c.ws + WS_XRES);
    for (size_t i = (size_t)c.bid * NTHREADS + c.tid; i < (size_t)NTOK * D / 4; i += (size_t)c.G * NTHREADS) {
        const size_t e = i * 4; const f32x4 v = (e < (size_t)NC * D) ? *(const f32x4*)(P.in[2] + e) : *(const f32x4*)(P.in[0] + (e - (size_t)NC * D));
        *(f32x4*)(xres + e) = v; }
    norm_rows(c, 0, 0, P.in[6], 0, NTOK, P.in[0], P.in[2], (bf16_t*)(c.ws + WS_H));
}
__device__ __forceinline__ int xcd_remap(int L, int n) { const int q = n / 8, r = n % 8, x = L % 8, off = L / 8; return (x < r ? x * (q + 1) : r * (q + 1) + (x - r) * q) + off; }

struct DenseSched {
    const char* A; const char* Bt; int K, nM, nN, pm0, G, c, nwg;
    __device__ __forceinline__ void init(const void* A_, const void* Bt_, int K_, int nM_, int nN_, int pm0_, int G_, int c_) { A = (const char*)A_; Bt = (const char*)Bt_; K = K_; nM = nM_ - pm0_; nN = nN_; pm0 = pm0_; G = G_; c = c_; nwg = nM * nN; }
    __device__ __forceinline__ bool next(int i, pg8::Unit& u) const {
        const long L = (long)i * G + c; if (L >= nwg) return false;
        const int wgid = xcd_remap((int)L, nwg);
        const int WGM = 8, nig = WGM * nN, gid = wgid / nig, fm = gid * WGM, gsz = (nM - fm) < WGM ? (nM - fm) : WGM;
        u.pm = pm0 + fm + ((wgid % nig) % gsz); u.pn = (wgid % nig) / gsz; u.e = 0; u.aux = 0;
        u.A = A + (size_t)u.pm * 256 * K * 2; u.B = Bt + (size_t)u.pn * 256 * K * 2; return true;
    }
    __device__ __forceinline__ void offsets(const pg8::Unit&, const int (&)[2], const int (&)[2], unsigned (&)[2][2]) const {}
};

struct MoeTable { const LAS int* tb; const LAS int* cn; };
__device__ __forceinline__ int moe_find(const MoeTable& t, int T) { int e = 0;
#pragma unroll 1
    for (int s = 64; s >= 1; s >>= 1) { if (e + s <= 64 && t.tb[e + s] <= T) e += s; } return e; }

struct MoeUpSched {
    MoeTable t; const char* H; const char* W; const int* ltok; int tok0, G, c, nwg;
    __device__ __forceinline__ bool next(int i, pg8::Unit& u) const {
        const long L = (long)i * G + c; if (L >= nwg) return false;
        const int id = xcd_remap((int)L, nwg); const int T = id >> 1; u.pn = id & 1; u.pm = T; u.e = moe_find(t, T); u.aux = T - t.tb[u.e];
        u.A = H; u.B = W + ((size_t)u.e * 512 + (size_t)u.pn * 256) * 1024 * 2; return true;
    }
    __device__ __forceinline__ void offsets(const pg8::Unit& u, const int (&Rr)[2], const int (&Cc)[2], unsigned (&vo)[2][2]) const {
        const int cnt = t.cn[u.e];
#pragma unroll
        for (int h = 0; h < 2; ++h)
#pragma unroll
            for (int i = 0; i < 2; ++i) { const int pos = u.aux * 256 + h * 128 + Rr[i]; int tok;
                if (u.e == 64) tok = tok0 + (pos < cnt ? pos : 0); else tok = (pos < cnt) ? ltok[(size_t)u.e * NTOK + pos] : tok0;
                vo[h][i] = (unsigned)(tok * 1024 + Cc[i]) * 2u; }
    }
};
struct MoeDownSched {
    MoeTable t; const char* ACT; const char* W; int G, c, nwg;
    __device__ __forceinline__ bool next(int i, pg8::Unit& u) const {
        const long L = (long)i * G + c; if (L >= nwg) return false;
        const int id = xcd_remap((int)L, nwg); const int T = id >> 2; u.pn = id & 3; u.pm = T; u.e = moe_find(t, T); u.aux = T - t.tb[u.e];
        u.A = ACT + (size_t)T * 256 * 256 * 2; u.B = W + ((size_t)u.e * 1024 + (size_t)u.pn * 256) * 256 * 2; return true;
    }
    __device__ __forceinline__ void offsets(const pg8::Unit&, const int (&)[2], const int (&)[2], unsigned (&)[2][2]) const {}
};

__device__ __forceinline__ void rope8(f32x4& v0, f32x4& v1, const f32x2* cs) {
    const f32x4 t0 = *(const f32x4*)(cs), t1 = *(const f32x4*)(cs + 2);
    float a, b;
    a = v0[0]; b = v0[1]; v0[0] = a * t0[0] - b * t0[1]; v0[1] = b * t0[0] + a * t0[1];
    a = v0[2]; b = v0[3]; v0[2] = a * t0[2] - b * t0[3]; v0[3] = b * t0[2] + a * t0[3];
    a = v1[0]; b = v1[1]; v1[0] = a * t1[0] - b * t1[1]; v1[1] = b * t1[0] + a * t1[1];
    a = v1[2]; b = v1[3]; v1[2] = a * t1[2] - b * t1[3]; v1[3] = b * t1[2] + a * t1[3];
}
struct EpiAbIn {
    static constexpr bool PERM = true;
    bf16_t* O; const f32x2* rope;
    __device__ __forceinline__ void operator()(const f32x4 (&acc)[2][2][4][2], const pg8::Unit& u, int wr, int wc, int fr, int fq) const {
        const int row0 = u.pm * 256 + wr * 64 + fr, colt = u.pn * 256 + wc * 32 + 8 * fq;
        const bool qk = u.pn < 4, lat = u.pm >= 1; const float ksc = (u.pn >= 2 && u.pn < 4) ? 0.08838834764831845f : 1.0f;
#pragma unroll
        for (int ai = 0; ai < 2; ++ai)
#pragma unroll
            for (int m = 0; m < 4; ++m) { const int row = row0 + ai * 128 + m * 16; bf16_t* rowp = O + (size_t)row * AB_IN + colt; const int t = row - NC;
#pragma unroll
                for (int bj = 0; bj < 2; ++bj) { f32x4 v0 = acc[ai][bj][m][0], v1 = acc[ai][bj][m][1];
                    if (qk) { if (lat) { const int p0 = ((colt + bj * 128) & 127) >> 1;
                            const f32x2* cs = (p0 < 32) ? rope + (size_t)(t >> 6) * 32 + p0 : rope + 256 * 32 + (size_t)(t & 63) * 32 + (p0 - 32);
                            rope8(v0, v1, cs); }
                        v0 *= ksc; v1 *= ksc; }
                    u32x4 w; w.x = cvtpk(v0[0], v0[1]); w.y = cvtpk(v0[2], v0[3]); w.z = cvtpk(v1[0], v1[1]); w.w = cvtpk(v1[2], v1[3]);
                    *(u32x4*)(rowp + bj * 128) = w; } }
    }
};
struct EpiDaIn {
    static constexpr bool PERM = true;
    bf16_t* O; const f32x2* rope;
    __device__ __forceinline__ void operator()(const f32x4 (&acc)[2][2][4][2], const pg8::Unit& u, int wr, int wc, int fr, int fq) const {
        const int row0 = u.pm * 256 + wr * 64 + fr, colt = u.pn * 256 + wc * 32 + 8 * fq;
        const bool qk = u.pn < 8, lat = u.pm >= 1; const float qsc = (u.pn < 4) ? 0.125f * 1.4426950408889634f : 1.0f;
#pragma unroll
        for (int ai = 0; ai < 2; ++ai)
#pragma unroll
            for (int m = 0; m < 4; ++m) { const int row = row0 + ai * 128 + m * 16; bf16_t* rowp = O + (size_t)row * DA_IN + colt; const int t = row - NC;
#pragma unroll
                for (int bj = 0; bj < 2; ++bj) { f32x4 v0 = acc[ai][bj][m][0], v1 = acc[ai][bj][m][1];
                    if (qk) { if (lat) { const int p0 = ((colt + bj * 128) & 63) >> 1;
                            const f32x2* cs = (p0 < 16) ? rope + (size_t)(t >> 6) * 16 + p0 : rope + 256 * 16 + (size_t)(t & 63) * 16 + (p0 - 16);
                            rope8(v0, v1, cs); }
                        v0 *= qsc; v1 *= qsc; }
                    u32x4 w; w.x = cvtpk(v0[0], v0[1]); w.y = cvtpk(v0[2], v0[3]); w.z = cvtpk(v1[0], v1[1]); w.w = cvtpk(v1[2], v1[3]);
                    *(u32x4*)(rowp + bj * 128) = w; } }
    }
};
struct EpiResid {
    static constexpr bool PERM = false;
    float* X; const float* mod;
    __device__ __forceinline__ void operator()(const f32x4 (&acc)[2][2][4][2], const pg8::Unit& u, int wr, int wc, int fr, int fq) const {
        const int row0 = u.pm * 256 + wr * 64 + fr, col0 = u.pn * 256 + wc * 32 + 4 * fq;
        const float* g = mod + ((u.pm == 0) ? 6144 : 0) + 2 * 1024;
        f32x4 gv[2][2];
#pragma unroll
        for (int bj = 0; bj < 2; ++bj)
#pragma unroll
            for (int n = 0; n < 2; ++n) gv[bj][n] = *(const f32x4*)(g + col0 + bj * 128 + n * 16);
#pragma unroll
        for (int ai = 0; ai < 2; ++ai)
#pragma unroll
            for (int m = 0; m < 4; ++m) { float* rowp = X + (size_t)(row0 + ai * 128 + m * 16) * D + col0;
#pragma unroll
                for (int bj = 0; bj < 2; ++bj)
#pragma unroll
                    for (int n = 0; n < 2; ++n) { f32x4* p = (f32x4*)(rowp + bj * 128 + n * 16); *p = *p + gv[bj][n] * acc[ai][bj][m][n]; } }
    }
};
struct EpiSwiglu {
    static constexpr bool PERM = true;
    bf16_t* ACT;
    __device__ __forceinline__ void operator()(const f32x4 (&acc)[2][2][4][2], const pg8::Unit& u, int wr, int wc, int fr, int fq) const {
        const int row0 = u.pm * 256 + wr * 64 + fr, col0 = u.pn * 128 + wc * 32 + 8 * fq;
#pragma unroll
        for (int ai = 0; ai < 2; ++ai)
#pragma unroll
            for (int m = 0; m < 4; ++m) { bf16_t* rowp = ACT + (size_t)(row0 + ai * 128 + m * 16) * 256 + col0; float o[8];
#pragma unroll
                for (int n = 0; n < 2; ++n)
#pragma unroll
                    for (int j = 0; j < 4; ++j) { const float g = acc[ai][0][m][n][j], up = acc[ai][1][m][n][j]; o[n * 4 + j] = siluf(g) * up; }
                u32x4 w; w.x = cvtpk(o[0], o[1]); w.y = cvtpk(o[2], o[3]); w.z = cvtpk(o[4], o[5]); w.w = cvtpk(o[6], o[7]);
                *(u32x4*)rowp = w; }
    }
};
struct EpiDown {
    static constexpr bool PERM = true;
    bf16_t* Y; const float* lw; MoeTable t;
    __device__ __forceinline__ void operator()(const f32x4 (&acc)[2][2][4][2], const pg8::Unit& u, int wr, int wc, int fr, int fq) const {
        const int r0 = wr * 64 + fr, col0 = u.pn * 256 + wc * 32 + 8 * fq; const int cnt = t.cn[u.e];
        float wv[2][4];
#pragma unroll
        for (int ai = 0; ai < 2; ++ai)
#pragma unroll
            for (int m = 0; m < 4; ++m) { const int pos = u.aux * 256 + r0 + ai * 128 + m * 16; const int pc = (pos < cnt) ? pos : 0;
                const float x = (u.e == 64) ? 1.0f : lw[(size_t)u.e * NTOK + pc]; wv[ai][m] = (u.e == 64 || pos < cnt) ? x : 0.0f; }
#pragma unroll
        for (int ai = 0; ai < 2; ++ai)
#pragma unroll
            for (int m = 0; m < 4; ++m) { const int r = r0 + ai * 128 + m * 16; const float w_ = wv[ai][m];
                bf16_t* rowp = Y + (size_t)(u.pm * 256 + r) * 1024 + col0;
#pragma unroll
                for (int bj = 0; bj < 2; ++bj) { const f32x4 v0 = acc[ai][bj][m][0] * w_, v1 = acc[ai][bj][m][1] * w_;
                    u32x4 w; w.x = cvtpk(v0[0], v0[1]); w.y = cvtpk(v0[2], v0[3]); w.z = cvtpk(v1[0], v1[1]); w.w = cvtpk(v1[2], v1[3]);
                    *(u32x4*)(rowp + bj * 128) = w; } }
    }
};
__device__ __forceinline__ int fphys(int i) { return i + ((i >> 6) << 2); }
__device__ __forceinline__ int brev14(int x) { return (int)(__brev((unsigned)x) >> 18); }
__device__ __forceinline__ int brevK(int s, int K) { return (int)(__brev((unsigned)s) >> (32 - K)); }
__device__ __forceinline__ void cmul(float& ar, float& ai, float br, float bi) { const float r = ar * br - ai * bi, i = ar * bi + ai * br; ar = r; ai = i; }
__device__ __forceinline__ constexpr float tw16c(int k) { return (k & 15) == 0 ? 1.f : (k & 15) == 1 ? 0.9238795325112867f : (k & 15) == 2 ? 0.7071067811865476f : (k & 15) == 3 ? 0.3826834323650898f : (k & 15) == 4 ? 0.f :
    (k & 15) == 5 ? -0.3826834323650898f : (k & 15) == 6 ? -0.7071067811865476f : (k & 15) == 7 ? -0.9238795325112867f : (k & 15) == 8 ? -1.f : (k & 15) == 9 ? -0.9238795325112867f : (k & 15) == 10 ? -0.7071067811865476f :
    (k & 15) == 11 ? -0.3826834323650898f : (k & 15) == 12 ? 0.f : (k & 15) == 13 ? 0.3826834323650898f : (k & 15) == 14 ? 0.7071067811865476f : 0.9238795325112867f; }
__device__ __forceinline__ constexpr float tw16s(int k) { return tw16c(k + 12); }

template <int LOGN, int K, bool INV>
__device__ __forceinline__ void fft_pass(LAS f32x2* z, int tid) {
    constexpr int R = 1 << K, LOGST = LOGN - K, ST = 1 << LOGST;
#pragma unroll 1
    for (int g = tid; g < FFT_M / R; g += NTHREADS) {
        const int b = g >> LOGST, j = g & (ST - 1), base = (b << LOGN) + j;
        float xr[R], xi[R];
#pragma unroll
        for (int q = 0; q < R; ++q) { const f32x2 v = z[fphys(base + (q << LOGST))]; xr[q] = v[0]; xi[q] = v[1]; }
        float wr_[R], wi_[R];
        if (LOGST > 0) {
            const float fr = (float)j * (1.0f / (float)(1 << LOGN));
            wr_[0] = 1.f; wi_[0] = 0.f;
#pragma unroll
            for (int bit = 1; bit < R; bit <<= 1) { const float a = fr * (float)bit; wr_[bit] = __builtin_amdgcn_cosf(a); wi_[bit] = INV ? __builtin_amdgcn_sinf(a) : -__builtin_amdgcn_sinf(a); }
#pragma unroll
            for (int r = 3; r < R; ++r) { if ((r & (r - 1)) != 0) { const int hb = 1 << (31 - __builtin_clz(r)); wr_[r] = wr_[hb]; wi_[r] = wi_[hb]; cmul(wr_[r], wi_[r], wr_[r - hb], wi_[r - hb]); } }
        }
        if (!INV) {
#pragma unroll
            for (int s = 0; s < K; ++s) { const int half = R >> (s + 1);
#pragma unroll
                for (int a = 0; a < R; ++a) if ((a & half) == 0) {
                    const int o = a & (half - 1); const int ti = o * (8 / half);
                    const float ur = xr[a], ui = xi[a], vr = xr[a + half], vi = xi[a + half];
                    xr[a] = ur + vr; xi[a] = ui + vi;
                    float dr = ur - vr, di = ui - vi;
                    if (half >= 1 && o != 0) cmul(dr, di, tw16c(ti), -tw16s(ti));
                    xr[a + half] = dr; xi[a + half] = di; } }
            if (LOGST > 0) {
#pragma unroll
                for (int s = 1; s < R; ++s) { const int r = brevK(s, K); cmul(xr[s], xi[s], wr_[r], wi_[r]); } }
        } else {
            if (LOGST > 0) {
#pragma unroll
                for (int s = 1; s < R; ++s) { const int r = brevK(s, K); cmul(xr[s], xi[s], wr_[r], wi_[r]); } }
#pragma unroll
            for (int s = K - 1; s >= 0; --s) { const int half = R >> (s + 1);
#pragma unroll
                for (int a = 0; a < R; ++a) if ((a & half) == 0) {
                    const int o = a & (half - 1); const int ti = o * (8 / half);
                    const float ur = xr[a], ui = xi[a]; float vr = xr[a + half], vi = xi[a + half];
                    if (o != 0) cmul(vr, vi, tw16c(ti), tw16s(ti));
                    xr[a] = ur + vr; xi[a] = ui + vi; xr[a + half] = ur - vr; xi[a + half] = ui - vi; } }
        }
#pragma unroll
        for (int q = 0; q < R; ++q) z[fphys(base + (q << LOGST))] = (f32x2){xr[q], xi[q]};
    }
}
__device__ __forceinline__ void fft_fwd(LAS f32x2* z, int tid) {
    fft_pass<14, 4, false>(z, tid); __syncthreads();
    fft_pass<10, 4, false>(z, tid); __syncthreads();
    fft_pass<6, 4, false>(z, tid);  __syncthreads();
    fft_pass<2, 2, false>(z, tid);  __syncthreads();
}
__device__ __forceinline__ void fft_inv(LAS f32x2* z, int tid) {
    fft_pass<2, 2, true>(z, tid);  __syncthreads();
    fft_pass<6, 4, true>(z, tid);  __syncthreads();
    fft_pass<10, 4, true>(z, tid); __syncthreads();
    fft_pass<14, 4, true>(z, tid); __syncthreads();
}
__device__ __forceinline__ void fft_pair_mul(LAS f32x2* z, const f32x2* Hs, int tid) {
    constexpr int M = FFT_M;
#pragma unroll 1
    for (int k = tid; k <= M / 2; k += NTHREADS) {
        if (k == 0) {
            const f32x2 z0 = z[0]; const float X0 = z0[0] + z0[1], XM = z0[0] - z0[1];
            const float Y0 = X0 * Hs[0][0], YM = XM * Hs[M][0];
            z[0] = (f32x2){0.5f * (Y0 + YM), 0.5f * (Y0 - YM)};
        } else {
            const int p1 = fphys(brev14(k)), p2 = fphys(brev14(M - k));
            const f32x2 zk = z[p1], zm = z[p2]; const f32x2 hk = Hs[k], hm = Hs[M - k];
            const float Er = 0.5f * (zk[0] + zm[0]), Ei = 0.5f * (zk[1] - zm[1]);
            const float Dr = 0.5f * (zk[0] - zm[0]), Di = 0.5f * (zk[1] + zm[1]);
            const float Or = Di, Oi = -Dr;
            const float a = (float)k * (1.0f / (float)(2 * M));
            const float wr = __builtin_amdgcn_cosf(a), wi = -__builtin_amdgcn_sinf(a);
            const float wOr = wr * Or - wi * Oi, wOi = wr * Oi + wi * Or;
            const float Xkr = Er + wOr, Xki = Ei + wOi;
            const float Xmr = Er - wOr, Xmi = -(Ei - wOi);
            const float Ykr = Xkr * hk[0] - Xki * hk[1], Yki = Xkr * hk[1] + Xki * hk[0];
            const float Ymr = Xmr * hm[0] - Xmi * hm[1], Ymi = Xmr * hm[1] + Xmi * hm[0];
            const float Yer = 0.5f * (Ykr + Ymr), Yei = 0.5f * (Yki - Ymi);
            const float Fr = 0.5f * (Ykr - Ymr), Fi = 0.5f * (Yki + Ymi);
            const float Yor = Fr * wr + Fi * wi, Yoi = Fi * wr - Fr * wi;
            z[p1] = (f32x2){Yer - Yoi, Yei + Yor};
            if (p2 != p1) z[p2] = (f32x2){Yer + Yoi, -Yei + Yor};
        }
    }
}
__device__ __forceinline__ void fft_unpack_store(const LAS f32x2* z, f32x2* Hs, float sc, int tid) {
    constexpr int M = FFT_M;
#pragma unroll 1
    for (int k = tid; k <= M / 2; k += NTHREADS) {
        if (k == 0) { const f32x2 z0 = z[0]; Hs[0] = (f32x2){(z0[0] + z0[1]) * sc, 0.f}; Hs[M] = (f32x2){(z0[0] - z0[1]) * sc, 0.f}; }
        else {
            const f32x2 zk = z[fphys(brev14(k))], zm = z[fphys(brev14(M - k))];
            const float Er = 0.5f * (zk[0] + zm[0]), Ei = 0.5f * (zk[1] - zm[1]);
            const float Dr = 0.5f * (zk[0] - zm[0]), Di = 0.5f * (zk[1] + zm[1]);
            const float Or = Di, Oi = -Dr;
            const float a = (float)k * (1.0f / (float)(2 * M));
            const float wr = __builtin_amdgcn_cosf(a), wi = -__builtin_amdgcn_sinf(a);
            const float wOr = wr * Or - wi * Oi, wOi = wr * Oi + wi * Or;
            Hs[k] = (f32x2){(Er + wOr) * sc, (Ei + wOi) * sc};
            if (k != M - k) Hs[M - k] = (f32x2){(Er - wOr) * sc, -(Ei - wOi) * sc};
        }
    }
}
__device__ __forceinline__ int crow(int r, int hi) { return (r & 3) + 8 * (r >> 2) + 4 * hi; }
__device__ __forceinline__ bf16x8 ldfrag(const LAS unsigned char* base, int pitch, int row, int kbyte) { return *(const LAS bf16x8*)(base + row * pitch + kbyte); }
constexpr int P136 = 272;

__device__ __forceinline__ float ret_log2g(const float* decay_logit, int dir, int h) { const float x = decay_logit[dir * 4 + h]; return -log1pf(expf(-x)) * 1.4426950408889634f; }

__device__ __forceinline__ void phase_f1(const Ctx& c, int j) {
    PREF P = *c.p;
    const float* w1 = P.in[13] + (size_t)j * 33 * 64; const float* b1 = P.in[14] + j * 64; const float* f1 = P.in[15] + j * 64;
    const float* w2 = P.in[16] + (size_t)j * 64 * 64; const float* b2 = P.in[17] + j * 64; const float* f2 = P.in[18] + j * 64;
    const bf16_t* w3t = (const bf16_t*)(c.ws + WS_W3T) + (size_t)j * 2048 * 64;
    float* taps = (float*)(c.ws + WS_TAPS); float* hid2c = (float*)(c.ws + WS_HID2C);
    LAS float* zs = (LAS float*)c.lds;
    LAS float* h1s = (LAS float*)(c.lds + 18432);
    LAS float* w1s = (LAS float*)(c.lds + 51712);
    LAS float* w2s = (LAS float*)(c.lds + 60160);
    LAS unsigned char* hb = c.lds + 76544;
    LAS unsigned char* as = c.lds + 94976;
    for (int u = c.bid; u < 130; u += c.G) {
        const int tid = opaque(c.tid);
        const bool isctx = u >= 128; const int L = isctx ? 256 : 16384; const int t0 = isctx ? (u - 128) * 128 : u * 128;
        for (int i = tid; i < 33 * 64; i += NTHREADS) w1s[i] = w1[i];
        for (int i = tid; i < 64 * 64; i += NTHREADS) w2s[i] = w2[i];
        {
            const int tl = tid >> 2, part = tid & 3; const float t = (float)(t0 + tl);
            if (part == 0) zs[tl * 36 + 0] = t / (float)(L - 1);
#pragma unroll
            for (int q = 0; q < 4; ++q) { const int b = part * 4 + q; const float band = 1e-4f + (float)b * ((15.0f - 1e-4f) / 15.0f);
                const float ang = (6.283185307179586f / (float)L) * t * band;
                zs[tl * 36 + 1 + b] = __cosf(ang); zs[tl * 36 + 17 + b] = -__sinf(ang); }
        }
        __syncthreads();
        {   const int tl = tid >> 2, og = (tid & 3) * 16; float a[16];
#pragma unroll
            for (int o = 0; o < 16; ++o) a[o] = b1[og + o];
#pragma unroll 1
            for (int f = 0; f < 33; ++f) { const float zv = zs[tl * 36 + f];
#pragma unroll
                for (int o = 0; o < 16; ++o) a[o] += zv * w1s[f * 64 + og + o]; }
#pragma unroll
            for (int o = 0; o < 16; ++o) h1s[tl * 65 + og + o] = __sinf(f1[og + o] * a[o]);
        }
        __syncthreads();
        {   const int tl = tid >> 2, og = (tid & 3) * 16; float a[16];
#pragma unroll
            for (int o = 0; o < 16; ++o) a[o] = b2[og + o];
#pragma unroll 1
            for (int k = 0; k < 64; ++k) { const float hv = h1s[tl * 65 + k];
#pragma unroll
                for (int o = 0; o < 16; ++o) a[o] += hv * w2s[k * 64 + og + o]; }
#pragma unroll
            for (int o = 0; o < 16; ++o) a[o] = __sinf(f2[og + o] * a[o]);
            if (isctx) {
#pragma unroll
                for (int o = 0; o < 16; ++o) hid2c[(size_t)(t0 + tl) * 64 + og + o] = a[o];
            } else {
#pragma unroll
                for (int o = 0; o < 16; o += 2) *(LAS unsigned*)(hb + tl * 144 + (og + o) * 2) = cvtpk(a[o], a[o + 1]);
            }
        }
        __syncthreads();
        if (!isctx) {
            const int lane = tid & 63, r32 = lane & 31, hi = lane >> 5, w = __builtin_amdgcn_readfirstlane(tid >> 6);
#pragma unroll 1
            for (int cc = 0; cc < 8; ++cc) {
                {   const int row = tid >> 1, hf = tid & 1; const u32x4* src = (const u32x4*)(w3t + (size_t)(cc * 256 + row) * 64 + hf * 32);
#pragma unroll
                    for (int q = 0; q < 4; ++q) *(LAS u32x4*)(as + row * 144 + hf * 64 + q * 16) = src[q]; }
                __syncthreads();
                f32x16 acc[4];
#pragma unroll
                for (int ni = 0; ni < 4; ++ni) acc[ni] = (f32x16){};
#pragma unroll
                for (int ks = 0; ks < 4; ++ks) { const bf16x8 a = ldfrag(as, 144, 32 * w + r32, ks * 32 + hi * 16);
#pragma unroll
                    for (int ni = 0; ni < 4; ++ni) { const bf16x8 b = ldfrag(hb, 144, 32 * ni + r32, ks * 32 + hi * 16); acc[ni] = __builtin_amdgcn_mfma_f32_32x32x16_bf16(a, b, acc[ni], 0, 0, 0); } }
#pragma unroll
                for (int ni = 0; ni < 4; ++ni) { const int t = t0 + 32 * ni + r32; const float tn = (float)t * (1.0f / 16383.0f);
#pragma unroll
                    for (int r = 0; r < 16; ++r) { const int fc = cc * 256 + 32 * w + crow(r, hi); const int ch = fc & 511;
                        const float delta = 3.0701134573253945f + (15.350567286626972f - 3.0701134573253945f) * ((float)ch * (1.0f / 511.0f));
                        taps[(size_t)fc * 16384 + t] = acc[ni][r] * __expf(-tn * delta); } }
                __syncthreads();
            }
        }
        __syncthreads();
    }
}

__device__ __forceinline__ void phase_f2(const Ctx& c) {
    const float* taps = (const float*)(c.ws + WS_TAPS); f32x2* hs = (f32x2*)(c.ws + WS_HSPEC);
    LAS f32x2* z = (LAS f32x2*)c.lds;
    for (int u = c.bid; u < 1024; u += c.G) {
        const int tid = opaque(c.tid);
        const int o = u >> 9, ch = u & 511;
        const float* hf = taps + (size_t)(o * 1024 + ch) * 16384; const float* hbk = taps + (size_t)(o * 1024 + 512 + ch) * 16384;
#pragma unroll 4
        for (int i = 0; i < 32; ++i) { const int m = tid + i * NTHREADS; f32x2 v;
            if (m < 8192) v = *(const f32x2*)(hf + 2 * m);
            else if (m == 8192) v = (f32x2){0.f, hbk[16383]};
            else { const int s = 32768 - 2 * m; v = (f32x2){hbk[s], hbk[s - 1]}; }
            z[fphys(m)] = v; }
        __syncthreads();
        fft_fwd(z, tid);
        fft_unpack_store(z, hs + (size_t)u * HSPEC_LD, 1.0f / (float)FFT_M, tid);
        __syncthreads();
    }
}

__device__ __forceinline__ void stage_T(const int tid, LAS unsigned char* dstT, const bf16_t* src, int ld, int ncols, const float* rowscale  ) {
    const int j = tid >> 2;
    for (int c8 = (tid & 3) * 8; c8 < ncols; c8 += 32) {
        const u32x4 v = *(const u32x4*)(src + (size_t)j * ld + c8); const unsigned w[4] = {v.x, v.y, v.z, v.w};
#pragma unroll
        for (int q = 0; q < 4; ++q) { *(LAS bf16_t*)(dstT + (c8 + 2 * q) * P136 + j * 2) = (bf16_t)(w[q] & 0xffffu); *(LAS bf16_t*)(dstT + (c8 + 2 * q + 1) * P136 + j * 2) = (bf16_t)(w[q] >> 16); }
    }
}
__device__ __forceinline__ void phase_r1(const Ctx& c, int j) {
    PREF P = *c.p; const bf16_t* proj = (const bf16_t*)(c.ws + WS_PROJ); bf16_t* upd = (bf16_t*)(c.ws + WS_UPD);
    LAS unsigned char* VT = c.lds; LAS unsigned char* KF = c.lds + 69632; LAS unsigned char* KB = c.lds + 104448;
    for (int u = c.bid; u < 130 * 4; u += c.G) {
        const int tid = opaque(c.tid), lane = tid & 63, r32 = lane & 31, hi = lane >> 5, w = __builtin_amdgcn_readfirstlane(tid >> 6);
        const int m = u >> 2, h = u & 3; const size_t row0 = (size_t)m * 128;
        const float lgf = ret_log2g(P.in[10] + j * 8, 0, h), lgb = ret_log2g(P.in[10] + j * 8, 1, h);
        stage_T(tid, VT, proj + row0 * AB_IN + 1024 + h * 256, AB_IN, 256, nullptr);
        {   const int jj = tid >> 2; const float sf = exp2f((float)(127 - jj) * lgf), sb = exp2f((float)jj * lgb);
            for (int c8 = (tid & 3) * 8; c8 < 128; c8 += 32) {
                const u32x4 v = *(const u32x4*)(proj + (row0 + jj) * AB_IN + 512 + h * 128 + c8); const unsigned wv[4] = {v.x, v.y, v.z, v.w};
#pragma unroll
                for (int q = 0; q < 4; ++q) { const float lo = bflo(wv[q]), hi_ = bfhi(wv[q]);
                    *(LAS bf16_t*)(KF + (c8 + 2 * q) * P136 + jj * 2) = f2bf(lo * sf); *(LAS bf16_t*)(KF + (c8 + 2 * q + 1) * P136 + jj * 2) = f2bf(hi_ * sf);
                    *(LAS bf16_t*)(KB + (c8 + 2 * q) * P136 + jj * 2) = f2bf(lo * sb); *(LAS bf16_t*)(KB + (c8 + 2 * q + 1) * P136 + jj * 2) = f2bf(hi_ * sb); } } }
        __syncthreads();
#pragma unroll 1
        for (int dir = 0; dir < 2; ++dir) {
            const LAS unsigned char* KX = dir ? KB : KF;
            f32x16 af[4];
#pragma unroll
            for (int n = 0; n < 4; ++n) af[n] = (f32x16){};
#pragma unroll
            for (int ks = 0; ks < 8; ++ks) { const bf16x8 a = ldfrag(VT, P136, 32 * w + r32, ks * 32 + hi * 16);
#pragma unroll
                for (int n = 0; n < 4; ++n) { const bf16x8 bf_ = ldfrag(KX, P136, 32 * n + r32, ks * 32 + hi * 16); af[n] = __builtin_amdgcn_mfma_f32_32x32x16_bf16(a, bf_, af[n], 0, 0, 0); } }
            bf16_t* of = upd + ((size_t)(m * 4 + h) * 2 + dir) * 32768;
#pragma unroll
            for (int n = 0; n < 4; ++n)
#pragma unroll
                for (int r = 0; r < 16; ++r) { const int e = 32 * w + crow(r, hi), d = 32 * n + r32; of[e * 128 + d] = f2bf(af[n][r]); }
        }
        __syncthreads();
    }
}

__device__ __forceinline__ void phase_hyprep(const Ctx& c, int j) {
    PREF P = *c.p; const bf16_t* proj = (const bf16_t*)(c.ws + WS_PROJ); bf16_t* uT = (bf16_t*)(c.ws + WS_UT);
    const float* cw = P.in[11] + (size_t)j * 3 * 1536; const float* cb = P.in[12] + (size_t)j * 1536;
    LAS float* t = (LAS float*)c.lds;
    const int tid = c.tid;
    for (int u = c.bid; u < 256 * 24; u += c.G) {
        const int tt = u / 24, ct = u % 24, t0 = tt * 64, ch0 = ct * 64;
        for (int idx = tid; idx < 66 * 8; idx += NTHREADS) { const int r = idx >> 3, c8 = (idx & 7) * 8; const int tg = t0 - 1 + r;
            u32x4 v = (u32x4){0u, 0u, 0u, 0u};
            if (tg >= 0 && tg < NX) v = *(const u32x4*)(proj + (size_t)(NC + tg) * AB_IN + 3072 + ch0 + c8);
            const unsigned wv[4] = {v.x, v.y, v.z, v.w};
#pragma unroll
            for (int q = 0; q < 4; ++q) { t[r * 65 + c8 + 2 * q] = bflo(wv[q]); t[r * 65 + c8 + 2 * q + 1] = bfhi(wv[q]); } }
        __syncthreads();
        {   const int ch = tid >> 3, t8 = (tid & 7) * 8; const int chg = ch0 + ch;
            const float w0 = cw[chg], w1 = cw[1536 + chg], w2 = cw[3072 + chg], bb = cb[chg]; float o[8];
#pragma unroll
            for (int q = 0; q < 8; ++q) o[q] = t[(t8 + q) * 65 + ch] * w0 + t[(t8 + q + 1) * 65 + ch] * w1 + t[(t8 + q + 2) * 65 + ch] * w2 + bb;
            u32x4 wv; wv.x = cvtpk(o[0], o[1]); wv.y = cvtpk(o[2], o[3]); wv.z = cvtpk(o[4], o[5]); wv.w = cvtpk(o[6], o[7]);
            *(u32x4*)(uT + (size_t)chg * NX + t0 + t8) = wv; }
        __syncthreads();
    }
}

__device__ __forceinline__ void phase_scan(const Ctx& c, int j) {
    PREF P = *c.p; const unsigned* upd = (const unsigned*)(c.ws + WS_UPD); unsigned* sp = (unsigned*)(c.ws + WS_SPREV);
    for (int idx = c.bid * NTHREADS + c.tid; idx < 4 * 2 * 16384; idx += c.G * NTHREADS) {
        const int h = idx >> 15, dir = (idx >> 14) & 1, pr = idx & 16383;
        const float g = exp2f(128.0f * ret_log2g(P.in[10] + j * 8, dir, h));
        float s0 = 0.f, s1 = 0.f;
        const size_t base = (size_t)(h * 2 + dir) * 16384 + pr, mstride = (size_t)4 * 2 * 16384;
#pragma unroll 1
        for (int it = 0; it < 130; it += 10) {
            unsigned uv[10]; int mm[10];
#pragma unroll
            for (int q = 0; q < 10; ++q) { const int s = it + q; mm[q] = (dir == 0) ? s : (s < 2 ? 1 - s : 131 - s); uv[q] = upd[base + (size_t)mm[q] * mstride]; }
#pragma unroll
            for (int q = 0; q < 10; ++q) { sp[base + (size_t)mm[q] * mstride] = cvtpk(s0, s1); s0 = g * s0 + bflo(uv[q]); s1 = g * s1 + bfhi(uv[q]); }
        }
    }
}
__device__ __forceinline__ void phase_hyconv(const Ctx& c, int j) {
    PREF P = *c.p; const unsigned* uT = (const unsigned*)(c.ws + WS_UT); unsigned* yT = (unsigned*)(c.ws + WS_YT);
    const f32x2* hs = (const f32x2*)(c.ws + WS_HSPEC); const float* skip = P.in[20] + (size_t)j * 2 * 512;
    LAS f32x2* z = (LAS f32x2*)c.lds;
    for (int ch = c.bid; ch < 512; ch += c.G) {
        const int tid = opaque(c.tid);
        const unsigned* vp = uT + (size_t)ch * (NX / 2); const unsigned* x1p = uT + (size_t)(512 + ch) * (NX / 2); const unsigned* x2p = uT + (size_t)(1024 + ch) * (NX / 2);
        const float sk0 = skip[ch], sk1 = skip[512 + ch];
#pragma unroll 4
        for (int i = 0; i < 16; ++i) { const int m = tid + i * NTHREADS; const unsigned w = vp[m]; z[fphys(m)] = (f32x2){bflo(w), bfhi(w)}; }
#pragma unroll 4
        for (int i = 16; i < 32; ++i) z[fphys(tid + i * NTHREADS)] = (f32x2){0.f, 0.f};
        __syncthreads();
        fft_fwd(z, tid); fft_pair_mul(z, hs + (size_t)ch * HSPEC_LD, tid); __syncthreads(); fft_inv(z, tid);
        f32x2* y1g = (f32x2*)(c.ws + WS_Y1) + (size_t)ch * (NX / 2);
#pragma unroll 4
        for (int i = 0; i < 16; ++i) { const int m = tid + i * NTHREADS; const f32x2 cv = z[fphys(m)]; const unsigned w = x1p[m], wv = vp[m];
            const f32x2 y = (f32x2){bflo(w) * (cv[0] + sk0 * bflo(wv)), bfhi(w) * (cv[1] + sk0 * bfhi(wv))};
            z[fphys(m)] = y; y1g[m] = y; }
#pragma unroll 4
        for (int i = 16; i < 32; ++i) z[fphys(tid + i * NTHREADS)] = (f32x2){0.f, 0.f};
        __syncthreads();
        fft_fwd(z, tid); fft_pair_mul(z, hs + (size_t)(512 + ch) * HSPEC_LD, tid); __syncthreads(); fft_inv(z, tid);
#pragma unroll 4
        for (int i = 0; i < 16; ++i) { const int m = tid + i * NTHREADS; const f32x2 cv = z[fphys(m)]; const unsigned w = x2p[m]; const f32x2 y1 = y1g[m];
            yT[(size_t)ch * (NX / 2) + m] = cvtpk(bflo(w) * (cv[0] + sk1 * y1[0]), bfhi(w) * (cv[1] + sk1 * y1[1])); }
        __syncthreads();
    }
}

__device__ __forceinline__ void phase_r3(const Ctx& c, int j) {
    PREF P = *c.p; const bf16_t* proj = (const bf16_t*)(c.ws + WS_PROJ); const bf16_t* spv = (const bf16_t*)(c.ws + WS_SPREV); bf16_t* cat = (bf16_t*)(c.ws + WS_CAT);
    LAS unsigned char* R0 = c.lds; LAS unsigned char* R1 = c.lds + 34816; LAS unsigned char* R2 = c.lds + 69632;
    for (int u = c.bid; u < 130 * 4; u += c.G) {
        const int tid = opaque(c.tid), lane = tid & 63, r32 = lane & 31, hi = lane >> 5, w = __builtin_amdgcn_readfirstlane(tid >> 6), wr2 = w >> 2, wc = w & 3;
        const int m = u >> 2, h = u & 3; const size_t row0 = (size_t)m * 128;
        const float lgf = ret_log2g(P.in[10] + j * 8, 0, h), lgb = ret_log2g(P.in[10] + j * 8, 1, h);
        {   const int jj = tid >> 2;
            for (int c8 = (tid & 3) * 8; c8 < 128; c8 += 32) {
                *(LAS u32x4*)(R0 + jj * P136 + c8 * 2) = *(const u32x4*)(proj + (row0 + jj) * AB_IN + h * 128 + c8);
                *(LAS u32x4*)(R1 + jj * P136 + c8 * 2) = *(const u32x4*)(proj + (row0 + jj) * AB_IN + 512 + h * 128 + c8); } }
        stage_T(tid, R2, proj + row0 * AB_IN + 1024 + h * 256, AB_IN, 256, nullptr);
        __syncthreads();
        f32x16 s[2] = {(f32x16){}, (f32x16){}};
#pragma unroll
        for (int ks = 0; ks < 8; ++ks) { const bf16x8 b = ldfrag(R1, P136, 32 * wc + r32, ks * 32 + hi * 16);
#pragma unroll
            for (int mi = 0; mi < 2; ++mi) { const bf16x8 a = ldfrag(R0, P136, 64 * wr2 + 32 * mi + r32, ks * 32 + hi * 16); s[mi] = __builtin_amdgcn_mfma_f32_32x32x16_bf16(a, b, s[mi], 0, 0, 0); } }
        __syncthreads();
#pragma unroll
        for (int mi = 0; mi < 2; ++mi)
#pragma unroll
            for (int r = 0; r < 16; ++r) { const int i = 64 * wr2 + 32 * mi + crow(r, hi), jc = 32 * wc + r32, rel = i - jc;
                const float dcy = (rel > 0) ? exp2f((float)rel * lgf) : ((rel < 0) ? exp2f((float)(-rel) * lgb) : 2.0f);
                *(LAS bf16_t*)(R1 + i * P136 + jc * 2) = f2bf(s[mi][r] * dcy); }
        __syncthreads();
        f32x16 o[2][2];
#pragma unroll
        for (int mi = 0; mi < 2; ++mi)
#pragma unroll
            for (int ni = 0; ni < 2; ++ni) o[mi][ni] = (f32x16){};
#pragma unroll
        for (int ks = 0; ks < 8; ++ks) { bf16x8 a[2], b[2];
#pragma unroll
            for (int q = 0; q < 2; ++q) { a[q] = ldfrag(R1, P136, 64 * wr2 + 32 * q + r32, ks * 32 + hi * 16); b[q] = ldfrag(R2, P136, 64 * wc + 32 * q + r32, ks * 32 + hi * 16); }
#pragma unroll
            for (int mi = 0; mi < 2; ++mi)
#pragma unroll
                for (int ni = 0; ni < 2; ++ni) o[mi][ni] = __builtin_amdgcn_mfma_f32_32x32x16_bf16(a[mi], b[ni], o[mi][ni], 0, 0, 0); }
        __syncthreads();
#pragma unroll 1
        for (int dir = 0; dir < 2; ++dir) {
            {   const int jj = tid >> 2; const float qd = (dir == 0) ? exp2f((float)(jj + 1) * lgf) : exp2f((float)(128 - jj) * lgb);
                for (int c8 = (tid & 3) * 8; c8 < 128; c8 += 32) { const u32x4 v = *(const LAS u32x4*)(R0 + jj * P136 + c8 * 2); u32x4 wv;
                    wv.x = cvtpk(bflo(v.x) * qd, bfhi(v.x) * qd); wv.y = cvtpk(bflo(v.y) * qd, bfhi(v.y) * qd); wv.z = cvtpk(bflo(v.z) * qd, bfhi(v.z) * qd); wv.w = cvtpk(bflo(v.w) * qd, bfhi(v.w) * qd);
                    *(LAS u32x4*)(R1 + jj * P136 + c8 * 2) = wv; } }
            {   const bf16_t* sp = spv + ((size_t)(m * 4 + h) * 2 + dir) * 32768;
                for (int idx = tid; idx < 256 * 16; idx += NTHREADS) { const int e = idx >> 4, c8 = (idx & 15) * 8; *(LAS u32x4*)(R2 + e * P136 + c8 * 2) = *(const u32x4*)(sp + e * 128 + c8); } }
            __syncthreads();
#pragma unroll
            for (int ks = 0; ks < 8; ++ks) { bf16x8 a[2], b[2];
#pragma unroll
                for (int q = 0; q < 2; ++q) { a[q] = ldfrag(R1, P136, 64 * wr2 + 32 * q + r32, ks * 32 + hi * 16); b[q] = ldfrag(R2, P136, 64 * wc + 32 * q + r32, ks * 32 + hi * 16); }
#pragma unroll
                for (int mi = 0; mi < 2; ++mi)
#pragma unroll
                    for (int ni = 0; ni < 2; ++ni) o[mi][ni] = __builtin_amdgcn_mfma_f32_32x32x16_bf16(a[mi], b[ni], o[mi][ni], 0, 0, 0); }
            __syncthreads();
        }
        for (int idx = tid; idx < 128 * 32; idx += NTHREADS) { const int i = idx >> 5, c8 = (idx & 31) * 8; *(LAS u32x4*)(R2 + i * 528 + c8 * 2) = *(const u32x4*)(proj + (row0 + i) * AB_IN + 2048 + h * 256 + c8); }
        LAS float* st = (LAS float*)R0;
#pragma unroll
        for (int mi = 0; mi < 2; ++mi)
#pragma unroll
            for (int r = 0; r < 16; ++r) { float sm = o[mi][0][r] + o[mi][1][r], sq = o[mi][0][r] * o[mi][0][r] + o[mi][1][r] * o[mi][1][r];
#pragma unroll
                for (int off = 16; off >= 1; off >>= 1) { sm += __shfl_xor(sm, off); sq += __shfl_xor(sq, off); }
                if (r32 == 0) { const int i = 64 * wr2 + 32 * mi + crow(r, hi); st[(i * 4 + wc) * 2 + 0] = sm; st[(i * 4 + wc) * 2 + 1] = sq; } }
        __syncthreads();
#pragma unroll
        for (int mi = 0; mi < 2; ++mi)
#pragma unroll
            for (int r = 0; r < 16; ++r) { const int i = 64 * wr2 + 32 * mi + crow(r, hi); float sm = 0.f, sq = 0.f;
#pragma unroll
                for (int q = 0; q < 4; ++q) { sm += st[(i * 4 + q) * 2 + 0]; sq += st[(i * 4 + q) * 2 + 1]; }
                const float mu = sm * (1.0f / 256.f), var = fmaxf(sq * (1.0f / 256.f) - mu * mu, 0.f), rstd = rsqrtf(var + EPS);
#pragma unroll
                for (int ni = 0; ni < 2; ++ni) { const int e = 64 * wc + 32 * ni + r32; LAS bf16_t* pg = (LAS bf16_t*)(R2 + i * 528 + e * 2); const float g = bf2f(*pg);
                    *pg = f2bf((o[mi][ni][r] - mu) * rstd * siluf(g)); } }
        __syncthreads();
        for (int idx = tid; idx < 128 * 32; idx += NTHREADS) { const int i = idx >> 5, c8 = (idx & 31) * 8; *(u32x4*)(cat + (row0 + i) * AB_CAT + h * 256 + c8) = *(const LAS u32x4*)(R2 + i * 528 + c8 * 2); }
        __syncthreads();
    }
}

__device__ __forceinline__ void phase_hytrans(const Ctx& c) {
    const bf16_t* yT = (const bf16_t*)(c.ws + WS_YT); bf16_t* cat = (bf16_t*)(c.ws + WS_CAT);
    LAS bf16_t* t = (LAS bf16_t*)c.lds;
    const int tid = c.tid;
    for (int u = c.bid; u < 256 * 8; u += c.G) {
        const int t0 = (u >> 3) * 64, ch0 = (u & 7) * 64;
        {   const int ch = tid >> 3, t8 = (tid & 7) * 8; const u32x4 v = *(const u32x4*)(yT + (size_t)(ch0 + ch) * NX + t0 + t8); const unsigned wv[4] = {v.x, v.y, v.z, v.w};
#pragma unroll
            for (int q = 0; q < 4; ++q) { t[ch * 66 + t8 + 2 * q] = (bf16_t)(wv[q] & 0xffffu); t[ch * 66 + t8 + 2 * q + 1] = (bf16_t)(wv[q] >> 16); } }
        __syncthreads();
        {   const int tt = tid >> 3, c8 = (tid & 7) * 8; unsigned short e[8];
#pragma unroll
            for (int q = 0; q < 8; ++q) e[q] = t[(c8 + q) * 66 + tt];
            u32x4 wv; wv.x = e[0] | ((unsigned)e[1] << 16); wv.y = e[2] | ((unsigned)e[3] << 16); wv.z = e[4] | ((unsigned)e[5] << 16); wv.w = e[6] | ((unsigned)e[7] << 16);
            *(u32x4*)(cat + (size_t)(NC + t0 + tt) * AB_CAT + 1024 + ch0 + c8) = wv; }
        __syncthreads();
    }
}

__device__ __forceinline__ void phase_hyctx(const Ctx& c, int j) {
    PREF P = *c.p; const bf16_t* proj = (const bf16_t*)(c.ws + WS_PROJ); bf16_t* cat = (bf16_t*)(c.ws + WS_CAT);
    const float* hid2c = (const float*)(c.ws + WS_HID2C); const float* w3 = P.in[19] + (size_t)j * 64 * 2048;
    const float* cw = P.in[11] + (size_t)j * 3 * 1536; const float* cb = P.in[12] + (size_t)j * 1536; const float* skip = P.in[20] + (size_t)j * 2 * 512;
    LAS float* raw = (LAS float*)c.lds;
    LAS float* ser = raw + 3 * 258;
    LAS float* flt = ser + 3 * 256;
    LAS float* yy = flt + 4 * 256;
    const int tid = c.tid;
    for (int ch = c.bid; ch < 512; ch += c.G) {
        for (int idx = tid; idx < 3 * 258; idx += NTHREADS) { const int s = idx / 258, r = idx % 258, t = r - 1; raw[idx] = (t >= 0 && t < 256) ? bf2f(proj[(size_t)t * AB_IN + 3072 + s * 512 + ch]) : 0.f; }
        {
            const int t = tid & 255, hf = tid >> 8; const float tn = (float)t * (1.0f / 255.0f);
            const float delta = 3.0701134573253945f + (15.350567286626972f - 3.0701134573253945f) * ((float)ch * (1.0f / 511.0f)); const float win = __expf(-tn * delta);
            float a0 = 0.f, a1 = 0.f; const int col0 = (2 * hf) * 512 + ch, col1 = (2 * hf + 1) * 512 + ch;
            for (int k = 0; k < 64; ++k) { const float hv = hid2c[t * 64 + k]; a0 += hv * w3[(size_t)k * 2048 + col0]; a1 += hv * w3[(size_t)k * 2048 + col1]; }
            flt[(2 * hf) * 256 + t] = a0 * win; flt[(2 * hf + 1) * 256 + t] = a1 * win; }
        __syncthreads();
        for (int idx = tid; idx < 3 * 256; idx += NTHREADS) { const int s = idx >> 8, t = idx & 255, cg = s * 512 + ch;
            ser[idx] = raw[s * 258 + t] * cw[cg] + raw[s * 258 + t + 1] * cw[1536 + cg] + raw[s * 258 + t + 2] * cw[3072 + cg] + cb[cg]; }
        __syncthreads();
        if (tid < 256) { const int t = tid; float a = 0.f;
            for (int s = 0; s <= t; ++s) a += flt[0 * 256 + (t - s)] * ser[s];
            for (int s = t + 1; s < 256; ++s) a += flt[1 * 256 + (s - t)] * ser[s];
            yy[t] = ser[256 + t] * (a + skip[ch] * ser[t]); }
        __syncthreads();
        if (tid < 256) { const int t = tid; float a = 0.f;
            for (int s = 0; s <= t; ++s) a += flt[2 * 256 + (t - s)] * yy[s];
            for (int s = t + 1; s < 256; ++s) a += flt[3 * 256 + (s - t)] * yy[s];
            cat[(size_t)t * AB_CAT + 1024 + ch] = f2bf(ser[512 + t] * (a + skip[512 + ch] * yy[t])); }
        __syncthreads();
    }
}
namespace da2 {
constexpr int KSLOT = 16384, VSLOT = 16384, NSLOT = 3;
constexpr int LDS_K = 0, LDS_V = NSLOT * KSLOT, LDS_WS = LDS_V + NSLOT * VSLOT;
#define D2_SBAR() __builtin_amdgcn_sched_barrier(0)
#define D2_WAIT_BAR(N) asm volatile("s_waitcnt vmcnt(" #N ") lgkmcnt(0)\n\ts_barrier" ::: "memory")
typedef short v4i16_t __attribute__((ext_vector_type(4)));
typedef LAS const char* lcp;
__device__ __forceinline__ void glds16(const void* gsrc, unsigned lds_dst) { unsigned keep;
    asm volatile("s_mov_b32 %0, m0\n\ts_mov_b32 m0, %2\n\ts_nop 0\n\tglobal_load_lds_dwordx4 %1, off\n\ts_mov_b32 m0, %0" : "=&s"(keep) : "v"(gsrc), "s"(lds_dst) : "memory"); }
__device__ __forceinline__ unsigned cvtpk_s(float lo, float hi) { f32x2 v = {lo, hi}; bf16x2_t b = __builtin_convertvector(v, bf16x2_t); return __builtin_bit_cast(unsigned, b); }
__device__ __forceinline__ s16x4 vtr(lcp p) { return __builtin_bit_cast(s16x4, __builtin_amdgcn_ds_read_tr16_b64_v4i16((LAS v4i16_t*)p)); }
__device__ __forceinline__ void kload8(bf16x8* kf, lcp kp) {
    kf[0] = *(const LAS bf16x8*)(kp);        kf[1] = *(const LAS bf16x8*)(kp + 512);
    kf[2] = *(const LAS bf16x8*)(kp + 2048); kf[3] = *(const LAS bf16x8*)(kp + 2560);
    kf[4] = *(const LAS bf16x8*)(kp + 4096); kf[5] = *(const LAS bf16x8*)(kp + 4608);
    kf[6] = *(const LAS bf16x8*)(kp + 6144); kf[7] = *(const LAS bf16x8*)(kp + 6656); }

__device__ __forceinline__ bool attn_unit_dma(LAS char* lds, const bf16_t* proj, bf16_t* cat, int h, int qrow0, int nkeys, float lam, float oscale, const float* subln) {
    constexpr int LD = DA_IN;
    const int tid = opaque((int)threadIdx.x), wid = __builtin_amdgcn_readfirstlane(tid >> 6), lane = tid & 63, r32 = lane & 31, hi = lane >> 5, comp = wid >> 2, qw = wid & 3;
    const unsigned lds0 = (unsigned)(uintptr_t)lds;
    LAS float* wsf = (LAS float*)(lds + LDS_WS) + wid * 64;
    const bf16_t* Kh = proj + 1024 + h * 128; const bf16_t* Vh = proj + 2048 + h * 128;
    const bf16_t* ksrc0 = Kh + (size_t)lane * LD + wid * 8; const bf16_t* ksrc1 = ksrc0 + 64;
    const bf16_t* vsrc0 = Vh + (size_t)(16 * (wid & 3) + (lane >> 2)) * LD + (wid >> 2) * 32 + (lane & 3) * 8; const bf16_t* vsrc1 = vsrc0 + 64;
    const unsigned kdst = lds0 + LDS_K + wid * 1024, vdst = lds0 + LDS_V + wid * 1024;
#define D2_DMA_K(t, slot) do { glds16(ksrc0 + (size_t)(t) * 64 * LD, (unsigned)__builtin_amdgcn_readfirstlane(kdst + (slot))); glds16(ksrc1 + (size_t)(t) * 64 * LD, (unsigned)__builtin_amdgcn_readfirstlane(kdst + (slot) + 8192)); } while (0)
#define D2_DMA_V(t, slot) do { glds16(vsrc0 + (size_t)(t) * 64 * LD, (unsigned)__builtin_amdgcn_readfirstlane(vdst + (slot))); glds16(vsrc1 + (size_t)(t) * 64 * LD, (unsigned)__builtin_amdgcn_readfirstlane(vdst + (slot) + 8192)); } while (0)
    const lcp shm3 = (lcp)lds;
    const lcp kp0 = shm3 + LDS_K + comp * 8192 + hi * 1024 + r32 * 16;
    const lcp vp0 = shm3 + LDS_V + ((lane >> 4) & 1) * 32 + (lane & 3) * 8 + (4 * hi + ((lane & 15) >> 2)) * 64;
    const int NT = nkeys / 64;
    D2_DMA_K(0, 0); D2_DMA_V(0, 0); D2_DMA_K(1, KSLOT);
    bf16x8 qr[4];
    { const bf16_t* Qw = proj + (size_t)(qrow0 + qw * 32 + r32) * LD + h * 128 + comp * 64 + hi * 8;
#pragma unroll
      for (int d0 = 0; d0 < 4; ++d0) qr[d0] = *reinterpret_cast<const bf16x8*>(Qw + d0 * 16); }
    float l_reg = 0.f; f32x16 o[4]; o[0] = f32x16{}; o[1] = f32x16{}; o[2] = f32x16{}; o[3] = f32x16{};
    f32x16 pA0, pA1, pB0, pB1; bf16x8 kf[8];
    int sl_prev = 0, sl_cur = 0, sl_next = KSLOT;
#define D2_ROT() do { sl_prev = sl_cur; sl_cur = sl_next; sl_next = (sl_next == (NSLOT - 1) * KSLOT) ? 0 : sl_next + KSLOT; } while (0)
    D2_DMA_K(2, 2 * KSLOT);
    D2_WAIT_BAR(6);
    { const lcp kb = kp0;
      pA0 = f32x16{}; pA1 = f32x16{};
#pragma unroll
      for (int d0 = 0; d0 < 4; ++d0) { const bf16x8 b0 = *(const LAS bf16x8*)(kb + d0 * 2048), b1 = *(const LAS bf16x8*)(kb + d0 * 2048 + 512);
          pA0 = __builtin_amdgcn_mfma_f32_32x32x16_bf16(b0, qr[d0], pA0, 0, 0, 0); pA1 = __builtin_amdgcn_mfma_f32_32x32x16_bf16(b1, qr[d0], pA1, 0, 0, 0); }
#pragma unroll
      for (int r = 0; r < 16; ++r) { pA0[r] = __builtin_amdgcn_exp2f(pA0[r]); pA1[r] = __builtin_amdgcn_exp2f(pA1[r]); } }
    D2_WAIT_BAR(0);
    D2_DMA_K(3, 0); D2_DMA_V(1, VSLOT);
    D2_ROT();
    kload8(kf, kp0 + sl_cur);
    D2_WAIT_BAR(4);
    s16x4 vlo[8], vhi[8]; u32x4 pw0, pw1, pw2, pw3;
#define D2_PKW(P, B) cvtpk_s(P[B], P[B + 1])
#define D2_PAF(k) __builtin_bit_cast(bf16x8, pw##k)
#define D2_VFR(s) (bf16x8){vlo[s][0], vlo[s][1], vlo[s][2], vlo[s][3], vhi[s][0], vhi[s][1], vhi[s][2], vhi[s][3]}
#define D2_PIN(x) asm volatile("" : "+v"(x))
#define D2_VRD(s, i) do { vlo[s] = vtr(vp_ + (((i) >> 2) * 4096 + ((i) & 3) * 1024)); vhi[s] = vtr(vp_ + (((i) >> 2) * 4096 + ((i) & 3) * 1024 + 512)); } while (0)
#define D2_GAPA(MF, A0, A1, A2, A3, W0, W1, PW) do { MF; sacc += A0; sacc += A1; sacc += A2; sacc += A3; D2_PIN(sacc); W0; W1; D2_PIN(PW); D2_SBAR(); } while (0)
#define D2_EX(v) __builtin_amdgcn_exp2f(v)
#define D2_GAPB(MF, X, B) do { MF; X[B] = D2_EX(X[B]); X[B + 1] = D2_EX(X[B + 1]); D2_PIN(X); D2_SBAR(); } while (0)
#define D2_KRD(G, j) do { if (G) { kf[j] = *(const LAS bf16x8*)(kp0 + sl_next + ((j) >> 1) * 2048 + ((j) & 1) * 512); D2_SBAR(); } } while (0)
#define D2_ORD(j) ((((j) & 3) << 2) | ((j) >> 2))
#define D2_STEP(C0, C1, P0, P1, t, GK, GV, GL) do { D2_SBAR(); \
    const lcp vp_ = vp0 + sl_prev; \
    D2_VRD(0, D2_ORD(0)); D2_SBAR(); float sacc = (P0[0] + P0[1]); \
    D2_GAPA(C0 = __builtin_amdgcn_mfma_f32_32x32x16_bf16(kf[0], qr[0], f32x16{}, 0, 0, 0), P0[2], P0[3], P0[4], P0[5],     pw0[0] = D2_PKW(P0, 0), pw0[1] = D2_PKW(P0, 2), pw0); \
    D2_VRD(1, D2_ORD(1)); D2_SBAR(); D2_GAPA(C1 = __builtin_amdgcn_mfma_f32_32x32x16_bf16(kf[1], qr[0], f32x16{}, 0, 0, 0), P0[6], P0[7], P0[8], P0[9],     pw0[2] = D2_PKW(P0, 4), pw0[3] = D2_PKW(P0, 6), pw0); \
    D2_VRD(2, D2_ORD(2)); D2_SBAR(); D2_GAPA(C0 = __builtin_amdgcn_mfma_f32_32x32x16_bf16(kf[2], qr[1], C0, 0, 0, 0),       P0[10], P0[11], P0[12], P0[13], pw1[0] = D2_PKW(P0, 8), pw1[1] = D2_PKW(P0, 10), pw1); \
    D2_VRD(3, D2_ORD(3)); D2_SBAR(); D2_GAPA(C1 = __builtin_amdgcn_mfma_f32_32x32x16_bf16(kf[3], qr[1], C1, 0, 0, 0),       P0[14], P0[15], P1[0], P1[1],   pw1[2] = D2_PKW(P0, 12), pw1[3] = D2_PKW(P0, 14), pw1); \
    D2_VRD(4, D2_ORD(4)); D2_SBAR(); D2_GAPA(C0 = __builtin_amdgcn_mfma_f32_32x32x16_bf16(kf[4], qr[2], C0, 0, 0, 0),       P1[2], P1[3], P1[4], P1[5],     pw2[0] = D2_PKW(P1, 0), pw2[1] = D2_PKW(P1, 2), pw2); \
    D2_VRD(5, D2_ORD(5)); D2_SBAR(); D2_GAPA(C1 = __builtin_amdgcn_mfma_f32_32x32x16_bf16(kf[5], qr[2], C1, 0, 0, 0),       P1[6], P1[7], P1[8], P1[9],     pw2[2] = D2_PKW(P1, 4), pw2[3] = D2_PKW(P1, 6), pw2); \
    D2_VRD(6, D2_ORD(6)); D2_SBAR(); D2_GAPA(C0 = __builtin_amdgcn_mfma_f32_32x32x16_bf16(kf[6], qr[3], C0, 0, 0, 0),       P1[10], P1[11], P1[12], P1[13], pw3[0] = D2_PKW(P1, 8), pw3[1] = D2_PKW(P1, 10), pw3); \
    D2_VRD(7, D2_ORD(7)); D2_SBAR(); D2_GAPA(C1 = __builtin_amdgcn_mfma_f32_32x32x16_bf16(kf[7], qr[3], C1, 0, 0, 0),       P1[14], P1[15], 0.f, 0.f,       pw3[2] = D2_PKW(P1, 12), pw3[3] = D2_PKW(P1, 14), pw3); \
    l_reg += sacc; \
    if (GK) { D2_DMA_K((t) + 3, sl_cur); } if (GV) { D2_DMA_V((t) + 1, sl_next); } \
    D2_SBAR(); \
    D2_GAPB(o[0] = __builtin_amdgcn_mfma_f32_32x32x16_bf16(D2_PAF(0), D2_VFR(0), o[0], 0, 0, 0), C0, 0);  D2_VRD(0, D2_ORD(8));  D2_SBAR(); \
    D2_GAPB(o[1] = __builtin_amdgcn_mfma_f32_32x32x16_bf16(D2_PAF(0), D2_VFR(1), o[1], 0, 0, 0), C0, 2);  D2_VRD(1, D2_ORD(9));  D2_SBAR(); \
    D2_GAPB(o[2] = __builtin_amdgcn_mfma_f32_32x32x16_bf16(D2_PAF(0), D2_VFR(2), o[2], 0, 0, 0), C0, 4);  D2_VRD(2, D2_ORD(10)); D2_SBAR(); \
    D2_GAPB(o[3] = __builtin_amdgcn_mfma_f32_32x32x16_bf16(D2_PAF(0), D2_VFR(3), o[3], 0, 0, 0), C0, 6);  D2_VRD(3, D2_ORD(11)); D2_SBAR(); \
    D2_KRD(GL, 0); D2_GAPB(o[0] = __builtin_amdgcn_mfma_f32_32x32x16_bf16(D2_PAF(1), D2_VFR(4), o[0], 0, 0, 0), C0, 8);  D2_VRD(4, D2_ORD(12)); D2_SBAR(); \
    D2_KRD(GL, 1); D2_GAPB(o[1] = __builtin_amdgcn_mfma_f32_32x32x16_bf16(D2_PAF(1), D2_VFR(5), o[1], 0, 0, 0), C0, 10); D2_VRD(5, D2_ORD(13)); D2_SBAR(); \
    D2_KRD(GL, 2); D2_GAPB(o[2] = __builtin_amdgcn_mfma_f32_32x32x16_bf16(D2_PAF(1), D2_VFR(6), o[2], 0, 0, 0), C0, 12); D2_VRD(6, D2_ORD(14)); D2_SBAR(); \
    D2_KRD(GL, 3); D2_GAPB(o[3] = __builtin_amdgcn_mfma_f32_32x32x16_bf16(D2_PAF(1), D2_VFR(7), o[3], 0, 0, 0), C0, 14); D2_VRD(7, D2_ORD(15)); D2_SBAR(); \
    D2_KRD(GL, 4); D2_GAPB(o[0] = __builtin_amdgcn_mfma_f32_32x32x16_bf16(D2_PAF(2), D2_VFR(0), o[0], 0, 0, 0), C1, 0); \
    D2_KRD(GL, 5); D2_GAPB(o[1] = __builtin_amdgcn_mfma_f32_32x32x16_bf16(D2_PAF(2), D2_VFR(1), o[1], 0, 0, 0), C1, 2); \
    D2_KRD(GL, 6); D2_GAPB(o[2] = __builtin_amdgcn_mfma_f32_32x32x16_bf16(D2_PAF(2), D2_VFR(2), o[2], 0, 0, 0), C1, 4); \
    D2_KRD(GL, 7); D2_GAPB(o[3] = __builtin_amdgcn_mfma_f32_32x32x16_bf16(D2_PAF(2), D2_VFR(3), o[3], 0, 0, 0), C1, 6); \
    D2_GAPB(o[0] = __builtin_amdgcn_mfma_f32_32x32x16_bf16(D2_PAF(3), D2_VFR(4), o[0], 0, 0, 0), C1, 8); \
    D2_GAPB(o[1] = __builtin_amdgcn_mfma_f32_32x32x16_bf16(D2_PAF(3), D2_VFR(5), o[1], 0, 0, 0), C1, 10); \
    D2_GAPB(o[2] = __builtin_amdgcn_mfma_f32_32x32x16_bf16(D2_PAF(3), D2_VFR(6), o[2], 0, 0, 0), C1, 12); \
    D2_GAPB(o[3] = __builtin_amdgcn_mfma_f32_32x32x16_bf16(D2_PAF(3), D2_VFR(7), o[3], 0, 0, 0), C1, 14); \
    } while (0)
    int t = 1;
    for (; t + 5 < NT; t += 2) {
        D2_STEP(pB0, pB1, pA0, pA1, t, true, true, true);     D2_WAIT_BAR(4); D2_ROT();
        D2_STEP(pA0, pA1, pB0, pB1, t + 1, true, true, true); D2_WAIT_BAR(4); D2_ROT();
    }
#define D2_ENDW(tt) do { if ((tt) + 3 < NT) { D2_WAIT_BAR(4); } else if ((tt) + 2 < NT) { D2_WAIT_BAR(2); } else { D2_WAIT_BAR(0); } } while (0)
    for (; t + 1 < NT; t += 2) {
        D2_STEP(pB0, pB1, pA0, pA1, t, (t + 3 < NT), (t + 1 < NT), (t + 1 < NT));         D2_ENDW(t);     D2_ROT();
        D2_STEP(pA0, pA1, pB0, pB1, t + 1, (t + 4 < NT), (t + 2 < NT), (t + 2 < NT));     D2_ENDW(t + 1); D2_ROT();
    }
    D2_STEP(pB0, pB1, pA0, pA1, NT - 1, false, false, false);
    { float sacc = pB0[0] + pB0[1];
#pragma unroll
      for (int r = 2; r < 16; ++r) sacc += pB0[r];
#pragma unroll
      for (int r = 0; r < 16; ++r) sacc += pB1[r];
      l_reg += sacc;
      pw0 = (u32x4){D2_PKW(pB0, 0), D2_PKW(pB0, 2), D2_PKW(pB0, 4), D2_PKW(pB0, 6)}; pw1 = (u32x4){D2_PKW(pB0, 8), D2_PKW(pB0, 10), D2_PKW(pB0, 12), D2_PKW(pB0, 14)};
      pw2 = (u32x4){D2_PKW(pB1, 0), D2_PKW(pB1, 2), D2_PKW(pB1, 4), D2_PKW(pB1, 6)}; pw3 = (u32x4){D2_PKW(pB1, 8), D2_PKW(pB1, 10), D2_PKW(pB1, 12), D2_PKW(pB1, 14)};
      D2_SBAR();
      const lcp vp_ = vp0 + sl_cur;
#pragma unroll
      for (int d0 = 0; d0 < 4; ++d0) {
#pragma unroll
          for (int ks = 0; ks < 4; ++ks) { vlo[ks] = vtr(vp_ + (d0 * 4096 + ks * 1024)); vhi[ks] = vtr(vp_ + (d0 * 4096 + ks * 1024 + 512)); }
          o[d0] = __builtin_amdgcn_mfma_f32_32x32x16_bf16(D2_PAF(0), D2_VFR(0), o[d0], 0, 0, 0); o[d0] = __builtin_amdgcn_mfma_f32_32x32x16_bf16(D2_PAF(1), D2_VFR(1), o[d0], 0, 0, 0);
          o[d0] = __builtin_amdgcn_mfma_f32_32x32x16_bf16(D2_PAF(2), D2_VFR(2), o[d0], 0, 0, 0); o[d0] = __builtin_amdgcn_mfma_f32_32x32x16_bf16(D2_PAF(3), D2_VFR(3), o[d0], 0, 0, 0); } }
    { auto rr = __builtin_amdgcn_permlane32_swap(__float_as_uint(l_reg), __float_as_uint(l_reg), false, false); l_reg = __uint_as_float(rr[0]) + __uint_as_float(rr[1]); }
    if (hi == 0) wsf[32 + r32] = l_reg; asm volatile("s_waitcnt lgkmcnt(0)" ::: "memory");
    {
#pragma unroll
      for (int r = 0; r < 16; ++r) { const float rl = __builtin_amdgcn_rcpf(wsf[32 + crow(r, hi)]);
#pragma unroll
          for (int d0 = 0; d0 < 4; ++d0) o[d0][r] *= rl; } }
    const int bad = (l_reg > 1.0e-30f && l_reg < 1.0e30f) ? 0 : 1;
    if (__syncthreads_or(bad)) return false;
    LAS float* xb = (LAS float*)lds;
    if (comp == 1) {
#pragma unroll
        for (int d0 = 0; d0 < 4; ++d0)
#pragma unroll
            for (int r = 0; r < 16; ++r) xb[((qw * 64) + d0 * 16 + r) * 64 + lane] = o[d0][r];
    }
    __syncthreads();
    if (comp == 0) {
        float ssq[16];
#pragma unroll
        for (int r = 0; r < 16; ++r) ssq[r] = 0.f;
#pragma unroll
        for (int d0 = 0; d0 < 4; ++d0)
#pragma unroll
            for (int r = 0; r < 16; ++r) { const float x = o[d0][r] - lam * xb[((qw * 64) + d0 * 16 + r) * 64 + lane]; o[d0][r] = x; ssq[r] += x * x; }
#pragma unroll
        for (int r = 0; r < 16; ++r) {
#pragma unroll
            for (int off = 16; off >= 1; off >>= 1) ssq[r] += __shfl_xor(ssq[r], off);
            ssq[r] = rsqrtf(ssq[r] * (1.0f / 128.f) + 1e-5f) * oscale; }
        asm volatile("" ::: "memory");
        LAS char* stg = lds + qw * 16384;
#pragma unroll
        for (int d0 = 0; d0 < 4; ++d0) { const float g = subln[d0 * 32 + r32];
#pragma unroll
            for (int r = 0; r < 16; ++r) *(LAS bf16_t*)(stg + crow(r, hi) * 272 + (d0 * 32 + r32) * 2) = f2bf(o[d0][r] * ssq[r] * g); }
        asm volatile("s_waitcnt lgkmcnt(0)" ::: "memory");
        bf16_t* Ow = cat + (size_t)(qrow0 + qw * 32) * DA_W + h * 128;
#pragma unroll
        for (int q = 0; q < 8; ++q) { const int id = q * 64 + lane, row = id >> 4, c16 = id & 15; *(u32x4*)(Ow + (size_t)row * DA_W + c16 * 8) = *(const LAS u32x4*)(stg + row * 272 + c16 * 16); }
    }
    __syncthreads();
    return true;
#undef D2_DMA_K
#undef D2_DMA_V
#undef D2_ROT
#undef D2_STEP
#undef D2_ENDW
}
}
namespace da {
constexpr int KVBLK = 64;
constexpr int SHM_V = KVBLK * 128 * 2, SHM_K = KVBLK * 128 * 2;
constexpr float THR2 = 11.5f;
#define DA_KSWZ(row, colB) ((row) * 256 + ((colB) ^ (((row) & 7) << 4)))
#define DA_SBAR() __builtin_amdgcn_sched_barrier(0)
__device__ __forceinline__ unsigned cvtpk_a(float lo, float hi) { unsigned r; asm volatile("v_cvt_pk_bf16_f32 %0, %1, %2" : "=v"(r) : "v"(lo), "v"(hi)); return r; }
__device__ __forceinline__ void partialSM(f32x16& p0, f32x16& p1, float& m_reg, float& alpha) {
    float pmax = p0[0];
#pragma unroll
    for (int r = 1; r < 16; ++r) pmax = fmaxf(pmax, p0[r]);
#pragma unroll
    for (int r = 0; r < 16; ++r) pmax = fmaxf(pmax, p1[r]);
    { auto rr = __builtin_amdgcn_permlane32_swap(__float_as_uint(pmax), __float_as_uint(pmax), false, false); pmax = fmaxf(__uint_as_float(rr[0]), __uint_as_float(rr[1])); }
    float mn;
    if (__builtin_expect(__all(pmax - m_reg <= THR2), 1)) { mn = m_reg; alpha = 1.f; }
    else { mn = fmaxf(m_reg, pmax); alpha = __builtin_amdgcn_exp2f(m_reg - mn); m_reg = mn; }
#pragma unroll
    for (int r = 0; r < 16; ++r) { p0[r] -= mn; p1[r] -= mn; }
#pragma unroll
    for (int r = 0; r < 16; ++r) p0[r] = __builtin_amdgcn_exp2f(p0[r]);
}
__device__ __forceinline__ void partialSM_fast(f32x16& p0, f32x16& p1, float& l_reg) {
#pragma unroll
    for (int r = 0; r < 16; ++r) p0[r] = __builtin_amdgcn_exp2f(p0[r]);
#pragma unroll
    for (int r = 0; r < 16; ++r) p1[r] = __builtin_amdgcn_exp2f(p1[r]);
    float ps = 0;
#pragma unroll
    for (int r = 0; r < 16; ++r) ps += p0[r];
#pragma unroll
    for (int r = 0; r < 16; ++r) ps += p1[r];
    l_reg += ps;
}
__device__ __forceinline__ void finishSM_fast(f32x16& p0, f32x16& p1, bf16x8& pa0, bf16x8& pa1, bf16x8& pa2, bf16x8& pa3) {
#define DA_PK4(P, BASE, OUT) do { unsigned a0 = cvtpk_a(P[BASE + 0], P[BASE + 1]), a1 = cvtpk_a(P[BASE + 2], P[BASE + 3]);   \
    unsigned b0 = cvtpk_a(P[BASE + 4], P[BASE + 5]), b1 = cvtpk_a(P[BASE + 6], P[BASE + 7]);                              \
    auto r0 = __builtin_amdgcn_permlane32_swap(a0, b0, false, false); auto r1 = __builtin_amdgcn_permlane32_swap(a1, b1, false, false); \
    u32x4 w = {r0[0], r1[0], r0[1], r1[1]}; OUT = *reinterpret_cast<bf16x8*>(&w); } while (0)
    DA_PK4(p0, 0, pa0); DA_PK4(p0, 8, pa1); DA_PK4(p1, 0, pa2); DA_PK4(p1, 8, pa3);
#undef DA_PK4
}
__device__ __forceinline__ void finishSM(f32x16& p0, f32x16& p1, float alpha, float& l_reg, bf16x8& pa0, bf16x8& pa1, bf16x8& pa2, bf16x8& pa3) {
#pragma unroll
    for (int r = 0; r < 16; ++r) p1[r] = __builtin_amdgcn_exp2f(p1[r]);
    float ps = 0;
#pragma unroll
    for (int r = 0; r < 16; ++r) ps += p0[r];
#pragma unroll
    for (int r = 0; r < 16; ++r) ps += p1[r];
    { auto rr = __builtin_amdgcn_permlane32_swap(__float_as_uint(ps), __float_as_uint(ps), false, false); ps = __uint_as_float(rr[0]) + __uint_as_float(rr[1]); }
    l_reg = l_reg * alpha + ps;
#define DA_PK4(P, BASE, OUT) do { unsigned a0 = cvtpk_a(P[BASE + 0], P[BASE + 1]), a1 = cvtpk_a(P[BASE + 2], P[BASE + 3]);   \
    unsigned b0 = cvtpk_a(P[BASE + 4], P[BASE + 5]), b1 = cvtpk_a(P[BASE + 6], P[BASE + 7]);                              \
    auto r0 = __builtin_amdgcn_permlane32_swap(a0, b0, false, false); auto r1 = __builtin_amdgcn_permlane32_swap(a1, b1, false, false); \
    u32x4 w = {r0[0], r1[0], r0[1], r1[1]}; OUT = *reinterpret_cast<bf16x8*>(&w); } while (0)
    DA_PK4(p0, 0, pa0); DA_PK4(p0, 8, pa1); DA_PK4(p1, 0, pa2); DA_PK4(p1, 8, pa3);
#undef DA_PK4
}
__device__ __forceinline__ void qkt(f32x16& p0, f32x16& p1, const LAS char* Ks, const bf16x8* qr, int r32, int hi, int comp) {
    p0 = f32x16{}; p1 = f32x16{};
#pragma unroll
    for (int d0 = 0; d0 < 4; ++d0) { const int cb = (comp * 64 + d0 * 16 + hi * 8) * 2;
        const bf16x8 b0 = *(const LAS bf16x8*)(Ks + DA_KSWZ(r32, cb));
        const bf16x8 b1 = *(const LAS bf16x8*)(Ks + DA_KSWZ(32 + r32, cb));
        p0 = __builtin_amdgcn_mfma_f32_32x32x16_bf16(b0, qr[d0], p0, 0, 0, 0);
        p1 = __builtin_amdgcn_mfma_f32_32x32x16_bf16(b1, qr[d0], p1, 0, 0, 0); }
}
__device__ __forceinline__ int v_st(int k, int c) { const int kk = (k & ~0xC) | ((k & 4) << 1) | ((k & 8) >> 1); return ((kk >> 3) * 4 + (c >> 5)) * 512 + ((kk & 7) * 32 + (c & 31)) * 2; }
__device__ __forceinline__ int v_rd_base(int lane) { return ((lane & 3) << 3) | (((lane >> 2) & 3) << 6) | (((lane >> 4) & 1) << 5) | (((lane >> 5) & 1) << 8); }
constexpr int v_rd_off(int d0, int ks, int half) { return d0 * 512 + ks * 4096 + half * 2048; }
template <int OFF> __device__ __forceinline__ s16x4 tr_read(int vb) { s16x4 r; asm volatile("ds_read_b64_tr_b16 %0, %1 offset:%2" : "=&v"(r) : "v"(vb), "i"(OFF) : "memory"); return r; }
template <int D0> __device__ __forceinline__ void pv_one(f32x16& od, int vb, bf16x8 pa0, bf16x8 pa1, bf16x8 pa2, bf16x8 pa3) {
    const s16x4 l0 = tr_read<v_rd_off(D0, 0, 0)>(vb), h0 = tr_read<v_rd_off(D0, 0, 1)>(vb), l1 = tr_read<v_rd_off(D0, 1, 0)>(vb), h1 = tr_read<v_rd_off(D0, 1, 1)>(vb);
    const s16x4 l2 = tr_read<v_rd_off(D0, 2, 0)>(vb), h2 = tr_read<v_rd_off(D0, 2, 1)>(vb), l3 = tr_read<v_rd_off(D0, 3, 0)>(vb), h3 = tr_read<v_rd_off(D0, 3, 1)>(vb);
    asm volatile("s_waitcnt lgkmcnt(0)" ::: "memory"); DA_SBAR();
#define DA_PK(L, H) (bf16x8){L[0], L[1], L[2], L[3], H[0], H[1], H[2], H[3]}
    od = __builtin_amdgcn_mfma_f32_32x32x16_bf16(pa0, DA_PK(l0, h0), od, 0, 0, 0);
    od = __builtin_amdgcn_mfma_f32_32x32x16_bf16(pa1, DA_PK(l1, h1), od, 0, 0, 0);
    od = __builtin_amdgcn_mfma_f32_32x32x16_bf16(pa2, DA_PK(l2, h2), od, 0, 0, 0);
    od = __builtin_amdgcn_mfma_f32_32x32x16_bf16(pa3, DA_PK(l3, h3), od, 0, 0, 0);
#undef DA_PK
}
__device__ __forceinline__ void pv_d0(f32x16* o, int vb, bf16x8 pa0, bf16x8 pa1, bf16x8 pa2, bf16x8 pa3) {
    pv_one<0>(o[0], vb, pa0, pa1, pa2, pa3); pv_one<1>(o[1], vb, pa0, pa1, pa2, pa3); pv_one<2>(o[2], vb, pa0, pa1, pa2, pa3); pv_one<3>(o[3], vb, pa0, pa1, pa2, pa3);
}

#define DA_PKV(L, H) (bf16x8){L[0], L[1], L[2], L[3], H[0], H[1], H[2], H[3]}
#define DA_TRSET(D0, l0, h0, l1, h1, l2, h2, l3, h3) do { if (VAR == 3) { l0 = h0 = l1 = h1 = l2 = h2 = l3 = h3 = (s16x4){1, 2, 3, 4}; break; } l0 = tr_read<v_rd_off(D0, 0, 0)>(vb); h0 = tr_read<v_rd_off(D0, 0, 1)>(vb); l1 = tr_read<v_rd_off(D0, 1, 0)>(vb); h1 = tr_read<v_rd_off(D0, 1, 1)>(vb); \
    l2 = tr_read<v_rd_off(D0, 2, 0)>(vb); h2 = tr_read<v_rd_off(D0, 2, 1)>(vb); l3 = tr_read<v_rd_off(D0, 3, 0)>(vb); h3 = tr_read<v_rd_off(D0, 3, 1)>(vb); } while (0)
#define DA_EX2(P, I) do { if (VAR != 1) { P[I] = __builtin_amdgcn_exp2f(P[I]); P[I + 1] = __builtin_amdgcn_exp2f(P[I + 1]); } } while (0)
#define DA_MF(OD, A, B) do { if (VAR != 2) OD = __builtin_amdgcn_mfma_f32_32x32x16_bf16(A, B, OD, 0, 0, 0); else asm volatile("" :: "v"(B)); } while (0)
#define DA_BLK(OD, PA0, PA1, PA2, PA3, l0, h0, l1, h1, l2, h2, l3, h3, P, I) do { \
    DA_MF(OD, PA0, DA_PKV(l0, h0)); DA_EX2(P, I);     DA_SBAR(); \
    DA_MF(OD, PA1, DA_PKV(l1, h1)); DA_EX2(P, I + 2); DA_SBAR(); \
    DA_MF(OD, PA2, DA_PKV(l2, h2)); DA_EX2(P, I + 4); DA_SBAR(); \
    DA_MF(OD, PA3, DA_PKV(l3, h3)); DA_EX2(P, I + 6); DA_SBAR(); } while (0)
template <int VAR>
__device__ __forceinline__ void pv_fast(f32x16* o, int vb, bf16x8 pa0, bf16x8 pa1, bf16x8 pa2, bf16x8 pa3, f32x16& n0, f32x16& n1, float& l_reg) {
    s16x4 al0, ah0, al1, ah1, al2, ah2, al3, ah3, bl0, bh0, bl1, bh1, bl2, bh2, bl3, bh3;
    DA_TRSET(0, al0, ah0, al1, ah1, al2, ah2, al3, ah3);
    asm volatile("s_waitcnt lgkmcnt(0)" ::: "memory"); DA_SBAR();
    DA_TRSET(1, bl0, bh0, bl1, bh1, bl2, bh2, bl3, bh3); DA_SBAR();
    DA_BLK(o[0], pa0, pa1, pa2, pa3, al0, ah0, al1, ah1, al2, ah2, al3, ah3, n0, 0);
    asm volatile("s_waitcnt lgkmcnt(0)" ::: "memory"); DA_SBAR();
    DA_TRSET(2, al0, ah0, al1, ah1, al2, ah2, al3, ah3); DA_SBAR();
    DA_BLK(o[1], pa0, pa1, pa2, pa3, bl0, bh0, bl1, bh1, bl2, bh2, bl3, bh3, n0, 8);
    asm volatile("s_waitcnt lgkmcnt(0)" ::: "memory"); DA_SBAR();
    DA_TRSET(3, bl0, bh0, bl1, bh1, bl2, bh2, bl3, bh3); DA_SBAR();
    DA_BLK(o[2], pa0, pa1, pa2, pa3, al0, ah0, al1, ah1, al2, ah2, al3, ah3, n1, 0);
    asm volatile("s_waitcnt lgkmcnt(0)" ::: "memory"); DA_SBAR();
    DA_BLK(o[3], pa0, pa1, pa2, pa3, bl0, bh0, bl1, bh1, bl2, bh2, bl3, bh3, n1, 8);
    float ps = 0;
#pragma unroll
    for (int r = 0; r < 16; ++r) ps += n0[r];
#pragma unroll
    for (int r = 0; r < 16; ++r) ps += n1[r];
    l_reg += ps;
}
template <bool FAST, int VAR = 0>
__device__ __forceinline__ bool attn_unit(LAS char* lds, const bf16_t* proj, bf16_t* cat, int h, int qrow0, int nkeys, float lam, float oscale, const float* subln) {
    constexpr int LD = DA_IN;
    const int tid = opaque((int)threadIdx.x), wid = __builtin_amdgcn_readfirstlane(tid >> 6), lane = tid & 63, r32 = lane & 31, hi = lane >> 5, comp = wid >> 2, qw = wid & 3;
    LAS char* V_lds = lds; LAS char* K_lds = lds + 2 * SHM_V;
    LAS float* ws = (LAS float*)(lds + 2 * SHM_V + 2 * SHM_K) + wid * 64; LAS float* li_l = ws; LAS float* al_l = ws + 32;
    float m_reg = -1e30f, l_reg = 0; f32x16 o[4] = {}; bf16x8 qr[4];
    const bf16_t* Qw = proj + (size_t)(qrow0 + qw * 32 + r32) * LD + h * 128 + comp * 64 + hi * 8;
#pragma unroll
    for (int d0 = 0; d0 < 4; ++d0) qr[d0] = *reinterpret_cast<const bf16x8*>(Qw + d0 * 16);
    const bf16_t* Kh = proj + 1024 + h * 128; const bf16_t* Vh = proj + 2048 + h * 128;
    const int sr = tid >> 4, sc = (tid & 15) * 8, vst0 = v_st(sr, sc), vst1 = v_st(32 + sr, sc);
    const int vb0 = (int)(unsigned)(uintptr_t)V_lds + v_rd_base(lane);
    struct { bf16x8 vs0, vs1, ks0, ks1; } sr_[2];
#define DA_SLOAD(i, k0) do { if (VAR == 4) break; sr_[i].vs0 = *(const bf16x8*)(&Vh[(size_t)((k0) + sr) * LD + sc]); sr_[i].vs1 = *(const bf16x8*)(&Vh[(size_t)((k0) + 32 + sr) * LD + sc]); \
    sr_[i].ks0 = *(const bf16x8*)(&Kh[(size_t)((k0) + sr) * LD + sc]); sr_[i].ks1 = *(const bf16x8*)(&Kh[(size_t)((k0) + 32 + sr) * LD + sc]); } while (0)
#define DA_SWRITE(b, i) do { if (VAR == 4) break; *(LAS bf16x8*)(V_lds + (b) * SHM_V + vst0) = sr_[i].vs0; *(LAS bf16x8*)(V_lds + (b) * SHM_V + vst1) = sr_[i].vs1; const int kc = sc * 2; \
    *(LAS bf16x8*)(K_lds + (b) * SHM_K + DA_KSWZ(sr, kc)) = sr_[i].ks0; *(LAS bf16x8*)(K_lds + (b) * SHM_K + DA_KSWZ(32 + sr, kc)) = sr_[i].ks1; } while (0)
#define DA_SWAIT() asm volatile("s_waitcnt vmcnt(4)" ::: "memory")
#define DA_RESC(a) do { if (__any((a) < 1.f)) { if (hi == 0) al_l[r32] = (a); asm volatile("s_waitcnt lgkmcnt(0)" ::: "memory"); \
    _Pragma("unroll") for (int d = 0; d < 4; ++d) _Pragma("unroll") for (int r = 0; r < 16; ++r) o[d][r] *= al_l[crow(r, hi)]; } } while (0)
    f32x16 pA0, pA1, pB0, pB1; float alA, alB; bf16x8 pa0, pa1, pa2, pa3; const int NT = nkeys / KVBLK;
#define DA_PSM(P0, P1, AL) do { if (FAST) { partialSM_fast(P0, P1, l_reg); AL = 1.f; } else partialSM(P0, P1, m_reg, AL); } while (0)
#define DA_PVS(VB, P0, P1, AL) do { if (FAST) { pv_fast<VAR>(o, VB, pa0, pa1, pa2, pa3, P0, P1, l_reg); AL = 1.f; } else { pv_d0(o, VB, pa0, pa1, pa2, pa3); partialSM(P0, P1, m_reg, AL); } } while (0)
#define DA_FSM(P0, P1, AL) do { if (FAST) finishSM_fast(P0, P1, pa0, pa1, pa2, pa3); else finishSM(P0, P1, AL, l_reg, pa0, pa1, pa2, pa3); } while (0)
#define DA_RESCX(a) do { if (!FAST) { DA_RESC(a); } } while (0)
    DA_SLOAD(0, 0); asm volatile("s_waitcnt vmcnt(0)" ::: "memory"); DA_SWRITE(0, 0); __syncthreads();
    qkt(pA0, pA1, K_lds, qr, r32, hi, comp); DA_PSM(pA0, pA1, alA);
    DA_SLOAD(1, KVBLK); if (2 < NT) DA_SLOAD(0, 2 * KVBLK);
    DA_SWAIT(); DA_SWRITE(1, 1); __syncthreads();
#define DA_SYNC() do { if (VAR != 5) __syncthreads(); } while (0)
#define DA_QKT(P0, P1, KS) do { if (VAR != 6) qkt(P0, P1, KS, qr, r32, hi, comp); else { P0 = f32x16{}; P1 = f32x16{}; } } while (0)
    for (int j = 1; j + 1 < NT; j += 2) {
        DA_SBAR(); DA_QKT(pB0, pB1, K_lds + SHM_K);
        DA_FSM(pA0, pA1, alA); DA_SBAR();
        DA_SLOAD(1, (j + 2) * KVBLK); DA_SBAR();
        DA_PVS(vb0, pB0, pB1, alB);
        DA_SYNC(); DA_SWAIT(); DA_SWRITE(0, 0);
        DA_RESCX(alB); DA_SYNC();
        DA_SBAR(); DA_QKT(pA0, pA1, K_lds);
        DA_FSM(pB0, pB1, alB); DA_SBAR();
        { const int tn = (j + 3 < NT) ? (j + 3) : (NT - 1); DA_SLOAD(0, tn * KVBLK); } DA_SBAR();
        DA_PVS(vb0 + SHM_V, pA0, pA1, alA);
        DA_SYNC(); DA_SWAIT(); DA_SWRITE(1, 1);
        DA_RESCX(alA); DA_SYNC();
    }
    DA_SBAR(); qkt(pB0, pB1, K_lds + SHM_K, qr, r32, hi, comp);
    DA_FSM(pA0, pA1, alA); DA_SBAR();
    DA_PVS(vb0, pB0, pB1, alB);
    __syncthreads(); DA_RESCX(alB);
    DA_FSM(pB0, pB1, alB); DA_SBAR();
    pv_d0(o, vb0 + SHM_V, pa0, pa1, pa2, pa3);
#undef DA_PSM
#undef DA_FSM
#undef DA_PVS
#undef DA_SYNC
#undef DA_QKT
    if (FAST) { auto rr = __builtin_amdgcn_permlane32_swap(__float_as_uint(l_reg), __float_as_uint(l_reg), false, false); l_reg = __uint_as_float(rr[0]) + __uint_as_float(rr[1]); }
#undef DA_RESCX
    if (hi == 0) li_l[r32] = l_reg; asm volatile("s_waitcnt lgkmcnt(0)" ::: "memory");
    float rli[16];
#pragma unroll
    for (int r = 0; r < 16; ++r) rli[r] = __builtin_amdgcn_rcpf(li_l[crow(r, hi)]);
#pragma unroll
    for (int d0 = 0; d0 < 4; ++d0)
#pragma unroll
        for (int r = 0; r < 16; ++r) o[d0][r] *= rli[r];
    {   const int bad = (l_reg > 1.0e-30f && l_reg < 1.0e30f) ? 0 : 1;
        if (__syncthreads_or(bad)) { if (FAST) return false; } }
    LAS float* xb = (LAS float*)lds;
    if (comp == 1) {
#pragma unroll
        for (int d0 = 0; d0 < 4; ++d0)
#pragma unroll
            for (int r = 0; r < 16; ++r) xb[((qw * 64) + d0 * 16 + r) * 64 + lane] = o[d0][r];
    }
    __syncthreads();
    if (comp == 0) {
        float ssq[16];
#pragma unroll
        for (int r = 0; r < 16; ++r) ssq[r] = 0.f;
#pragma unroll
        for (int d0 = 0; d0 < 4; ++d0)
#pragma unroll
            for (int r = 0; r < 16; ++r) { const float x = o[d0][r] - lam * xb[((qw * 64) + d0 * 16 + r) * 64 + lane]; o[d0][r] = x; ssq[r] += x * x; }
#pragma unroll
        for (int r = 0; r < 16; ++r) {
#pragma unroll
            for (int off = 16; off >= 1; off >>= 1) ssq[r] += __shfl_xor(ssq[r], off);
            ssq[r] = rsqrtf(ssq[r] * (1.0f / 128.f) + 1e-5f) * oscale; }
        asm volatile("" ::: "memory");
        LAS char* stg = lds + qw * 16384;
#pragma unroll
        for (int d0 = 0; d0 < 4; ++d0) { const float g = subln[d0 * 32 + r32];
#pragma unroll
            for (int r = 0; r < 16; ++r) *(LAS bf16_t*)(stg + crow(r, hi) * 272 + (d0 * 32 + r32) * 2) = f2bf(o[d0][r] * ssq[r] * g); }
        asm volatile("s_waitcnt lgkmcnt(0)" ::: "memory");
        bf16_t* Ow = cat + (size_t)(qrow0 + qw * 32) * DA_W + h * 128;
#pragma unroll
        for (int q = 0; q < 8; ++q) { const int id = q * 64 + lane, row = id >> 4, c16 = id & 15; *(u32x4*)(Ow + (size_t)row * DA_W + c16 * 8) = *(const LAS u32x4*)(stg + row * 272 + c16 * 16); }
    }
    __syncthreads();
    return true;
#undef DA_SLOAD
#undef DA_SWRITE
#undef DA_SWAIT
#undef DA_RESC
}
}

__device__ __forceinline__ void phase_attn(const Ctx& c, int jj, bool with_ctx) {
    PREF P = *c.p; const bf16_t* proj = (const bf16_t*)(c.ws + WS_PROJ); bf16_t* cat = (bf16_t*)(c.ws + WS_CAT);
    const float lam = ((const float*)(c.ws + WS_MISC))[jj * 2 + 0], linit = ((const float*)(c.ws + WS_MISC))[jj * 2 + 1];
    const float* subln = P.in[24] + (size_t)jj * 128;
    const int nunits = 1024 + (with_ctx ? 16 : 0);
    unsigned failed = 0u; int it = 0;
#pragma unroll 1
    for (int L = c.bid; L < nunits; L += c.G, ++it) {
        int h, q0, nk;
        if (L < 1024) { h = L & 7; q0 = NC + (L >> 3) * 128; nk = NTOK; } else { const int i = L - 1024; h = i & 7; q0 = (i >> 3) * 128; nk = NC; }
        if (!da2::attn_unit_dma((LAS char*)c.lds, proj, cat, h, q0, nk, lam, 1.0f - linit, subln)) failed |= 1u << (it & 31);
    }
    failed = (unsigned)__builtin_amdgcn_readfirstlane((int)failed);
    if (failed) {
        it = 0;
#pragma unroll 1
        for (int L = c.bid; L < nunits; L += c.G, ++it) {
            if (!((failed >> (it & 31)) & 1u)) continue;
            int h, q0, nk;
            if (L < 1024) { h = L & 7; q0 = NC + (L >> 3) * 128; nk = NTOK; } else { const int i = L - 1024; h = i & 7; q0 = (i >> 3) * 128; nk = NC; }
            (void)da::attn_unit<false>((LAS char*)c.lds, proj, cat, h, q0, nk, lam, 1.0f - linit, subln);
        }
    }
}
__device__ __forceinline__ MoeTable moe_table(const Ctx& c, int layer, int ntok_l) {
    LAS int* tb = (LAS int*)(c.lds + LDS_MISC + 64); LAS int* cn = (LAS int*)(c.lds + LDS_MISC + 512);
    const unsigned* cg = (const unsigned*)(c.ws + WS_CTL) + CW_CNT + c.cnt_off + layer * 64;
    __syncthreads();
    if (c.tid == 0) { int t = 0;
        for (int e = 0; e < 65; ++e) { const int n = (e < 64) ? (int)cg[e] : ntok_l; cn[e] = n; tb[e] = t; t += (n + 255) >> 8; }
        tb[65] = t; }
    __syncthreads();
    MoeTable r; r.tb = tb; r.cn = cn; return r;
}

__device__ __forceinline__ void phase_p6(const Ctx& c, int layer, int tok0) {
    PREF P = *c.p; unsigned char* ws = c.ws; const int tid = c.tid, lane = c.lane, w = c.wid;
#ifndef DUP_CVT
#define DUP_CVT 1
#endif
#ifndef PROBE_SKIP
#define PROBE_SKIP 0
#endif
    if (!((PROBE_SKIP & 1) && c.pass == 0))
    _Pragma("unroll 1") for (int rep_ = 0; rep_ < DUP_CVT; ++rep_) {
        const float* wg = P.in[27] + (size_t)layer * 64 * 1024 * 256; const float* wu = P.in[28] + (size_t)layer * 64 * 1024 * 256; const float* wd = P.in[29] + (size_t)layer * 64 * 256 * 1024;
        const float* sg = P.in[30] + (size_t)layer * 1024 * 256; const float* su = P.in[31] + (size_t)layer * 1024 * 256; const float* sd = P.in[32] + (size_t)layer * 256 * 1024;
        bf16_t* WGU = (bf16_t*)(ws + WS_WGU); bf16_t* WD = (bf16_t*)(ws + WS_WD);
        const int NT_ = 65 * 192;
        for (int u = c.bid; u < NT_; u += c.G) {
            const int e = u / 192, r = u % 192, kind = r >> 6, q = r & 63;
            if (kind == 0) { const float* src = (e < 64) ? wg + (size_t)e * 1024 * 256 : sg; cvt_tile(c, src, 256, (q >> 2) * 64, (q & 3) * 64, WGU + (size_t)e * 512 * 1024, 1024, RowGate()); }
            else if (kind == 1) { const float* src = (e < 64) ? wu + (size_t)e * 1024 * 256 : su; cvt_tile(c, src, 256, (q >> 2) * 64, (q & 3) * 64, WGU + (size_t)e * 512 * 1024, 1024, RowUp()); }
            else { const float* src = (e < 64) ? wd + (size_t)e * 256 * 1024 : sd; cvt_tile(c, src, 1024, (q >> 4) * 64, (q & 15) * 64, WD + (size_t)e * 1024 * 256, 256, RowId()); }
        }
    }
    __syncthreads();
    if ((PROBE_SKIP & 2) && c.pass == 0) return;
    const int ntok_l = NTOK - tok0, tpb = (ntok_l + c.G - 1) / c.G;
    const int tb0 = tok0 + c.bid * tpb, tb1 = (tb0 + tpb < NTOK) ? tb0 + tpb : NTOK; const int nloc = (tb1 > tb0) ? tb1 - tb0 : 0;
    LAS float* lg = (LAS float*)c.lds;
    LAS int* che = (LAS int*)(c.lds + 40960); LAS float* chw = (LAS float*)(c.lds + 46080);
    LAS int* cntl = (LAS int*)(c.lds + 51200); LAS int* basel = (LAS int*)(c.lds + 51456);
    if (tid < 64) cntl[tid] = 0;
    const float* xres = (const float*)(ws + WS_XRES); bf16_t* hB = (bf16_t*)(ws + WS_H); bf16_t* hL = (bf16_t*)(ws + WS_HLO);
    const float* gain = P.in[7] + (size_t)layer * D; const float* modl = (const float*)(ws + WS_MOD) + (size_t)layer * 2 * 6144;
    const bf16_t* wrh = (const bf16_t*)(ws + WS_WR) + (size_t)(layer * 2 + 0) * 64 * 1024; const bf16_t* wrl = wrh + 64 * 1024;
    const float* rbias = P.in[26] + (size_t)layer * 64;
#ifndef DUP_TOK
#define DUP_TOK 1
#endif
    _Pragma("unroll 1") for (int rept_ = 0; rept_ < DUP_TOK; ++rept_) {
#pragma unroll 1
    for (int tl0 = w * 2; tl0 < nloc; tl0 += 16) {
        f32x4 v[2][4]; float ss[2];
#pragma unroll
        for (int t = 0; t < 2; ++t) { const int tl = (tl0 + t < nloc) ? tl0 + t : nloc - 1; const float* x = xres + (size_t)(tb0 + tl) * D; ss[t] = 0.f;
#pragma unroll
            for (int q = 0; q < 4; ++q) { v[t][q] = *(const f32x4*)(x + q * 256 + lane * 4); ss[t] += v[t][q][0] * v[t][q][0] + v[t][q][1] * v[t][q][1] + v[t][q][2] * v[t][q][2] + v[t][q][3] * v[t][q][3]; } }
        ss[0] = wave_sum(ss[0]); ss[1] = wave_sum(ss[1]);
#pragma unroll
        for (int t = 0; t < 2; ++t) { if (tl0 + t < nloc) { const int row = tb0 + tl0 + t; const float* m = modl + ((row < NC) ? 6144 : 0); const float rstd = rsqrtf(ss[t] * (1.0f / 1024.f) + EPS);
#pragma unroll
            for (int q = 0; q < 4; ++q) { const int col = q * 256 + lane * 4;
                const f32x4 g = *(const f32x4*)(gain + col), sc = *(const f32x4*)(m + 4 * 1024 + col), sh = *(const f32x4*)(m + 3 * 1024 + col);
                float o[4], lo_[4];
#pragma unroll
                for (int k = 0; k < 4; ++k) { o[k] = v[t][q][k] * rstd * g[k] * (1.0f + sc[k]) + sh[k]; lo_[k] = o[k] - bf2f(f2bf(o[k])); }
                u32x2 wv; wv.x = cvtpk(o[0], o[1]); wv.y = cvtpk(o[2], o[3]);
                *(u32x2*)(hB + (size_t)row * D + col) = wv;
                u32x2 wl; wl.x = cvtpk(lo_[0], lo_[1]); wl.y = cvtpk(lo_[2], lo_[3]);
                *(u32x2*)(hL + (size_t)row * D + col) = wl; } } }
    }
    asm volatile("s_waitcnt vmcnt(0)" ::: "memory");
    __syncthreads();
    {   const int et = w & 3, kh = w >> 2, fr = lane & 15, fq = lane >> 4; const int nmt = (nloc + 15) >> 4;
        f32x4 acc[5];
#pragma unroll
        for (int mt = 0; mt < 5; ++mt) acc[mt] = (f32x4){0.f, 0.f, 0.f, 0.f};
        const bf16_t* bh = wrh + (size_t)(et * 16 + fr) * 1024 + kh * 512 + fq * 8; const bf16_t* bl = wrl + (size_t)(et * 16 + fr) * 1024 + kh * 512 + fq * 8;
        size_t arow[5];
#pragma unroll
        for (int mt = 0; mt < 5; ++mt) { int tl = mt * 16 + fr; tl = (tl < nloc) ? tl : (nloc > 0 ? nloc - 1 : 0); arow[mt] = (size_t)(tb0 + tl) * D + kh * 512 + fq * 8; }
#pragma unroll 2
        for (int ks = 0; ks < 16; ++ks) {
            const bf16x8 vbh = *(const bf16x8*)(bh + ks * 32), vbl = *(const bf16x8*)(bl + ks * 32);
#pragma unroll
            for (int mt = 0; mt < 5; ++mt) { if (mt < nmt) {
                const bf16x8 ah = *(const bf16x8*)(hB + arow[mt] + ks * 32), al = *(const bf16x8*)(hL + arow[mt] + ks * 32);
                acc[mt] = __builtin_amdgcn_mfma_f32_16x16x32_bf16(ah, vbh, acc[mt], 0, 0, 0);
                acc[mt] = __builtin_amdgcn_mfma_f32_16x16x32_bf16(ah, vbl, acc[mt], 0, 0, 0);
                acc[mt] = __builtin_amdgcn_mfma_f32_16x16x32_bf16(al, vbh, acc[mt], 0, 0, 0); } } }
#pragma unroll
        for (int mt = 0; mt < 5; ++mt)
#pragma unroll
            for (int r = 0; r < 4; ++r) lg[(kh * 80 + mt * 16 + fq * 4 + r) * 64 + et * 16 + fr] = acc[mt][r];
    }
    __syncthreads();
    }
#pragma unroll 1
    for (int tl = w; tl < nloc; tl += 8) {
        const float logit = lg[tl * 64 + lane] + lg[(80 + tl) * 64 + lane];
        const float score = sigmoidf_(logit), choice = score + rbias[lane];
        float m1 = choice;
#pragma unroll
        for (int off = 1; off <= 4; off <<= 1) m1 = fmaxf(m1, __shfl_xor(m1, off));
        const unsigned long long bm = __ballot(choice == m1); const unsigned gb = (unsigned)(bm >> (lane & 56)) & 0xffu;
        const bool isfirst = ((lane & 7) == (__builtin_ctz(gb) & 7));
        float m2 = isfirst ? -INFINITY : choice;
#pragma unroll
        for (int off = 1; off <= 4; off <<= 1) m2 = fmaxf(m2, __shfl_xor(m2, off));
        const float gs = m1 + m2; const int g = lane >> 3; int grank = 0;
#pragma unroll
        for (int g2 = 0; g2 < 8; ++g2) { const float o = __shfl(gs, g2 * 8); grank += (o > gs || (o == gs && g2 < g)) ? 1 : 0; }
        const bool gsel = grank < 4; const float mc = gsel ? choice : -INFINITY; int erank = 0;
#pragma unroll 8
        for (int e2 = 0; e2 < 64; ++e2) { const float o = __shfl(mc, e2); erank += (o > mc || (o == mc && e2 < lane)) ? 1 : 0; }
        const bool sel = gsel && erank < 8;
        const float sw = wave_sum(sel ? score : 0.f);
        if (sel) { che[tl * 8 + erank] = lane; chw[tl * 8 + erank] = score / (sw + 1e-20f) * 2.5f; atomicAdd((int*)&cntl[lane], 1); }
    }
    __syncthreads();
    if (tid < 64) { const int n = cntl[tid]; unsigned* cg = (unsigned*)(ws + WS_CTL) + CW_CNT + c.cnt_off + layer * 64;
        basel[tid] = n ? (int)__hip_atomic_fetch_add(cg + tid, (unsigned)n, __ATOMIC_RELAXED, __HIP_MEMORY_SCOPE_AGENT) : 0; cntl[tid] = 0; }
    __syncthreads();
    int* ltok = (int*)(ws + WS_LTOK); float* lw = (float*)(ws + WS_LW); int* slot = (int*)(ws + WS_SLOT);
    for (int idx = tid; idx < nloc * 8; idx += NTHREADS) { const int tl = idx >> 3, e = che[idx]; const int pos = basel[e] + atomicAdd((int*)&cntl[e], 1);
        ltok[(size_t)e * NTOK + pos] = tb0 + tl; lw[(size_t)e * NTOK + pos] = chw[idx]; slot[(size_t)(tb0 + tl) * 8 + (idx & 7)] = (e << 20) | pos; }
    __syncthreads();
}

__device__ __forceinline__ void phase_p9(const Ctx& c, int layer, int tok0, const MoeTable& t) {
    PREF P = *c.p; unsigned char* ws = c.ws; const int lane = c.lane;
    float* xres = (float*)(ws + WS_XRES); const bf16_t* Y = (const bf16_t*)(ws + WS_YSLOT); const int* slot = (const int*)(ws + WS_SLOT);
    const float* modl = (const float*)(ws + WS_MOD) + (size_t)layer * 2 * 6144;
    const bool fin = (layer == DEPTH - 1);
    const float* gain = fin ? P.in[33] : P.in[6] + (size_t)(layer + 1) * D; const float* modn = (const float*)(ws + WS_MOD) + (size_t)(layer + 1) * 2 * 6144;
    bf16_t* hA = (bf16_t*)(ws + WS_H);
    const size_t shrow0 = (size_t)t.tb[64] * 256;
    for (int row = tok0 + c.bid * 8 + c.wid; row < NTOK; row += c.G * 8) {
        const int sl = (lane < 8) ? slot[(size_t)row * 8 + lane] : 0;
        float acc[16];
#pragma unroll
        for (int k = 0; k < 16; ++k) acc[k] = 0.f;
#pragma unroll
        for (int k = 0; k < 9; ++k) { size_t yr;
            if (k < 8) { const int s = __shfl(sl, k); yr = (size_t)t.tb[s >> 20] * 256 + (s & 0xfffff); } else yr = shrow0 + (size_t)(row - tok0);
#pragma unroll
            for (int q = 0; q < 2; ++q) { const u32x4 v = *(const u32x4*)(Y + yr * 1024 + q * 512 + lane * 8);
                acc[q * 8 + 0] += bflo(v.x); acc[q * 8 + 1] += bfhi(v.x); acc[q * 8 + 2] += bflo(v.y); acc[q * 8 + 3] += bfhi(v.y);
                acc[q * 8 + 4] += bflo(v.z); acc[q * 8 + 5] += bfhi(v.z); acc[q * 8 + 6] += bflo(v.w); acc[q * 8 + 7] += bfhi(v.w); } }
        const float* m = modl + ((row < NC) ? 6144 : 0) + 5 * 1024; float* x = xres + (size_t)row * D; float xn[16]; float ss = 0.f;
#pragma unroll
        for (int q = 0; q < 2; ++q)
#pragma unroll
            for (int hh = 0; hh < 2; ++hh) { const int col = q * 512 + lane * 8 + hh * 4; const f32x4 xv = *(const f32x4*)(x + col), g = *(const f32x4*)(m + col); f32x4 o;
#pragma unroll
                for (int k = 0; k < 4; ++k) { o[k] = xv[k] + g[k] * acc[q * 8 + hh * 4 + k]; xn[q * 8 + hh * 4 + k] = o[k]; ss += o[k] * o[k]; }
                *(f32x4*)(x + col) = o; }
        ss = wave_sum(ss); const float rstd = rsqrtf(ss * (1.0f / 1024.f) + EPS);
        if (fin) {
            float* out = P.out + (size_t)(row - NC) * D;
#pragma unroll
            for (int q = 0; q < 2; ++q)
#pragma unroll
                for (int hh = 0; hh < 2; ++hh) { const int col = q * 512 + lane * 8 + hh * 4; const f32x4 g = *(const f32x4*)(gain + col); f32x4 o;
#pragma unroll
                    for (int k = 0; k < 4; ++k) o[k] = xn[q * 8 + hh * 4 + k] * rstd * g[k];
                    *(f32x4*)(out + col) = o; }
        } else {
            const float* mn = modn + ((row < NC) ? 6144 : 0);
#pragma unroll
            for (int q = 0; q < 2; ++q) { const int col = q * 512 + lane * 8; float o[8];
#pragma unroll
                for (int hh = 0; hh < 2; ++hh) { const f32x4 g = *(const f32x4*)(gain + col + hh * 4), sc = *(const f32x4*)(mn + 1024 + col + hh * 4), sh = *(const f32x4*)(mn + col + hh * 4);
#pragma unroll
                    for (int k = 0; k < 4; ++k) o[hh * 4 + k] = xn[q * 8 + hh * 4 + k] * rstd * g[k] * (1.0f + sc[k]) + sh[k]; }
                u32x4 wv; wv.x = cvtpk(o[0], o[1]); wv.y = cvtpk(o[2], o[3]); wv.z = cvtpk(o[4], o[5]); wv.w = cvtpk(o[6], o[7]);
                *(u32x4*)(hA + (size_t)row * D + col) = wv; }
        }
    }
}
#ifndef DUP_INPROJ
#define DUP_INPROJ 1
#endif
#ifndef DUP_ATTN
#define DUP_ATTN 1
#endif
#ifndef DUP_UP
#define DUP_UP 1
#endif
#ifndef DUP_DOWN
#define DUP_DOWN 1
#endif
#ifndef DUP_F
#define DUP_F 1
#endif
#ifndef DUP_HYCONV
#define DUP_HYCONV 1
#endif
#ifndef DUP_R1
#define DUP_R1 1
#endif
#ifndef DUP_R3
#define DUP_R3 1
#endif
#ifndef DUP_MISC
#define DUP_MISC 1
#endif
#ifndef DUP_PR
#define DUP_PR 1
#endif
#ifndef DUP_CVT
#define DUP_CVT 1
#endif
#define REPEAT(n) _Pragma("unroll 1") for (int rep_ = 0; rep_ < (n); ++rep_)
constexpr int NPHASE = 38;
__global__ void __launch_bounds__(NTHREADS, 2) fwd_kernel(Params prm) {
    extern __shared__ __attribute__((aligned(16))) unsigned char lds_raw[];
    const KParams kp0 = (KParams)__builtin_amdgcn_kernarg_segment_ptr();
    Ctx c; c.p = kp0; c.lds = (LAS unsigned char*)lds_raw; c.tid = threadIdx.x; c.lane = c.tid & 63; c.wid = __builtin_amdgcn_readfirstlane(c.tid >> 6); c.G = gridDim.x; c.bid = blockIdx.x; c.ws = kp0->ws;
    volatile LAS unsigned* misc = (volatile LAS unsigned*)(c.lds + LDS_MISC);
    if (c.tid < 4) misc[c.tid] = 0u;
    __syncthreads();
#ifdef PROBE_STOP
    const int lo = 0; int hi = PROBE_STOP; int cnt_off = 256;
#else
    const int lo = kp0->ph_lo, hi = kp0->ph_hi; const int cnt_off = 0;
#endif
    XcdBarrier bar; bar.bar = (unsigned*)(c.ws + WS_CTL) + CW_BAR; bar.x = 0; bar.st = misc;
    if (kp0->ph_hi - kp0->ph_lo > 1) bar = xcd_barrier_post((unsigned*)(c.ws + WS_CTL) + CW_BAR, misc);
#define IN(k) ((lo <= (k) && (k) < hi) && ((c.tid = opaque((int)threadIdx.x)), (c.lane = c.tid & 63), (c.wid = __builtin_amdgcn_readfirstlane(c.tid >> 6)), (c.p = opaque_kp(kp0)), (c.ws = c.p->ws), (ws = c.ws), (c.G = opaque_s((int)gridDim.x)), (c.bid = opaque_s((int)blockIdx.x)), true))
#define SEAM(k) do { if ((lo <= (k)) && ((k) + 1 < hi)) { bar.bar = (unsigned*)(opaque_kp(kp0)->ws + WS_CTL) + CW_BAR; xcd_barrier(bar); } } while (0)
    unsigned char* ws = c.ws;
#ifdef PROBE_STOP
#pragma unroll 1
    for (int pass = 0; pass < 2; ++pass) {
    if (pass == 1) { xcd_barrier(bar); hi = NPHASE; cnt_off = 0; }
#endif
    c.cnt_off = cnt_off;
#ifdef PROBE_STOP
    c.pass = pass;
#else
    c.pass = 1;
#endif
    if (IN(0)) { REPEAT(DUP_PR) phase_pr0(c); } SEAM(0);
    if (IN(1)) { REPEAT(DUP_PR) phase_pr1(c); } SEAM(1);
#pragma unroll 1
    for (int jj = 0; jj < 2; ++jj) {
        const int pb = 2 + jj * 18;
        { const int layer = 2 * jj;
        if (IN(pb + 0)) { REPEAT(DUP_F) phase_f1(c, jj); } SEAM(pb + 0);
        if (IN(pb + 1)) { REPEAT(DUP_F) phase_f2(c); } SEAM(pb + 1);
        if (IN(pb + 2)) {
            DenseSched S; S.init(ws + WS_H, (const bf16_t*)(ws + WS_WAB_IN) + (size_t)jj * AB_IN * 1024, 1024, 65, 18, 0, c.G, c.bid);
            EpiAbIn E{(bf16_t*)(ws + WS_PROJ), (const f32x2*)(ws + WS_ROPE)};
            REPEAT(DUP_INPROJ) pg8::gemm_phase<EpiAbIn, DenseSched, false>(c.lds, 1024, S, E); } SEAM(pb + 2);
        if (IN(pb + 3)) { REPEAT(DUP_R1) phase_r1(c, jj); REPEAT(DUP_MISC) phase_hyprep(c, jj); } SEAM(pb + 3);
        if (IN(pb + 4)) { REPEAT(DUP_HYCONV) phase_hyconv(c, jj); REPEAT(DUP_MISC) phase_scan(c, jj); } SEAM(pb + 4);
        if (IN(pb + 5)) { REPEAT(DUP_R3) phase_r3(c, jj); REPEAT(DUP_MISC) { phase_hytrans(c); phase_hyctx(c, jj); } } SEAM(pb + 5);
        if (IN(pb + 6)) {
            DenseSched S; S.init(ws + WS_CAT, (const bf16_t*)(ws + WS_WAB_OUT) + (size_t)jj * 1024 * AB_CAT, AB_CAT, 65, 4, 0, c.G, c.bid);
            EpiResid E{(float*)(ws + WS_XRES), (const float*)(ws + WS_MOD) + (size_t)layer * 2 * 6144};
            pg8::gemm_phase<EpiResid, DenseSched, false>(c.lds, AB_CAT, S, E); } SEAM(pb + 6);
        if (IN(pb + 7)) { phase_p6(c, layer, 0); } SEAM(pb + 7);
        if (IN(pb + 8)) { const MoeTable t = moe_table(c, layer, NTOK);
            MoeUpSched S; S.t = t; S.H = (const char*)(ws + WS_H); S.W = (const char*)(ws + WS_WGU); S.ltok = (const int*)(ws + WS_LTOK); S.tok0 = 0; S.G = c.G; S.c = c.bid; S.nwg = t.tb[65] * 2;
            EpiSwiglu E{(bf16_t*)(ws + WS_ACT)};
            REPEAT(DUP_UP) pg8::gemm_phase<EpiSwiglu, MoeUpSched, true>(c.lds, 1024, S, E); } SEAM(pb + 8);
        if (IN(pb + 9)) { const MoeTable t = moe_table(c, layer, NTOK);
            MoeDownSched S; S.t = t; S.ACT = (const char*)(ws + WS_ACT); S.W = (const char*)(ws + WS_WD); S.G = c.G; S.c = c.bid; S.nwg = t.tb[65] * 4;
            EpiDown E{(bf16_t*)(ws + WS_YSLOT), (const float*)(ws + WS_LW), t};
            REPEAT(DUP_DOWN) pg8::gemm_phase<EpiDown, MoeDownSched, false>(c.lds, 256, S, E); } SEAM(pb + 9);
        if (IN(pb + 10)) { const MoeTable t = moe_table(c, layer, NTOK); phase_p9(c, layer, 0, t); } SEAM(pb + 10);
        }
        { const int layer = 2 * jj + 1; const bool with_ctx = layer < DEPTH - 1; const int tok0 = with_ctx ? 0 : NC; const int pm0 = with_ctx ? 0 : 1;
        if (IN(pb + 11)) {
            DenseSched S; S.init(ws + WS_H, (const bf16_t*)(ws + WS_WDA_IN) + (size_t)jj * DA_IN * 1024, 1024, 65, 12, 0, c.G, c.bid);
            EpiDaIn E{(bf16_t*)(ws + WS_PROJ), (const f32x2*)(ws + WS_ROPE) + (256 * 32 + 64 * 32)};
            REPEAT(DUP_INPROJ) pg8::gemm_phase<EpiDaIn, DenseSched, false>(c.lds, 1024, S, E); } SEAM(pb + 11);
        if (IN(pb + 12)) { REPEAT(DUP_ATTN) phase_attn(c, jj, with_ctx); } SEAM(pb + 12);
        if (IN(pb + 13)) {
            DenseSched S; S.init(ws + WS_CAT, (const bf16_t*)(ws + WS_WDA_OUT) + (size_t)jj * 1024 * 1024, 1024, 65, 4, pm0, c.G, c.bid);
            EpiResid E{(float*)(ws + WS_XRES), (const float*)(ws + WS_MOD) + (size_t)layer * 2 * 6144};
            pg8::gemm_phase<EpiResid, DenseSched, false>(c.lds, 1024, S, E); } SEAM(pb + 13);
        if (IN(pb + 14)) { phase_p6(c, layer, tok0); } SEAM(pb + 14);
        if (IN(pb + 15)) { const MoeTable t = moe_table(c, layer, NTOK - tok0);
            MoeUpSched S; S.t = t; S.H = (const char*)(ws + WS_H); S.W = (const char*)(ws + WS_WGU); S.ltok = (const int*)(ws + WS_LTOK); S.tok0 = tok0; S.G = c.G; S.c = c.bid; S.nwg = t.tb[65] * 2;
            EpiSwiglu E{(bf16_t*)(ws + WS_ACT)};
            REPEAT(DUP_UP) pg8::gemm_phase<EpiSwiglu, MoeUpSched, true>(c.lds, 1024, S, E); } SEAM(pb + 15);
        if (IN(pb + 16)) { const MoeTable t = moe_table(c, layer, NTOK - tok0);
            MoeDownSched S; S.t = t; S.ACT = (const char*)(ws + WS_ACT); S.W = (const char*)(ws + WS_WD); S.G = c.G; S.c = c.bid; S.nwg = t.tb[65] * 4;
            EpiDown E{(bf16_t*)(ws + WS_YSLOT), (const float*)(ws + WS_LW), t};
            REPEAT(DUP_DOWN) pg8::gemm_phase<EpiDown, MoeDownSched, false>(c.lds, 256, S, E); } SEAM(pb + 16);
        if (IN(pb + 17)) { const MoeTable t = moe_table(c, layer, NTOK - tok0); phase_p9(c, layer, tok0, t); } SEAM(pb + 17);
        }
    }
#ifdef PROBE_STOP
    }
#endif
#undef IN
#undef SEAM
}

#ifdef DBG_K
__global__ void dbg_dump(const unsigned* w, size_t nwords, float* out, int nout) {
    for (int i = blockIdx.x * blockDim.x + threadIdx.x; i < nout; i += gridDim.x * blockDim.x) { unsigned h = 0;
        for (size_t q = i; q < nwords; q += (size_t)nout) { unsigned x = w[q]; x ^= x >> 16; x *= 0x7feb352du; x ^= x >> 15; x *= 0x846ca68bu; x ^= x >> 16; h += x; }
        out[i] = (float)(h & 0xFFFFFu); }
}
#endif
#ifndef MK_SPLIT
#define MK_SPLIT 0
#endif
extern "C" void kernel_launch(void* const* d_in, const int* in_sizes, int n_in, void* d_out, int out_size, void* d_ws, size_t ws_size, hipStream_t stream) {
    static int grid = 0;
    if (grid == 0) {
        if (n_in != 34 || out_size != NX * D || ws_size < WS_END) { fprintf(stderr, "kernel_launch: unexpected shapes: n_in %d out %d ws %zu (need %zu)\n", n_in, out_size, ws_size, (size_t)WS_END); grid = -1; return; }
        int dev = 0, cus = 0, per_cu = 0;
        if (hipGetDevice(&dev) != hipSuccess || hipDeviceGetAttribute(&cus, hipDeviceAttributeMultiprocessorCount, dev) != hipSuccess) { grid = -1; return; }
        if (hipFuncSetAttribute((const void*)fwd_kernel, hipFuncAttributeMaxDynamicSharedMemorySize, LDS_BYTES) != hipSuccess) { fprintf(stderr, "kernel_launch: hipFuncSetAttribute failed\n"); grid = -1; return; }
        if (hipOccupancyMaxActiveBlocksPerMultiprocessor(&per_cu, (const void*)fwd_kernel, NTHREADS, LDS_BYTES) != hipSuccess || per_cu < 1) { fprintf(stderr, "kernel_launch: occupancy query says %d\n", per_cu); grid = -1; return; }
        grid = cus;
        if (grid > 256) grid = 256;
        grid &= ~7;
    }
    if (grid <= 0) return;
    (void)hipMemsetAsync((char*)d_ws + WS_CTL, 0, CTL_ZERO_BYTES, stream);
    Params p{};
    for (int i = 0; i < 34; ++i) p.in[i] = (const float*)d_in[i];
    p.out = (float*)d_out; p.ws = (unsigned char*)d_ws;
#ifdef DBG_K
    for (int k = 0; k <= DBG_K; ++k) { p.ph_lo = k; p.ph_hi = k + 1; hipLaunchKernelGGL(fwd_kernel, dim3(grid), dim3(NTHREADS), LDS_BYTES, stream, p); }
    hipLaunchKernelGGL(dbg_dump, dim3(1024), dim3(256), 0, stream, (const unsigned*)((const char*)d_ws + (size_t)(DBG_OFF)), (size_t)(DBG_BYTES) / 4, (float*)d_out, out_size);
#elif MK_SPLIT
    for (int k = 0; k < NPHASE; ++k) { p.ph_lo = k; p.ph_hi = k + 1; hipLaunchKernelGGL(fwd_kernel, dim3(grid), dim3(NTHREADS), LDS_BYTES, stream, p); }
#else
    p.ph_lo = 0; p.ph_hi = NPHASE;
    hipLaunchKernelGGL(fwd_kernel, dim3(grid), dim3(NTHREADS), LDS_BYTES, stream, p);
#endif
    const hipError_t le = hipPeekAtLastError();
    if (le != hipSuccess) fprintf(stderr, "kernel_launch: launch failed: %s\n", hipGetErrorName(le));
}
```

```cpp
#include <hip/hip_runtime.h>
#include <cstdio>
#include <cstdint>
#include <cmath>

#define LAS __attribute__((address_space(3)))
typedef unsigned short bf16_t;
typedef short bf16x8 __attribute__((ext_vector_type(8)));
typedef short s16x4 __attribute__((ext_vector_type(4)));
typedef float f32x2 __attribute__((ext_vector_type(2)));
typedef float f32x4 __attribute__((ext_vector_type(4)));
typedef float f32x16 __attribute__((ext_vector_type(16)));
typedef unsigned u32x2 __attribute__((ext_vector_type(2)));
typedef unsigned u32x4 __attribute__((ext_vector_type(4)));
typedef __bf16 bf16x2_t __attribute__((ext_vector_type(2)));

constexpr int D = 1024, NC = 256, NX = 16384, NTOK = NC + NX, DEPTH = 4;
constexpr int AB_IN = 4608, AB_CAT = 1536, DA_IN = 3072, DA_W = 1024;
constexpr int NEXP = 64, TOPK = 8, EDIM = 256;
constexpr int FFT_M = 16384;
constexpr int HSPEC_LD = 16400;
constexpr float EPS = 1e-6f;

__device__ __forceinline__ unsigned cvtpk(float lo, float hi) { f32x2 v = {lo, hi}; bf16x2_t b = __builtin_convertvector(v, bf16x2_t); return __builtin_bit_cast(unsigned, b); }
__device__ __forceinline__ bf16_t f2bf(float x) { return (bf16_t)(cvtpk(x, 0.f) & 0xffffu); }
__device__ __forceinline__ float bf2f(bf16_t b) { return __uint_as_float(((unsigned)b) << 16); }
__device__ __forceinline__ float bflo(unsigned w) { return __uint_as_float(w << 16); }
__device__ __forceinline__ float bfhi(unsigned w) { return __uint_as_float(w & 0xffff0000u); }
__device__ __forceinline__ float siluf(float x) { return x / (1.0f + __expf(-x)); }
__device__ __forceinline__ float sigmoidf_(float x) { return 1.0f / (1.0f + __expf(-x)); }
__device__ __forceinline__ int opaque(int x) { asm volatile("" : "+v"(x)); return x; }
__device__ __forceinline__ int opaque_s(int x) { asm volatile("" : "+s"(x)); return x; }
template <class T> __device__ __forceinline__ T* opaque_p(T* p) { asm volatile("" : "+s"(p)); return p; }
__device__ __forceinline__ float wave_sum(float v) {
#pragma unroll
    for (int o = 32; o >= 1; o >>= 1) v += __shfl_xor(v, o);
    return v;
}

#define XB_TMO      128
#define XB_XCNT(j)  (256  + 64 * (j))
#define XB_XSUB(j)  (1280 + 64 * (j))
#define XB_XGEN(j)  (2304 + 64 * (j))
#define XB_TOP      3328
#define XB_TOPGEN   3392
#define XCD_BAR_WORDS 3456
#define XB_SPIN_CAP (1u << 18)

__device__ __forceinline__ unsigned xb_ld(unsigned* p)              { return __hip_atomic_load(p, __ATOMIC_RELAXED, __HIP_MEMORY_SCOPE_AGENT); }
__device__ __forceinline__ unsigned xb_add(unsigned* p, unsigned v) { return __hip_atomic_fetch_add(p, v, __ATOMIC_RELAXED, __HIP_MEMORY_SCOPE_AGENT); }
__device__ __forceinline__ unsigned xb_xcc_id() { return (unsigned)__builtin_amdgcn_s_getreg((3 << 11) | 20) & 0xFu; }
#define XB_SPIN(cond, bar) do { unsigned _sp = 0; while (cond) { __builtin_amdgcn_s_sleep(1); \
    if ((++_sp & 255u) == 0u) { if (xb_ld(&(bar)[XB_TMO])) break; if (_sp > XB_SPIN_CAP) { atomicAdd(&(bar)[XB_TMO], 1u); break; } } } } while (0)

struct XcdBarrier { unsigned* bar; unsigned x; volatile LAS unsigned* st; };

__device__ __forceinline__ XcdBarrier xcd_barrier_post(unsigned* bar, volatile LAS unsigned* st) {
    XcdBarrier b; b.bar = bar; b.x = xb_xcc_id(); b.st = st;
    if (threadIdx.x == 0) (void)xb_add(&bar[XB_XCNT(b.x)], 1u);
    return b;
}
__device__ __forceinline__ void xcd_barrier_complete(unsigned* bar, unsigned x, unsigned& nloc, unsigned& nx) {
    const unsigned G = gridDim.x * gridDim.y * gridDim.z;
    unsigned sum, cnt, mine, sp = 0u;
    for (;;) {
        sum = 0u; cnt = 0u; mine = 0u;
#pragma unroll
        for (unsigned j = 0; j < 16; ++j) { const unsigned c = xb_ld(&bar[XB_XCNT(j)]); sum += c; cnt += (c > 0u) ? 1u : 0u; mine = (j == x) ? c : mine; }
        if (sum == G) break;
        __builtin_amdgcn_s_sleep(1);
        if ((++sp & 255u) == 0u) { if (xb_ld(&bar[XB_TMO])) break; if (sp > XB_SPIN_CAP) { atomicAdd(&bar[XB_TMO], 1u); break; } }
    }
    nloc = mine > 0u ? mine : 1u; nx = cnt > 0u ? cnt : 1u;
}
__device__ __forceinline__ void xcd_barrier(const XcdBarrier& b) {
    asm volatile("s_waitcnt vmcnt(0)" ::: "memory");
    __syncthreads();
    if (threadIdx.x == 0) {
        unsigned* bar = b.bar;
        __builtin_amdgcn_s_waitcnt(0);
        unsigned nloc = b.st[0], nx = b.st[1];
        if (nloc == 0u) { xcd_barrier_complete(bar, b.x, nloc, nx); b.st[0] = nloc; b.st[1] = nx; }
        const unsigned old = xb_add(&bar[XB_XSUB(b.x)], 1u);
        const unsigned gen = old / nloc;
        if (old + 1u == (gen + 1u) * nloc) {
            __builtin_amdgcn_fence(__ATOMIC_RELEASE, "agent");
            asm volatile("s_waitcnt vmcnt(0)" ::: "memory");
            const unsigned og = xb_add(&bar[XB_TOP], 1u);
            const unsigned tg = og / nx;
            if (og + 1u == (tg + 1u) * nx) xb_add(&bar[XB_TOPGEN], 1u);
            else XB_SPIN(xb_ld(&bar[XB_TOPGEN]) == tg, bar);
            __builtin_amdgcn_fence(__ATOMIC_ACQUIRE, "agent");
            xb_add(&bar[XB_XGEN(b.x)], 1u);
            asm volatile("s_waitcnt vmcnt(0)" ::: "memory");
        } else {
            XB_SPIN(xb_ld(&bar[XB_XGEN(b.x)]) == gen, bar);
            __builtin_amdgcn_fence(__ATOMIC_ACQUIRE, "agent");
            asm volatile("s_waitcnt vmcnt(0)" ::: "memory");
        }
    }
    __syncthreads();
}

namespace pg8 {
constexpr int BM = 256, BK = 64, HALF = 128, HTB = HALF * BK * 2, STAGE_BYTES = 8 * HTB;
__host__ __device__ __forceinline__ int lds_byte(int r, int c) { const int st = (r >> 4) * 2 + (c >> 5), rr = r & 15, cc = c & 31, ob = rr * 64 + cc * 2; return st * 1024 + (ob ^ (((ob >> 9) & 1) << 5)); }
__host__ __device__ __forceinline__ void stage_rc(int b, int& R, int& C) { const int st = b / 1024, sb = b % 1024, swz = sb ^ (((sb >> 9) & 1) << 5); R = (st >> 1) * 16 + swz / 64; C = (st & 1) * 32 + (swz % 64) / 2; }
__host__ __device__ __forceinline__ int perm32(int rho) { const int n = rho >> 4, i = rho & 15; return 8 * (i >> 2) + 4 * n + (i & 3); }

struct Unit { const char* A; const char* B; int pm, pn, e, aux; };

template <class Epi, class Sched, bool GATHER>
__device__ __forceinline__ void gemm_phase(LAS unsigned char* lds, const int K_, const Sched& S, const Epi& E) {
    int K = K_; asm volatile("" : "+s"(K));
    const int tid = opaque((int)threadIdx.x), wid = __builtin_amdgcn_readfirstlane(tid >> 6), lane = tid & 63, wr = wid >> 2, wc = wid & 3, fr = lane & 15, fq = lane >> 4;
    const int nt = K / BK;
    int Rr[2], Cc[2];
    unsigned voffB[2], vAc[2][2], vAn[2][2];
    const size_t kstep = (size_t)(BK * 2);
    const size_t hstep = (size_t)HALF * K * 2;
#pragma unroll
    for (int i = 0; i < 2; ++i) { int R, C; stage_rc(tid * 16 + i * 8192, R, C); Rr[i] = R; Cc[i] = C; const int Rb = Epi::PERM ? ((R & ~31) + perm32(R & 31)) : R;
        voffB[i] = (unsigned)(Rb * K + C) * 2u; vAc[0][i] = (unsigned)(R * K + C) * 2u; vAc[1][i] = vAc[0][i] + (unsigned)hstep; vAn[0][i] = vAc[0][i]; vAn[1][i] = vAc[1][i]; }
    const unsigned ldsw = (unsigned)wid * 1024u;
    const int aoff = lds_byte(wr * 64 + fr, fq * 8), boff = lds_byte(wc * 32 + fr, fq * 8);
#define PG8_SA(b, h) (((b) * 2 + (h)) * HTB)
#define PG8_SB(b, h) ((4 + (b) * 2 + (h)) * HTB)
#define PG8_STAGE(bufoff, gbase, voff) do { _Pragma("unroll") for (int _i = 0; _i < 2; ++_i) \
        __builtin_amdgcn_global_load_lds((const unsigned*)((const char*)(gbase) + (voff)[_i]), (LAS unsigned*)(lds + (bufoff) + ldsw + _i * 8192), 16, 0, 0); } while (0)
#define PG8_LDA(dst, b, h) do { _Pragma("unroll") for (int m = 0; m < 4; ++m) _Pragma("unroll") for (int k = 0; k < 2; ++k) dst[m][k] = *(const LAS bf16x8*)(lds + PG8_SA(b, h) + aoff + m * 2048 + k * 1024); } while (0)
#define PG8_LDB(dst, b, h) do { _Pragma("unroll") for (int n = 0; n < 2; ++n) _Pragma("unroll") for (int k = 0; k < 2; ++k) dst[n][k] = *(const LAS bf16x8*)(lds + PG8_SB(b, h) + boff + n * 2048 + k * 1024); } while (0)
#define PG8_MMA(ai, bj, At, Bt) do { __builtin_amdgcn_s_setprio(1); _Pragma("unroll") for (int m = 0; m < 4; ++m) _Pragma("unroll") for (int n = 0; n < 2; ++n) _Pragma("unroll") for (int k = 0; k < 2; ++k) \
        acc[ai][bj][m][n] = __builtin_amdgcn_mfma_f32_16x16x32_bf16(Bt[n][k], At[m][k], acc[ai][bj][m][n], 0, 0, 0); __builtin_amdgcn_s_setprio(0); } while (0)
#define PG8_WAIT_V(n) asm volatile("s_waitcnt vmcnt(" #n ")" ::: "memory")
#define PG8_WAIT_L(n) asm volatile("s_waitcnt lgkmcnt(" #n ")" ::: "memory")
#define PG8_BAR __builtin_amdgcn_s_barrier()
#define PG8_SCHED __builtin_amdgcn_sched_barrier(0)
    Unit cur, nxt; int ui = 0;
    if (!S.next(0, cur)) return;
    if (GATHER) { S.offsets(cur, Rr, Cc, vAc); }
    f32x4 acc[2][2][4][2];
#pragma unroll
    for (int a = 0; a < 2; ++a)
#pragma unroll
        for (int b = 0; b < 2; ++b)
#pragma unroll
            for (int m = 0; m < 4; ++m)
#pragma unroll
                for (int n = 0; n < 2; ++n) acc[a][b][m][n] = (f32x4){0.f, 0.f, 0.f, 0.f};
    bf16x8 At[4][2], B0[2][2], B1[2][2];
    const char* cA = cur.A; const char* cB = cur.B;
    PG8_STAGE(PG8_SB(0, 0), cB, voffB); PG8_STAGE(PG8_SA(0, 0), cA, vAc[0]); PG8_STAGE(PG8_SB(0, 1), cB + hstep, voffB); PG8_STAGE(PG8_SA(0, 1), cA, vAc[1]);
    if (wr == 1) PG8_BAR;
    PG8_WAIT_V(4); PG8_BAR;
    PG8_STAGE(PG8_SB(1, 0), cB + kstep, voffB); PG8_STAGE(PG8_SA(1, 0), cA + kstep, vAc[0]); PG8_STAGE(PG8_SB(1, 1), cB + hstep + kstep, voffB);
    PG8_WAIT_V(6); PG8_BAR;
    for (;;) {
        const bool has_next = S.next(ui + 1, nxt);
        const char* nA = has_next ? nxt.A : cA; const char* nB = has_next ? nxt.B : cB;
        if (GATHER) { if (has_next) S.offsets(nxt, Rr, Cc, vAn); else { vAn[0][0] = vAc[0][0]; vAn[0][1] = vAc[0][1]; vAn[1][0] = vAc[1][0]; vAn[1][1] = vAc[1][1]; } }
        for (int t = 0; t < nt; t += 2) {
            const bool last = (t == nt - 2);
            const char* a1 = cA + (size_t)(t + 1) * kstep;
            const char* a2 = last ? nA : cA + (size_t)(t + 2) * kstep; const char* b2 = last ? nB : cB + (size_t)(t + 2) * kstep;
            const char* a3 = a2 + kstep; const char* b3 = b2 + kstep;
            unsigned v2[2][2];
            if (GATHER) { v2[0][0] = last ? vAn[0][0] : vAc[0][0]; v2[0][1] = last ? vAn[0][1] : vAc[0][1]; v2[1][0] = last ? vAn[1][0] : vAc[1][0]; v2[1][1] = last ? vAn[1][1] : vAc[1][1]; }
            else { v2[0][0] = vAc[0][0]; v2[0][1] = vAc[0][1]; v2[1][0] = vAc[1][0]; v2[1][1] = vAc[1][1]; }
            PG8_LDB(B0, 0, 0); PG8_SCHED; PG8_LDA(At, 0, 0); PG8_STAGE(PG8_SA(1, 1), a1, vAc[1]);
            PG8_WAIT_L(8); PG8_BAR; PG8_WAIT_L(0); PG8_MMA(0, 0, At, B0); PG8_BAR; PG8_SCHED;
            PG8_LDB(B1, 0, 1); PG8_STAGE(PG8_SB(0, 0), b2, voffB);
            PG8_BAR; PG8_WAIT_L(0); PG8_MMA(0, 1, At, B1); PG8_BAR;
            PG8_LDA(At, 0, 1); PG8_STAGE(PG8_SA(0, 0), a2, v2[0]);
            PG8_BAR; PG8_WAIT_L(0); PG8_MMA(1, 0, At, B0); PG8_BAR; PG8_SCHED;
            PG8_STAGE(PG8_SB(0, 1), b2 + hstep, voffB);
            PG8_WAIT_V(6); PG8_BAR; PG8_MMA(1, 1, At, B1); PG8_BAR;
            PG8_LDB(B0, 1, 0); PG8_SCHED; PG8_LDA(At, 1, 0); PG8_STAGE(PG8_SA(0, 1), a2, v2[1]);
            PG8_WAIT_L(8); PG8_BAR; PG8_WAIT_L(0); PG8_MMA(0, 0, At, B0); PG8_BAR; PG8_SCHED;
            PG8_LDB(B1, 1, 1); PG8_STAGE(PG8_SB(1, 0), b3, voffB);
            PG8_BAR; PG8_WAIT_L(0); PG8_MMA(0, 1, At, B1); PG8_BAR;
            PG8_LDA(At, 1, 1); PG8_STAGE(PG8_SA(1, 0), a3, v2[0]);
            PG8_BAR; PG8_WAIT_L(0); PG8_MMA(1, 0, At, B0); PG8_BAR; PG8_SCHED;
            PG8_STAGE(PG8_SB(1, 1), b3 + hstep, voffB);
            PG8_WAIT_V(6); PG8_BAR; PG8_MMA(1, 1, At, B1); PG8_BAR;
        }
        E(acc, cur, wr, wc, fr, fq);
        if (!has_next) break;
#pragma unroll
        for (int a = 0; a < 2; ++a)
#pragma unroll
            for (int b = 0; b < 2; ++b)
#pragma unroll
                for (int m = 0; m < 4; ++m)
#pragma unroll
                    for (int n = 0; n < 2; ++n) acc[a][b][m][n] = (f32x4){0.f, 0.f, 0.f, 0.f};
        cur = nxt; cA = nA; cB = nB; ++ui;
        if (GATHER) { vAc[0][0] = vAn[0][0]; vAc[0][1] = vAn[0][1]; vAc[1][0] = vAn[1][0]; vAc[1][1] = vAn[1][1]; }
    }
    PG8_WAIT_V(0);
    if (wr == 0) PG8_BAR;
    PG8_BAR;
#undef PG8_SA
#undef PG8_SB
#undef PG8_STAGE
#undef PG8_LDA
#undef PG8_LDB
#undef PG8_MMA
#undef PG8_WAIT_V
#undef PG8_WAIT_L
#undef PG8_BAR
#undef PG8_SCHED
}
}
constexpr size_t MiB = 1u << 20;
constexpr size_t WS_CTL = 0, CTL_ZERO_BYTES = 1 * MiB;
constexpr size_t WS_MOD = 1 * MiB;
constexpr size_t WS_ROPE = WS_MOD + 256 * 1024;
constexpr size_t WS_MISC = WS_ROPE + 256 * 1024;
constexpr size_t WS_WAB_IN = 2 * MiB;
constexpr size_t WS_WAB_OUT = 20 * MiB;
constexpr size_t WS_WDA_IN = 26 * MiB;
constexpr size_t WS_WDA_OUT = 38 * MiB;
constexpr size_t WS_WR = 42 * MiB;
constexpr size_t WS_W3T = 43 * MiB;
constexpr size_t WS_HID2C = WS_W3T + 512 * 1024;
constexpr size_t WS_WGU = 44 * MiB;
constexpr size_t WS_WD = 109 * MiB;
constexpr size_t WS_XRES = 142 * MiB;
constexpr size_t WS_H = 207 * MiB;
constexpr size_t WS_LTOK = 240 * MiB;
constexpr size_t WS_LW = WS_LTOK + 5 * MiB;
constexpr size_t WS_SLOT = WS_LW + 5 * MiB;
constexpr size_t WS_SLOTW = WS_SLOT + 1 * MiB;
constexpr size_t WS_U = 252 * MiB;
constexpr size_t WS_PROJ = WS_U;
constexpr size_t WS_TAPS = WS_U;
constexpr size_t WS_CAT = WS_U + 147 * MiB;
constexpr size_t WS_UPD = WS_U + 196 * MiB;
constexpr size_t WS_SPREV = WS_U + 261 * MiB;
constexpr size_t WS_UT = WS_U + 326 * MiB;
constexpr size_t WS_YT = WS_U + 374 * MiB;
constexpr size_t WS_HSPEC = WS_U + 390 * MiB;
constexpr size_t WS_Y1 = WS_U + 519 * MiB;
constexpr size_t WS_MIX_END = WS_U + 551 * MiB;
constexpr int MAX_TILES = 649;
constexpr size_t WS_ACT = WS_U;
constexpr size_t WS_YSLOT = WS_U + 82 * MiB;
constexpr size_t WS_HLO = WS_YSLOT;
constexpr size_t WS_END = WS_U + 551 * MiB;
static_assert(WS_YSLOT + (size_t)MAX_TILES * 256 * 1024 * 2 <= WS_END, "moe view");
static_assert(WS_HSPEC + (size_t)2 * 512 * HSPEC_LD * 8 <= WS_MIX_END, "mixer view");

constexpr int CW_BAR = 1024;
constexpr int CW_CNT = 8192;
constexpr int CW_ERR = 16;

constexpr int LDS_BIG = 139264;
constexpr int LDS_MISC = LDS_BIG;
constexpr int LDS_BYTES = LDS_BIG + 16384;
constexpr int NTHREADS = 512;

struct Params {
    const float* in[34];
    float* out;
    unsigned char* ws;
    int ph_lo, ph_hi;
};

typedef const __attribute__((address_space(4))) Params* KParams;
#define PREF const __attribute__((address_space(4))) Params&
__device__ __forceinline__ KParams opaque_kp(KParams p) { asm volatile("" : "+s"(p)); return p; }
struct Ctx {
    KParams p;
    LAS unsigned char* lds;
    int tid, lane, wid, G, bid, cnt_off, pass;
    unsigned char* ws;
};

template <class RowMap>
__device__ __forceinline__ void cvt_tile(const Ctx& c, const float* src, int ldn, int k0, int n0, bf16_t* dst, int ldk, const RowMap& rm) {
    LAS float* t = (LAS float*)c.lds;
    const int tid = c.tid;
    {   const int kr = tid >> 4, nc = (tid & 15) * 4;
#pragma unroll
        for (int h = 0; h < 2; ++h) { const f32x4 v = *(const f32x4*)(src + (size_t)(k0 + kr + 32 * h) * ldn + n0 + nc);
            t[(kr + 32 * h) * 65 + nc + 0] = v[0]; t[(kr + 32 * h) * 65 + nc + 1] = v[1]; t[(kr + 32 * h) * 65 + nc + 2] = v[2]; t[(kr + 32 * h) * 65 + nc + 3] = v[3]; } }
    __syncthreads();
    {   const int n = tid >> 3, k8 = (tid & 7) * 8; float f[8];
#pragma unroll
        for (int j = 0; j < 8; ++j) f[j] = t[(k8 + j) * 65 + n];
        u32x4 w; w.x = cvtpk(f[0], f[1]); w.y = cvtpk(f[2], f[3]); w.z = cvtpk(f[4], f[5]); w.w = cvtpk(f[6], f[7]);
        *(u32x4*)(dst + (size_t)rm(n0 + n) * ldk + k0 + k8) = w; }
    __syncthreads();
}
struct RowId { __device__ __forceinline__ int operator()(int n) const { return n; } };
struct RowAbIn { __device__ __forceinline__ int operator()(int n) const { if (n >= 1024) return n; const int d = n & 127; return (n & ~127) + ((d < 64) ? 2 * d : 2 * (d - 64) + 1); } };
struct RowDaIn { __device__ __forceinline__ int operator()(int n) const { if (n >= 2048) return n; const int d = n & 63; return (n & ~63) + ((d < 32) ? 2 * d : 2 * (d - 32) + 1); } };
struct RowGate { __device__ __forceinline__ int operator()(int n) const { return (n >> 7) * 256 + (n & 127); } };
struct RowDown { __device__ __forceinline__ int operator()(int n) const { return (n & ~255) + 128 * ((n >> 3) & 1) + 32 * ((n >> 6) & 3) + 8 * ((n >> 4) & 3) + (n & 7); } };
struct RowUp   { __device__ __forceinline__ int operator()(int n) const { return (n >> 7) * 256 + 128 + (n & 127); } };

__device__ __forceinline__ void cvt_router_tile(const Ctx& c, const float* src, int k0, bf16_t* dhi, bf16_t* dlo) {
    LAS float* t = (LAS float*)c.lds; const int tid = c.tid;
    {   const int kr = tid >> 4, nc = (tid & 15) * 4;
#pragma unroll
        for (int h = 0; h < 2; ++h) { const f32x4 v = *(const f32x4*)(src + (size_t)(k0 + kr + 32 * h) * 64 + nc);
            t[(kr + 32 * h) * 65 + nc + 0] = v[0]; t[(kr + 32 * h) * 65 + nc + 1] = v[1]; t[(kr + 32 * h) * 65 + nc + 2] = v[2]; t[(kr + 32 * h) * 65 + nc + 3] = v[3]; } }
    __syncthreads();
    {   const int n = tid >> 3, k8 = (tid & 7) * 8; float f[8], g[8];
#pragma unroll
        for (int j = 0; j < 8; ++j) { f[j] = t[(k8 + j) * 65 + n]; const float h = bf2f(f2bf(f[j])); g[j] = f[j] - h; f[j] = h; }
        u32x4 w; w.x = cvtpk(f[0], f[1]); w.y = cvtpk(f[2], f[3]); w.z = cvtpk(f[4], f[5]); w.w = cvtpk(f[6], f[7]);
        *(u32x4*)(dhi + (size_t)n * 1024 + k0 + k8) = w;
        w.x = cvtpk(g[0], g[1]); w.y = cvtpk(g[2], g[3]); w.z = cvtpk(g[4], g[5]); w.w = cvtpk(g[6], g[7]);
        *(u32x4*)(dlo + (size_t)n * 1024 + k0 + k8) = w; }
    __syncthreads();
}

__device__ __forceinline__ void phase_pr0(const Ctx& c) {
    PREF P = *c.p; unsigned char* ws = c.ws;
    const int T_ABIN = 2 * 16 * 72, T_ABOUT = 2 * 24 * 16, T_DAIN = 2 * 16 * 48, T_DAOUT = 2 * 16 * 16, T_R = 4 * 16, T_W3 = 2 * 1 * 32;
    const int T_ALL = T_ABIN + T_ABOUT + T_DAIN + T_DAOUT + T_R + T_W3;
    for (int u = c.bid; u < T_ALL; u += c.G) {
        int v = u;
        if (v < T_ABIN) { const int j = v / (16 * 72), r = v % (16 * 72), kt = r / 72, ntile = r % 72;
            cvt_tile(c, P.in[8] + (size_t)j * 1024 * AB_IN, AB_IN, kt * 64, ntile * 64, (bf16_t*)(ws + WS_WAB_IN) + (size_t)j * AB_IN * 1024, 1024, RowAbIn()); continue; }
        v -= T_ABIN;
        if (v < T_ABOUT) { const int j = v / (24 * 16), r = v % (24 * 16), kt = r / 16, ntile = r % 16;
            cvt_tile(c, P.in[9] + (size_t)j * AB_CAT * 1024, 1024, kt * 64, ntile * 64, (bf16_t*)(ws + WS_WAB_OUT) + (size_t)j * 1024 * AB_CAT, AB_CAT, RowId()); continue; }
        v -= T_ABOUT;
        if (v < T_DAIN) { const int j = v / (16 * 48), r = v % (16 * 48), kt = r / 48, ntile = r % 48;
            cvt_tile(c, P.in[21] + (size_t)j * 1024 * DA_IN, DA_IN, kt * 64, ntile * 64, (bf16_t*)(ws + WS_WDA_IN) + (size_t)j * DA_IN * 1024, 1024, RowDaIn()); continue; }
        v -= T_DAIN;
        if (v < T_DAOUT) { const int j = v / (16 * 16), r = v % (16 * 16), kt = r / 16, ntile = r % 16;
            cvt_tile(c, P.in[22] + (size_t)j * 1024 * 1024, 1024, kt * 64, ntile * 64, (bf16_t*)(ws + WS_WDA_OUT) + (size_t)j * 1024 * 1024, 1024, RowId()); continue; }
        v -= T_DAOUT;
        if (v < T_R) { const int i = v / 16, kt = v % 16;
            cvt_router_tile(c, P.in[25] + (size_t)i * 1024 * 64, kt * 64, (bf16_t*)(ws + WS_WR) + (size_t)(i * 2 + 0) * 64 * 1024, (bf16_t*)(ws + WS_WR) + (size_t)(i * 2 + 1) * 64 * 1024); continue; }
        v -= T_R;
        { const int j = v / 32, ntile = v % 32;
            cvt_tile(c, P.in[19] + (size_t)j * 64 * 2048, 2048, 0, ntile * 64, (bf16_t*)(ws + WS_W3T) + (size_t)j * 2048 * 64, 64, RowId()); }
    }
    {
        LAS float* red = (LAS float*)c.lds;
        for (int u = c.bid; u < 192; u += c.G) {
            const int i = u / 48, j0 = (u % 48) * 128, col = c.tid & 127, kg = c.tid >> 7;
            const float* w = P.in[4] + (size_t)i * 1024 * 6144 + j0 + col;
            float a0 = 0.f, a1 = 0.f;
#pragma unroll 8
            for (int k = kg * 256; k < kg * 256 + 256; ++k) { const float wv = w[(size_t)k * 6144]; a0 += siluf(P.in[1][k]) * wv; a1 += siluf(P.in[3][k]) * wv; }
            red[(kg * 2 + 0) * 128 + col] = a0; red[(kg * 2 + 1) * 128 + col] = a1;
            __syncthreads();
            if (c.tid < 256) { const int s = c.tid >> 7; float v = 0.f;
#pragma unroll
                for (int g = 0; g < 4; ++g) v += red[(g * 2 + s) * 128 + col];
                ((float*)(ws + WS_MOD))[(size_t)(i * 2 + s) * 6144 + j0 + col] = v + P.in[5][(size_t)i * 6144 + j0 + col]; }
            __syncthreads();
        }
    }
    {
        f32x2* rt = (f32x2*)(ws + WS_ROPE);
        const int NRR = 256 * 32, NRC = 64 * 32, NDR = 256 * 16, NDC = 64 * 16;
        for (int idx = c.bid * NTHREADS + c.tid; idx < NRR + NRC + NDR + NDC; idx += c.G * NTHREADS) {
            int v = idx; float pos, inv;
            if (v < NRR) { pos = (float)(v >> 5); inv = powf(10000.f, -(float)(v & 31) / 32.f); }
            else if ((v -= NRR) < NRC) { pos = (float)(v >> 5); inv = powf(10000.f, -(float)(v & 31) / 32.f); }
            else if ((v -= NRC) < NDR) { pos = (float)(v >> 4); inv = powf(10000.f, -(float)(v & 15) / 16.f); }
            else { v -= NDR; pos = (float)(v >> 4); inv = powf(10000.f, -(float)(v & 15) / 16.f); }
            const float ang = pos * inv;
            rt[idx] = (f32x2){cosf(ang), sinf(ang)};
        }
    }
    if (c.bid == 0 && c.wid < 2) {
        const int j = c.wid; const float* lam = P.in[23] + (size_t)j * 4 * 64;
        float a = lam[c.lane] * lam[64 + c.lane], b = lam[128 + c.lane] * lam[192 + c.lane];
        a = wave_sum(a); b = wave_sum(b);
        const float linit = 0.8f - 0.6f * expf(-0.3f * (float)(2 * j + 1));
        if (c.lane == 0) { ((float*)(ws + WS_MISC))[j * 2 + 0] = expf(a) - expf(b) + linit; ((float*)(ws + WS_MISC))[j * 2 + 1] = linit; }
    }
}

__device__ __forceinline__ void norm_rows(const Ctx& c, int layer, int which  , const float* gain, int row_lo, int row_hi, const float* xsrc_lat, const float* xsrc_ctx, bf16_t* dst) {
    const float* mod = (const float*)(c.ws + WS_MOD) + (size_t)layer * 2 * 6144;
    const int sh_off = which ? 3 * 1024 : 0, sc_off = which ? 4 * 1024 : 1024;
    for (int row = row_lo + c.bid * 8 + c.wid; row < row_hi; row += c.G * 8) {
        const float* x = (row < NC) ? (xsrc_ctx + (size_t)row * D) : (xsrc_lat + (size_t)(row - NC) * D);
        const float* m = mod + ((row < NC) ? 6144 : 0);
        f32x4 v[4]; float ss = 0.f;
#pragma unroll
        for (int q = 0; q < 4; ++q) { v[q] = *(const f32x4*)(x + q * 256 + c.lane * 4); ss += v[q][0] * v[q][0] + v[q][1] * v[q][1] + v[q][2] * v[q][2] + v[q][3] * v[q][3]; }
        ss = wave_sum(ss);
        const float rstd = rsqrtf(ss * (1.0f / 1024.f) + EPS);
#pragma unroll
        for (int q = 0; q < 4; ++q) { const int col = q * 256 + c.lane * 4;
            const f32x4 g = *(const f32x4*)(gain + col), sc = *(const f32x4*)(m + sc_off + col), sh = *(const f32x4*)(m + sh_off + col);
            float o[4];
#pragma unroll
            for (int j = 0; j < 4; ++j) o[j] = v[q][j] * rstd * g[j] * (1.0f + sc[j]) + sh[j];
            u32x2 w; w.x = cvtpk(o[0], o[1]); w.y = cvtpk(o[2], o[3]);
            *(u32x2*)(dst + (size_t)row * D + col) = w; }
    }
}

__device__ __forceinline__ void phase_pr1(const Ctx& c) {
    PREF P = *c.p;
    float* xres = (float*)(c.ws + WS_XRES);
    for (size_t i = (size_t)c.bid * NTHREADS + c.tid; i < (size_t)NTOK * D / 4; i += (size_t)c.G * NTHREADS) {
        const size_t e = i * 4; const f32x4 v = (e < (size_t)NC * D) ? *(const f32x4*)(P.in[2] + e) : *(const f32x4*)(P.in[0] + (e - (size_t)NC * D));
        *(f32x4*)(xres + e) = v; }
    norm_rows(c, 0, 0, P.in[6], 0, NTOK, P.in[0], P.in[2], (bf16_t*)(c.ws + WS_H));
}
__device__ __forceinline__ int xcd_remap(int L, int n) { const int q = n / 8, r = n % 8, x = L % 8, off = L / 8; return (x < r ? x * (q + 1) : r * (q + 1) + (x - r) * q) + off; }

struct DenseSched {
    const char* A; const char* Bt; int K, nM, nN, pm0, G, c, nwg;
    __device__ __forceinline__ void init(const void* A_, const void* Bt_, int K_, int nM_, int nN_, int pm0_, int G_, int c_) { A = (const char*)A_; Bt = (const char*)Bt_; K = K_; nM = nM_ - pm0_; nN = nN_; pm0 = pm0_; G = G_; c = c_; nwg = nM * nN; }
    __device__ __forceinline__ bool next(int i, pg8::Unit& u) const {
        const long L = (long)i * G + c; if (L >= nwg) return false;
        const int wgid = xcd_remap((int)L, nwg);
        const int WGM = 8, nig = WGM * nN, gid = wgid / nig, fm = gid * WGM, gsz = (nM - fm) < WGM ? (nM - fm) : WGM;
        u.pm = pm0 + fm + ((wgid % nig) % gsz); u.pn = (wgid % nig) / gsz; u.e = 0; u.aux = 0;
        u.A = A + (size_t)u.pm * 256 * K * 2; u.B = Bt + (size_t)u.pn * 256 * K * 2; return true;
    }
    __device__ __forceinline__ void offsets(const pg8::Unit&, const int (&)[2], const int (&)[2], unsigned (&)[2][2]) const {}
};

struct MoeTable { const LAS int* tb; const LAS int* cn; };
__device__ __forceinline__ int moe_find(const MoeTable& t, int T) { int e = 0;
#pragma unroll 1
    for (int s = 64; s >= 1; s >>= 1) { if (e + s <= 64 && t.tb[e + s] <= T) e += s; } return e; }

struct MoeUpSched {
    MoeTable t; const char* H; const char* W; const int* ltok; int tok0, G, c, nwg;
    __device__ __forceinline__ bool next(int i, pg8::Unit& u) const {
        const long L = (long)i * G + c; if (L >= nwg) return false;
        const int id = xcd_remap((int)L, nwg); const int T = id >> 1; u.pn = id & 1; u.pm = T; u.e = moe_find(t, T); u.aux = T - t.tb[u.e];
        u.A = H; u.B = W + ((size_t)u.e * 512 + (size_t)u.pn * 256) * 1024 * 2; return true;
    }
    __device__ __forceinline__ void offsets(const pg8::Unit& u, const int (&Rr)[2], const int (&Cc)[2], unsigned (&vo)[2][2]) const {
        const int cnt = t.cn[u.e];
#pragma unroll
        for (int h = 0; h < 2; ++h)
#pragma unroll
            for (int i = 0; i < 2; ++i) { const int pos = u.aux * 256 + h * 128 + Rr[i]; int tok;
                if (u.e == 64) tok = tok0 + (pos < cnt ? pos : 0); else tok = (pos < cnt) ? ltok[(size_t)u.e * NTOK + pos] : tok0;
                vo[h][i] = (unsigned)(tok * 1024 + Cc[i]) * 2u; }
    }
};
struct MoeDownSched {
    MoeTable t; const char* ACT; const char* W; int G, c, nwg;
    __device__ __forceinline__ bool next(int i, pg8::Unit& u) const {
        const long L = (long)i * G + c; if (L >= nwg) return false;
        const int id = xcd_remap((int)L, nwg); const int T = id >> 2; u.pn = id & 3; u.pm = T; u.e = moe_find(t, T); u.aux = T - t.tb[u.e];
        u.A = ACT + (size_t)T * 256 * 256 * 2; u.B = W + ((size_t)u.e * 1024 + (size_t)u.pn * 256) * 256 * 2; return true;
    }
    __device__ __forceinline__ void offsets(const pg8::Unit&, const int (&)[2], const int (&)[2], unsigned (&)[2][2]) const {}
};

__device__ __forceinline__ void rope8(f32x4& v0, f32x4& v1, const f32x2* cs) {
    const f32x4 t0 = *(const f32x4*)(cs), t1 = *(const f32x4*)(cs + 2);
    float a, b;
    a = v0[0]; b = v0[1]; v0[0] = a * t0[0] - b * t0[1]; v0[1] = b * t0[0] + a * t0[1];
    a = v0[2]; b = v0[3]; v0[2] = a * t0[2] - b * t0[3]; v0[3] = b * t0[2] + a * t0[3];
    a = v1[0]; b = v1[1]; v1[0] = a * t1[0] - b * t1[1]; v1[1] = b * t1[0] + a * t1[1];
    a = v1[2]; b = v1[3]; v1[2] = a * t1[2] - b * t1[3]; v1[3] = b * t1[2] + a * t1[3];
}
struct EpiAbIn {
    static constexpr bool PERM = true;
    bf16_t* O; const f32x2* rope;
    __device__ __forceinline__ void operator()(const f32x4 (&acc)[2][2][4][2], const pg8::Unit& u, int wr, int wc, int fr, int fq) const {
        const int row0 = u.pm * 256 + wr * 64 + fr, colt = u.pn * 256 + wc * 32 + 8 * fq;
        const bool qk = u.pn < 4, lat = u.pm >= 1; const float ksc = (u.pn >= 2 && u.pn < 4) ? 0.08838834764831845f : 1.0f;
#pragma unroll
        for (int ai = 0; ai < 2; ++ai)
#pragma unroll
            for (int m = 0; m < 4; ++m) { const int row = row0 + ai * 128 + m * 16; bf16_t* rowp = O + (size_t)row * AB_IN + colt; const int t = row - NC;
#pragma unroll
                for (int bj = 0; bj < 2; ++bj) { f32x4 v0 = acc[ai][bj][m][0], v1 = acc[ai][bj][m][1];
                    if (qk) { if (lat) { const int p0 = ((colt + bj * 128) & 127) >> 1;
                            const f32x2* cs = (p0 < 32) ? rope + (size_t)(t >> 6) * 32 + p0 : rope + 256 * 32 + (size_t)(t & 63) * 32 + (p0 - 32);
                            rope8(v0, v1, cs); }
                        v0 *= ksc; v1 *= ksc; }
                    u32x4 w; w.x = cvtpk(v0[0], v0[1]); w.y = cvtpk(v0[2], v0[3]); w.z = cvtpk(v1[0], v1[1]); w.w = cvtpk(v1[2], v1[3]);
                    *(u32x4*)(rowp + bj * 128) = w; } }
    }
};
struct EpiDaIn {
    static constexpr bool PERM = true;
    bf16_t* O; const f32x2* rope;
    __device__ __forceinline__ void operator()(const f32x4 (&acc)[2][2][4][2], const pg8::Unit& u, int wr, int wc, int fr, int fq) const {
        const int row0 = u.pm * 256 + wr * 64 + fr, colt = u.pn * 256 + wc * 32 + 8 * fq;
        const bool qk = u.pn < 8, lat = u.pm >= 1; const float qsc = (u.pn < 4) ? 0.125f * 1.4426950408889634f : 1.0f;
#pragma unroll
        for (int ai = 0; ai < 2; ++ai)
#pragma unroll
            for (int m = 0; m < 4; ++m) { const int row = row0 + ai * 128 + m * 16; bf16_t* rowp = O + (size_t)row * DA_IN + colt; const int t = row - NC;
#pragma unroll
                for (int bj = 0; bj < 2; ++bj) { f32x4 v0 = acc[ai][bj][m][0], v1 = acc[ai][bj][m][1];
                    if (qk) { if (lat) { const int p0 = ((colt + bj * 128) & 63) >> 1;
                            const f32x2* cs = (p0 < 16) ? rope + (size_t)(t >> 6) * 16 + p0 : rope + 256 * 16 + (size_t)(t & 63) * 16 + (p0 - 16);
                            rope8(v0, v1, cs); }
                        v0 *= qsc; v1 *= qsc; }
                    u32x4 w; w.x = cvtpk(v0[0], v0[1]); w.y = cvtpk(v0[2], v0[3]); w.z = cvtpk(v1[0], v1[1]); w.w = cvtpk(v1[2], v1[3]);
                    *(u32x4*)(rowp + bj * 128) = w; } }
    }
};
struct EpiResid {
    static constexpr bool PERM = false;
    float* X; const float* mod;
    __device__ __forceinline__ void operator()(const f32x4 (&acc)[2][2][4][2], const pg8::Unit& u, int wr, int wc, int fr, int fq) const {
        const int row0 = u.pm * 256 + wr * 64 + fr, col0 = u.pn * 256 + wc * 32 + 4 * fq;
        const float* g = mod + ((u.pm == 0) ? 6144 : 0) + 2 * 1024;
        f32x4 gv[2][2];
#pragma unroll
        for (int bj = 0; bj < 2; ++bj)
#pragma unroll
            for (int n = 0; n < 2; ++n) gv[bj][n] = *(const f32x4*)(g + col0 + bj * 128 + n * 16);
#pragma unroll
        for (int ai = 0; ai < 2; ++ai)
#pragma unroll
            for (int m = 0; m < 4; ++m) { float* rowp = X + (size_t)(row0 + ai * 128 + m * 16) * D + col0;
#pragma unroll
                for (int bj = 0; bj < 2; ++bj)
#pragma unroll
                    for (int n = 0; n < 2; ++n) { f32x4* p = (f32x4*)(rowp + bj * 128 + n * 16); *p = *p + gv[bj][n] * acc[ai][bj][m][n]; } }
    }
};
struct EpiSwiglu {
    static constexpr bool PERM = true;
    bf16_t* ACT;
    __device__ __forceinline__ void operator()(const f32x4 (&acc)[2][2][4][2], const pg8::Unit& u, int wr, int wc, int fr, int fq) const {
        const int row0 = u.pm * 256 + wr * 64 + fr, col0 = u.pn * 128 + wc * 32 + 8 * fq;
#pragma unroll
        for (int ai = 0; ai < 2; ++ai)
#pragma unroll
            for (int m = 0; m < 4; ++m) { bf16_t* rowp = ACT + (size_t)(row0 + ai * 128 + m * 16) * 256 + col0; float o[8];
#pragma unroll
                for (int n = 0; n < 2; ++n)
#pragma unroll
                    for (int j = 0; j < 4; ++j) { const float g = acc[ai][0][m][n][j], up = acc[ai][1][m][n][j]; o[n * 4 + j] = siluf(g) * up; }
                u32x4 w; w.x = cvtpk(o[0], o[1]); w.y = cvtpk(o[2], o[3]); w.z = cvtpk(o[4], o[5]); w.w = cvtpk(o[6], o[7]);
                *(u32x4*)rowp = w; }
    }
};
struct EpiDown {
    static constexpr bool PERM = true;
    unsigned char* Y; const float* lw; MoeTable t; int skip;
    __device__ __forceinline__ void operator()(const f32x4 (&acc)[2][2][4][2], const pg8::Unit& u, int wr, int wc, int fr, int fq) const {
        if (skip) { asm volatile("" :: "v"(acc[0][0][0][0]), "v"(acc[1][1][3][1])); return; }
        const int r0 = wr * 64 + fr, col0 = u.pn * 256 + wc * 64 + 16 * fq; const int cnt = t.cn[u.e];
        float wv[2][4];
#pragma unroll
        for (int ai = 0; ai < 2; ++ai)
#pragma unroll
            for (int m = 0; m < 4; ++m) { const int pos = u.aux * 256 + r0 + ai * 128 + m * 16; const int pc = (pos < cnt) ? pos : 0;
                const float x = (u.e == 64) ? 1.0f : lw[(size_t)u.e * NTOK + pc]; wv[ai][m] = (u.e == 64 || pos < cnt) ? x : 0.0f; }
#pragma unroll
        for (int ai = 0; ai < 2; ++ai)
#pragma unroll
            for (int m = 0; m < 4; ++m) { const int r = r0 + ai * 128 + m * 16; const float w_ = wv[ai][m];
                unsigned char* rowp = Y + (size_t)(u.pm * 256 + r) * 1024 + col0; u32x4 w;
#pragma unroll
                for (int bj = 0; bj < 2; ++bj) { const f32x4 v0 = acc[ai][bj][m][0] * w_, v1 = acc[ai][bj][m][1] * w_; int lo = 0, hi = 0;
                    lo = __builtin_amdgcn_cvt_pk_fp8_f32(v0[0], v0[1], lo, false); lo = __builtin_amdgcn_cvt_pk_fp8_f32(v0[2], v0[3], lo, true);
                    hi = __builtin_amdgcn_cvt_pk_fp8_f32(v1[0], v1[1], hi, false); hi = __builtin_amdgcn_cvt_pk_fp8_f32(v1[2], v1[3], hi, true);
                    if (bj == 0) { w.x = (unsigned)lo; w.y = (unsigned)hi; } else { w.z = (unsigned)lo; w.w = (unsigned)hi; } }
                *(u32x4*)rowp = w; }
    }
};
__device__ __forceinline__ int fphys(int i) { return i + ((i >> 6) << 2); }
__device__ __forceinline__ int brev14(int x) { return (int)(__brev((unsigned)x) >> 18); }
__device__ __forceinline__ int brevK(int s, int K) { return (int)(__brev((unsigned)s) >> (32 - K)); }
__device__ __forceinline__ void cmul(float& ar, float& ai, float br, float bi) { const float r = ar * br - ai * bi, i = ar * bi + ai * br; ar = r; ai = i; }
__device__ __forceinline__ constexpr float tw16c(int k) { return (k & 15) == 0 ? 1.f : (k & 15) == 1 ? 0.9238795325112867f : (k & 15) == 2 ? 0.7071067811865476f : (k & 15) == 3 ? 0.3826834323650898f : (k & 15) == 4 ? 0.f :
    (k & 15) == 5 ? -0.3826834323650898f : (k & 15) == 6 ? -0.7071067811865476f : (k & 15) == 7 ? -0.9238795325112867f : (k & 15) == 8 ? -1.f : (k & 15) == 9 ? -0.9238795325112867f : (k & 15) == 10 ? -0.7071067811865476f :
    (k & 15) == 11 ? -0.3826834323650898f : (k & 15) == 12 ? 0.f : (k & 15) == 13 ? 0.3826834323650898f : (k & 15) == 14 ? 0.7071067811865476f : 0.9238795325112867f; }
__device__ __forceinline__ constexpr float tw16s(int k) { return tw16c(k + 12); }

template <int LOGN, int K, bool INV>
__device__ __forceinline__ void fft_pass(LAS f32x2* z, int tid) {
    constexpr int R = 1 << K, LOGST = LOGN - K, ST = 1 << LOGST;
#pragma unroll 1
    for (int g = tid; g < FFT_M / R; g += NTHREADS) {
        const int b = g >> LOGST, j = g & (ST - 1), base = (b << LOGN) + j;
        float xr[R], xi[R];
#pragma unroll
        for (int q = 0; q < R; ++q) { const f32x2 v = z[fphys(base + (q << LOGST))]; xr[q] = v[0]; xi[q] = v[1]; }
        float wr_[R], wi_[R];
        if (LOGST > 0) {
            const float fr = (float)j * (1.0f / (float)(1 << LOGN));
            wr_[0] = 1.f; wi_[0] = 0.f;
#pragma unroll
            for (int bit = 1; bit < R; bit <<= 1) { const float a = fr * (float)bit; wr_[bit] = __builtin_amdgcn_cosf(a); wi_[bit] = INV ? __builtin_amdgcn_sinf(a) : -__builtin_amdgcn_sinf(a); }
#pragma unroll
            for (int r = 3; r < R; ++r) { if ((r & (r - 1)) != 0) { const int hb = 1 << (31 - __builtin_clz(r)); wr_[r] = wr_[hb]; wi_[r] = wi_[hb]; cmul(wr_[r], wi_[r], wr_[r - hb], wi_[r - hb]); } }
        }
        if (!INV) {
#pragma unroll
            for (int s = 0; s < K; ++s) { const int half = R >> (s + 1);
#pragma unroll
                for (int a = 0; a < R; ++a) if ((a & half) == 0) {
                    const int o = a & (half - 1); const int ti = o * (8 / half);
                    const float ur = xr[a], ui = xi[a], vr = xr[a + half], vi = xi[a + half];
                    xr[a] = ur + vr; xi[a] = ui + vi;
                    float dr = ur - vr, di = ui - vi;
                    if (half >= 1 && o != 0) cmul(dr, di, tw16c(ti), -tw16s(ti));
                    xr[a + half] = dr; xi[a + half] = di; } }
            if (LOGST > 0) {
#pragma unroll
                for (int s = 1; s < R; ++s) { const int r = brevK(s, K); cmul(xr[s], xi[s], wr_[r], wi_[r]); } }
        } else {
            if (LOGST > 0) {
#pragma unroll
                for (int s = 1; s < R; ++s) { const int r = brevK(s, K); cmul(xr[s], xi[s], wr_[r], wi_[r]); } }
#pragma unroll
            for (int s = K - 1; s >= 0; --s) { const int half = R >> (s + 1);
#pragma unroll
                for (int a = 0; a < R; ++a) if ((a & half) == 0) {
                    const int o = a & (half - 1); const int ti = o * (8 / half);
                    const float ur = xr[a], ui = xi[a]; float vr = xr[a + half], vi = xi[a + half];
                    if (o != 0) cmul(vr, vi, tw16c(ti), tw16s(ti));
                    xr[a] = ur + vr; xi[a] = ui + vi; xr[a + half] = ur - vr; xi[a + half] = ui - vi; } }
        }
#pragma unroll
        for (int q = 0; q < R; ++q) z[fphys(base + (q << LOGST))] = (f32x2){xr[q], xi[q]};
    }
}
__device__ __forceinline__ void fft_fwd(LAS f32x2* z, int tid) {
    fft_pass<14, 4, false>(z, tid); __syncthreads();
    fft_pass<10, 4, false>(z, tid); __syncthreads();
    fft_pass<6, 4, false>(z, tid);  __syncthreads();
    fft_pass<2, 2, false>(z, tid);  __syncthreads();
}
__device__ __forceinline__ void fft_inv(LAS f32x2* z, int tid) {
    fft_pass<2, 2, true>(z, tid);  __syncthreads();
    fft_pass<6, 4, true>(z, tid);  __syncthreads();
    fft_pass<10, 4, true>(z, tid); __syncthreads();
    fft_pass<14, 4, true>(z, tid); __syncthreads();
}
__device__ __forceinline__ void fft_pair_mul(LAS f32x2* z, const f32x2* Hs, int tid) {
    constexpr int M = FFT_M;
#pragma unroll 1
    for (int k = tid; k <= M / 2; k += NTHREADS) {
        if (k == 0) {
            const f32x2 z0 = z[0]; const float X0 = z0[0] + z0[1], XM = z0[0] - z0[1];
            const float Y0 = X0 * Hs[0][0], YM = XM * Hs[M][0];
            z[0] = (f32x2){0.5f * (Y0 + YM), 0.5f * (Y0 - YM)};
        } else {
            const int p1 = fphys(brev14(k)), p2 = fphys(brev14(M - k));
            const f32x2 zk = z[p1], zm = z[p2]; const f32x2 hk = Hs[k], hm = Hs[M - k];
            const float Er = 0.5f * (zk[0] + zm[0]), Ei = 0.5f * (zk[1] - zm[1]);
            const float Dr = 0.5f * (zk[0] - zm[0]), Di = 0.5f * (zk[1] + zm[1]);
            const float Or = Di, Oi = -Dr;
            const float a = (float)k * (1.0f / (float)(2 * M));
            const float wr = __builtin_amdgcn_cosf(a), wi = -__builtin_amdgcn_sinf(a);
            const float wOr = wr * Or - wi * Oi, wOi = wr * Oi + wi * Or;
            const float Xkr = Er + wOr, Xki = Ei + wOi;
            const float Xmr = Er - wOr, Xmi = -(Ei - wOi);
            const float Ykr = Xkr * hk[0] - Xki * hk[1], Yki = Xkr * hk[1] + Xki * hk[0];
            const float Ymr = Xmr * hm[0] - Xmi * hm[1], Ymi = Xmr * hm[1] + Xmi * hm[0];
            const float Yer = 0.5f * (Ykr + Ymr), Yei = 0.5f * (Yki - Ymi);
            const float Fr = 0.5f * (Ykr - Ymr), Fi = 0.5f * (Yki + Ymi);
            const float Yor = Fr * wr + Fi * wi, Yoi = Fi * wr - Fr * wi;
            z[p1] = (f32x2){Yer - Yoi, Yei + Yor};
            if (p2 != p1) z[p2] = (f32x2){Yer + Yoi, -Yei + Yor};
        }
    }
}
__device__ __forceinline__ void fft_unpack_store(const LAS f32x2* z, f32x2* Hs, float sc, int tid) {
    constexpr int M = FFT_M;
#pragma unroll 1
    for (int k = tid; k <= M / 2; k += NTHREADS) {
        if (k == 0) { const f32x2 z0 = z[0]; Hs[0] = (f32x2){(z0[0] + z0[1]) * sc, 0.f}; Hs[M] = (f32x2){(z0[0] - z0[1]) * sc, 0.f}; }
        else {
            const f32x2 zk = z[fphys(brev14(k))], zm = z[fphys(brev14(M - k))];
            const float Er = 0.5f * (zk[0] + zm[0]), Ei = 0.5f * (zk[1] - zm[1]);
            const float Dr = 0.5f * (zk[0] - zm[0]), Di = 0.5f * (zk[1] + zm[1]);
            const float Or = Di, Oi = -Dr;
            const float a = (float)k * (1.0f / (float)(2 * M));
            const float wr = __builtin_amdgcn_cosf(a), wi = -__builtin_amdgcn_sinf(a);
            const float wOr = wr * Or - wi * Oi, wOi = wr * Oi + wi * Or;
            Hs[k] = (f32x2){(Er + wOr) * sc, (Ei + wOi) * sc};
            if (k != M - k) Hs[M - k] = (f32x2){(Er - wOr) * sc, -(Ei - wOi) * sc};
        }
    }
}
__device__ __forceinline__ int crow(int r, int hi) { return (r & 3) + 8 * (r >> 2) + 4 * hi; }
__device__ __forceinline__ bf16x8 ldfrag(const LAS unsigned char* base, int pitch, int row, int kbyte) { return *(const LAS bf16x8*)(base + row * pitch + kbyte); }
constexpr int P136 = 272;

__device__ __forceinline__ float ret_log2g(const float* decay_logit, int dir, int h) { const float x = decay_logit[dir * 4 + h]; return -log1pf(expf(-x)) * 1.4426950408889634f; }

__device__ __forceinline__ void phase_f1(const Ctx& c, int j) {
    PREF P = *c.p;
    const float* w1 = P.in[13] + (size_t)j * 33 * 64; const float* b1 = P.in[14] + j * 64; const float* f1 = P.in[15] + j * 64;
    const float* w2 = P.in[16] + (size_t)j * 64 * 64; const float* b2 = P.in[17] + j * 64; const float* f2 = P.in[18] + j * 64;
    const bf16_t* w3t = (const bf16_t*)(c.ws + WS_W3T) + (size_t)j * 2048 * 64;
    float* taps = (float*)(c.ws + WS_TAPS); float* hid2c = (float*)(c.ws + WS_HID2C);
    LAS float* zs = (LAS float*)c.lds;
    LAS float* h1s = (LAS float*)(c.lds + 18432);
    LAS float* w1s = (LAS float*)(c.lds + 51712);
    LAS float* w2s = (LAS float*)(c.lds + 60160);
    LAS unsigned char* hb = c.lds + 76544;
    LAS unsigned char* as = c.lds + 94976;
    for (int u = c.bid; u < 130; u += c.G) {
        const int tid = opaque(c.tid);
        const bool isctx = u >= 128; const int L = isctx ? 256 : 16384; const int t0 = isctx ? (u - 128) * 128 : u * 128;
        for (int i = tid; i < 33 * 64; i += NTHREADS) w1s[i] = w1[i];
        for (int i = tid; i < 64 * 64; i += NTHREADS) w2s[i] = w2[i];
        {
            const int tl = tid >> 2, part = tid & 3; const float t = (float)(t0 + tl);
            if (part == 0) zs[tl * 36 + 0] = t / (float)(L - 1);
#pragma unroll
            for (int q = 0; q < 4; ++q) { const int b = part * 4 + q; const float band = 1e-4f + (float)b * ((15.0f - 1e-4f) / 15.0f);
                const float ang = (6.283185307179586f / (float)L) * t * band;
                zs[tl * 36 + 1 + b] = __cosf(ang); zs[tl * 36 + 17 + b] = -__sinf(ang); }
        }
        __syncthreads();
        {   const int tl = tid >> 2, og = (tid & 3) * 16; float a[16];
#pragma unroll
            for (int o = 0; o < 16; ++o) a[o] = b1[og + o];
#pragma unroll 1
            for (int f = 0; f < 33; ++f) { const float zv = zs[tl * 36 + f];
#pragma unroll
                for (int o = 0; o < 16; ++o) a[o] += zv * w1s[f * 64 + og + o]; }
#pragma unroll
            for (int o = 0; o < 16; ++o) h1s[tl * 65 + og + o] = __sinf(f1[og + o] * a[o]);
        }
        __syncthreads();
        {   const int tl = tid >> 2, og = (tid & 3) * 16; float a[16];
#pragma unroll
            for (int o = 0; o < 16; ++o) a[o] = b2[og + o];
#pragma unroll 1
            for (int k = 0; k < 64; ++k) { const float hv = h1s[tl * 65 + k];
#pragma unroll
                for (int o = 0; o < 16; ++o) a[o] += hv * w2s[k * 64 + og + o]; }
#pragma unroll
            for (int o = 0; o < 16; ++o) a[o] = __sinf(f2[og + o] * a[o]);
            if (isctx) {
#pragma unroll
                for (int o = 0; o < 16; ++o) hid2c[(size_t)(t0 + tl) * 64 + og + o] = a[o];
            } else {
#pragma unroll
                for (int o = 0; o < 16; o += 2) *(LAS unsigned*)(hb + tl * 144 + (og + o) * 2) = cvtpk(a[o], a[o + 1]);
            }
        }
        __syncthreads();
        if (!isctx) {
            const int lane = tid & 63, r32 = lane & 31, hi = lane >> 5, w = __builtin_amdgcn_readfirstlane(tid >> 6);
#pragma unroll 1
            for (int cc = 0; cc < 8; ++cc) {
                {   const int row = tid >> 1, hf = tid & 1; const u32x4* src = (const u32x4*)(w3t + (size_t)(cc * 256 + row) * 64 + hf * 32);
#pragma unroll
                    for (int q = 0; q < 4; ++q) *(LAS u32x4*)(as + row * 144 + hf * 64 + q * 16) = src[q]; }
                __syncthreads();
                f32x16 acc[4];
#pragma unroll
                for (int ni = 0; ni < 4; ++ni) acc[ni] = (f32x16){};
#pragma unroll
                for (int ks = 0; ks < 4; ++ks) { const bf16x8 a = ldfrag(as, 144, 32 * w + r32, ks * 32 + hi * 16);
#pragma unroll
                    for (int ni = 0; ni < 4; ++ni) { const bf16x8 b = ldfrag(hb, 144, 32 * ni + r32, ks * 32 + hi * 16); acc[ni] = __builtin_amdgcn_mfma_f32_32x32x16_bf16(a, b, acc[ni], 0, 0, 0); } }
#pragma unroll
                for (int ni = 0; ni < 4; ++ni) { const int t = t0 + 32 * ni + r32; const float tn = (float)t * (1.0f / 16383.0f);
#pragma unroll
                    for (int r = 0; r < 16; ++r) { const int fc = cc * 256 + 32 * w + crow(r, hi); const int ch = fc & 511;
                        const float delta = 3.0701134573253945f + (15.350567286626972f - 3.0701134573253945f) * ((float)ch * (1.0f / 511.0f));
                        taps[(size_t)fc * 16384 + t] = acc[ni][r] * __expf(-tn * delta); } }
                __syncthreads();
            }
        }
        __syncthreads();
    }
}

__device__ __forceinline__ void phase_f2(const Ctx& c) {
    const float* taps = (const float*)(c.ws + WS_TAPS); f32x2* hs = (f32x2*)(c.ws + WS_HSPEC);
    LAS f32x2* z = (LAS f32x2*)c.lds;
    for (int u = c.bid; u < 1024; u += c.G) {
        const int tid = opaque(c.tid);
        const int o = u >> 9, ch = u & 511;
        const float* hf = taps + (size_t)(o * 1024 + ch) * 16384; const float* hbk = taps + (size_t)(o * 1024 + 512 + ch) * 16384;
#pragma unroll 4
        for (int i = 0; i < 32; ++i) { const int m = tid + i * NTHREADS; f32x2 v;
            if (m < 8192) v = *(const f32x2*)(hf + 2 * m);
            else if (m == 8192) v = (f32x2){0.f, hbk[16383]};
            else { const int s = 32768 - 2 * m; v = (f32x2){hbk[s], hbk[s - 1]}; }
            z[fphys(m)] = v; }
        __syncthreads();
        fft_fwd(z, tid);
        fft_unpack_store(z, hs + (size_t)u * HSPEC_LD, 1.0f / (float)FFT_M, tid);
        __syncthreads();
    }
}

__device__ __forceinline__ void stage_T(const int tid, LAS unsigned char* dstT, const bf16_t* src, int ld, int ncols, const float* rowscale  ) {
    const int j = tid >> 2;
    for (int c8 = (tid & 3) * 8; c8 < ncols; c8 += 32) {
        const u32x4 v = *(const u32x4*)(src + (size_t)j * ld + c8); const unsigned w[4] = {v.x, v.y, v.z, v.w};
#pragma unroll
        for (int q = 0; q < 4; ++q) { *(LAS bf16_t*)(dstT + (c8 + 2 * q) * P136 + j * 2) = (bf16_t)(w[q] & 0xffffu); *(LAS bf16_t*)(dstT + (c8 + 2 * q + 1) * P136 + j * 2) = (bf16_t)(w[q] >> 16); }
    }
}
__device__ __forceinline__ void phase_r1(const Ctx& c, int j) {
    PREF P = *c.p; const bf16_t* proj = (const bf16_t*)(c.ws + WS_PROJ); bf16_t* upd = (bf16_t*)(c.ws + WS_UPD);
    LAS unsigned char* VT = c.lds; LAS unsigned char* KF = c.lds + 69632; LAS unsigned char* KB = c.lds + 104448;
    for (int u = c.bid; u < 130 * 4; u += c.G) {
        const int tid = opaque(c.tid), lane = tid & 63, r32 = lane & 31, hi = lane >> 5, w = __builtin_amdgcn_readfirstlane(tid >> 6);
        const int m = u >> 2, h = u & 3; const size_t row0 = (size_t)m * 128;
        const float lgf = ret_log2g(P.in[10] + j * 8, 0, h), lgb = ret_log2g(P.in[10] + j * 8, 1, h);
        stage_T(tid, VT, proj + row0 * AB_IN + 1024 + h * 256, AB_IN, 256, nullptr);
        {   const int jj = tid >> 2; const float sf = exp2f((float)(127 - jj) * lgf), sb = exp2f((float)jj * lgb);
            for (int c8 = (tid & 3) * 8; c8 < 128; c8 += 32) {
                const u32x4 v = *(const u32x4*)(proj + (row0 + jj) * AB_IN + 512 + h * 128 + c8); const unsigned wv[4] = {v.x, v.y, v.z, v.w};
#pragma unroll
                for (int q = 0; q < 4; ++q) { const float lo = bflo(wv[q]), hi_ = bfhi(wv[q]);
                    *(LAS bf16_t*)(KF + (c8 + 2 * q) * P136 + jj * 2) = f2bf(lo * sf); *(LAS bf16_t*)(KF + (c8 + 2 * q + 1) * P136 + jj * 2) = f2bf(hi_ * sf);
                    *(LAS bf16_t*)(KB + (c8 + 2 * q) * P136 + jj * 2) = f2bf(lo * sb); *(LAS bf16_t*)(KB + (c8 + 2 * q + 1) * P136 + jj * 2) = f2bf(hi_ * sb); } } }
        __syncthreads();
#pragma unroll 1
        for (int dir = 0; dir < 2; ++dir) {
            const LAS unsigned char* KX = dir ? KB : KF;
            f32x16 af[4];
#pragma unroll
            for (int n = 0; n < 4; ++n) af[n] = (f32x16){};
#pragma unroll
            for (int ks = 0; ks < 8; ++ks) { const bf16x8 a = ldfrag(VT, P136, 32 * w + r32, ks * 32 + hi * 16);
#pragma unroll
                for (int n = 0; n < 4; ++n) { const bf16x8 bf_ = ldfrag(KX, P136, 32 * n + r32, ks * 32 + hi * 16); af[n] = __builtin_amdgcn_mfma_f32_32x32x16_bf16(a, bf_, af[n], 0, 0, 0); } }
            bf16_t* of = upd + ((size_t)(m * 4 + h) * 2 + dir) * 32768;
#pragma unroll
            for (int n = 0; n < 4; ++n)
#pragma unroll
                for (int r = 0; r < 16; ++r) { const int e = 32 * w + crow(r, hi), d = 32 * n + r32; of[e * 128 + d] = f2bf(af[n][r]); }
        }
        __syncthreads();
    }
}

__device__ __forceinline__ void phase_hyprep(const Ctx& c, int j) {
    PREF P = *c.p; const bf16_t* proj = (const bf16_t*)(c.ws + WS_PROJ); bf16_t* uT = (bf16_t*)(c.ws + WS_UT);
    const float* cw = P.in[11] + (size_t)j * 3 * 1536; const float* cb = P.in[12] + (size_t)j * 1536;
    LAS float* t = (LAS float*)c.lds;
    const int tid = c.tid;
    for (int u = c.bid; u < 256 * 24; u += c.G) {
        const int tt = u / 24, ct = u % 24, t0 = tt * 64, ch0 = ct * 64;
        for (int idx = tid; idx < 66 * 8; idx += NTHREADS) { const int r = idx >> 3, c8 = (idx & 7) * 8; const int tg = t0 - 1 + r;
            u32x4 v = (u32x4){0u, 0u, 0u, 0u};
            if (tg >= 0 && tg < NX) v = *(const u32x4*)(proj + (size_t)(NC + tg) * AB_IN + 3072 + ch0 + c8);
            const unsigned wv[4] = {v.x, v.y, v.z, v.w};
#pragma unroll
            for (int q = 0; q < 4; ++q) { t[r * 65 + c8 + 2 * q] = bflo(wv[q]); t[r * 65 + c8 + 2 * q + 1] = bfhi(wv[q]); } }
        __syncthreads();
        {   const int ch = tid >> 3, t8 = (tid & 7) * 8; const int chg = ch0 + ch;
            const float w0 = cw[chg], w1 = cw[1536 + chg], w2 = cw[3072 + chg], bb = cb[chg]; float o[8];
#pragma unroll
            for (int q = 0; q < 8; ++q) o[q] = t[(t8 + q) * 65 + ch] * w0 + t[(t8 + q + 1) * 65 + ch] * w1 + t[(t8 + q + 2) * 65 + ch] * w2 + bb;
            u32x4 wv; wv.x = cvtpk(o[0], o[1]); wv.y = cvtpk(o[2], o[3]); wv.z = cvtpk(o[4], o[5]); wv.w = cvtpk(o[6], o[7]);
            *(u32x4*)(uT + (size_t)chg * NX + t0 + t8) = wv; }
        __syncthreads();
    }
}

__device__ __forceinline__ void phase_scan(const Ctx& c, int j) {
    PREF P = *c.p; const unsigned* upd = (const unsigned*)(c.ws + WS_UPD); unsigned* sp = (unsigned*)(c.ws + WS_SPREV);
    for (int idx = c.bid * NTHREADS + c.tid; idx < 4 * 2 * 16384; idx += c.G * NTHREADS) {
        const int h = idx >> 15, dir = (idx >> 14) & 1, pr = idx & 16383;
        const float g = exp2f(128.0f * ret_log2g(P.in[10] + j * 8, dir, h));
        float s0 = 0.f, s1 = 0.f;
        const size_t base = (size_t)(h * 2 + dir) * 16384 + pr, mstride = (size_t)4 * 2 * 16384;
#pragma unroll 1
        for (int it = 0; it < 130; it += 10) {
            unsigned uv[10]; int mm[10];
#pragma unroll
            for (int q = 0; q < 10; ++q) { const int s = it + q; mm[q] = (dir == 0) ? s : (s < 2 ? 1 - s : 131 - s); uv[q] = upd[base + (size_t)mm[q] * mstride]; }
#pragma unroll
            for (int q = 0; q < 10; ++q) { sp[base + (size_t)mm[q] * mstride] = cvtpk(s0, s1); s0 = g * s0 + bflo(uv[q]); s1 = g * s1 + bfhi(uv[q]); }
        }
    }
}
__device__ __forceinline__ void phase_hyconv(const Ctx& c, int j) {
    PREF P = *c.p; const unsigned* uT = (const unsigned*)(c.ws + WS_UT); unsigned* yT = (unsigned*)(c.ws + WS_YT);
    const f32x2* hs = (const f32x2*)(c.ws + WS_HSPEC); const float* skip = P.in[20] + (size_t)j * 2 * 512;
    LAS f32x2* z = (LAS f32x2*)c.lds;
    for (int ch = c.bid; ch < 512; ch += c.G) {
        const int tid = opaque(c.tid);
        const unsigned* vp = uT + (size_t)ch * (NX / 2); const unsigned* x1p = uT + (size_t)(512 + ch) * (NX / 2); const unsigned* x2p = uT + (size_t)(1024 + ch) * (NX / 2);
        const float sk0 = skip[ch], sk1 = skip[512 + ch];
#pragma unroll 4
        for (int i = 0; i < 16; ++i) { const int m = tid + i * NTHREADS; const unsigned w = vp[m]; z[fphys(m)] = (f32x2){bflo(w), bfhi(w)}; }
#pragma unroll 4
        for (int i = 16; i < 32; ++i) z[fphys(tid + i * NTHREADS)] = (f32x2){0.f, 0.f};
        __syncthreads();
        fft_fwd(z, tid); fft_pair_mul(z, hs + (size_t)ch * HSPEC_LD, tid); __syncthreads(); fft_inv(z, tid);
        f32x2* y1g = (f32x2*)(c.ws + WS_Y1) + (size_t)ch * (NX / 2);
#pragma unroll 4
        for (int i = 0; i < 16; ++i) { const int m = tid + i * NTHREADS; const f32x2 cv = z[fphys(m)]; const unsigned w = x1p[m], wv = vp[m];
            const f32x2 y = (f32x2){bflo(w) * (cv[0] + sk0 * bflo(wv)), bfhi(w) * (cv[1] + sk0 * bfhi(wv))};
            z[fphys(m)] = y; y1g[m] = y; }
#pragma unroll 4
        for (int i = 16; i < 32; ++i) z[fphys(tid + i * NTHREADS)] = (f32x2){0.f, 0.f};
        __syncthreads();
        fft_fwd(z, tid); fft_pair_mul(z, hs + (size_t)(512 + ch) * HSPEC_LD, tid); __syncthreads(); fft_inv(z, tid);
#pragma unroll 4
        for (int i = 0; i < 16; ++i) { const int m = tid + i * NTHREADS; const f32x2 cv = z[fphys(m)]; const unsigned w = x2p[m]; const f32x2 y1 = y1g[m];
            yT[(size_t)ch * (NX / 2) + m] = cvtpk(bflo(w) * (cv[0] + sk1 * y1[0]), bfhi(w) * (cv[1] + sk1 * y1[1])); }
        __syncthreads();
    }
}

__device__ __forceinline__ void phase_r3(const Ctx& c, int j) {
    PREF P = *c.p; const bf16_t* proj = (const bf16_t*)(c.ws + WS_PROJ); const bf16_t* spv = (const bf16_t*)(c.ws + WS_SPREV); bf16_t* cat = (bf16_t*)(c.ws + WS_CAT);
    LAS unsigned char* R0 = c.lds; LAS unsigned char* R1 = c.lds + 34816; LAS unsigned char* R2 = c.lds + 69632;
    for (int u = c.bid; u < 130 * 4; u += c.G) {
        const int tid = opaque(c.tid), lane = tid & 63, r32 = lane & 31, hi = lane >> 5, w = __builtin_amdgcn_readfirstlane(tid >> 6), wr2 = w >> 2, wc = w & 3;
        const int m = u >> 2, h = u & 3; const size_t row0 = (size_t)m * 128;
        const float lgf = ret_log2g(P.in[10] + j * 8, 0, h), lgb = ret_log2g(P.in[10] + j * 8, 1, h);
        {   const int jj = tid >> 2;
            for (int c8 = (tid & 3) * 8; c8 < 128; c8 += 32) {
                *(LAS u32x4*)(R0 + jj * P136 + c8 * 2) = *(const u32x4*)(proj + (row0 + jj) * AB_IN + h * 128 + c8);
                *(LAS u32x4*)(R1 + jj * P136 + c8 * 2) = *(const u32x4*)(proj + (row0 + jj) * AB_IN + 512 + h * 128 + c8); } }
        stage_T(tid, R2, proj + row0 * AB_IN + 1024 + h * 256, AB_IN, 256, nullptr);
        __syncthreads();
        f32x16 s[2] = {(f32x16){}, (f32x16){}};
#pragma unroll
        for (int ks = 0; ks < 8; ++ks) { const bf16x8 b = ldfrag(R1, P136, 32 * wc + r32, ks * 32 + hi * 16);
#pragma unroll
            for (int mi = 0; mi < 2; ++mi) { const bf16x8 a = ldfrag(R0, P136, 64 * wr2 + 32 * mi + r32, ks * 32 + hi * 16); s[mi] = __builtin_amdgcn_mfma_f32_32x32x16_bf16(a, b, s[mi], 0, 0, 0); } }
        __syncthreads();
#pragma unroll
        for (int mi = 0; mi < 2; ++mi)
#pragma unroll
            for (int r = 0; r < 16; ++r) { const int i = 64 * wr2 + 32 * mi + crow(r, hi), jc = 32 * wc + r32, rel = i - jc;
                const float dcy = (rel > 0) ? exp2f((float)rel * lgf) : ((rel < 0) ? exp2f((float)(-rel) * lgb) : 2.0f);
                *(LAS bf16_t*)(R1 + i * P136 + jc * 2) = f2bf(s[mi][r] * dcy); }
        __syncthreads();
        f32x16 o[2][2];
#pragma unroll
        for (int mi = 0; mi < 2; ++mi)
#pragma unroll
            for (int ni = 0; ni < 2; ++ni) o[mi][ni] = (f32x16){};
#pragma unroll
        for (int ks = 0; ks < 8; ++ks) { bf16x8 a[2], b[2];
#pragma unroll
            for (int q = 0; q < 2; ++q) { a[q] = ldfrag(R1, P136, 64 * wr2 + 32 * q + r32, ks * 32 + hi * 16); b[q] = ldfrag(R2, P136, 64 * wc + 32 * q + r32, ks * 32 + hi * 16); }
#pragma unroll
            for (int mi = 0; mi < 2; ++mi)
#pragma unroll
                for (int ni = 0; ni < 2; ++ni) o[mi][ni] = __builtin_amdgcn_mfma_f32_32x32x16_bf16(a[mi], b[ni], o[mi][ni], 0, 0, 0); }
        __syncthreads();
#pragma unroll 1
        for (int dir = 0; dir < 2; ++dir) {
            {   const int jj = tid >> 2; const float qd = (dir == 0) ? exp2f((float)(jj + 1) * lgf) : exp2f((float)(128 - jj) * lgb);
                for (int c8 = (tid & 3) * 8; c8 < 128; c8 += 32) { const u32x4 v = *(const LAS u32x4*)(R0 + jj * P136 + c8 * 2); u32x4 wv;
                    wv.x = cvtpk(bflo(v.x) * qd, bfhi(v.x) * qd); wv.y = cvtpk(bflo(v.y) * qd, bfhi(v.y) * qd); wv.z = cvtpk(bflo(v.z) * qd, bfhi(v.z) * qd); wv.w = cvtpk(bflo(v.w) * qd, bfhi(v.w) * qd);
                    *(LAS u32x4*)(R1 + jj * P136 + c8 * 2) = wv; } }
            {   const bf16_t* sp = spv + ((size_t)(m * 4 + h) * 2 + dir) * 32768;
                for (int idx = tid; idx < 256 * 16; idx += NTHREADS) { const int e = idx >> 4, c8 = (idx & 15) * 8; *(LAS u32x4*)(R2 + e * P136 + c8 * 2) = *(const u32x4*)(sp + e * 128 + c8); } }
            __syncthreads();
#pragma unroll
            for (int ks = 0; ks < 8; ++ks) { bf16x8 a[2], b[2];
#pragma unroll
                for (int q = 0; q < 2; ++q) { a[q] = ldfrag(R1, P136, 64 * wr2 + 32 * q + r32, ks * 32 + hi * 16); b[q] = ldfrag(R2, P136, 64 * wc + 32 * q + r32, ks * 32 + hi * 16); }
#pragma unroll
                for (int mi = 0; mi < 2; ++mi)
#pragma unroll
                    for (int ni = 0; ni < 2; ++ni) o[mi][ni] = __builtin_amdgcn_mfma_f32_32x32x16_bf16(a[mi], b[ni], o[mi][ni], 0, 0, 0); }
            __syncthreads();
        }
        for (int idx = tid; idx < 128 * 32; idx += NTHREADS) { const int i = idx >> 5, c8 = (idx & 31) * 8; *(LAS u32x4*)(R2 + i * 528 + c8 * 2) = *(const u32x4*)(proj + (row0 + i) * AB_IN + 2048 + h * 256 + c8); }
        LAS float* st = (LAS float*)R0;
#pragma unroll
        for (int mi = 0; mi < 2; ++mi)
#pragma unroll
            for (int r = 0; r < 16; ++r) { float sm = o[mi][0][r] + o[mi][1][r], sq = o[mi][0][r] * o[mi][0][r] + o[mi][1][r] * o[mi][1][r];
#pragma unroll
                for (int off = 16; off >= 1; off >>= 1) { sm += __shfl_xor(sm, off); sq += __shfl_xor(sq, off); }
                if (r32 == 0) { const int i = 64 * wr2 + 32 * mi + crow(r, hi); st[(i * 4 + wc) * 2 + 0] = sm; st[(i * 4 + wc) * 2 + 1] = sq; } }
        __syncthreads();
#pragma unroll
        for (int mi = 0; mi < 2; ++mi)
#pragma unroll
            for (int r = 0; r < 16; ++r) { const int i = 64 * wr2 + 32 * mi + crow(r, hi); float sm = 0.f, sq = 0.f;
#pragma unroll
                for (int q = 0; q < 4; ++q) { sm += st[(i * 4 + q) * 2 + 0]; sq += st[(i * 4 + q) * 2 + 1]; }
                const float mu = sm * (1.0f / 256.f), var = fmaxf(sq * (1.0f / 256.f) - mu * mu, 0.f), rstd = rsqrtf(var + EPS);
#pragma unroll
                for (int ni = 0; ni < 2; ++ni) { const int e = 64 * wc + 32 * ni + r32; LAS bf16_t* pg = (LAS bf16_t*)(R2 + i * 528 + e * 2); const float g = bf2f(*pg);
                    *pg = f2bf((o[mi][ni][r] - mu) * rstd * siluf(g)); } }
        __syncthreads();
        for (int idx = tid; idx < 128 * 32; idx += NTHREADS) { const int i = idx >> 5, c8 = (idx & 31) * 8; *(u32x4*)(cat + (row0 + i) * AB_CAT + h * 256 + c8) = *(const LAS u32x4*)(R2 + i * 528 + c8 * 2); }
        __syncthreads();
    }
}

__device__ __forceinline__ void phase_hytrans(const Ctx& c) {
    const bf16_t* yT = (const bf16_t*)(c.ws + WS_YT); bf16_t* cat = (bf16_t*)(c.ws + WS_CAT);
    LAS bf16_t* t = (LAS bf16_t*)c.lds;
    const int tid = c.tid;
    for (int u = c.bid; u < 256 * 8; u += c.G) {
        const int t0 = (u >> 3) * 64, ch0 = (u & 7) * 64;
        {   const int ch = tid >> 3, t8 = (tid & 7) * 8; const u32x4 v = *(const u32x4*)(yT + (size_t)(ch0 + ch) * NX + t0 + t8); const unsigned wv[4] = {v.x, v.y, v.z, v.w};
#pragma unroll
            for (int q = 0; q < 4; ++q) { t[ch * 66 + t8 + 2 * q] = (bf16_t)(wv[q] & 0xffffu); t[ch * 66 + t8 + 2 * q + 1] = (bf16_t)(wv[q] >> 16); } }
        __syncthreads();
        {   const int tt = tid >> 3, c8 = (tid & 7) * 8; unsigned short e[8];
#pragma unroll
            for (int q = 0; q < 8; ++q) e[q] = t[(c8 + q) * 66 + tt];
            u32x4 wv; wv.x = e[0] | ((unsigned)e[1] << 16); wv.y = e[2] | ((unsigned)e[3] << 16); wv.z = e[4] | ((unsigned)e[5] << 16); wv.w = e[6] | ((unsigned)e[7] << 16);
            *(u32x4*)(cat + (size_t)(NC + t0 + tt) * AB_CAT + 1024 + ch0 + c8) = wv; }
        __syncthreads();
    }
}

__device__ __forceinline__ void phase_hyctx(const Ctx& c, int j) {
    PREF P = *c.p; const bf16_t* proj = (const bf16_t*)(c.ws + WS_PROJ); bf16_t* cat = (bf16_t*)(c.ws + WS_CAT);
    const float* hid2c = (const float*)(c.ws + WS_HID2C); const float* w3 = P.in[19] + (size_t)j * 64 * 2048;
    const float* cw = P.in[11] + (size_t)j * 3 * 1536; const float* cb = P.in[12] + (size_t)j * 1536; const float* skip = P.in[20] + (size_t)j * 2 * 512;
    LAS float* raw = (LAS float*)c.lds;
    LAS float* ser = raw + 3 * 258;
    LAS float* flt = ser + 3 * 256;
    LAS float* yy = flt + 4 * 256;
    const int tid = c.tid;
    for (int ch = c.bid; ch < 512; ch += c.G) {
        for (int idx = tid; idx < 3 * 258; idx += NTHREADS) { const int s = idx / 258, r = idx % 258, t = r - 1; raw[idx] = (t >= 0 && t < 256) ? bf2f(proj[(size_t)t * AB_IN + 3072 + s * 512 + ch]) : 0.f; }
        {
            const int t = tid & 255, hf = tid >> 8; const float tn = (float)t * (1.0f / 255.0f);
            const float delta = 3.0701134573253945f + (15.350567286626972f - 3.0701134573253945f) * ((float)ch * (1.0f / 511.0f)); const float win = __expf(-tn * delta);
            float a0 = 0.f, a1 = 0.f; const int col0 = (2 * hf) * 512 + ch, col1 = (2 * hf + 1) * 512 + ch;
            for (int k = 0; k < 64; ++k) { const float hv = hid2c[t * 64 + k]; a0 += hv * w3[(size_t)k * 2048 + col0]; a1 += hv * w3[(size_t)k * 2048 + col1]; }
            flt[(2 * hf) * 256 + t] = a0 * win; flt[(2 * hf + 1) * 256 + t] = a1 * win; }
        __syncthreads();
        for (int idx = tid; idx < 3 * 256; idx += NTHREADS) { const int s = idx >> 8, t = idx & 255, cg = s * 512 + ch;
            ser[idx] = raw[s * 258 + t] * cw[cg] + raw[s * 258 + t + 1] * cw[1536 + cg] + raw[s * 258 + t + 2] * cw[3072 + cg] + cb[cg]; }
        __syncthreads();
        if (tid < 256) { const int t = tid; float a = 0.f;
            for (int s = 0; s <= t; ++s) a += flt[0 * 256 + (t - s)] * ser[s];
            for (int s = t + 1; s < 256; ++s) a += flt[1 * 256 + (s - t)] * ser[s];
            yy[t] = ser[256 + t] * (a + skip[ch] * ser[t]); }
        __syncthreads();
        if (tid < 256) { const int t = tid; float a = 0.f;
            for (int s = 0; s <= t; ++s) a += flt[2 * 256 + (t - s)] * yy[s];
            for (int s = t + 1; s < 256; ++s) a += flt[3 * 256 + (s - t)] * yy[s];
            cat[(size_t)t * AB_CAT + 1024 + ch] = f2bf(ser[512 + t] * (a + skip[512 + ch] * yy[t])); }
        __syncthreads();
    }
}
namespace da2 {
constexpr int KSLOT = 16384, VSLOT = 16384, NSLOT = 3;
constexpr int LDS_K = 0, LDS_V = NSLOT * KSLOT, LDS_WS = LDS_V + NSLOT * VSLOT;
#define D2_SBAR() __builtin_amdgcn_sched_barrier(0)
#define D2_WAIT_BAR(N) asm volatile("s_waitcnt vmcnt(" #N ") lgkmcnt(0)\n\ts_barrier" ::: "memory")
typedef short v4i16_t __attribute__((ext_vector_type(4)));
typedef LAS const char* lcp;
__device__ __forceinline__ void glds16(const void* gsrc, unsigned lds_dst) { unsigned keep;
    asm volatile("s_mov_b32 %0, m0\n\ts_mov_b32 m0, %2\n\ts_nop 0\n\tglobal_load_lds_dwordx4 %1, off\n\ts_mov_b32 m0, %0" : "=&s"(keep) : "v"(gsrc), "s"(lds_dst) : "memory"); }
__device__ __forceinline__ unsigned cvtpk_s(float lo, float hi) { f32x2 v = {lo, hi}; bf16x2_t b = __builtin_convertvector(v, bf16x2_t); return __builtin_bit_cast(unsigned, b); }
__device__ __forceinline__ s16x4 vtr(lcp p) { return __builtin_bit_cast(s16x4, __builtin_amdgcn_ds_read_tr16_b64_v4i16((LAS v4i16_t*)p)); }
__device__ __forceinline__ void kload8(bf16x8* kf, lcp kp) {
    kf[0] = *(const LAS bf16x8*)(kp);        kf[1] = *(const LAS bf16x8*)(kp + 512);
    kf[2] = *(const LAS bf16x8*)(kp + 2048); kf[3] = *(const LAS bf16x8*)(kp + 2560);
    kf[4] = *(const LAS bf16x8*)(kp + 4096); kf[5] = *(const LAS bf16x8*)(kp + 4608);
    kf[6] = *(const LAS bf16x8*)(kp + 6144); kf[7] = *(const LAS bf16x8*)(kp + 6656); }

__device__ __forceinline__ bool attn_unit_dma(LAS char* lds, const bf16_t* proj, bf16_t* cat, int h, int qrow0, int nkeys, float lam, float oscale, const float* subln) {
    constexpr int LD = DA_IN;
    const int tid = opaque((int)threadIdx.x), wid = __builtin_amdgcn_readfirstlane(tid >> 6), lane = tid & 63, r32 = lane & 31, hi = lane >> 5, comp = wid >> 2, qw = wid & 3;
    const unsigned lds0 = (unsigned)(uintptr_t)lds;
    LAS float* wsf = (LAS float*)(lds + LDS_WS) + wid * 64;
    const bf16_t* Kh = proj + 1024 + h * 128; const bf16_t* Vh = proj + 2048 + h * 128;
    const bf16_t* ksrc0 = Kh + (size_t)lane * LD + wid * 8; const bf16_t* ksrc1 = ksrc0 + 64;
    const bf16_t* vsrc0 = Vh + (size_t)(16 * (wid & 3) + (lane >> 2)) * LD + (wid >> 2) * 32 + (lane & 3) * 8; const bf16_t* vsrc1 = vsrc0 + 64;
    const unsigned kdst = lds0 + LDS_K + wid * 1024, vdst = lds0 + LDS_V + wid * 1024;
#define D2_DMA_K(t, slot) do { glds16(ksrc0 + (size_t)(t) * 64 * LD, (unsigned)__builtin_amdgcn_readfirstlane(kdst + (slot))); glds16(ksrc1 + (size_t)(t) * 64 * LD, (unsigned)__builtin_amdgcn_readfirstlane(kdst + (slot) + 8192)); } while (0)
#define D2_DMA_V(t, slot) do { glds16(vsrc0 + (size_t)(t) * 64 * LD, (unsigned)__builtin_amdgcn_readfirstlane(vdst + (slot))); glds16(vsrc1 + (size_t)(t) * 64 * LD, (unsigned)__builtin_amdgcn_readfirstlane(vdst + (slot) + 8192)); } while (0)
    const lcp shm3 = (lcp)lds;
    const lcp kp0 = shm3 + LDS_K + comp * 8192 + hi * 1024 + r32 * 16;
    const lcp vp0 = shm3 + LDS_V + ((lane >> 4) & 1) * 32 + (lane & 3) * 8 + (4 * hi + ((lane & 15) >> 2)) * 64;
    const int NT = nkeys / 64;
    D2_DMA_K(0, 0); D2_DMA_V(0, 0); D2_DMA_K(1, KSLOT);
    bf16x8 qr[4];
    { const bf16_t* Qw = proj + (size_t)(qrow0 + qw * 32 + r32) * LD + h * 128 + comp * 64 + hi * 8;
#pragma unroll
      for (int d0 = 0; d0 < 4; ++d0) qr[d0] = *reinterpret_cast<const bf16x8*>(Qw + d0 * 16); }
    float l_reg = 0.f; f32x16 o[4]; o[0] = f32x16{}; o[1] = f32x16{}; o[2] = f32x16{}; o[3] = f32x16{};
    f32x16 pA0, pA1, pB0, pB1; bf16x8 kf[8];
    int sl_prev = 0, sl_cur = 0, sl_next = KSLOT;
#define D2_ROT() do { sl_prev = sl_cur; sl_cur = sl_next; sl_next = (sl_next == (NSLOT - 1) * KSLOT) ? 0 : sl_next + KSLOT; } while (0)
    D2_DMA_K(2, 2 * KSLOT);
    D2_WAIT_BAR(6);
    { const lcp kb = kp0;
      pA0 = f32x16{}; pA1 = f32x16{};
#pragma unroll
      for (int d0 = 0; d0 < 4; ++d0) { const bf16x8 b0 = *(const LAS bf16x8*)(kb + d0 * 2048), b1 = *(const LAS bf16x8*)(kb + d0 * 2048 + 512);
          pA0 = __builtin_amdgcn_mfma_f32_32x32x16_bf16(b0, qr[d0], pA0, 0, 0, 0); pA1 = __builtin_amdgcn_mfma_f32_32x32x16_bf16(b1, qr[d0], pA1, 0, 0, 0); }
#pragma unroll
      for (int r = 0; r < 16; ++r) { pA0[r] = __builtin_amdgcn_exp2f(pA0[r]); pA1[r] = __builtin_amdgcn_exp2f(pA1[r]); } }
    D2_WAIT_BAR(0);
    D2_DMA_K(3, 0); D2_DMA_V(1, VSLOT);
    D2_ROT();
    kload8(kf, kp0 + sl_cur);
    D2_WAIT_BAR(4);
    s16x4 vlo[8], vhi[8]; u32x4 pw0, pw1, pw2, pw3;
#define D2_PKW(P, B) cvtpk_s(P[B], P[B + 1])
#define D2_PAF(k) __builtin_bit_cast(bf16x8, pw##k)
#define D2_VFR(s) (bf16x8){vlo[s][0], vlo[s][1], vlo[s][2], vlo[s][3], vhi[s][0], vhi[s][1], vhi[s][2], vhi[s][3]}
#define D2_PIN(x) asm volatile("" : "+v"(x))
#define D2_VRD(s, i) do { vlo[s] = vtr(vp_ + (((i) >> 2) * 4096 + ((i) & 3) * 1024)); vhi[s] = vtr(vp_ + (((i) >> 2) * 4096 + ((i) & 3) * 1024 + 512)); } while (0)
#define D2_GAPA(MF, A0, A1, A2, A3, W0, W1, PW) do { MF; sacc += A0; sacc += A1; sacc += A2; sacc += A3; D2_PIN(sacc); W0; W1; D2_PIN(PW); D2_SBAR(); } while (0)
#define D2_EX(v) __builtin_amdgcn_exp2f(v)
#define D2_GAPB(MF, X, B) do { MF; X[B] = D2_EX(X[B]); X[B + 1] = D2_EX(X[B + 1]); D2_PIN(X); D2_SBAR(); } while (0)
#define D2_KRD(G, j) do { if (G) { kf[j] = *(const LAS bf16x8*)(kp0 + sl_next + ((j) >> 1) * 2048 + ((j) & 1) * 512); D2_SBAR(); } } while (0)
#define D2_ORD(j) ((((j) & 3) << 2) | ((j) >> 2))
#define D2_STEP(C0, C1, P0, P1, t, GK, GV, GL) do { D2_SBAR(); \
    const lcp vp_ = vp0 + sl_prev; \
    D2_VRD(0, D2_ORD(0)); D2_SBAR(); float sacc = (P0[0] + P0[1]); \
    D2_GAPA(C0 = __builtin_amdgcn_mfma_f32_32x32x16_bf16(kf[0], qr[0], f32x16{}, 0, 0, 0), P0[2], P0[3], P0[4], P0[5],     pw0[0] = D2_PKW(P0, 0), pw0[1] = D2_PKW(P0, 2), pw0); \
    D2_VRD(1, D2_ORD(1)); D2_SBAR(); D2_GAPA(C1 = __builtin_amdgcn_mfma_f32_32x32x16_bf16(kf[1], qr[0], f32x16{}, 0, 0, 0), P0[6], P0[7], P0[8], P0[9],     pw0[2] = D2_PKW(P0, 4), pw0[3] = D2_PKW(P0, 6), pw0); \
    D2_VRD(2, D2_ORD(2)); D2_SBAR(); D2_GAPA(C0 = __builtin_amdgcn_mfma_f32_32x32x16_bf16(kf[2], qr[1], C0, 0, 0, 0),       P0[10], P0[11], P0[12], P0[13], pw1[0] = D2_PKW(P0, 8), pw1[1] = D2_PKW(P0, 10), pw1); \
    D2_VRD(3, D2_ORD(3)); D2_SBAR(); D2_GAPA(C1 = __builtin_amdgcn_mfma_f32_32x32x16_bf16(kf[3], qr[1], C1, 0, 0, 0),       P0[14], P0[15], P1[0], P1[1],   pw1[2] = D2_PKW(P0, 12), pw1[3] = D2_PKW(P0, 14), pw1); \
    D2_VRD(4, D2_ORD(4)); D2_SBAR(); D2_GAPA(C0 = __builtin_amdgcn_mfma_f32_32x32x16_bf16(kf[4], qr[2], C0, 0, 0, 0),       P1[2], P1[3], P1[4], P1[5],     pw2[0] = D2_PKW(P1, 0), pw2[1] = D2_PKW(P1, 2), pw2); \
    D2_VRD(5, D2_ORD(5)); D2_SBAR(); D2_GAPA(C1 = __builtin_amdgcn_mfma_f32_32x32x16_bf16(kf[5], qr[2], C1, 0, 0, 0),       P1[6], P1[7], P1[8], P1[9],     pw2[2] = D2_PKW(P1, 4), pw2[3] = D2_PKW(P1, 6), pw2); \
    D2_VRD(6, D2_ORD(6)); D2_SBAR(); D2_GAPA(C0 = __builtin_amdgcn_mfma_f32_32x32x16_bf16(kf[6], qr[3], C0, 0, 0, 0),       P1[10], P1[11], P1[12], P1[13], pw3[0] = D2_PKW(P1, 8), pw3[1] = D2_PKW(P1, 10), pw3); \
    D2_VRD(7, D2_ORD(7)); D2_SBAR(); D2_GAPA(C1 = __builtin_amdgcn_mfma_f32_32x32x16_bf16(kf[7], qr[3], C1, 0, 0, 0),       P1[14], P1[15], 0.f, 0.f,       pw3[2] = D2_PKW(P1, 12), pw3[3] = D2_PKW(P1, 14), pw3); \
    l_reg += sacc; \
    if (GK) { D2_DMA_K((t) + 3, sl_cur); } if (GV) { D2_DMA_V((t) + 1, sl_next); } \
    D2_SBAR(); \
    D2_GAPB(o[0] = __builtin_amdgcn_mfma_f32_32x32x16_bf16(D2_PAF(0), D2_VFR(0), o[0], 0, 0, 0), C0, 0);  D2_VRD(0, D2_ORD(8));  D2_SBAR(); \
    D2_GAPB(o[1] = __builtin_amdgcn_mfma_f32_32x32x16_bf16(D2_PAF(0), D2_VFR(1), o[1], 0, 0, 0), C0, 2);  D2_VRD(1, D2_ORD(9));  D2_SBAR(); \
    D2_GAPB(o[2] = __builtin_amdgcn_mfma_f32_32x32x16_bf16(D2_PAF(0), D2_VFR(2), o[2], 0, 0, 0), C0, 4);  D2_VRD(2, D2_ORD(10)); D2_SBAR(); \
    D2_GAPB(o[3] = __builtin_amdgcn_mfma_f32_32x32x16_bf16(D2_PAF(0), D2_VFR(3), o[3], 0, 0, 0), C0, 6);  D2_VRD(3, D2_ORD(11)); D2_SBAR(); \
    D2_KRD(GL, 0); D2_GAPB(o[0] = __builtin_amdgcn_mfma_f32_32x32x16_bf16(D2_PAF(1), D2_VFR(4), o[0], 0, 0, 0), C0, 8);  D2_VRD(4, D2_ORD(12)); D2_SBAR(); \
    D2_KRD(GL, 1); D2_GAPB(o[1] = __builtin_amdgcn_mfma_f32_32x32x16_bf16(D2_PAF(1), D2_VFR(5), o[1], 0, 0, 0), C0, 10); D2_VRD(5, D2_ORD(13)); D2_SBAR(); \
    D2_KRD(GL, 2); D2_GAPB(o[2] = __builtin_amdgcn_mfma_f32_32x32x16_bf16(D2_PAF(1), D2_VFR(6), o[2], 0, 0, 0), C0, 12); D2_VRD(6, D2_ORD(14)); D2_SBAR(); \
    D2_KRD(GL, 3); D2_GAPB(o[3] = __builtin_amdgcn_mfma_f32_32x32x16_bf16(D2_PAF(1), D2_VFR(7), o[3], 0, 0, 0), C0, 14); D2_VRD(7, D2_ORD(15)); D2_SBAR(); \
    D2_KRD(GL, 4); D2_GAPB(o[0] = __builtin_amdgcn_mfma_f32_32x32x16_bf16(D2_PAF(2), D2_VFR(0), o[0], 0, 0, 0), C1, 0); \
    D2_KRD(GL, 5); D2_GAPB(o[1] = __builtin_amdgcn_mfma_f32_32x32x16_bf16(D2_PAF(2), D2_VFR(1), o[1], 0, 0, 0), C1, 2); \
    D2_KRD(GL, 6); D2_GAPB(o[2] = __builtin_amdgcn_mfma_f32_32x32x16_bf16(D2_PAF(2), D2_VFR(2), o[2], 0, 0, 0), C1, 4); \
    D2_KRD(GL, 7); D2_GAPB(o[3] = __builtin_amdgcn_mfma_f32_32x32x16_bf16(D2_PAF(2), D2_VFR(3), o[3], 0, 0, 0), C1, 6); \
    D2_GAPB(o[0] = __builtin_amdgcn_mfma_f32_32x32x16_bf16(D2_PAF(3), D2_VFR(4), o[0], 0, 0, 0), C1, 8); \
    D2_GAPB(o[1] = __builtin_amdgcn_mfma_f32_32x32x16_bf16(D2_PAF(3), D2_VFR(5), o[1], 0, 0, 0), C1, 10); \
    D2_GAPB(o[2] = __builtin_amdgcn_mfma_f32_32x32x16_bf16(D2_PAF(3), D2_VFR(6), o[2], 0, 0, 0), C1, 12); \
    D2_GAPB(o[3] = __builtin_amdgcn_mfma_f32_32x32x16_bf16(D2_PAF(3), D2_VFR(7), o[3], 0, 0, 0), C1, 14); \
    } while (0)
    int t = 1;
    for (; t + 5 < NT; t += 2) {
        D2_STEP(pB0, pB1, pA0, pA1, t, true, true, true);     D2_WAIT_BAR(4); D2_ROT();
        D2_STEP(pA0, pA1, pB0, pB1, t + 1, true, true, true); D2_WAIT_BAR(4); D2_ROT();
    }
#define D2_ENDW(tt) do { if ((tt) + 3 < NT) { D2_WAIT_BAR(4); } else if ((tt) + 2 < NT) { D2_WAIT_BAR(2); } else { D2_WAIT_BAR(0); } } while (0)
    for (; t + 1 < NT; t += 2) {
        D2_STEP(pB0, pB1, pA0, pA1, t, (t + 3 < NT), (t + 1 < NT), (t + 1 < NT));         D2_ENDW(t);     D2_ROT();
        D2_STEP(pA0, pA1, pB0, pB1, t + 1, (t + 4 < NT), (t + 2 < NT), (t + 2 < NT));     D2_ENDW(t + 1); D2_ROT();
    }
    D2_STEP(pB0, pB1, pA0, pA1, NT - 1, false, false, false);
    { float sacc = pB0[0] + pB0[1];
#pragma unroll
      for (int r = 2; r < 16; ++r) sacc += pB0[r];
#pragma unroll
      for (int r = 0; r < 16; ++r) sacc += pB1[r];
      l_reg += sacc;
      pw0 = (u32x4){D2_PKW(pB0, 0), D2_PKW(pB0, 2), D2_PKW(pB0, 4), D2_PKW(pB0, 6)}; pw1 = (u32x4){D2_PKW(pB0, 8), D2_PKW(pB0, 10), D2_PKW(pB0, 12), D2_PKW(pB0, 14)};
      pw2 = (u32x4){D2_PKW(pB1, 0), D2_PKW(pB1, 2), D2_PKW(pB1, 4), D2_PKW(pB1, 6)}; pw3 = (u32x4){D2_PKW(pB1, 8), D2_PKW(pB1, 10), D2_PKW(pB1, 12), D2_PKW(pB1, 14)};
      D2_SBAR();
      const lcp vp_ = vp0 + sl_cur;
#pragma unroll
      for (int d0 = 0; d0 < 4; ++d0) {
#pragma unroll
          for (int ks = 0; ks < 4; ++ks) { vlo[ks] = vtr(vp_ + (d0 * 4096 + ks * 1024)); vhi[ks] = vtr(vp_ + (d0 * 4096 + ks * 1024 + 512)); }
          o[d0] = __builtin_amdgcn_mfma_f32_32x32x16_bf16(D2_PAF(0), D2_VFR(0), o[d0], 0, 0, 0); o[d0] = __builtin_amdgcn_mfma_f32_32x32x16_bf16(D2_PAF(1), D2_VFR(1), o[d0], 0, 0, 0);
          o[d0] = __builtin_amdgcn_mfma_f32_32x32x16_bf16(D2_PAF(2), D2_VFR(2), o[d0], 0, 0, 0); o[d0] = __builtin_amdgcn_mfma_f32_32x32x16_bf16(D2_PAF(3), D2_VFR(3), o[d0], 0, 0, 0); } }
    { auto rr = __builtin_amdgcn_permlane32_swap(__float_as_uint(l_reg), __float_as_uint(l_reg), false, false); l_reg = __uint_as_float(rr[0]) + __uint_as_float(rr[1]); }
    if (hi == 0) wsf[32 + r32] = l_reg; asm volatile("s_waitcnt lgkmcnt(0)" ::: "memory");
    {
#pragma unroll
      for (int r = 0; r < 16; ++r) { const float rl = __builtin_amdgcn_rcpf(wsf[32 + crow(r, hi)]);
#pragma unroll
          for (int d0 = 0; d0 < 4; ++d0) o[d0][r] *= rl; } }
    const int bad = (l_reg > 1.0e-30f && l_reg < 1.0e30f) ? 0 : 1;
    LAS int* flg = (LAS int*)(lds + LDS_WS + 8 * 256);
    { const int anyb = (__ballot(bad) != 0ull) ? 1 : 0; if (lane == 0) flg[wid] = anyb; }
    __syncthreads();
    { int f = 0;
#pragma unroll
      for (int q = 0; q < 8; ++q) f |= flg[q];
      if (__builtin_amdgcn_readfirstlane(f)) { __syncthreads(); return false; } }
    LAS float* xb = (LAS float*)lds;
    if (comp == 1) {
#pragma unroll
        for (int d0 = 0; d0 < 4; ++d0)
#pragma unroll
            for (int r = 0; r < 16; ++r) xb[((qw * 64) + d0 * 16 + r) * 64 + lane] = o[d0][r];
    }
    __syncthreads();
    if (comp == 0) {
        float ssq[16];
#pragma unroll
        for (int r = 0; r < 16; ++r) ssq[r] = 0.f;
#pragma unroll
        for (int d0 = 0; d0 < 4; ++d0)
#pragma unroll
            for (int r = 0; r < 16; ++r) { const float x = o[d0][r] - lam * xb[((qw * 64) + d0 * 16 + r) * 64 + lane]; o[d0][r] = x; ssq[r] += x * x; }
#pragma unroll
        for (int r = 0; r < 16; ++r) {
#pragma unroll
            for (int off = 16; off >= 1; off >>= 1) ssq[r] += __shfl_xor(ssq[r], off);
            ssq[r] = rsqrtf(ssq[r] * (1.0f / 128.f) + 1e-5f) * oscale; }
        asm volatile("" ::: "memory");
        LAS char* stg = lds + qw * 16384;
#pragma unroll
        for (int d0 = 0; d0 < 4; ++d0) { const float g = subln[d0 * 32 + r32];
#pragma unroll
            for (int r = 0; r < 16; ++r) *(LAS bf16_t*)(stg + crow(r, hi) * 272 + (d0 * 32 + r32) * 2) = f2bf(o[d0][r] * ssq[r] * g); }
        asm volatile("s_waitcnt lgkmcnt(0)" ::: "memory");
        bf16_t* Ow = cat + (size_t)(qrow0 + qw * 32) * DA_W + h * 128;
#pragma unroll
        for (int q = 0; q < 8; ++q) { const int id = q * 64 + lane, row = id >> 4, c16 = id & 15; *(u32x4*)(Ow + (size_t)row * DA_W + c16 * 8) = *(const LAS u32x4*)(stg + row * 272 + c16 * 16); }
    }
    __syncthreads();
    return true;
#undef D2_DMA_K
#undef D2_DMA_V
#undef D2_ROT
#undef D2_STEP
#undef D2_ENDW
}
}
namespace da {
constexpr int KVBLK = 64;
constexpr int SHM_V = KVBLK * 128 * 2, SHM_K = KVBLK * 128 * 2;
constexpr float THR2 = 11.5f;
#define DA_KSWZ(row, colB) ((row) * 256 + ((colB) ^ (((row) & 7) << 4)))
#define DA_SBAR() __builtin_amdgcn_sched_barrier(0)
__device__ __forceinline__ unsigned cvtpk_a(float lo, float hi) { unsigned r; asm volatile("v_cvt_pk_bf16_f32 %0, %1, %2" : "=v"(r) : "v"(lo), "v"(hi)); return r; }
__device__ __forceinline__ void partialSM(f32x16& p0, f32x16& p1, float& m_reg, float& alpha) {
    float pmax = p0[0];
#pragma unroll
    for (int r = 1; r < 16; ++r) pmax = fmaxf(pmax, p0[r]);
#pragma unroll
    for (int r = 0; r < 16; ++r) pmax = fmaxf(pmax, p1[r]);
    { auto rr = __builtin_amdgcn_permlane32_swap(__float_as_uint(pmax), __float_as_uint(pmax), false, false); pmax = fmaxf(__uint_as_float(rr[0]), __uint_as_float(rr[1])); }
    float mn;
    if (__builtin_expect(__all(pmax - m_reg <= THR2), 1)) { mn = m_reg; alpha = 1.f; }
    else { mn = fmaxf(m_reg, pmax); alpha = __builtin_amdgcn_exp2f(m_reg - mn); m_reg = mn; }
#pragma unroll
    for (int r = 0; r < 16; ++r) { p0[r] -= mn; p1[r] -= mn; }
#pragma unroll
    for (int r = 0; r < 16; ++r) p0[r] = __builtin_amdgcn_exp2f(p0[r]);
}
__device__ __forceinline__ void partialSM_fast(f32x16& p0, f32x16& p1, float& l_reg) {
#pragma unroll
    for (int r = 0; r < 16; ++r) p0[r] = __builtin_amdgcn_exp2f(p0[r]);
#pragma unroll
    for (int r = 0; r < 16; ++r) p1[r] = __builtin_amdgcn_exp2f(p1[r]);
    float ps = 0;
#pragma unroll
    for (int r = 0; r < 16; ++r) ps += p0[r];
#pragma unroll
    for (int r = 0; r < 16; ++r) ps += p1[r];
    l_reg += ps;
}
__device__ __forceinline__ void finishSM_fast(f32x16& p0, f32x16& p1, bf16x8& pa0, bf16x8& pa1, bf16x8& pa2, bf16x8& pa3) {
#define DA_PK4(P, BASE, OUT) do { unsigned a0 = cvtpk_a(P[BASE + 0], P[BASE + 1]), a1 = cvtpk_a(P[BASE + 2], P[BASE + 3]);   \
    unsigned b0 = cvtpk_a(P[BASE + 4], P[BASE + 5]), b1 = cvtpk_a(P[BASE + 6], P[BASE + 7]);                              \
    auto r0 = __builtin_amdgcn_permlane32_swap(a0, b0, false, false); auto r1 = __builtin_amdgcn_permlane32_swap(a1, b1, false, false); \
    u32x4 w = {r0[0], r1[0], r0[1], r1[1]}; OUT = *reinterpret_cast<bf16x8*>(&w); } while (0)
    DA_PK4(p0, 0, pa0); DA_PK4(p0, 8, pa1); DA_PK4(p1, 0, pa2); DA_PK4(p1, 8, pa3);
#undef DA_PK4
}
__device__ __forceinline__ void finishSM(f32x16& p0, f32x16& p1, float alpha, float& l_reg, bf16x8& pa0, bf16x8& pa1, bf16x8& pa2, bf16x8& pa3) {
#pragma unroll
    for (int r = 0; r < 16; ++r) p1[r] = __builtin_amdgcn_exp2f(p1[r]);
    float ps = 0;
#pragma unroll
    for (int r = 0; r < 16; ++r) ps += p0[r];
#pragma unroll
    for (int r = 0; r < 16; ++r) ps += p1[r];
    { auto rr = __builtin_amdgcn_permlane32_swap(__float_as_uint(ps), __float_as_uint(ps), false, false); ps = __uint_as_float(rr[0]) + __uint_as_float(rr[1]); }
    l_reg = l_reg * alpha + ps;
#define DA_PK4(P, BASE, OUT) do { unsigned a0 = cvtpk_a(P[BASE + 0], P[BASE + 1]), a1 = cvtpk_a(P[BASE + 2], P[BASE + 3]);   \
    unsigned b0 = cvtpk_a(P[BASE + 4], P[BASE + 5]), b1 = cvtpk_a(P[BASE + 6], P[BASE + 7]);                              \
    auto r0 = __builtin_amdgcn_permlane32_swap(a0, b0, false, false); auto r1 = __builtin_amdgcn_permlane32_swap(a1, b1, false, false); \
    u32x4 w = {r0[0], r1[0], r0[1], r1[1]}; OUT = *reinterpret_cast<bf16x8*>(&w); } while (0)
    DA_PK4(p0, 0, pa0); DA_PK4(p0, 8, pa1); DA_PK4(p1, 0, pa2); DA_PK4(p1, 8, pa3);
#undef DA_PK4
}
__device__ __forceinline__ void qkt(f32x16& p0, f32x16& p1, const LAS char* Ks, const bf16x8* qr, int r32, int hi, int comp) {
    p0 = f32x16{}; p1 = f32x16{};
#pragma unroll
    for (int d0 = 0; d0 < 4; ++d0) { const int cb = (comp * 64 + d0 * 16 + hi * 8) * 2;
        const bf16x8 b0 = *(const LAS bf16x8*)(Ks + DA_KSWZ(r32, cb));
        const bf16x8 b1 = *(const LAS bf16x8*)(Ks + DA_KSWZ(32 + r32, cb));
        p0 = __builtin_amdgcn_mfma_f32_32x32x16_bf16(b0, qr[d0], p0, 0, 0, 0);
        p1 = __builtin_amdgcn_mfma_f32_32x32x16_bf16(b1, qr[d0], p1, 0, 0, 0); }
}
__device__ __forceinline__ int v_st(int k, int c) { const int kk = (k & ~0xC) | ((k & 4) << 1) | ((k & 8) >> 1); return ((kk >> 3) * 4 + (c >> 5)) * 512 + ((kk & 7) * 32 + (c & 31)) * 2; }
__device__ __forceinline__ int v_rd_base(int lane) { return ((lane & 3) << 3) | (((lane >> 2) & 3) << 6) | (((lane >> 4) & 1) << 5) | (((lane >> 5) & 1) << 8); }
constexpr int v_rd_off(int d0, int ks, int half) { return d0 * 512 + ks * 4096 + half * 2048; }
template <int OFF> __device__ __forceinline__ s16x4 tr_read(int vb) { s16x4 r; asm volatile("ds_read_b64_tr_b16 %0, %1 offset:%2" : "=&v"(r) : "v"(vb), "i"(OFF) : "memory"); return r; }
template <int D0> __device__ __forceinline__ void pv_one(f32x16& od, int vb, bf16x8 pa0, bf16x8 pa1, bf16x8 pa2, bf16x8 pa3) {
    const s16x4 l0 = tr_read<v_rd_off(D0, 0, 0)>(vb), h0 = tr_read<v_rd_off(D0, 0, 1)>(vb), l1 = tr_read<v_rd_off(D0, 1, 0)>(vb), h1 = tr_read<v_rd_off(D0, 1, 1)>(vb);
    const s16x4 l2 = tr_read<v_rd_off(D0, 2, 0)>(vb), h2 = tr_read<v_rd_off(D0, 2, 1)>(vb), l3 = tr_read<v_rd_off(D0, 3, 0)>(vb), h3 = tr_read<v_rd_off(D0, 3, 1)>(vb);
    asm volatile("s_waitcnt lgkmcnt(0)" ::: "memory"); DA_SBAR();
#define DA_PK(L, H) (bf16x8){L[0], L[1], L[2], L[3], H[0], H[1], H[2], H[3]}
    od = __builtin_amdgcn_mfma_f32_32x32x16_bf16(pa0, DA_PK(l0, h0), od, 0, 0, 0);
    od = __builtin_amdgcn_mfma_f32_32x32x16_bf16(pa1, DA_PK(l1, h1), od, 0, 0, 0);
    od = __builtin_amdgcn_mfma_f32_32x32x16_bf16(pa2, DA_PK(l2, h2), od, 0, 0, 0);
    od = __builtin_amdgcn_mfma_f32_32x32x16_bf16(pa3, DA_PK(l3, h3), od, 0, 0, 0);
#undef DA_PK
}
__device__ __forceinline__ void pv_d0(f32x16* o, int vb, bf16x8 pa0, bf16x8 pa1, bf16x8 pa2, bf16x8 pa3) {
    pv_one<0>(o[0], vb, pa0, pa1, pa2, pa3); pv_one<1>(o[1], vb, pa0, pa1, pa2, pa3); pv_one<2>(o[2], vb, pa0, pa1, pa2, pa3); pv_one<3>(o[3], vb, pa0, pa1, pa2, pa3);
}

#define DA_PKV(L, H) (bf16x8){L[0], L[1], L[2], L[3], H[0], H[1], H[2], H[3]}
#define DA_TRSET(D0, l0, h0, l1, h1, l2, h2, l3, h3) do { if (VAR == 3) { l0 = h0 = l1 = h1 = l2 = h2 = l3 = h3 = (s16x4){1, 2, 3, 4}; break; } l0 = tr_read<v_rd_off(D0, 0, 0)>(vb); h0 = tr_read<v_rd_off(D0, 0, 1)>(vb); l1 = tr_read<v_rd_off(D0, 1, 0)>(vb); h1 = tr_read<v_rd_off(D0, 1, 1)>(vb); \
    l2 = tr_read<v_rd_off(D0, 2, 0)>(vb); h2 = tr_read<v_rd_off(D0, 2, 1)>(vb); l3 = tr_read<v_rd_off(D0, 3, 0)>(vb); h3 = tr_read<v_rd_off(D0, 3, 1)>(vb); } while (0)
#define DA_EX2(P, I) do { if (VAR != 1) { P[I] = __builtin_amdgcn_exp2f(P[I]); P[I + 1] = __builtin_amdgcn_exp2f(P[I + 1]); } } while (0)
#define DA_MF(OD, A, B) do { if (VAR != 2) OD = __builtin_amdgcn_mfma_f32_32x32x16_bf16(A, B, OD, 0, 0, 0); else asm volatile("" :: "v"(B)); } while (0)
#define DA_BLK(OD, PA0, PA1, PA2, PA3, l0, h0, l1, h1, l2, h2, l3, h3, P, I) do { \
    DA_MF(OD, PA0, DA_PKV(l0, h0)); DA_EX2(P, I);     DA_SBAR(); \
    DA_MF(OD, PA1, DA_PKV(l1, h1)); DA_EX2(P, I + 2); DA_SBAR(); \
    DA_MF(OD, PA2, DA_PKV(l2, h2)); DA_EX2(P, I + 4); DA_SBAR(); \
    DA_MF(OD, PA3, DA_PKV(l3, h3)); DA_EX2(P, I + 6); DA_SBAR(); } while (0)
template <int VAR>
__device__ __forceinline__ void pv_fast(f32x16* o, int vb, bf16x8 pa0, bf16x8 pa1, bf16x8 pa2, bf16x8 pa3, f32x16& n0, f32x16& n1, float& l_reg) {
    s16x4 al0, ah0, al1, ah1, al2, ah2, al3, ah3, bl0, bh0, bl1, bh1, bl2, bh2, bl3, bh3;
    DA_TRSET(0, al0, ah0, al1, ah1, al2, ah2, al3, ah3);
    asm volatile("s_waitcnt lgkmcnt(0)" ::: "memory"); DA_SBAR();
    DA_TRSET(1, bl0, bh0, bl1, bh1, bl2, bh2, bl3, bh3); DA_SBAR();
    DA_BLK(o[0], pa0, pa1, pa2, pa3, al0, ah0, al1, ah1, al2, ah2, al3, ah3, n0, 0);
    asm volatile("s_waitcnt lgkmcnt(0)" ::: "memory"); DA_SBAR();
    DA_TRSET(2, al0, ah0, al1, ah1, al2, ah2, al3, ah3); DA_SBAR();
    DA_BLK(o[1], pa0, pa1, pa2, pa3, bl0, bh0, bl1, bh1, bl2, bh2, bl3, bh3, n0, 8);
    asm volatile("s_waitcnt lgkmcnt(0)" ::: "memory"); DA_SBAR();
    DA_TRSET(3, bl0, bh0, bl1, bh1, bl2, bh2, bl3, bh3); DA_SBAR();
    DA_BLK(o[2], pa0, pa1, pa2, pa3, al0, ah0, al1, ah1, al2, ah2, al3, ah3, n1, 0);
    asm volatile("s_waitcnt lgkmcnt(0)" ::: "memory"); DA_SBAR();
    DA_BLK(o[3], pa0, pa1, pa2, pa3, bl0, bh0, bl1, bh1, bl2, bh2, bl3, bh3, n1, 8);
    float ps = 0;
#pragma unroll
    for (int r = 0; r < 16; ++r) ps += n0[r];
#pragma unroll
    for (int r = 0; r < 16; ++r) ps += n1[r];
    l_reg += ps;
}
template <bool FAST, int VAR = 0>
__device__ __forceinline__ bool attn_unit(LAS char* lds, const bf16_t* proj, bf16_t* cat, int h, int qrow0, int nkeys, float lam, float oscale, const float* subln) {
    constexpr int LD = DA_IN;
    const int tid = opaque((int)threadIdx.x), wid = __builtin_amdgcn_readfirstlane(tid >> 6), lane = tid & 63, r32 = lane & 31, hi = lane >> 5, comp = wid >> 2, qw = wid & 3;
    LAS char* V_lds = lds; LAS char* K_lds = lds + 2 * SHM_V;
    LAS float* ws = (LAS float*)(lds + 2 * SHM_V + 2 * SHM_K) + wid * 64; LAS float* li_l = ws; LAS float* al_l = ws + 32;
    float m_reg = -1e30f, l_reg = 0; f32x16 o[4] = {}; bf16x8 qr[4];
    const bf16_t* Qw = proj + (size_t)(qrow0 + qw * 32 + r32) * LD + h * 128 + comp * 64 + hi * 8;
#pragma unroll
    for (int d0 = 0; d0 < 4; ++d0) qr[d0] = *reinterpret_cast<const bf16x8*>(Qw + d0 * 16);
    const bf16_t* Kh = proj + 1024 + h * 128; const bf16_t* Vh = proj + 2048 + h * 128;
    const int sr = tid >> 4, sc = (tid & 15) * 8, vst0 = v_st(sr, sc), vst1 = v_st(32 + sr, sc);
    const int vb0 = (int)(unsigned)(uintptr_t)V_lds + v_rd_base(lane);
    struct { bf16x8 vs0, vs1, ks0, ks1; } sr_[2];
#define DA_SLOAD(i, k0) do { if (VAR == 4) break; sr_[i].vs0 = *(const bf16x8*)(&Vh[(size_t)((k0) + sr) * LD + sc]); sr_[i].vs1 = *(const bf16x8*)(&Vh[(size_t)((k0) + 32 + sr) * LD + sc]); \
    sr_[i].ks0 = *(const bf16x8*)(&Kh[(size_t)((k0) + sr) * LD + sc]); sr_[i].ks1 = *(const bf16x8*)(&Kh[(size_t)((k0) + 32 + sr) * LD + sc]); } while (0)
#define DA_SWRITE(b, i) do { if (VAR == 4) break; *(LAS bf16x8*)(V_lds + (b) * SHM_V + vst0) = sr_[i].vs0; *(LAS bf16x8*)(V_lds + (b) * SHM_V + vst1) = sr_[i].vs1; const int kc = sc * 2; \
    *(LAS bf16x8*)(K_lds + (b) * SHM_K + DA_KSWZ(sr, kc)) = sr_[i].ks0; *(LAS bf16x8*)(K_lds + (b) * SHM_K + DA_KSWZ(32 + sr, kc)) = sr_[i].ks1; } while (0)
#define DA_SWAIT() asm volatile("s_waitcnt vmcnt(4)" ::: "memory")
#define DA_RESC(a) do { if (__any((a) < 1.f)) { if (hi == 0) al_l[r32] = (a); asm volatile("s_waitcnt lgkmcnt(0)" ::: "memory"); \
    _Pragma("unroll") for (int d = 0; d < 4; ++d) _Pragma("unroll") for (int r = 0; r < 16; ++r) o[d][r] *= al_l[crow(r, hi)]; } } while (0)
    f32x16 pA0, pA1, pB0, pB1; float alA, alB; bf16x8 pa0, pa1, pa2, pa3; const int NT = nkeys / KVBLK;
#define DA_PSM(P0, P1, AL) do { if (FAST) { partialSM_fast(P0, P1, l_reg); AL = 1.f; } else partialSM(P0, P1, m_reg, AL); } while (0)
#define DA_PVS(VB, P0, P1, AL) do { if (FAST) { pv_fast<VAR>(o, VB, pa0, pa1, pa2, pa3, P0, P1, l_reg); AL = 1.f; } else { pv_d0(o, VB, pa0, pa1, pa2, pa3); partialSM(P0, P1, m_reg, AL); } } while (0)
#define DA_FSM(P0, P1, AL) do { if (FAST) finishSM_fast(P0, P1, pa0, pa1, pa2, pa3); else finishSM(P0, P1, AL, l_reg, pa0, pa1, pa2, pa3); } while (0)
#define DA_RESCX(a) do { if (!FAST) { DA_RESC(a); } } while (0)
    DA_SLOAD(0, 0); asm volatile("s_waitcnt vmcnt(0)" ::: "memory"); DA_SWRITE(0, 0); __syncthreads();
    qkt(pA0, pA1, K_lds, qr, r32, hi, comp); DA_PSM(pA0, pA1, alA);
    DA_SLOAD(1, KVBLK); if (2 < NT) DA_SLOAD(0, 2 * KVBLK);
    DA_SWAIT(); DA_SWRITE(1, 1); __syncthreads();
#define DA_SYNC() do { if (VAR != 5) __syncthreads(); } while (0)
#define DA_QKT(P0, P1, KS) do { if (VAR != 6) qkt(P0, P1, KS, qr, r32, hi, comp); else { P0 = f32x16{}; P1 = f32x16{}; } } while (0)
    for (int j = 1; j + 1 < NT; j += 2) {
        DA_SBAR(); DA_QKT(pB0, pB1, K_lds + SHM_K);
        DA_FSM(pA0, pA1, alA); DA_SBAR();
        DA_SLOAD(1, (j + 2) * KVBLK); DA_SBAR();
        DA_PVS(vb0, pB0, pB1, alB);
        DA_SYNC(); DA_SWAIT(); DA_SWRITE(0, 0);
        DA_RESCX(alB); DA_SYNC();
        DA_SBAR(); DA_QKT(pA0, pA1, K_lds);
        DA_FSM(pB0, pB1, alB); DA_SBAR();
        { const int tn = (j + 3 < NT) ? (j + 3) : (NT - 1); DA_SLOAD(0, tn * KVBLK); } DA_SBAR();
        DA_PVS(vb0 + SHM_V, pA0, pA1, alA);
        DA_SYNC(); DA_SWAIT(); DA_SWRITE(1, 1);
        DA_RESCX(alA); DA_SYNC();
    }
    DA_SBAR(); qkt(pB0, pB1, K_lds + SHM_K, qr, r32, hi, comp);
    DA_FSM(pA0, pA1, alA); DA_SBAR();
    DA_PVS(vb0, pB0, pB1, alB);
    __syncthreads(); DA_RESCX(alB);
    DA_FSM(pB0, pB1, alB); DA_SBAR();
    pv_d0(o, vb0 + SHM_V, pa0, pa1, pa2, pa3);
#undef DA_PSM
#undef DA_FSM
#undef DA_PVS
#undef DA_SYNC
#undef DA_QKT
    if (FAST) { auto rr = __builtin_amdgcn_permlane32_swap(__float_as_uint(l_reg), __float_as_uint(l_reg), false, false); l_reg = __uint_as_float(rr[0]) + __uint_as_float(rr[1]); }
#undef DA_RESCX
    if (hi == 0) li_l[r32] = l_reg; asm volatile("s_waitcnt lgkmcnt(0)" ::: "memory");
    float rli[16];
#pragma unroll
    for (int r = 0; r < 16; ++r) rli[r] = __builtin_amdgcn_rcpf(li_l[crow(r, hi)]);
#pragma unroll
    for (int d0 = 0; d0 < 4; ++d0)
#pragma unroll
        for (int r = 0; r < 16; ++r) o[d0][r] *= rli[r];
    {   const int bad = (l_reg > 1.0e-30f && l_reg < 1.0e30f) ? 0 : 1;
        (void)bad; __syncthreads(); }
    LAS float* xb = (LAS float*)lds;
    if (comp == 1) {
#pragma unroll
        for (int d0 = 0; d0 < 4; ++d0)
#pragma unroll
            for (int r = 0; r < 16; ++r) xb[((qw * 64) + d0 * 16 + r) * 64 + lane] = o[d0][r];
    }
    __syncthreads();
    if (comp == 0) {
        float ssq[16];
#pragma unroll
        for (int r = 0; r < 16; ++r) ssq[r] = 0.f;
#pragma unroll
        for (int d0 = 0; d0 < 4; ++d0)
#pragma unroll
            for (int r = 0; r < 16; ++r) { const float x = o[d0][r] - lam * xb[((qw * 64) + d0 * 16 + r) * 64 + lane]; o[d0][r] = x; ssq[r] += x * x; }
#pragma unroll
        for (int r = 0; r < 16; ++r) {
#pragma unroll
            for (int off = 16; off >= 1; off >>= 1) ssq[r] += __shfl_xor(ssq[r], off);
            ssq[r] = rsqrtf(ssq[r] * (1.0f / 128.f) + 1e-5f) * oscale; }
        asm volatile("" ::: "memory");
        LAS char* stg = lds + qw * 16384;
#pragma unroll
        for (int d0 = 0; d0 < 4; ++d0) { const float g = subln[d0 * 32 + r32];
#pragma unroll
            for (int r = 0; r < 16; ++r) *(LAS bf16_t*)(stg + crow(r, hi) * 272 + (d0 * 32 + r32) * 2) = f2bf(o[d0][r] * ssq[r] * g); }
        asm volatile("s_waitcnt lgkmcnt(0)" ::: "memory");
        bf16_t* Ow = cat + (size_t)(qrow0 + qw * 32) * DA_W + h * 128;
#pragma unroll
        for (int q = 0; q < 8; ++q) { const int id = q * 64 + lane, row = id >> 4, c16 = id & 15; *(u32x4*)(Ow + (size_t)row * DA_W + c16 * 8) = *(const LAS u32x4*)(stg + row * 272 + c16 * 16); }
    }
    __syncthreads();
    return true;
#undef DA_SLOAD
#undef DA_SWRITE
#undef DA_SWAIT
#undef DA_RESC
}
}

__device__ __forceinline__ void phase_attn(const Ctx& c, int jj, bool with_ctx) {
    PREF P = *c.p; const bf16_t* proj = (const bf16_t*)(c.ws + WS_PROJ); bf16_t* cat = (bf16_t*)(c.ws + WS_CAT);
    const float lam = ((const float*)(c.ws + WS_MISC))[jj * 2 + 0], linit = ((const float*)(c.ws + WS_MISC))[jj * 2 + 1];
    const float* subln = P.in[24] + (size_t)jj * 128;
    const int nunits = 1024 + (with_ctx ? 16 : 0);
    unsigned failed = 0u; int it = 0;
#pragma unroll 1
    for (int L = c.bid; L < nunits; L += c.G, ++it) {
        int h, q0, nk;
        if (L < 1024) { h = L & 7; q0 = NC + (L >> 3) * 128; nk = NTOK; } else { const int i = L - 1024; h = i & 7; q0 = (i >> 3) * 128; nk = NC; }
        if (!da2::attn_unit_dma((LAS char*)c.lds, proj, cat, h, q0, nk, lam, 1.0f - linit, subln)) failed |= 1u << (it & 31);
    }
    failed = (unsigned)__builtin_amdgcn_readfirstlane((int)failed);
    if (failed) {
        it = 0;
#pragma unroll 1
        for (int L = c.bid; L < nunits; L += c.G, ++it) {
            if (!((failed >> (it & 31)) & 1u)) continue;
            int h, q0, nk;
            if (L < 1024) { h = L & 7; q0 = NC + (L >> 3) * 128; nk = NTOK; } else { const int i = L - 1024; h = i & 7; q0 = (i >> 3) * 128; nk = NC; }
            (void)da::attn_unit<false>((LAS char*)c.lds, proj, cat, h, q0, nk, lam, 1.0f - linit, subln);
        }
    }
}
__device__ __forceinline__ MoeTable moe_table(const Ctx& c, int layer, int ntok_l) {
    LAS int* tb = (LAS int*)(c.lds + LDS_MISC + 64); LAS int* cn = (LAS int*)(c.lds + LDS_MISC + 512);
    const unsigned* cg = (const unsigned*)(c.ws + WS_CTL) + CW_CNT + c.cnt_off + layer * 64;
    __syncthreads();
    if (c.tid == 0) { int t = 0;
        for (int e = 0; e < 65; ++e) { const int n = (e < 64) ? (int)cg[e] : ntok_l; cn[e] = n; tb[e] = t; t += (n + 255) >> 8; }
        tb[65] = t; }
    __syncthreads();
    MoeTable r; r.tb = tb; r.cn = cn; return r;
}

__device__ __forceinline__ void phase_p6(const Ctx& c, int layer, int tok0) {
    PREF P = *c.p; unsigned char* ws = c.ws; const int tid = c.tid, lane = c.lane, w = c.wid;
#ifndef DUP_CVT
#define DUP_CVT 1
#endif
#ifndef PROBE_SKIP
#define PROBE_SKIP 0
#endif
    if (!((PROBE_SKIP & 1) && c.pass == 0))
    _Pragma("unroll 1") for (int rep_ = 0; rep_ < DUP_CVT; ++rep_) {
        const float* wg = P.in[27] + (size_t)layer * 64 * 1024 * 256; const float* wu = P.in[28] + (size_t)layer * 64 * 1024 * 256; const float* wd = P.in[29] + (size_t)layer * 64 * 256 * 1024;
        const float* sg = P.in[30] + (size_t)layer * 1024 * 256; const float* su = P.in[31] + (size_t)layer * 1024 * 256; const float* sd = P.in[32] + (size_t)layer * 256 * 1024;
        bf16_t* WGU = (bf16_t*)(ws + WS_WGU); bf16_t* WD = (bf16_t*)(ws + WS_WD);
        const int NT_ = 65 * 192;
        for (int u = c.bid; u < NT_; u += c.G) {
            const int e = u / 192, r = u % 192, kind = r >> 6, q = r & 63;
            if (kind == 0) { const float* src = (e < 64) ? wg + (size_t)e * 1024 * 256 : sg; cvt_tile(c, src, 256, (q >> 2) * 64, (q & 3) * 64, WGU + (size_t)e * 512 * 1024, 1024, RowGate()); }
            else if (kind == 1) { const float* src = (e < 64) ? wu + (size_t)e * 1024 * 256 : su; cvt_tile(c, src, 256, (q >> 2) * 64, (q & 3) * 64, WGU + (size_t)e * 512 * 1024, 1024, RowUp()); }
            else { const float* src = (e < 64) ? wd + (size_t)e * 256 * 1024 : sd; cvt_tile(c, src, 1024, (q >> 4) * 64, (q & 15) * 64, WD + (size_t)e * 1024 * 256, 256, RowDown()); }
        }
    }
    __syncthreads();
    if ((PROBE_SKIP & 2) && c.pass == 0) return;
    const int ntok_l = NTOK - tok0, tpb = (ntok_l + c.G - 1) / c.G;
    const int tb0 = tok0 + c.bid * tpb, tb1 = (tb0 + tpb < NTOK) ? tb0 + tpb : NTOK; const int nloc = (tb1 > tb0) ? tb1 - tb0 : 0;
    LAS float* lg = (LAS float*)c.lds;
    LAS int* che = (LAS int*)(c.lds + 40960); LAS float* chw = (LAS float*)(c.lds + 46080);
    LAS int* cntl = (LAS int*)(c.lds + 51200); LAS int* basel = (LAS int*)(c.lds + 51456);
    if (tid < 64) cntl[tid] = 0;
    const float* xres = (const float*)(ws + WS_XRES); bf16_t* hB = (bf16_t*)(ws + WS_H); bf16_t* hL = (bf16_t*)(ws + WS_HLO);
    const float* gain = P.in[7] + (size_t)layer * D; const float* modl = (const float*)(ws + WS_MOD) + (size_t)layer * 2 * 6144;
    const bf16_t* wrh = (const bf16_t*)(ws + WS_WR) + (size_t)(layer * 2 + 0) * 64 * 1024; const bf16_t* wrl = wrh + 64 * 1024;
    const float* rbias = P.in[26] + (size_t)layer * 64;
#ifndef DUP_TOK
#define DUP_TOK 1
#endif
    _Pragma("unroll 1") for (int rept_ = 0; rept_ < DUP_TOK; ++rept_) {
#pragma unroll 1
    for (int tl0 = w * 2; tl0 < nloc; tl0 += 16) {
        f32x4 v[2][4]; float ss[2];
#pragma unroll
        for (int t = 0; t < 2; ++t) { const int tl = (tl0 + t < nloc) ? tl0 + t : nloc - 1; const float* x = xres + (size_t)(tb0 + tl) * D; ss[t] = 0.f;
#pragma unroll
            for (int q = 0; q < 4; ++q) { v[t][q] = *(const f32x4*)(x + q * 256 + lane * 4); ss[t] += v[t][q][0] * v[t][q][0] + v[t][q][1] * v[t][q][1] + v[t][q][2] * v[t][q][2] + v[t][q][3] * v[t][q][3]; } }
        ss[0] = wave_sum(ss[0]); ss[1] = wave_sum(ss[1]);
#pragma unroll
        for (int t = 0; t < 2; ++t) { if (tl0 + t < nloc) { const int row = tb0 + tl0 + t; const float* m = modl + ((row < NC) ? 6144 : 0); const float rstd = rsqrtf(ss[t] * (1.0f / 1024.f) + EPS);
#pragma unroll
            for (int q = 0; q < 4; ++q) { const int col = q * 256 + lane * 4;
                const f32x4 g = *(const f32x4*)(gain + col), sc = *(const f32x4*)(m + 4 * 1024 + col), sh = *(const f32x4*)(m + 3 * 1024 + col);
                float o[4], lo_[4];
#pragma unroll
                for (int k = 0; k < 4; ++k) { o[k] = v[t][q][k] * rstd * g[k] * (1.0f + sc[k]) + sh[k]; lo_[k] = o[k] - bf2f(f2bf(o[k])); }
                u32x2 wv; wv.x = cvtpk(o[0], o[1]); wv.y = cvtpk(o[2], o[3]);
                *(u32x2*)(hB + (size_t)row * D + col) = wv;
                u32x2 wl; wl.x = cvtpk(lo_[0], lo_[1]); wl.y = cvtpk(lo_[2], lo_[3]);
                *(u32x2*)(hL + (size_t)row * D + col) = wl; } } }
    }
    asm volatile("s_waitcnt vmcnt(0)" ::: "memory");
    __syncthreads();
    {   const int et = w & 3, kh = w >> 2, fr = lane & 15, fq = lane >> 4; const int nmt = (nloc + 15) >> 4;
        f32x4 acc[5];
#pragma unroll
        for (int mt = 0; mt < 5; ++mt) acc[mt] = (f32x4){0.f, 0.f, 0.f, 0.f};
        const bf16_t* bh = wrh + (size_t)(et * 16 + fr) * 1024 + kh * 512 + fq * 8; const bf16_t* bl = wrl + (size_t)(et * 16 + fr) * 1024 + kh * 512 + fq * 8;
        size_t arow[5];
#pragma unroll
        for (int mt = 0; mt < 5; ++mt) { int tl = mt * 16 + fr; tl = (tl < nloc) ? tl : (nloc > 0 ? nloc - 1 : 0); arow[mt] = (size_t)(tb0 + tl) * D + kh * 512 + fq * 8; }
#pragma unroll 2
        for (int ks = 0; ks < 16; ++ks) {
            const bf16x8 vbh = *(const bf16x8*)(bh + ks * 32), vbl = *(const bf16x8*)(bl + ks * 32);
#pragma unroll
            for (int mt = 0; mt < 5; ++mt) { if (mt < nmt) {
                const bf16x8 ah = *(const bf16x8*)(hB + arow[mt] + ks * 32), al = *(const bf16x8*)(hL + arow[mt] + ks * 32);
                acc[mt] = __builtin_amdgcn_mfma_f32_16x16x32_bf16(ah, vbh, acc[mt], 0, 0, 0);
                acc[mt] = __builtin_amdgcn_mfma_f32_16x16x32_bf16(ah, vbl, acc[mt], 0, 0, 0);
                acc[mt] = __builtin_amdgcn_mfma_f32_16x16x32_bf16(al, vbh, acc[mt], 0, 0, 0); } } }
#pragma unroll
        for (int mt = 0; mt < 5; ++mt)
#pragma unroll
            for (int r = 0; r < 4; ++r) lg[(kh * 80 + mt * 16 + fq * 4 + r) * 64 + et * 16 + fr] = acc[mt][r];
    }
    __syncthreads();
    }
#pragma unroll 1
    for (int tl = w; tl < nloc; tl += 8) {
        const float logit = lg[tl * 64 + lane] + lg[(80 + tl) * 64 + lane];
        const float score = sigmoidf_(logit), choice = score + rbias[lane];
        float m1 = choice;
#pragma unroll
        for (int off = 1; off <= 4; off <<= 1) m1 = fmaxf(m1, __shfl_xor(m1, off));
        const unsigned long long bm = __ballot(choice == m1); const unsigned gb = (unsigned)(bm >> (lane & 56)) & 0xffu;
        const bool isfirst = ((lane & 7) == (__builtin_ctz(gb) & 7));
        float m2 = isfirst ? -INFINITY : choice;
#pragma unroll
        for (int off = 1; off <= 4; off <<= 1) m2 = fmaxf(m2, __shfl_xor(m2, off));
        const float gs = m1 + m2; const int g = lane >> 3; int grank = 0;
#pragma unroll
        for (int g2 = 0; g2 < 8; ++g2) { const float o = __shfl(gs, g2 * 8); grank += (o > gs || (o == gs && g2 < g)) ? 1 : 0; }
        const bool gsel = grank < 4; const float mc = gsel ? choice : -INFINITY; int erank = 0;
#pragma unroll 8
        for (int e2 = 0; e2 < 64; ++e2) { const float o = __shfl(mc, e2); erank += (o > mc || (o == mc && e2 < lane)) ? 1 : 0; }
        const bool sel = gsel && erank < 8;
        const float sw = wave_sum(sel ? score : 0.f);
        if (sel) { che[tl * 8 + erank] = lane; chw[tl * 8 + erank] = score / (sw + 1e-20f) * 2.5f; atomicAdd((int*)&cntl[lane], 1); }
    }
    __syncthreads();
    if (tid < 64) { const int n = cntl[tid]; unsigned* cg = (unsigned*)(ws + WS_CTL) + CW_CNT + c.cnt_off + layer * 64;
        basel[tid] = n ? (int)__hip_atomic_fetch_add(cg + tid, (unsigned)n, __ATOMIC_RELAXED, __HIP_MEMORY_SCOPE_AGENT) : 0; cntl[tid] = 0; }
    __syncthreads();
    int* ltok = (int*)(ws + WS_LTOK); float* lw = (float*)(ws + WS_LW); int* slot = (int*)(ws + WS_SLOT);
    for (int idx = tid; idx < nloc * 8; idx += NTHREADS) { const int tl = idx >> 3, e = che[idx]; const int pos = basel[e] + atomicAdd((int*)&cntl[e], 1);
        ltok[(size_t)e * NTOK + pos] = tb0 + tl; lw[(size_t)e * NTOK + pos] = chw[idx]; slot[(size_t)(tb0 + tl) * 8 + (idx & 7)] = (e << 20) | pos; }
    __syncthreads();
}

__device__ __forceinline__ void phase_p9(const Ctx& c, int layer, int tok0, const MoeTable& t) {
    PREF P = *c.p; unsigned char* ws = c.ws; const int lane = c.lane;
    float* xres = (float*)(ws + WS_XRES); const unsigned char* Y = (const unsigned char*)(ws + WS_YSLOT); const int* slot = (const int*)(ws + WS_SLOT);
    const float* modl = (const float*)(ws + WS_MOD) + (size_t)layer * 2 * 6144;
    const bool fin = (layer == DEPTH - 1);
    const float* gain = fin ? P.in[33] : P.in[6] + (size_t)(layer + 1) * D; const float* modn = (const float*)(ws + WS_MOD) + (size_t)(layer + 1) * 2 * 6144;
    bf16_t* hA = (bf16_t*)(ws + WS_H);
    const size_t shrow0 = (size_t)t.tb[64] * 256;
    const int col0 = lane * 16;
    for (int row = tok0 + c.bid * 8 + c.wid; row < NTOK; row += c.G * 8) {
        const int sl = (lane < 8) ? slot[(size_t)row * 8 + lane] : 0;
        float acc[16];
#pragma unroll
        for (int k = 0; k < 16; ++k) acc[k] = 0.f;
        u32x4 yv[9];
#pragma unroll
        for (int k = 0; k < 9; ++k) { size_t yr;
            if (k < 8) { const int s = __shfl(sl, k); yr = (size_t)t.tb[s >> 20] * 256 + (s & 0xfffff); } else yr = shrow0 + (size_t)(row - tok0);
            yv[k] = *(const u32x4*)(Y + yr * 1024 + col0); }
#pragma unroll
        for (int k = 0; k < 9; ++k) { const unsigned w4[4] = {yv[k].x, yv[k].y, yv[k].z, yv[k].w};
#pragma unroll
            for (int q = 0; q < 4; ++q) { const f32x2 a = __builtin_amdgcn_cvt_pk_f32_fp8((int)w4[q], false), b = __builtin_amdgcn_cvt_pk_f32_fp8((int)w4[q], true);
                acc[q * 4 + 0] += a[0]; acc[q * 4 + 1] += a[1]; acc[q * 4 + 2] += b[0]; acc[q * 4 + 3] += b[1]; } }
        const float* m = modl + ((row < NC) ? 6144 : 0) + 5 * 1024; float* x = xres + (size_t)row * D; float xn[16]; float ss = 0.f;
#pragma unroll
        for (int q = 0; q < 4; ++q) { const int col = col0 + q * 4; const f32x4 xv = *(const f32x4*)(x + col), g = *(const f32x4*)(m + col); f32x4 o;
#pragma unroll
            for (int k = 0; k < 4; ++k) { o[k] = xv[k] + g[k] * acc[q * 4 + k]; xn[q * 4 + k] = o[k]; ss += o[k] * o[k]; }
            *(f32x4*)(x + col) = o; }
        ss = wave_sum(ss); const float rstd = rsqrtf(ss * (1.0f / 1024.f) + EPS);
        if (fin) {
            float* out = P.out + (size_t)(row - NC) * D;
#pragma unroll
            for (int q = 0; q < 4; ++q) { const int col = col0 + q * 4; const f32x4 g = *(const f32x4*)(gain + col); f32x4 o;
#pragma unroll
                for (int k = 0; k < 4; ++k) o[k] = xn[q * 4 + k] * rstd * g[k];
                *(f32x4*)(out + col) = o; }
        } else {
            const float* mn = modn + ((row < NC) ? 6144 : 0); float o[16];
#pragma unroll
            for (int q = 0; q < 4; ++q) { const int col = col0 + q * 4; const f32x4 g = *(const f32x4*)(gain + col), sc = *(const f32x4*)(mn + 1024 + col), sh = *(const f32x4*)(mn + col);
#pragma unroll
                for (int k = 0; k < 4; ++k) o[q * 4 + k] = xn[q * 4 + k] * rstd * g[k] * (1.0f + sc[k]) + sh[k]; }
            u32x4 w0, w1; w0.x = cvtpk(o[0], o[1]); w0.y = cvtpk(o[2], o[3]); w0.z = cvtpk(o[4], o[5]); w0.w = cvtpk(o[6], o[7]);
            w1.x = cvtpk(o[8], o[9]); w1.y = cvtpk(o[10], o[11]); w1.z = cvtpk(o[12], o[13]); w1.w = cvtpk(o[14], o[15]);
            *(u32x4*)(hA + (size_t)row * D + col0) = w0; *(u32x4*)(hA + (size_t)row * D + col0 + 8) = w1;
        }
    }
}
#ifndef DUP_INPROJ
#define DUP_INPROJ 1
#endif
#ifndef DUP_ATTN
#define DUP_ATTN 1
#endif
#ifndef DUP_UP
#define DUP_UP 1
#endif
#ifndef DUP_DOWN
#define DUP_DOWN 1
#endif
#ifndef DUP_F
#define DUP_F 1
#endif
#ifndef DUP_HYCONV
#define DUP_HYCONV 1
#endif
#ifndef DUP_R1
#define DUP_R1 1
#endif
#ifndef DUP_R3
#define DUP_R3 1
#endif
#ifndef DUP_MISC
#define DUP_MISC 1
#endif
#ifndef DUP_PR
#define DUP_PR 1
#endif
#ifndef DUP_CVT
#define DUP_CVT 1
#endif
#define REPEAT(n) _Pragma("unroll 1") for (int rep_ = 0; rep_ < (n); ++rep_)
constexpr int NPHASE = 38;
__global__ void __launch_bounds__(NTHREADS, 2) fwd_kernel(Params prm) {
    extern __shared__ __attribute__((aligned(16))) unsigned char lds_raw[];
    const KParams kp0 = (KParams)__builtin_amdgcn_kernarg_segment_ptr();
    Ctx c; c.p = kp0; c.lds = (LAS unsigned char*)lds_raw; c.tid = threadIdx.x; c.lane = c.tid & 63; c.wid = __builtin_amdgcn_readfirstlane(c.tid >> 6); c.G = gridDim.x; c.bid = blockIdx.x; c.ws = kp0->ws;
    volatile LAS unsigned* misc = (volatile LAS unsigned*)(c.lds + LDS_MISC);
    if (c.tid < 4) misc[c.tid] = 0u;
    __syncthreads();
#ifdef PROBE_STOP
    const int lo = 0; int hi = PROBE_STOP; int cnt_off = 256;
#else
    const int lo = kp0->ph_lo, hi = kp0->ph_hi; const int cnt_off = 0;
#endif
    XcdBarrier bar; bar.bar = (unsigned*)(c.ws + WS_CTL) + CW_BAR; bar.x = 0; bar.st = misc;
    if (kp0->ph_hi - kp0->ph_lo > 1) bar = xcd_barrier_post((unsigned*)(c.ws + WS_CTL) + CW_BAR, misc);
#define IN(k) ((lo <= (k) && (k) < hi) && ((c.tid = opaque((int)threadIdx.x)), (c.lane = c.tid & 63), (c.wid = __builtin_amdgcn_readfirstlane(c.tid >> 6)), (c.p = opaque_kp(kp0)), (c.ws = c.p->ws), (ws = c.ws), (c.G = opaque_s((int)gridDim.x)), (c.bid = opaque_s((int)blockIdx.x)), true))
#define SEAM(k) do { if ((lo <= (k)) && ((k) + 1 < hi)) { bar.bar = (unsigned*)(opaque_kp(kp0)->ws + WS_CTL) + CW_BAR; xcd_barrier(bar); } } while (0)
    unsigned char* ws = c.ws;
#ifdef PROBE_STOP
#pragma unroll 1
    for (int pass = 0; pass < 2; ++pass) {
    if (pass == 1) { xcd_barrier(bar); hi = NPHASE; cnt_off = 0; }
#endif
    c.cnt_off = cnt_off;
#ifdef PROBE_STOP
    c.pass = pass;
#else
    c.pass = 1;
#endif
    if (IN(0)) { REPEAT(DUP_PR) phase_pr0(c); } SEAM(0);
    if (IN(1)) { REPEAT(DUP_PR) phase_pr1(c); } SEAM(1);
#pragma unroll 1
    for (int jj = 0; jj < 2; ++jj) {
        const int pb = 2 + jj * 18;
        { const int layer = 2 * jj;
        if (IN(pb + 0)) { REPEAT(DUP_F) phase_f1(c, jj); } SEAM(pb + 0);
        if (IN(pb + 1)) { REPEAT(DUP_F) phase_f2(c); } SEAM(pb + 1);
        if (IN(pb + 2)) {
            DenseSched S; S.init(ws + WS_H, (const bf16_t*)(ws + WS_WAB_IN) + (size_t)jj * AB_IN * 1024, 1024, 65, 18, 0, c.G, c.bid);
            EpiAbIn E{(bf16_t*)(ws + WS_PROJ), (const f32x2*)(ws + WS_ROPE)};
            REPEAT(DUP_INPROJ) pg8::gemm_phase<EpiAbIn, DenseSched, false>(c.lds, 1024, S, E); } SEAM(pb + 2);
        if (IN(pb + 3)) { REPEAT(DUP_R1) phase_r1(c, jj); REPEAT(DUP_MISC) phase_hyprep(c, jj); } SEAM(pb + 3);
        if (IN(pb + 4)) { REPEAT(DUP_HYCONV) phase_hyconv(c, jj); REPEAT(DUP_MISC) phase_scan(c, jj); } SEAM(pb + 4);
        if (IN(pb + 5)) { REPEAT(DUP_R3) phase_r3(c, jj); REPEAT(DUP_MISC) { phase_hytrans(c); phase_hyctx(c, jj); } } SEAM(pb + 5);
        if (IN(pb + 6)) {
            DenseSched S; S.init(ws + WS_CAT, (const bf16_t*)(ws + WS_WAB_OUT) + (size_t)jj * 1024 * AB_CAT, AB_CAT, 65, 4, 0, c.G, c.bid);
            EpiResid E{(float*)(ws + WS_XRES), (const float*)(ws + WS_MOD) + (size_t)layer * 2 * 6144};
            pg8::gemm_phase<EpiResid, DenseSched, false>(c.lds, AB_CAT, S, E); } SEAM(pb + 6);
        if (IN(pb + 7)) { phase_p6(c, layer, 0); } SEAM(pb + 7);
        if (IN(pb + 8)) { const MoeTable t = moe_table(c, layer, NTOK);
            MoeUpSched S; S.t = t; S.H = (const char*)(ws + WS_H); S.W = (const char*)(ws + WS_WGU); S.ltok = (const int*)(ws + WS_LTOK); S.tok0 = 0; S.G = c.G; S.c = c.bid; S.nwg = t.tb[65] * 2;
            EpiSwiglu E{(bf16_t*)(ws + WS_ACT)};
            REPEAT(DUP_UP) pg8::gemm_phase<EpiSwiglu, MoeUpSched, true>(c.lds, 1024, S, E); } SEAM(pb + 8);
        if (IN(pb + 9)) { const MoeTable t = moe_table(c, layer, NTOK);
            MoeDownSched S; S.t = t; S.ACT = (const char*)(ws + WS_ACT); S.W = (const char*)(ws + WS_WD); S.G = c.G; S.c = c.bid; S.nwg = t.tb[65] * 4;
            EpiDown E{(unsigned char*)(ws + WS_YSLOT), (const float*)(ws + WS_LW), t, 0};
#ifdef PROBE_DOWN_NOEPI
            { EpiDown E0 = E; E0.skip = 1; pg8::gemm_phase<EpiDown, MoeDownSched, false>(c.lds, 256, S, E0); }
#endif
            REPEAT(DUP_DOWN) pg8::gemm_phase<EpiDown, MoeDownSched, false>(c.lds, 256, S, E); } SEAM(pb + 9);
        if (IN(pb + 10)) { const MoeTable t = moe_table(c, layer, NTOK); phase_p9(c, layer, 0, t); } SEAM(pb + 10);
        }
        { const int layer = 2 * jj + 1; const bool with_ctx = layer < DEPTH - 1; const int tok0 = with_ctx ? 0 : NC; const int pm0 = with_ctx ? 0 : 1;
        if (IN(pb + 11)) {
            DenseSched S; S.init(ws + WS_H, (const bf16_t*)(ws + WS_WDA_IN) + (size_t)jj * DA_IN * 1024, 1024, 65, 12, 0, c.G, c.bid);
            EpiDaIn E{(bf16_t*)(ws + WS_PROJ), (const f32x2*)(ws + WS_ROPE) + (256 * 32 + 64 * 32)};
            REPEAT(DUP_INPROJ) pg8::gemm_phase<EpiDaIn, DenseSched, false>(c.lds, 1024, S, E); } SEAM(pb + 11);
        if (IN(pb + 12)) { REPEAT(DUP_ATTN) phase_attn(c, jj, with_ctx); } SEAM(pb + 12);
        if (IN(pb + 13)) {
            DenseSched S; S.init(ws + WS_CAT, (const bf16_t*)(ws + WS_WDA_OUT) + (size_t)jj * 1024 * 1024, 1024, 65, 4, pm0, c.G, c.bid);
            EpiResid E{(float*)(ws + WS_XRES), (const float*)(ws + WS_MOD) + (size_t)layer * 2 * 6144};
            pg8::gemm_phase<EpiResid, DenseSched, false>(c.lds, 1024, S, E); } SEAM(pb + 13);
        if (IN(pb + 14)) { phase_p6(c, layer, tok0); } SEAM(pb + 14);
        if (IN(pb + 15)) { const MoeTable t = moe_table(c, layer, NTOK - tok0);
            MoeUpSched S; S.t = t; S.H = (const char*)(ws + WS_H); S.W = (const char*)(ws + WS_WGU); S.ltok = (const int*)(ws + WS_LTOK); S.tok0 = tok0; S.G = c.G; S.c = c.bid; S.nwg = t.tb[65] * 2;
            EpiSwiglu E{(bf16_t*)(ws + WS_ACT)};
            REPEAT(DUP_UP) pg8::gemm_phase<EpiSwiglu, MoeUpSched, true>(c.lds, 1024, S, E); } SEAM(pb + 15);
        if (IN(pb + 16)) { const MoeTable t = moe_table(c, layer, NTOK - tok0);
            MoeDownSched S; S.t = t; S.ACT = (const char*)(ws + WS_ACT); S.W = (const char*)(ws + WS_WD); S.G = c.G; S.c = c.bid; S.nwg = t.tb[65] * 4;
            EpiDown E{(unsigned char*)(ws + WS_YSLOT), (const float*)(ws + WS_LW), t, 0};
#ifdef PROBE_DOWN_NOEPI
            { EpiDown E0 = E; E0.skip = 1; pg8::gemm_phase<EpiDown, MoeDownSched, false>(c.lds, 256, S, E0); }
#endif
            REPEAT(DUP_DOWN) pg8::gemm_phase<EpiDown, MoeDownSched, false>(c.lds, 256, S, E); } SEAM(pb + 16);
        if (IN(pb + 17)) { const MoeTable t = moe_table(c, layer, NTOK - tok0); phase_p9(c, layer, tok0, t); } SEAM(pb + 17);
        }
    }
#ifdef PROBE_STOP
    }
#endif
#undef IN
#undef SEAM
}

#ifdef DBG_K
__global__ void dbg_dump(const unsigned* w, size_t nwords, float* out, int nout) {
    for (int i = blockIdx.x * blockDim.x + threadIdx.x; i < nout; i += gridDim.x * blockDim.x) { unsigned h = 0;
        for (size_t q = i; q < nwords; q += (size_t)nout) { unsigned x = w[q]; x ^= x >> 16; x *= 0x7feb352du; x ^= x >> 15; x *= 0x846ca68bu; x ^= x >> 16; h += x; }
        out[i] = (float)(h & 0xFFFFFu); }
}
#endif
#ifndef MK_SPLIT
#define MK_SPLIT 0
#endif
extern "C" void kernel_launch(void* const* d_in, const int* in_sizes, int n_in, void* d_out, int out_size, void* d_ws, size_t ws_size, hipStream_t stream) {
    static int grid = 0;
    if (grid == 0) {
        if (n_in != 34 || out_size != NX * D || ws_size < WS_END) { fprintf(stderr, "kernel_launch: unexpected shapes: n_in %d out %d ws %zu (need %zu)\n", n_in, out_size, ws_size, (size_t)WS_END); grid = -1; return; }
        int dev = 0, cus = 0, per_cu = 0;
        if (hipGetDevice(&dev) != hipSuccess || hipDeviceGetAttribute(&cus, hipDeviceAttributeMultiprocessorCount, dev) != hipSuccess) { grid = -1; return; }
        if (hipFuncSetAttribute((const void*)fwd_kernel, hipFuncAttributeMaxDynamicSharedMemorySize, LDS_BYTES) != hipSuccess) { fprintf(stderr, "kernel_launch: hipFuncSetAttribute failed\n"); grid = -1; return; }
        if (hipOccupancyMaxActiveBlocksPerMultiprocessor(&per_cu, (const void*)fwd_kernel, NTHREADS, LDS_BYTES) != hipSuccess || per_cu < 1) { fprintf(stderr, "kernel_launch: occupancy query says %d\n", per_cu); grid = -1; return; }
        grid = cus;
        if (grid > 256) grid = 256;
        grid &= ~7;
    }
    if (grid <= 0) return;
    (void)hipMemsetAsync((char*)d_ws + WS_CTL, 0, CTL_ZERO_BYTES, stream);
    Params p{};
    for (int i = 0; i < 34; ++i) p.in[i] = (const float*)d_in[i];
    p.out = (float*)d_out; p.ws = (unsigned char*)d_ws;
#ifdef DBG_K
    for (int k = 0; k <= DBG_K; ++k) { p.ph_lo = k; p.ph_hi = k + 1; hipLaunchKernelGGL(fwd_kernel, dim3(grid), dim3(NTHREADS), LDS_BYTES, stream, p); }
    hipLaunchKernelGGL(dbg_dump, dim3(1024), dim3(256), 0, stream, (const unsigned*)((const char*)d_ws + (size_t)(DBG_OFF)), (size_t)(DBG_BYTES) / 4, (float*)d_out, out_size);
#elif MK_SPLIT
    for (int k = 0; k < NPHASE; ++k) { p.ph_lo = k; p.ph_hi = k + 1; hipLaunchKernelGGL(fwd_kernel, dim3(grid), dim3(NTHREADS), LDS_BYTES, stream, p); }
#else
    p.ph_lo = 0; p.ph_hi = NPHASE;
    hipLaunchKernelGGL(fwd_kernel, dim3(grid), dim3(NTHREADS), LDS_BYTES, stream, p);
#endif
    const hipError_t le = hipPeekAtLastError();
    if (le != hipSuccess) fprintf(stderr, "kernel_launch: launch failed: %s\n", hipGetErrorName(le));
}
```

```cpp
#include <hip/hip_runtime.h>
#include <cstdio>
#include <cstdint>
#include <cmath>

#define LAS __attribute__((address_space(3)))
typedef unsigned short bf16_t;
typedef short bf16x8 __attribute__((ext_vector_type(8)));
typedef short s16x4 __attribute__((ext_vector_type(4)));
typedef float f32x2 __attribute__((ext_vector_type(2)));
typedef float f32x4 __attribute__((ext_vector_type(4)));
typedef float f32x16 __attribute__((ext_vector_type(16)));
typedef unsigned u32x2 __attribute__((ext_vector_type(2)));
typedef unsigned u32x4 __attribute__((ext_vector_type(4)));
typedef __bf16 bf16x2_t __attribute__((ext_vector_type(2)));

constexpr int D = 1024, NC = 256, NX = 16384, NTOK = NC + NX, DEPTH = 4;
constexpr int AB_IN = 4608, AB_CAT = 1536, DA_IN = 3072, DA_W = 1024;
constexpr int NEXP = 64, TOPK = 8, EDIM = 256;
constexpr int FFT_M = 16384;
constexpr int HSPEC_LD = 16400;
constexpr float EPS = 1e-6f;

__device__ __forceinline__ unsigned cvtpk(float lo, float hi) { f32x2 v = {lo, hi}; bf16x2_t b = __builtin_convertvector(v, bf16x2_t); return __builtin_bit_cast(unsigned, b); }
__device__ __forceinline__ bf16_t f2bf(float x) { return (bf16_t)(cvtpk(x, 0.f) & 0xffffu); }
__device__ __forceinline__ float bf2f(bf16_t b) { return __uint_as_float(((unsigned)b) << 16); }
__device__ __forceinline__ float bflo(unsigned w) { return __uint_as_float(w << 16); }
__device__ __forceinline__ float bfhi(unsigned w) { return __uint_as_float(w & 0xffff0000u); }
__device__ __forceinline__ float siluf(float x) { return x / (1.0f + __expf(-x)); }
__device__ __forceinline__ float sigmoidf_(float x) { return 1.0f / (1.0f + __expf(-x)); }
__device__ __forceinline__ int opaque(int x) { asm volatile("" : "+v"(x)); return x; }
__device__ __forceinline__ int opaque_s(int x) { asm volatile("" : "+s"(x)); return x; }
template <class T> __device__ __forceinline__ T* opaque_p(T* p) { asm volatile("" : "+s"(p)); return p; }
__device__ __forceinline__ float wave_sum(float v) {
#pragma unroll
    for (int o = 32; o >= 1; o >>= 1) v += __shfl_xor(v, o);
    return v;
}

#define XB_TMO      128
#define XB_XCNT(j)  (256  + 64 * (j))
#define XB_XSUB(j)  (1280 + 64 * (j))
#define XB_XGEN(j)  (2304 + 64 * (j))
#define XB_TOP      3328
#define XB_TOPGEN   3392
#define XCD_BAR_WORDS 3456
#define XB_SPIN_CAP (1u << 18)

__device__ __forceinline__ unsigned xb_ld(unsigned* p)              { return __hip_atomic_load(p, __ATOMIC_RELAXED, __HIP_MEMORY_SCOPE_AGENT); }
__device__ __forceinline__ unsigned xb_add(unsigned* p, unsigned v) { return __hip_atomic_fetch_add(p, v, __ATOMIC_RELAXED, __HIP_MEMORY_SCOPE_AGENT); }
__device__ __forceinline__ unsigned xb_xcc_id() { return (unsigned)__builtin_amdgcn_s_getreg((3 << 11) | 20) & 0xFu; }
#define XB_SPIN(cond, bar) do { unsigned _sp = 0; while (cond) { __builtin_amdgcn_s_sleep(1); \
    if ((++_sp & 255u) == 0u) { if (xb_ld(&(bar)[XB_TMO])) break; if (_sp > XB_SPIN_CAP) { atomicAdd(&(bar)[XB_TMO], 1u); break; } } } } while (0)

struct XcdBarrier { unsigned* bar; unsigned x; volatile LAS unsigned* st; };

__device__ __forceinline__ XcdBarrier xcd_barrier_post(unsigned* bar, volatile LAS unsigned* st) {
    XcdBarrier b; b.bar = bar; b.x = xb_xcc_id(); b.st = st;
    if (threadIdx.x == 0) (void)xb_add(&bar[XB_XCNT(b.x)], 1u);
    return b;
}
__device__ __forceinline__ void xcd_barrier_complete(unsigned* bar, unsigned x, unsigned& nloc, unsigned& nx) {
    const unsigned G = gridDim.x * gridDim.y * gridDim.z;
    unsigned sum, cnt, mine, sp = 0u;
    for (;;) {
        sum = 0u; cnt = 0u; mine = 0u;
#pragma unroll
        for (unsigned j = 0; j < 16; ++j) { const unsigned c = xb_ld(&bar[XB_XCNT(j)]); sum += c; cnt += (c > 0u) ? 1u : 0u; mine = (j == x) ? c : mine; }
        if (sum == G) break;
        __builtin_amdgcn_s_sleep(1);
        if ((++sp & 255u) == 0u) { if (xb_ld(&bar[XB_TMO])) break; if (sp > XB_SPIN_CAP) { atomicAdd(&bar[XB_TMO], 1u); break; } }
    }
    nloc = mine > 0u ? mine : 1u; nx = cnt > 0u ? cnt : 1u;
}
__device__ __forceinline__ void xcd_barrier(const XcdBarrier& b) {
    asm volatile("s_waitcnt vmcnt(0)" ::: "memory");
    __syncthreads();
    if (threadIdx.x == 0) {
        unsigned* bar = b.bar;
        __builtin_amdgcn_s_waitcnt(0);
        unsigned nloc = b.st[0], nx = b.st[1];
        if (nloc == 0u) { xcd_barrier_complete(bar, b.x, nloc, nx); b.st[0] = nloc; b.st[1] = nx; }
        const unsigned old = xb_add(&bar[XB_XSUB(b.x)], 1u);
        const unsigned gen = old / nloc;
        if (old + 1u == (gen + 1u) * nloc) {
            __builtin_amdgcn_fence(__ATOMIC_RELEASE, "agent");
            asm volatile("s_waitcnt vmcnt(0)" ::: "memory");
            const unsigned og = xb_add(&bar[XB_TOP], 1u);
            const unsigned tg = og / nx;
            if (og + 1u == (tg + 1u) * nx) xb_add(&bar[XB_TOPGEN], 1u);
            else XB_SPIN(xb_ld(&bar[XB_TOPGEN]) == tg, bar);
            __builtin_amdgcn_fence(__ATOMIC_ACQUIRE, "agent");
            xb_add(&bar[XB_XGEN(b.x)], 1u);
            asm volatile("s_waitcnt vmcnt(0)" ::: "memory");
        } else {
            XB_SPIN(xb_ld(&bar[XB_XGEN(b.x)]) == gen, bar);
            __builtin_amdgcn_fence(__ATOMIC_ACQUIRE, "agent");
            asm volatile("s_waitcnt vmcnt(0)" ::: "memory");
        }
    }
    __syncthreads();
}

namespace pg8 {
constexpr int BM = 256, BK = 64, HALF = 128, HTB = HALF * BK * 2, STAGE_BYTES = 8 * HTB;
__host__ __device__ __forceinline__ int lds_byte(int r, int c) { const int st = (r >> 4) * 2 + (c >> 5), rr = r & 15, cc = c & 31, ob = rr * 64 + cc * 2; return st * 1024 + (ob ^ (((ob >> 9) & 1) << 5)); }
__host__ __device__ __forceinline__ void stage_rc(int b, int& R, int& C) { const int st = b / 1024, sb = b % 1024, swz = sb ^ (((sb >> 9) & 1) << 5); R = (st >> 1) * 16 + swz / 64; C = (st & 1) * 32 + (swz % 64) / 2; }
__host__ __device__ __forceinline__ int perm32(int rho) { const int n = rho >> 4, i = rho & 15; return 8 * (i >> 2) + 4 * n + (i & 3); }

struct Unit { const char* A; const char* B; int pm, pn, e, aux; };

template <class Epi, class Sched, bool GATHER>
__device__ __forceinline__ void gemm_phase(LAS unsigned char* lds, const int K_, const Sched& S, const Epi& E) {
    int K = K_; asm volatile("" : "+s"(K));
    const int tid = opaque((int)threadIdx.x), wid = __builtin_amdgcn_readfirstlane(tid >> 6), lane = tid & 63, wr = wid >> 2, wc = wid & 3, fr = lane & 15, fq = lane >> 4;
    const int nt = K / BK;
    int Rr[2], Cc[2];
    unsigned voffB[2], vAc[2][2], vAn[2][2];
    const size_t kstep = (size_t)(BK * 2);
    const size_t hstep = (size_t)HALF * K * 2;
#pragma unroll
    for (int i = 0; i < 2; ++i) { int R, C; stage_rc(tid * 16 + i * 8192, R, C); Rr[i] = R; Cc[i] = C; const int Rb = Epi::PERM ? ((R & ~31) + perm32(R & 31)) : R;
        voffB[i] = (unsigned)(Rb * K + C) * 2u; vAc[0][i] = (unsigned)(R * K + C) * 2u; vAc[1][i] = vAc[0][i] + (unsigned)hstep; vAn[0][i] = vAc[0][i]; vAn[1][i] = vAc[1][i]; }
    const unsigned ldsw = (unsigned)wid * 1024u;
    const int aoff = lds_byte(wr * 64 + fr, fq * 8), boff = lds_byte(wc * 32 + fr, fq * 8);
#define PG8_SA(b, h) (((b) * 2 + (h)) * HTB)
#define PG8_SB(b, h) ((4 + (b) * 2 + (h)) * HTB)
#define PG8_STAGE(bufoff, gbase, voff) do { _Pragma("unroll") for (int _i = 0; _i < 2; ++_i) \
        __builtin_amdgcn_global_load_lds((const unsigned*)((const char*)(gbase) + (voff)[_i]), (LAS unsigned*)(lds + (bufoff) + ldsw + _i * 8192), 16, 0, 0); } while (0)
#define PG8_LDA(dst, b, h) do { _Pragma("unroll") for (int m = 0; m < 4; ++m) _Pragma("unroll") for (int k = 0; k < 2; ++k) dst[m][k] = *(const LAS bf16x8*)(lds + PG8_SA(b, h) + aoff + m * 2048 + k * 1024); } while (0)
#define PG8_LDB(dst, b, h) do { _Pragma("unroll") for (int n = 0; n < 2; ++n) _Pragma("unroll") for (int k = 0; k < 2; ++k) dst[n][k] = *(const LAS bf16x8*)(lds + PG8_SB(b, h) + boff + n * 2048 + k * 1024); } while (0)
#define PG8_MMA(ai, bj, At, Bt) do { __builtin_amdgcn_s_setprio(1); _Pragma("unroll") for (int m = 0; m < 4; ++m) _Pragma("unroll") for (int n = 0; n < 2; ++n) _Pragma("unroll") for (int k = 0; k < 2; ++k) \
        acc[ai][bj][m][n] = __builtin_amdgcn_mfma_f32_16x16x32_bf16(Bt[n][k], At[m][k], acc[ai][bj][m][n], 0, 0, 0); __builtin_amdgcn_s_setprio(0); } while (0)
#define PG8_WAIT_V(n) asm volatile("s_waitcnt vmcnt(" #n ")" ::: "memory")
#define PG8_WAIT_L(n) asm volatile("s_waitcnt lgkmcnt(" #n ")" ::: "memory")
#define PG8_BAR __builtin_amdgcn_s_barrier()
#define PG8_SCHED __builtin_amdgcn_sched_barrier(0)
    Unit cur, nxt; int ui = 0;
    if (!S.next(0, cur)) return;
    if (GATHER) { S.offsets(cur, Rr, Cc, vAc); }
    f32x4 acc[2][2][4][2];
#pragma unroll
    for (int a = 0; a < 2; ++a)
#pragma unroll
        for (int b = 0; b < 2; ++b)
#pragma unroll
            for (int m = 0; m < 4; ++m)
#pragma unroll
                for (int n = 0; n < 2; ++n) acc[a][b][m][n] = (f32x4){0.f, 0.f, 0.f, 0.f};
    bf16x8 At[4][2], B0[2][2], B1[2][2];
    const char* cA = cur.A; const char* cB = cur.B;
    PG8_STAGE(PG8_SB(0, 0), cB, voffB); PG8_STAGE(PG8_SA(0, 0), cA, vAc[0]); PG8_STAGE(PG8_SB(0, 1), cB + hstep, voffB); PG8_STAGE(PG8_SA(0, 1), cA, vAc[1]);
    if (wr == 1) PG8_BAR;
    PG8_WAIT_V(4); PG8_BAR;
    PG8_STAGE(PG8_SB(1, 0), cB + kstep, voffB); PG8_STAGE(PG8_SA(1, 0), cA + kstep, vAc[0]); PG8_STAGE(PG8_SB(1, 1), cB + hstep + kstep, voffB);
    PG8_WAIT_V(6); PG8_BAR;
    for (;;) {
        const bool has_next = S.next(ui + 1, nxt);
        const char* nA = has_next ? nxt.A : cA; const char* nB = has_next ? nxt.B : cB;
        if (GATHER) { if (has_next) S.offsets(nxt, Rr, Cc, vAn); else { vAn[0][0] = vAc[0][0]; vAn[0][1] = vAc[0][1]; vAn[1][0] = vAc[1][0]; vAn[1][1] = vAc[1][1]; } }
        for (int t = 0; t < nt; t += 2) {
            const bool last = (t == nt - 2);
            const char* a1 = cA + (size_t)(t + 1) * kstep;
            const char* a2 = last ? nA : cA + (size_t)(t + 2) * kstep; const char* b2 = last ? nB : cB + (size_t)(t + 2) * kstep;
            const char* a3 = a2 + kstep; const char* b3 = b2 + kstep;
            unsigned v2[2][2];
            if (GATHER) { v2[0][0] = last ? vAn[0][0] : vAc[0][0]; v2[0][1] = last ? vAn[0][1] : vAc[0][1]; v2[1][0] = last ? vAn[1][0] : vAc[1][0]; v2[1][1] = last ? vAn[1][1] : vAc[1][1]; }
            else { v2[0][0] = vAc[0][0]; v2[0][1] = vAc[0][1]; v2[1][0] = vAc[1][0]; v2[1][1] = vAc[1][1]; }
            PG8_LDB(B0, 0, 0); PG8_SCHED; PG8_LDA(At, 0, 0); PG8_STAGE(PG8_SA(1, 1), a1, vAc[1]);
            PG8_WAIT_L(8); PG8_BAR; PG8_WAIT_L(0); PG8_MMA(0, 0, At, B0); PG8_BAR; PG8_SCHED;
            PG8_LDB(B1, 0, 1); PG8_STAGE(PG8_SB(0, 0), b2, voffB);
            PG8_BAR; PG8_WAIT_L(0); PG8_MMA(0, 1, At, B1); PG8_BAR;
            PG8_LDA(At, 0, 1); PG8_STAGE(PG8_SA(0, 0), a2, v2[0]);
            PG8_BAR; PG8_WAIT_L(0); PG8_MMA(1, 0, At, B0); PG8_BAR; PG8_SCHED;
            PG8_STAGE(PG8_SB(0, 1), b2 + hstep, voffB);
            PG8_WAIT_V(6); PG8_BAR; PG8_MMA(1, 1, At, B1); PG8_BAR;
            PG8_LDB(B0, 1, 0); PG8_SCHED; PG8_LDA(At, 1, 0); PG8_STAGE(PG8_SA(0, 1), a2, v2[1]);
            PG8_WAIT_L(8); PG8_BAR; PG8_WAIT_L(0); PG8_MMA(0, 0, At, B0); PG8_BAR; PG8_SCHED;
            PG8_LDB(B1, 1, 1); PG8_STAGE(PG8_SB(1, 0), b3, voffB);
            PG8_BAR; PG8_WAIT_L(0); PG8_MMA(0, 1, At, B1); PG8_BAR;
            PG8_LDA(At, 1, 1); PG8_STAGE(PG8_SA(1, 0), a3, v2[0]);
            PG8_BAR; PG8_WAIT_L(0); PG8_MMA(1, 0, At, B0); PG8_BAR; PG8_SCHED;
            PG8_STAGE(PG8_SB(1, 1), b3 + hstep, voffB);
            PG8_WAIT_V(6); PG8_BAR; PG8_MMA(1, 1, At, B1); PG8_BAR;
        }
        E(acc, cur, wr, wc, fr, fq);
        if (!has_next) break;
#pragma unroll
        for (int a = 0; a < 2; ++a)
#pragma unroll
            for (int b = 0; b < 2; ++b)
#pragma unroll
                for (int m = 0; m < 4; ++m)
#pragma unroll
                    for (int n = 0; n < 2; ++n) acc[a][b][m][n] = (f32x4){0.f, 0.f, 0.f, 0.f};
        cur = nxt; cA = nA; cB = nB; ++ui;
        if (GATHER) { vAc[0][0] = vAn[0][0]; vAc[0][1] = vAn[0][1]; vAc[1][0] = vAn[1][0]; vAc[1][1] = vAn[1][1]; }
    }
    PG8_WAIT_V(0);
    if (wr == 0) PG8_BAR;
    PG8_BAR;
#undef PG8_SA
#undef PG8_SB
#undef PG8_STAGE
#undef PG8_LDA
#undef PG8_LDB
#undef PG8_MMA
#undef PG8_WAIT_V
#undef PG8_WAIT_L
#undef PG8_BAR
#undef PG8_SCHED
}
}
constexpr size_t MiB = 1u << 20;
constexpr size_t WS_CTL = 0, CTL_ZERO_BYTES = 1 * MiB;
constexpr size_t WS_MOD = 1 * MiB;
constexpr size_t WS_ROPE = WS_MOD + 256 * 1024;
constexpr size_t WS_MISC = WS_ROPE + 256 * 1024;
constexpr size_t WS_WAB_IN = 2 * MiB;
constexpr size_t WS_WAB_OUT = 20 * MiB;
constexpr size_t WS_WDA_IN = 26 * MiB;
constexpr size_t WS_WDA_OUT = 38 * MiB;
constexpr size_t WS_WR = 42 * MiB;
constexpr size_t WS_W3T = 43 * MiB;
constexpr size_t WS_HID2C = WS_W3T + 512 * 1024;
constexpr size_t WS_WGU = 44 * MiB;
constexpr size_t WS_WD = 109 * MiB;
constexpr size_t WS_XRES = 142 * MiB;
constexpr size_t WS_H = 207 * MiB;
constexpr size_t WS_LTOK = 240 * MiB;
constexpr size_t WS_LW = WS_LTOK + 5 * MiB;
constexpr size_t WS_SLOT = WS_LW + 5 * MiB;
constexpr size_t WS_SLOTW = WS_SLOT + 1 * MiB;
constexpr size_t WS_U = 252 * MiB;
constexpr size_t WS_PROJ = WS_U;
constexpr size_t WS_TAPS = WS_U;
constexpr size_t WS_CAT = WS_U + 147 * MiB;
constexpr size_t WS_UPD = WS_U + 196 * MiB;
constexpr size_t WS_SPREV = WS_U + 261 * MiB;
constexpr size_t WS_UT = WS_U + 326 * MiB;
constexpr size_t WS_YT = WS_U + 374 * MiB;
constexpr size_t WS_HSPEC = WS_U + 390 * MiB;
constexpr size_t WS_Y1 = WS_U + 519 * MiB;
constexpr size_t WS_MIX_END = WS_U + 551 * MiB;
constexpr int MAX_TILES = 649;
constexpr size_t WS_ACT = WS_U;
constexpr size_t WS_YSLOT = WS_U + 82 * MiB;
constexpr size_t WS_HLO = WS_YSLOT;
constexpr size_t WS_END = WS_U + 551 * MiB;
static_assert(WS_YSLOT + (size_t)MAX_TILES * 256 * 1024 * 2 <= WS_END, "moe view");
static_assert(WS_HSPEC + (size_t)2 * 512 * HSPEC_LD * 8 <= WS_MIX_END, "mixer view");

constexpr int CW_BAR = 1024;
constexpr int CW_CNT = 8192;
constexpr int CW_ERR = 16;
constexpr int CW_CVTQ = 9216;

constexpr int LDS_BIG = 139264;
constexpr int LDS_MISC = LDS_BIG;
constexpr int LDS_BYTES = LDS_BIG + 16384;
constexpr int NTHREADS = 512;

struct Params {
    const float* in[34];
    float* out;
    unsigned char* ws;
    int ph_lo, ph_hi;
};

typedef const __attribute__((address_space(4))) Params* KParams;
#define PREF const __attribute__((address_space(4))) Params&
__device__ __forceinline__ KParams opaque_kp(KParams p) { asm volatile("" : "+s"(p)); return p; }
struct Ctx {
    KParams p;
    LAS unsigned char* lds;
    int tid, lane, wid, G, bid, cnt_off, pass;
    unsigned char* ws;
};

template <class RowMap>
__device__ __forceinline__ void cvt_tile(const Ctx& c, const float* src, int ldn, int k0, int n0, bf16_t* dst, int ldk, const RowMap& rm) {
    LAS float* t = (LAS float*)c.lds;
    const int tid = c.tid;
    {   const int kr = tid >> 4, nc = (tid & 15) * 4;
#pragma unroll
        for (int h = 0; h < 2; ++h) { const f32x4 v = *(const f32x4*)(src + (size_t)(k0 + kr + 32 * h) * ldn + n0 + nc);
            t[(kr + 32 * h) * 65 + nc + 0] = v[0]; t[(kr + 32 * h) * 65 + nc + 1] = v[1]; t[(kr + 32 * h) * 65 + nc + 2] = v[2]; t[(kr + 32 * h) * 65 + nc + 3] = v[3]; } }
    __syncthreads();
    {   const int n = tid >> 3, k8 = (tid & 7) * 8; float f[8];
#pragma unroll
        for (int j = 0; j < 8; ++j) f[j] = t[(k8 + j) * 65 + n];
        u32x4 w; w.x = cvtpk(f[0], f[1]); w.y = cvtpk(f[2], f[3]); w.z = cvtpk(f[4], f[5]); w.w = cvtpk(f[6], f[7]);
        *(u32x4*)(dst + (size_t)rm(n0 + n) * ldk + k0 + k8) = w; }
    __syncthreads();
}
template <class RowMap>
__device__ __forceinline__ void cvt_tile128(const Ctx& c, const float* src, int ldn, int k0, int n0, bf16_t* dst, int ldk, const RowMap& rm) {
    LAS float* t = (LAS float*)c.lds;
    const int tid = c.tid;
    {   const int kr = tid >> 4, nc = (tid & 15) * 4;
#pragma unroll
        for (int h = 0; h < 4; ++h) { const f32x4 v = *(const f32x4*)(src + (size_t)(k0 + kr + 32 * h) * ldn + n0 + nc);
            t[(kr + 32 * h) * 65 + nc + 0] = v[0]; t[(kr + 32 * h) * 65 + nc + 1] = v[1]; t[(kr + 32 * h) * 65 + nc + 2] = v[2]; t[(kr + 32 * h) * 65 + nc + 3] = v[3]; } }
    __syncthreads();
    {   const int k8 = (tid & 15) * 8;
#pragma unroll
        for (int h = 0; h < 2; ++h) { const int n = (tid >> 4) + 32 * h; float f[8];
#pragma unroll
            for (int j = 0; j < 8; ++j) f[j] = t[(k8 + j) * 65 + n];
            u32x4 w; w.x = cvtpk(f[0], f[1]); w.y = cvtpk(f[2], f[3]); w.z = cvtpk(f[4], f[5]); w.w = cvtpk(f[6], f[7]);
            *(u32x4*)(dst + (size_t)rm(n0 + n) * ldk + k0 + k8) = w; } }
    __syncthreads();
}
struct RowId { __device__ __forceinline__ int operator()(int n) const { return n; } };
struct RowAbIn { __device__ __forceinline__ int operator()(int n) const { if (n >= 1024) return n; const int d = n & 127; return (n & ~127) + ((d < 64) ? 2 * d : 2 * (d - 64) + 1); } };
struct RowDaIn { __device__ __forceinline__ int operator()(int n) const { if (n >= 2048) return n; const int d = n & 63; return (n & ~63) + ((d < 32) ? 2 * d : 2 * (d - 32) + 1); } };
struct RowGate { __device__ __forceinline__ int operator()(int n) const { return (n >> 7) * 256 + (n & 127); } };
struct RowDown { __device__ __forceinline__ int operator()(int n) const { return (n & ~255) + 128 * ((n >> 3) & 1) + 32 * ((n >> 6) & 3) + 8 * ((n >> 4) & 3) + (n & 7); } };
struct RowUp   { __device__ __forceinline__ int operator()(int n) const { return (n >> 7) * 256 + 128 + (n & 127); } };

__device__ __forceinline__ void cvt_router_tile(const Ctx& c, const float* src, int k0, bf16_t* dhi, bf16_t* dlo) {
    LAS float* t = (LAS float*)c.lds; const int tid = c.tid;
    {   const int kr = tid >> 4, nc = (tid & 15) * 4;
#pragma unroll
        for (int h = 0; h < 2; ++h) { const f32x4 v = *(const f32x4*)(src + (size_t)(k0 + kr + 32 * h) * 64 + nc);
            t[(kr + 32 * h) * 65 + nc + 0] = v[0]; t[(kr + 32 * h) * 65 + nc + 1] = v[1]; t[(kr + 32 * h) * 65 + nc + 2] = v[2]; t[(kr + 32 * h) * 65 + nc + 3] = v[3]; } }
    __syncthreads();
    {   const int n = tid >> 3, k8 = (tid & 7) * 8; float f[8], g[8];
#pragma unroll
        for (int j = 0; j < 8; ++j) { f[j] = t[(k8 + j) * 65 + n]; const float h = bf2f(f2bf(f[j])); g[j] = f[j] - h; f[j] = h; }
        u32x4 w; w.x = cvtpk(f[0], f[1]); w.y = cvtpk(f[2], f[3]); w.z = cvtpk(f[4], f[5]); w.w = cvtpk(f[6], f[7]);
        *(u32x4*)(dhi + (size_t)n * 1024 + k0 + k8) = w;
        w.x = cvtpk(g[0], g[1]); w.y = cvtpk(g[2], g[3]); w.z = cvtpk(g[4], g[5]); w.w = cvtpk(g[6], g[7]);
        *(u32x4*)(dlo + (size_t)n * 1024 + k0 + k8) = w; }
    __syncthreads();
}

__device__ __forceinline__ void phase_pr0(const Ctx& c) {
    PREF P = *c.p; unsigned char* ws = c.ws;
    const int T_ABIN = 2 * 16 * 72, T_ABOUT = 2 * 24 * 16, T_DAIN = 2 * 16 * 48, T_DAOUT = 2 * 16 * 16, T_R = 4 * 16, T_W3 = 2 * 1 * 32;
    const int T_ALL = T_ABIN + T_ABOUT + T_DAIN + T_DAOUT + T_R + T_W3;
    for (int u = c.bid; u < T_ALL; u += c.G) {
        int v = u;
        if (v < T_ABIN) { const int j = v / (16 * 72), r = v % (16 * 72), kt = r / 72, ntile = r % 72;
            cvt_tile(c, P.in[8] + (size_t)j * 1024 * AB_IN, AB_IN, kt * 64, ntile * 64, (bf16_t*)(ws + WS_WAB_IN) + (size_t)j * AB_IN * 1024, 1024, RowAbIn()); continue; }
        v -= T_ABIN;
        if (v < T_ABOUT) { const int j = v / (24 * 16), r = v % (24 * 16), kt = r / 16, ntile = r % 16;
            cvt_tile(c, P.in[9] + (size_t)j * AB_CAT * 1024, 1024, kt * 64, ntile * 64, (bf16_t*)(ws + WS_WAB_OUT) + (size_t)j * 1024 * AB_CAT, AB_CAT, RowId()); continue; }
        v -= T_ABOUT;
        if (v < T_DAIN) { const int j = v / (16 * 48), r = v % (16 * 48), kt = r / 48, ntile = r % 48;
            cvt_tile(c, P.in[21] + (size_t)j * 1024 * DA_IN, DA_IN, kt * 64, ntile * 64, (bf16_t*)(ws + WS_WDA_IN) + (size_t)j * DA_IN * 1024, 1024, RowDaIn()); continue; }
        v -= T_DAIN;
        if (v < T_DAOUT) { const int j = v / (16 * 16), r = v % (16 * 16), kt = r / 16, ntile = r % 16;
            cvt_tile(c, P.in[22] + (size_t)j * 1024 * 1024, 1024, kt * 64, ntile * 64, (bf16_t*)(ws + WS_WDA_OUT) + (size_t)j * 1024 * 1024, 1024, RowId()); continue; }
        v -= T_DAOUT;
        if (v < T_R) { const int i = v / 16, kt = v % 16;
            cvt_router_tile(c, P.in[25] + (size_t)i * 1024 * 64, kt * 64, (bf16_t*)(ws + WS_WR) + (size_t)(i * 2 + 0) * 64 * 1024, (bf16_t*)(ws + WS_WR) + (size_t)(i * 2 + 1) * 64 * 1024); continue; }
        v -= T_R;
        { const int j = v / 32, ntile = v % 32;
            cvt_tile(c, P.in[19] + (size_t)j * 64 * 2048, 2048, 0, ntile * 64, (bf16_t*)(ws + WS_W3T) + (size_t)j * 2048 * 64, 64, RowId()); }
    }
    {
        LAS float* red = (LAS float*)c.lds;
        for (int u = c.bid; u < 192; u += c.G) {
            const int i = u / 48, j0 = (u % 48) * 128, col = c.tid & 127, kg = c.tid >> 7;
            const float* w = P.in[4] + (size_t)i * 1024 * 6144 + j0 + col;
            float a0 = 0.f, a1 = 0.f;
#pragma unroll 8
            for (int k = kg * 256; k < kg * 256 + 256; ++k) { const float wv = w[(size_t)k * 6144]; a0 += siluf(P.in[1][k]) * wv; a1 += siluf(P.in[3][k]) * wv; }
            red[(kg * 2 + 0) * 128 + col] = a0; red[(kg * 2 + 1) * 128 + col] = a1;
            __syncthreads();
            if (c.tid < 256) { const int s = c.tid >> 7; float v = 0.f;
#pragma unroll
                for (int g = 0; g < 4; ++g) v += red[(g * 2 + s) * 128 + col];
                ((float*)(ws + WS_MOD))[(size_t)(i * 2 + s) * 6144 + j0 + col] = v + P.in[5][(size_t)i * 6144 + j0 + col]; }
            __syncthreads();
        }
    }
    {
        f32x2* rt = (f32x2*)(ws + WS_ROPE);
        const int NRR = 256 * 32, NRC = 64 * 32, NDR = 256 * 16, NDC = 64 * 16;
        for (int idx = c.bid * NTHREADS + c.tid; idx < NRR + NRC + NDR + NDC; idx += c.G * NTHREADS) {
            int v = idx; float pos, inv;
            if (v < NRR) { pos = (float)(v >> 5); inv = powf(10000.f, -(float)(v & 31) / 32.f); }
            else if ((v -= NRR) < NRC) { pos = (float)(v >> 5); inv = powf(10000.f, -(float)(v & 31) / 32.f); }
            else if ((v -= NRC) < NDR) { pos = (float)(v >> 4); inv = powf(10000.f, -(float)(v & 15) / 16.f); }
            else { v -= NDR; pos = (float)(v >> 4); inv = powf(10000.f, -(float)(v & 15) / 16.f); }
            const float ang = pos * inv;
            rt[idx] = (f32x2){cosf(ang), sinf(ang)};
        }
    }
    if (c.bid == 0 && c.wid < 2) {
        const int j = c.wid; const float* lam = P.in[23] + (size_t)j * 4 * 64;
        float a = lam[c.lane] * lam[64 + c.lane], b = lam[128 + c.lane] * lam[192 + c.lane];
        a = wave_sum(a); b = wave_sum(b);
        const float linit = 0.8f - 0.6f * expf(-0.3f * (float)(2 * j + 1));
        if (c.lane == 0) { ((float*)(ws + WS_MISC))[j * 2 + 0] = expf(a) - expf(b) + linit; ((float*)(ws + WS_MISC))[j * 2 + 1] = linit; }
    }
}

__device__ __forceinline__ void norm_rows(const Ctx& c, int layer, int which  , const float* gain, int row_lo, int row_hi, const float* xsrc_lat, const float* xsrc_ctx, bf16_t* dst) {
    const float* mod = (const float*)(c.ws + WS_MOD) + (size_t)layer * 2 * 6144;
    const int sh_off = which ? 3 * 1024 : 0, sc_off = which ? 4 * 1024 : 1024;
    for (int row = row_lo + c.bid * 8 + c.wid; row < row_hi; row += c.G * 8) {
        const float* x = (row < NC) ? (xsrc_ctx + (size_t)row * D) : (xsrc_lat + (size_t)(row - NC) * D);
        const float* m = mod + ((row < NC) ? 6144 : 0);
        f32x4 v[4]; float ss = 0.f;
#pragma unroll
        for (int q = 0; q < 4; ++q) { v[q] = *(const f32x4*)(x + q * 256 + c.lane * 4); ss += v[q][0] * v[q][0] + v[q][1] * v[q][1] + v[q][2] * v[q][2] + v[q][3] * v[q][3]; }
        ss = wave_sum(ss);
        const float rstd = rsqrtf(ss * (1.0f / 1024.f) + EPS);
#pragma unroll
        for (int q = 0; q < 4; ++q) { const int col = q * 256 + c.lane * 4;
            const f32x4 g = *(const f32x4*)(gain + col), sc = *(const f32x4*)(m + sc_off + col), sh = *(const f32x4*)(m + sh_off + col);
            float o[4];
#pragma unroll
            for (int j = 0; j < 4; ++j) o[j] = v[q][j] * rstd * g[j] * (1.0f + sc[j]) + sh[j];
            u32x2 w; w.x = cvtpk(o[0], o[1]); w.y = cvtpk(o[2], o[3]);
            *(u32x2*)(dst + (size_t)row * D + col) = w; }
    }
}

__device__ __forceinline__ void phase_pr1(const Ctx& c) {
    PREF P = *c.p;
    float* xres = (float*)(c.ws + WS_XRES);
    for (size_t i = (size_t)c.bid * NTHREADS + c.tid; i < (size_t)NTOK * D / 4; i += (size_t)c.G * NTHREADS) {
        const size_t e = i * 4; const f32x4 v = (e < (size_t)NC * D) ? *(const f32x4*)(P.in[2] + e) : *(const f32x4*)(P.in[0] + (e - (size_t)NC * D));
        *(f32x4*)(xres + e) = v; }
    norm_rows(c, 0, 0, P.in[6], 0, NTOK, P.in[0], P.in[2], (bf16_t*)(c.ws + WS_H));
}
__device__ __forceinline__ int xcd_remap(int L, int n) { const int q = n / 8, r = n % 8, x = L % 8, off = L / 8; return (x < r ? x * (q + 1) : r * (q + 1) + (x - r) * q) + off; }

struct DenseSched {
    const char* A; const char* Bt; int K, nM, nN, pm0, G, c, nwg;
    __device__ __forceinline__ void init(const void* A_, const void* Bt_, int K_, int nM_, int nN_, int pm0_, int G_, int c_) { A = (const char*)A_; Bt = (const char*)Bt_; K = K_; nM = nM_ - pm0_; nN = nN_; pm0 = pm0_; G = G_; c = c_; nwg = nM * nN; }
    __device__ __forceinline__ bool next(int i, pg8::Unit& u) const {
        const long L = (long)i * G + c; if (L >= nwg) return false;
        const int wgid = xcd_remap((int)L, nwg);
        const int WGM = 8, nig = WGM * nN, gid = wgid / nig, fm = gid * WGM, gsz = (nM - fm) < WGM ? (nM - fm) : WGM;
        u.pm = pm0 + fm + ((wgid % nig) % gsz); u.pn = (wgid % nig) / gsz; u.e = 0; u.aux = 0;
        u.A = A + (size_t)u.pm * 256 * K * 2; u.B = Bt + (size_t)u.pn * 256 * K * 2; return true;
    }
    __device__ __forceinline__ void offsets(const pg8::Unit&, const int (&)[2], const int (&)[2], unsigned (&)[2][2]) const {}
};

struct MoeTable { const LAS int* tb; const LAS int* cn; };
__device__ __forceinline__ int moe_find(const MoeTable& t, int T) { int e = 0;
#pragma unroll 1
    for (int s = 64; s >= 1; s >>= 1) { if (e + s <= 64 && t.tb[e + s] <= T) e += s; } return e; }

struct MoeUpSched {
    MoeTable t; const char* H; const char* W; const int* ltok; int tok0, G, c, nwg;
    __device__ __forceinline__ bool next(int i, pg8::Unit& u) const {
        const long L = (long)i * G + c; if (L >= nwg) return false;
        const int id = xcd_remap((int)L, nwg); const int T = id >> 1; u.pn = id & 1; u.pm = T; u.e = moe_find(t, T); u.aux = T - t.tb[u.e];
        u.A = H; u.B = W + ((size_t)u.e * 512 + (size_t)u.pn * 256) * 1024 * 2; return true;
    }
    __device__ __forceinline__ void offsets(const pg8::Unit& u, const int (&Rr)[2], const int (&Cc)[2], unsigned (&vo)[2][2]) const {
        const int cnt = t.cn[u.e];
#pragma unroll
        for (int h = 0; h < 2; ++h)
#pragma unroll
            for (int i = 0; i < 2; ++i) { const int pos = u.aux * 256 + h * 128 + Rr[i]; int tok;
                if (u.e == 64) tok = tok0 + (pos < cnt ? pos : 0); else tok = (pos < cnt) ? ltok[(size_t)u.e * NTOK + pos] : tok0;
                vo[h][i] = (unsigned)(tok * 1024 + Cc[i]) * 2u; }
    }
};
struct MoeDownSched {
    MoeTable t; const char* ACT; const char* W; int G, c, nwg;
    __device__ __forceinline__ bool next(int i, pg8::Unit& u) const {
        const long L = (long)i * G + c; if (L >= nwg) return false;
        const int id = xcd_remap((int)L, nwg); const int T = id >> 2; u.pn = id & 3; u.pm = T; u.e = moe_find(t, T); u.aux = T - t.tb[u.e];
        u.A = ACT + (size_t)T * 256 * 256 * 2; u.B = W + ((size_t)u.e * 1024 + (size_t)u.pn * 256) * 256 * 2; return true;
    }
    __device__ __forceinline__ void offsets(const pg8::Unit&, const int (&)[2], const int (&)[2], unsigned (&)[2][2]) const {}
};

__device__ __forceinline__ void rope8(f32x4& v0, f32x4& v1, const f32x2* cs) {
    const f32x4 t0 = *(const f32x4*)(cs), t1 = *(const f32x4*)(cs + 2);
    float a, b;
    a = v0[0]; b = v0[1]; v0[0] = a * t0[0] - b * t0[1]; v0[1] = b * t0[0] + a * t0[1];
    a = v0[2]; b = v0[3]; v0[2] = a * t0[2] - b * t0[3]; v0[3] = b * t0[2] + a * t0[3];
    a = v1[0]; b = v1[1]; v1[0] = a * t1[0] - b * t1[1]; v1[1] = b * t1[0] + a * t1[1];
    a = v1[2]; b = v1[3]; v1[2] = a * t1[2] - b * t1[3]; v1[3] = b * t1[2] + a * t1[3];
}
struct EpiAbIn {
    static constexpr bool PERM = true;
    bf16_t* O; const f32x2* rope;
    __device__ __forceinline__ void operator()(const f32x4 (&acc)[2][2][4][2], const pg8::Unit& u, int wr, int wc, int fr, int fq) const {
        const int row0 = u.pm * 256 + wr * 64 + fr, colt = u.pn * 256 + wc * 32 + 8 * fq;
        const bool qk = u.pn < 4, lat = u.pm >= 1; const float ksc = (u.pn >= 2 && u.pn < 4) ? 0.08838834764831845f : 1.0f;
#pragma unroll
        for (int ai = 0; ai < 2; ++ai)
#pragma unroll
            for (int m = 0; m < 4; ++m) { const int row = row0 + ai * 128 + m * 16; bf16_t* rowp = O + (size_t)row * AB_IN + colt; const int t = row - NC;
#pragma unroll
                for (int bj = 0; bj < 2; ++bj) { f32x4 v0 = acc[ai][bj][m][0], v1 = acc[ai][bj][m][1];
                    if (qk) { if (lat) { const int p0 = ((colt + bj * 128) & 127) >> 1;
                            const f32x2* cs = (p0 < 32) ? rope + (size_t)(t >> 6) * 32 + p0 : rope + 256 * 32 + (size_t)(t & 63) * 32 + (p0 - 32);
                            rope8(v0, v1, cs); }
                        v0 *= ksc; v1 *= ksc; }
                    u32x4 w; w.x = cvtpk(v0[0], v0[1]); w.y = cvtpk(v0[2], v0[3]); w.z = cvtpk(v1[0], v1[1]); w.w = cvtpk(v1[2], v1[3]);
                    *(u32x4*)(rowp + bj * 128) = w; } }
    }
};
struct EpiDaIn {
    static constexpr bool PERM = true;
    bf16_t* O; const f32x2* rope;
    __device__ __forceinline__ void operator()(const f32x4 (&acc)[2][2][4][2], const pg8::Unit& u, int wr, int wc, int fr, int fq) const {
        const int row0 = u.pm * 256 + wr * 64 + fr, colt = u.pn * 256 + wc * 32 + 8 * fq;
        const bool qk = u.pn < 8, lat = u.pm >= 1; const float qsc = (u.pn < 4) ? 0.125f * 1.4426950408889634f : 1.0f;
#pragma unroll
        for (int ai = 0; ai < 2; ++ai)
#pragma unroll
            for (int m = 0; m < 4; ++m) { const int row = row0 + ai * 128 + m * 16; bf16_t* rowp = O + (size_t)row * DA_IN + colt; const int t = row - NC;
#pragma unroll
                for (int bj = 0; bj < 2; ++bj) { f32x4 v0 = acc[ai][bj][m][0], v1 = acc[ai][bj][m][1];
                    if (qk) { if (lat) { const int p0 = ((colt + bj * 128) & 63) >> 1;
                            const f32x2* cs = (p0 < 16) ? rope + (size_t)(t >> 6) * 16 + p0 : rope + 256 * 16 + (size_t)(t & 63) * 16 + (p0 - 16);
                            rope8(v0, v1, cs); }
                        v0 *= qsc; v1 *= qsc; }
                    u32x4 w; w.x = cvtpk(v0[0], v0[1]); w.y = cvtpk(v0[2], v0[3]); w.z = cvtpk(v1[0], v1[1]); w.w = cvtpk(v1[2], v1[3]);
                    *(u32x4*)(rowp + bj * 128) = w; } }
    }
};
struct EpiResid {
    static constexpr bool PERM = false;
    float* X; const float* mod;
    __device__ __forceinline__ void operator()(const f32x4 (&acc)[2][2][4][2], const pg8::Unit& u, int wr, int wc, int fr, int fq) const {
        const int row0 = u.pm * 256 + wr * 64 + fr, col0 = u.pn * 256 + wc * 32 + 4 * fq;
        const float* g = mod + ((u.pm == 0) ? 6144 : 0) + 2 * 1024;
        f32x4 gv[2][2];
#pragma unroll
        for (int bj = 0; bj < 2; ++bj)
#pragma unroll
            for (int n = 0; n < 2; ++n) gv[bj][n] = *(const f32x4*)(g + col0 + bj * 128 + n * 16);
#pragma unroll
        for (int ai = 0; ai < 2; ++ai)
#pragma unroll
            for (int m = 0; m < 4; ++m) { float* rowp = X + (size_t)(row0 + ai * 128 + m * 16) * D + col0;
#pragma unroll
                for (int bj = 0; bj < 2; ++bj)
#pragma unroll
                    for (int n = 0; n < 2; ++n) { f32x4* p = (f32x4*)(rowp + bj * 128 + n * 16); *p = *p + gv[bj][n] * acc[ai][bj][m][n]; } }
    }
};
struct EpiSwiglu {
    static constexpr bool PERM = true;
    bf16_t* ACT;
    __device__ __forceinline__ void operator()(const f32x4 (&acc)[2][2][4][2], const pg8::Unit& u, int wr, int wc, int fr, int fq) const {
        const int row0 = u.pm * 256 + wr * 64 + fr, col0 = u.pn * 128 + wc * 32 + 8 * fq;
#pragma unroll
        for (int ai = 0; ai < 2; ++ai)
#pragma unroll
            for (int m = 0; m < 4; ++m) { bf16_t* rowp = ACT + (size_t)(row0 + ai * 128 + m * 16) * 256 + col0; float o[8];
#pragma unroll
                for (int n = 0; n < 2; ++n)
#pragma unroll
                    for (int j = 0; j < 4; ++j) { const float g = acc[ai][0][m][n][j], up = acc[ai][1][m][n][j]; o[n * 4 + j] = siluf(g) * up; }
                u32x4 w; w.x = cvtpk(o[0], o[1]); w.y = cvtpk(o[2], o[3]); w.z = cvtpk(o[4], o[5]); w.w = cvtpk(o[6], o[7]);
                *(u32x4*)rowp = w; }
    }
};
struct EpiDown {
    static constexpr bool PERM = true;
    unsigned char* Y; const float* lw; MoeTable t; int skip;
    __device__ __forceinline__ void operator()(const f32x4 (&acc)[2][2][4][2], const pg8::Unit& u, int wr, int wc, int fr, int fq) const {
        if (skip) { asm volatile("" :: "v"(acc[0][0][0][0]), "v"(acc[1][1][3][1])); return; }
        const int r0 = wr * 64 + fr, col0 = u.pn * 256 + wc * 64 + 16 * fq; const int cnt = t.cn[u.e];
        float wv[2][4];
#pragma unroll
        for (int ai = 0; ai < 2; ++ai)
#pragma unroll
            for (int m = 0; m < 4; ++m) { const int pos = u.aux * 256 + r0 + ai * 128 + m * 16; const int pc = (pos < cnt) ? pos : 0;
                const float x = (u.e == 64) ? 1.0f : lw[(size_t)u.e * NTOK + pc]; wv[ai][m] = (u.e == 64 || pos < cnt) ? x : 0.0f; }
#pragma unroll
        for (int ai = 0; ai < 2; ++ai)
#pragma unroll
            for (int m = 0; m < 4; ++m) { const int r = r0 + ai * 128 + m * 16; const float w_ = wv[ai][m];
                unsigned char* rowp = Y + (size_t)(u.pm * 256 + r) * 1024 + col0; u32x4 w;
#pragma unroll
                for (int bj = 0; bj < 2; ++bj) { const f32x4 v0 = acc[ai][bj][m][0] * w_, v1 = acc[ai][bj][m][1] * w_; int lo = 0, hi = 0;
                    lo = __builtin_amdgcn_cvt_pk_fp8_f32(v0[0], v0[1], lo, false); lo = __builtin_amdgcn_cvt_pk_fp8_f32(v0[2], v0[3], lo, true);
                    hi = __builtin_amdgcn_cvt_pk_fp8_f32(v1[0], v1[1], hi, false); hi = __builtin_amdgcn_cvt_pk_fp8_f32(v1[2], v1[3], hi, true);
                    if (bj == 0) { w.x = (unsigned)lo; w.y = (unsigned)hi; } else { w.z = (unsigned)lo; w.w = (unsigned)hi; } }
                *(u32x4*)rowp = w; }
    }
};
__device__ __forceinline__ int fphys(int i) { return i + ((i >> 6) << 2); }
__device__ __forceinline__ int brev14(int x) { return (int)(__brev((unsigned)x) >> 18); }
__device__ __forceinline__ int brevK(int s, int K) { return (int)(__brev((unsigned)s) >> (32 - K)); }
__device__ __forceinline__ void cmul(float& ar, float& ai, float br, float bi) { const float r = ar * br - ai * bi, i = ar * bi + ai * br; ar = r; ai = i; }
__device__ __forceinline__ constexpr float tw16c(int k) { return (k & 15) == 0 ? 1.f : (k & 15) == 1 ? 0.9238795325112867f : (k & 15) == 2 ? 0.7071067811865476f : (k & 15) == 3 ? 0.3826834323650898f : (k & 15) == 4 ? 0.f :
    (k & 15) == 5 ? -0.3826834323650898f : (k & 15) == 6 ? -0.7071067811865476f : (k & 15) == 7 ? -0.9238795325112867f : (k & 15) == 8 ? -1.f : (k & 15) == 9 ? -0.9238795325112867f : (k & 15) == 10 ? -0.7071067811865476f :
    (k & 15) == 11 ? -0.3826834323650898f : (k & 15) == 12 ? 0.f : (k & 15) == 13 ? 0.3826834323650898f : (k & 15) == 14 ? 0.7071067811865476f : 0.9238795325112867f; }
__device__ __forceinline__ constexpr float tw16s(int k) { return tw16c(k + 12); }

template <int LOGN, int K, bool INV>
__device__ __forceinline__ void fft_pass(LAS f32x2* z, int tid) {
    constexpr int R = 1 << K, LOGST = LOGN - K, ST = 1 << LOGST;
#pragma unroll 1
    for (int g = tid; g < FFT_M / R; g += NTHREADS) {
        const int b = g >> LOGST, j = g & (ST - 1), base = (b << LOGN) + j;
        float xr[R], xi[R];
#pragma unroll
        for (int q = 0; q < R; ++q) { const f32x2 v = z[fphys(base + (q << LOGST))]; xr[q] = v[0]; xi[q] = v[1]; }
        float wr_[R], wi_[R];
        if (LOGST > 0) {
            const float fr = (float)j * (1.0f / (float)(1 << LOGN));
            wr_[0] = 1.f; wi_[0] = 0.f;
#pragma unroll
            for (int bit = 1; bit < R; bit <<= 1) { const float a = fr * (float)bit; wr_[bit] = __builtin_amdgcn_cosf(a); wi_[bit] = INV ? __builtin_amdgcn_sinf(a) : -__builtin_amdgcn_sinf(a); }
#pragma unroll
            for (int r = 3; r < R; ++r) { if ((r & (r - 1)) != 0) { const int hb = 1 << (31 - __builtin_clz(r)); wr_[r] = wr_[hb]; wi_[r] = wi_[hb]; cmul(wr_[r], wi_[r], wr_[r - hb], wi_[r - hb]); } }
        }
        if (!INV) {
#pragma unroll
            for (int s = 0; s < K; ++s) { const int half = R >> (s + 1);
#pragma unroll
                for (int a = 0; a < R; ++a) if ((a & half) == 0) {
                    const int o = a & (half - 1); const int ti = o * (8 / half);
                    const float ur = xr[a], ui = xi[a], vr = xr[a + half], vi = xi[a + half];
                    xr[a] = ur + vr; xi[a] = ui + vi;
                    float dr = ur - vr, di = ui - vi;
                    if (half >= 1 && o != 0) cmul(dr, di, tw16c(ti), -tw16s(ti));
                    xr[a + half] = dr; xi[a + half] = di; } }
            if (LOGST > 0) {
#pragma unroll
                for (int s = 1; s < R; ++s) { const int r = brevK(s, K); cmul(xr[s], xi[s], wr_[r], wi_[r]); } }
        } else {
            if (LOGST > 0) {
#pragma unroll
                for (int s = 1; s < R; ++s) { const int r = brevK(s, K); cmul(xr[s], xi[s], wr_[r], wi_[r]); } }
#pragma unroll
            for (int s = K - 1; s >= 0; --s) { const int half = R >> (s + 1);
#pragma unroll
                for (int a = 0; a < R; ++a) if ((a & half) == 0) {
                    const int o = a & (half - 1); const int ti = o * (8 / half);
                    const float ur = xr[a], ui = xi[a]; float vr = xr[a + half], vi = xi[a + half];
                    if (o != 0) cmul(vr, vi, tw16c(ti), tw16s(ti));
                    xr[a] = ur + vr; xi[a] = ui + vi; xr[a + half] = ur - vr; xi[a + half] = ui - vi; } }
        }
#pragma unroll
        for (int q = 0; q < R; ++q) z[fphys(base + (q << LOGST))] = (f32x2){xr[q], xi[q]};
    }
}
__device__ __forceinline__ void fft_fwd(LAS f32x2* z, int tid) {
    fft_pass<14, 4, false>(z, tid); __syncthreads();
    fft_pass<10, 4, false>(z, tid); __syncthreads();
    fft_pass<6, 4, false>(z, tid);  __syncthreads();
    fft_pass<2, 2, false>(z, tid);  __syncthreads();
}
__device__ __forceinline__ void fft_inv(LAS f32x2* z, int tid) {
    fft_pass<2, 2, true>(z, tid);  __syncthreads();
    fft_pass<6, 4, true>(z, tid);  __syncthreads();
    fft_pass<10, 4, true>(z, tid); __syncthreads();
    fft_pass<14, 4, true>(z, tid); __syncthreads();
}
__device__ __forceinline__ void fft_pair_mul(LAS f32x2* z, const f32x2* Hs, int tid) {
    constexpr int M = FFT_M;
#pragma unroll 1
    for (int k = tid; k <= M / 2; k += NTHREADS) {
        if (k == 0) {
            const f32x2 z0 = z[0]; const float X0 = z0[0] + z0[1], XM = z0[0] - z0[1];
            const float Y0 = X0 * Hs[0][0], YM = XM * Hs[M][0];
            z[0] = (f32x2){0.5f * (Y0 + YM), 0.5f * (Y0 - YM)};
        } else {
            const int p1 = fphys(brev14(k)), p2 = fphys(brev14(M - k));
            const f32x2 zk = z[p1], zm = z[p2]; const f32x2 hk = Hs[k], hm = Hs[M - k];
            const float Er = 0.5f * (zk[0] + zm[0]), Ei = 0.5f * (zk[1] - zm[1]);
            const float Dr = 0.5f * (zk[0] - zm[0]), Di = 0.5f * (zk[1] + zm[1]);
            const float Or = Di, Oi = -Dr;
            const float a = (float)k * (1.0f / (float)(2 * M));
            const float wr = __builtin_amdgcn_cosf(a), wi = -__builtin_amdgcn_sinf(a);
            const float wOr = wr * Or - wi * Oi, wOi = wr * Oi + wi * Or;
            const float Xkr = Er + wOr, Xki = Ei + wOi;
            const float Xmr = Er - wOr, Xmi = -(Ei - wOi);
            const float Ykr = Xkr * hk[0] - Xki * hk[1], Yki = Xkr * hk[1] + Xki * hk[0];
            const float Ymr = Xmr * hm[0] - Xmi * hm[1], Ymi = Xmr * hm[1] + Xmi * hm[0];
            const float Yer = 0.5f * (Ykr + Ymr), Yei = 0.5f * (Yki - Ymi);
            const float Fr = 0.5f * (Ykr - Ymr), Fi = 0.5f * (Yki + Ymi);
            const float Yor = Fr * wr + Fi * wi, Yoi = Fi * wr - Fr * wi;
            z[p1] = (f32x2){Yer - Yoi, Yei + Yor};
            if (p2 != p1) z[p2] = (f32x2){Yer + Yoi, -Yei + Yor};
        }
    }
}
__device__ __forceinline__ void fft_unpack_store(const LAS f32x2* z, f32x2* Hs, float sc, int tid) {
    constexpr int M = FFT_M;
#pragma unroll 1
    for (int k = tid; k <= M / 2; k += NTHREADS) {
        if (k == 0) { const f32x2 z0 = z[0]; Hs[0] = (f32x2){(z0[0] + z0[1]) * sc, 0.f}; Hs[M] = (f32x2){(z0[0] - z0[1]) * sc, 0.f}; }
        else {
            const f32x2 zk = z[fphys(brev14(k))], zm = z[fphys(brev14(M - k))];
            const float Er = 0.5f * (zk[0] + zm[0]), Ei = 0.5f * (zk[1] - zm[1]);
            const float Dr = 0.5f * (zk[0] - zm[0]), Di = 0.5f * (zk[1] + zm[1]);
            const float Or = Di, Oi = -Dr;
            const float a = (float)k * (1.0f / (float)(2 * M));
            const float wr = __builtin_amdgcn_cosf(a), wi = -__builtin_amdgcn_sinf(a);
            const float wOr = wr * Or - wi * Oi, wOi = wr * Oi + wi * Or;
            Hs[k] = (f32x2){(Er + wOr) * sc, (Ei + wOi) * sc};
            if (k != M - k) Hs[M - k] = (f32x2){(Er - wOr) * sc, -(Ei - wOi) * sc};
        }
    }
}
__device__ __forceinline__ int crow(int r, int hi) { return (r & 3) + 8 * (r >> 2) + 4 * hi; }
__device__ __forceinline__ bf16x8 ldfrag(const LAS unsigned char* base, int pitch, int row, int kbyte) { return *(const LAS bf16x8*)(base + row * pitch + kbyte); }
constexpr int P136 = 272;

__device__ __forceinline__ float ret_log2g(const float* decay_logit, int dir, int h) { const float x = decay_logit[dir * 4 + h]; return -log1pf(expf(-x)) * 1.4426950408889634f; }

__device__ __forceinline__ void phase_f1(const Ctx& c, int j) {
    PREF P = *c.p;
    const float* w1 = P.in[13] + (size_t)j * 33 * 64; const float* b1 = P.in[14] + j * 64; const float* f1 = P.in[15] + j * 64;
    const float* w2 = P.in[16] + (size_t)j * 64 * 64; const float* b2 = P.in[17] + j * 64; const float* f2 = P.in[18] + j * 64;
    const bf16_t* w3t = (const bf16_t*)(c.ws + WS_W3T) + (size_t)j * 2048 * 64;
    float* taps = (float*)(c.ws + WS_TAPS); float* hid2c = (float*)(c.ws + WS_HID2C);
    LAS float* zs = (LAS float*)c.lds;
    LAS float* h1s = (LAS float*)(c.lds + 18432);
    LAS float* w1s = (LAS float*)(c.lds + 51712);
    LAS float* w2s = (LAS float*)(c.lds + 60160);
    LAS unsigned char* hb = c.lds + 76544;
    LAS unsigned char* as = c.lds + 94976;
    for (int u = c.bid; u < 130; u += c.G) {
        const int tid = opaque(c.tid);
        const bool isctx = u >= 128; const int L = isctx ? 256 : 16384; const int t0 = isctx ? (u - 128) * 128 : u * 128;
        for (int i = tid; i < 33 * 64; i += NTHREADS) w1s[i] = w1[i];
        for (int i = tid; i < 64 * 64; i += NTHREADS) w2s[i] = w2[i];
        {
            const int tl = tid >> 2, part = tid & 3; const float t = (float)(t0 + tl);
            if (part == 0) zs[tl * 36 + 0] = t / (float)(L - 1);
#pragma unroll
            for (int q = 0; q < 4; ++q) { const int b = part * 4 + q; const float band = 1e-4f + (float)b * ((15.0f - 1e-4f) / 15.0f);
                const float ang = (6.283185307179586f / (float)L) * t * band;
                zs[tl * 36 + 1 + b] = __cosf(ang); zs[tl * 36 + 17 + b] = -__sinf(ang); }
        }
        __syncthreads();
        {   const int tl = tid >> 2, og = (tid & 3) * 16; float a[16];
#pragma unroll
            for (int o = 0; o < 16; ++o) a[o] = b1[og + o];
#pragma unroll 1
            for (int f = 0; f < 33; ++f) { const float zv = zs[tl * 36 + f];
#pragma unroll
                for (int o = 0; o < 16; ++o) a[o] += zv * w1s[f * 64 + og + o]; }
#pragma unroll
            for (int o = 0; o < 16; ++o) h1s[tl * 65 + og + o] = __sinf(f1[og + o] * a[o]);
        }
        __syncthreads();
        {   const int tl = tid >> 2, og = (tid & 3) * 16; float a[16];
#pragma unroll
            for (int o = 0; o < 16; ++o) a[o] = b2[og + o];
#pragma unroll 1
            for (int k = 0; k < 64; ++k) { const float hv = h1s[tl * 65 + k];
#pragma unroll
                for (int o = 0; o < 16; ++o) a[o] += hv * w2s[k * 64 + og + o]; }
#pragma unroll
            for (int o = 0; o < 16; ++o) a[o] = __sinf(f2[og + o] * a[o]);
            if (isctx) {
#pragma unroll
                for (int o = 0; o < 16; ++o) hid2c[(size_t)(t0 + tl) * 64 + og + o] = a[o];
            } else {
#pragma unroll
                for (int o = 0; o < 16; o += 2) *(LAS unsigned*)(hb + tl * 144 + (og + o) * 2) = cvtpk(a[o], a[o + 1]);
            }
        }
        __syncthreads();
        if (!isctx) {
            const int lane = tid & 63, r32 = lane & 31, hi = lane >> 5, w = __builtin_amdgcn_readfirstlane(tid >> 6);
#pragma unroll 1
            for (int cc = 0; cc < 8; ++cc) {
                {   const int row = tid >> 1, hf = tid & 1; const u32x4* src = (const u32x4*)(w3t + (size_t)(cc * 256 + row) * 64 + hf * 32);
#pragma unroll
                    for (int q = 0; q < 4; ++q) *(LAS u32x4*)(as + row * 144 + hf * 64 + q * 16) = src[q]; }
                __syncthreads();
                f32x16 acc[4];
#pragma unroll
                for (int ni = 0; ni < 4; ++ni) acc[ni] = (f32x16){};
#pragma unroll
                for (int ks = 0; ks < 4; ++ks) { const bf16x8 a = ldfrag(as, 144, 32 * w + r32, ks * 32 + hi * 16);
#pragma unroll
                    for (int ni = 0; ni < 4; ++ni) { const bf16x8 b = ldfrag(hb, 144, 32 * ni + r32, ks * 32 + hi * 16); acc[ni] = __builtin_amdgcn_mfma_f32_32x32x16_bf16(a, b, acc[ni], 0, 0, 0); } }
#pragma unroll
                for (int ni = 0; ni < 4; ++ni) { const int t = t0 + 32 * ni + r32; const float tn = (float)t * (1.0f / 16383.0f);
#pragma unroll
                    for (int r = 0; r < 16; ++r) { const int fc = cc * 256 + 32 * w + crow(r, hi); const int ch = fc & 511;
                        const float delta = 3.0701134573253945f + (15.350567286626972f - 3.0701134573253945f) * ((float)ch * (1.0f / 511.0f));
                        taps[(size_t)fc * 16384 + t] = acc[ni][r] * __expf(-tn * delta); } }
                __syncthreads();
            }
        }
        __syncthreads();
    }
}

__device__ __forceinline__ void phase_f2(const Ctx& c) {
    const float* taps = (const float*)(c.ws + WS_TAPS); f32x2* hs = (f32x2*)(c.ws + WS_HSPEC);
    LAS f32x2* z = (LAS f32x2*)c.lds;
    for (int u = c.bid; u < 1024; u += c.G) {
        const int tid = opaque(c.tid);
        const int o = u >> 9, ch = u & 511;
        const float* hf = taps + (size_t)(o * 1024 + ch) * 16384; const float* hbk = taps + (size_t)(o * 1024 + 512 + ch) * 16384;
#pragma unroll 4
        for (int i = 0; i < 32; ++i) { const int m = tid + i * NTHREADS; f32x2 v;
            if (m < 8192) v = *(const f32x2*)(hf + 2 * m);
            else if (m == 8192) v = (f32x2){0.f, hbk[16383]};
            else { const int s = 32768 - 2 * m; v = (f32x2){hbk[s], hbk[s - 1]}; }
            z[fphys(m)] = v; }
        __syncthreads();
        fft_fwd(z, tid);
        fft_unpack_store(z, hs + (size_t)u * HSPEC_LD, 1.0f / (float)FFT_M, tid);
        __syncthreads();
    }
}

__device__ __forceinline__ void stage_T(const int tid, LAS unsigned char* dstT, const bf16_t* src, int ld, int ncols, const float* rowscale  ) {
    const int j = tid >> 2;
    for (int c8 = (tid & 3) * 8; c8 < ncols; c8 += 32) {
        const u32x4 v = *(const u32x4*)(src + (size_t)j * ld + c8); const unsigned w[4] = {v.x, v.y, v.z, v.w};
#pragma unroll
        for (int q = 0; q < 4; ++q) { *(LAS bf16_t*)(dstT + (c8 + 2 * q) * P136 + j * 2) = (bf16_t)(w[q] & 0xffffu); *(LAS bf16_t*)(dstT + (c8 + 2 * q + 1) * P136 + j * 2) = (bf16_t)(w[q] >> 16); }
    }
}
__device__ __forceinline__ void phase_r1(const Ctx& c, int j) {
    PREF P = *c.p; const bf16_t* proj = (const bf16_t*)(c.ws + WS_PROJ); bf16_t* upd = (bf16_t*)(c.ws + WS_UPD);
    LAS unsigned char* VT = c.lds; LAS unsigned char* KF = c.lds + 69632; LAS unsigned char* KB = c.lds + 104448;
    for (int u = c.bid; u < 130 * 4; u += c.G) {
        const int tid = opaque(c.tid), lane = tid & 63, r32 = lane & 31, hi = lane >> 5, w = __builtin_amdgcn_readfirstlane(tid >> 6);
        const int m = u >> 2, h = u & 3; const size_t row0 = (size_t)m * 128;
        const float lgf = ret_log2g(P.in[10] + j * 8, 0, h), lgb = ret_log2g(P.in[10] + j * 8, 1, h);
        stage_T(tid, VT, proj + row0 * AB_IN + 1024 + h * 256, AB_IN, 256, nullptr);
        {   const int jj = tid >> 2; const float sf = exp2f((float)(127 - jj) * lgf), sb = exp2f((float)jj * lgb);
            for (int c8 = (tid & 3) * 8; c8 < 128; c8 += 32) {
                const u32x4 v = *(const u32x4*)(proj + (row0 + jj) * AB_IN + 512 + h * 128 + c8); const unsigned wv[4] = {v.x, v.y, v.z, v.w};
#pragma unroll
                for (int q = 0; q < 4; ++q) { const float lo = bflo(wv[q]), hi_ = bfhi(wv[q]);
                    *(LAS bf16_t*)(KF + (c8 + 2 * q) * P136 + jj * 2) = f2bf(lo * sf); *(LAS bf16_t*)(KF + (c8 + 2 * q + 1) * P136 + jj * 2) = f2bf(hi_ * sf);
                    *(LAS bf16_t*)(KB + (c8 + 2 * q) * P136 + jj * 2) = f2bf(lo * sb); *(LAS bf16_t*)(KB + (c8 + 2 * q + 1) * P136 + jj * 2) = f2bf(hi_ * sb); } } }
        __syncthreads();
#pragma unroll 1
        for (int dir = 0; dir < 2; ++dir) {
            const LAS unsigned char* KX = dir ? KB : KF;
            f32x16 af[4];
#pragma unroll
            for (int n = 0; n < 4; ++n) af[n] = (f32x16){};
#pragma unroll
            for (int ks = 0; ks < 8; ++ks) { const bf16x8 a = ldfrag(VT, P136, 32 * w + r32, ks * 32 + hi * 16);
#pragma unroll
                for (int n = 0; n < 4; ++n) { const bf16x8 bf_ = ldfrag(KX, P136, 32 * n + r32, ks * 32 + hi * 16); af[n] = __builtin_amdgcn_mfma_f32_32x32x16_bf16(a, bf_, af[n], 0, 0, 0); } }
            bf16_t* of = upd + ((size_t)(m * 4 + h) * 2 + dir) * 32768;
#pragma unroll
            for (int n = 0; n < 4; ++n)
#pragma unroll
                for (int r = 0; r < 16; ++r) { const int e = 32 * w + crow(r, hi), d = 32 * n + r32; of[e * 128 + d] = f2bf(af[n][r]); }
        }
        __syncthreads();
    }
}

__device__ __forceinline__ void phase_hyprep(const Ctx& c, int j) {
    PREF P = *c.p; const bf16_t* proj = (const bf16_t*)(c.ws + WS_PROJ); bf16_t* uT = (bf16_t*)(c.ws + WS_UT);
    const float* cw = P.in[11] + (size_t)j * 3 * 1536; const float* cb = P.in[12] + (size_t)j * 1536;
    LAS float* t = (LAS float*)c.lds;
    const int tid = c.tid;
    for (int u = c.bid; u < 256 * 24; u += c.G) {
        const int tt = u / 24, ct = u % 24, t0 = tt * 64, ch0 = ct * 64;
        for (int idx = tid; idx < 66 * 8; idx += NTHREADS) { const int r = idx >> 3, c8 = (idx & 7) * 8; const int tg = t0 - 1 + r;
            u32x4 v = (u32x4){0u, 0u, 0u, 0u};
            if (tg >= 0 && tg < NX) v = *(const u32x4*)(proj + (size_t)(NC + tg) * AB_IN + 3072 + ch0 + c8);
            const unsigned wv[4] = {v.x, v.y, v.z, v.w};
#pragma unroll
            for (int q = 0; q < 4; ++q) { t[r * 65 + c8 + 2 * q] = bflo(wv[q]); t[r * 65 + c8 + 2 * q + 1] = bfhi(wv[q]); } }
        __syncthreads();
        {   const int ch = tid >> 3, t8 = (tid & 7) * 8; const int chg = ch0 + ch;
            const float w0 = cw[chg], w1 = cw[1536 + chg], w2 = cw[3072 + chg], bb = cb[chg]; float o[8];
#pragma unroll
            for (int q = 0; q < 8; ++q) o[q] = t[(t8 + q) * 65 + ch] * w0 + t[(t8 + q + 1) * 65 + ch] * w1 + t[(t8 + q + 2) * 65 + ch] * w2 + bb;
            u32x4 wv; wv.x = cvtpk(o[0], o[1]); wv.y = cvtpk(o[2], o[3]); wv.z = cvtpk(o[4], o[5]); wv.w = cvtpk(o[6], o[7]);
            *(u32x4*)(uT + (size_t)chg * NX + t0 + t8) = wv; }
        __syncthreads();
    }
}

__device__ __forceinline__ void phase_scan(const Ctx& c, int j) {
    PREF P = *c.p; const unsigned* upd = (const unsigned*)(c.ws + WS_UPD); unsigned* sp = (unsigned*)(c.ws + WS_SPREV);
    for (int idx = c.bid * NTHREADS + c.tid; idx < 4 * 2 * 16384; idx += c.G * NTHREADS) {
        const int h = idx >> 15, dir = (idx >> 14) & 1, pr = idx & 16383;
        const float g = exp2f(128.0f * ret_log2g(P.in[10] + j * 8, dir, h));
        float s0 = 0.f, s1 = 0.f;
        const size_t base = (size_t)(h * 2 + dir) * 16384 + pr, mstride = (size_t)4 * 2 * 16384;
#pragma unroll 1
        for (int it = 0; it < 130; it += 10) {
            unsigned uv[10]; int mm[10];
#pragma unroll
            for (int q = 0; q < 10; ++q) { const int s = it + q; mm[q] = (dir == 0) ? s : (s < 2 ? 1 - s : 131 - s); uv[q] = upd[base + (size_t)mm[q] * mstride]; }
#pragma unroll
            for (int q = 0; q < 10; ++q) { sp[base + (size_t)mm[q] * mstride] = cvtpk(s0, s1); s0 = g * s0 + bflo(uv[q]); s1 = g * s1 + bfhi(uv[q]); }
        }
    }
}
__device__ __forceinline__ void phase_hyconv(const Ctx& c, int j) {
    PREF P = *c.p; const unsigned* uT = (const unsigned*)(c.ws + WS_UT); unsigned* yT = (unsigned*)(c.ws + WS_YT);
    const f32x2* hs = (const f32x2*)(c.ws + WS_HSPEC); const float* skip = P.in[20] + (size_t)j * 2 * 512;
    LAS f32x2* z = (LAS f32x2*)c.lds;
    for (int ch = c.bid; ch < 512; ch += c.G) {
        const int tid = opaque(c.tid);
        const unsigned* vp = uT + (size_t)ch * (NX / 2); const unsigned* x1p = uT + (size_t)(512 + ch) * (NX / 2); const unsigned* x2p = uT + (size_t)(1024 + ch) * (NX / 2);
        const float sk0 = skip[ch], sk1 = skip[512 + ch];
#pragma unroll 4
        for (int i = 0; i < 16; ++i) { const int m = tid + i * NTHREADS; const unsigned w = vp[m]; z[fphys(m)] = (f32x2){bflo(w), bfhi(w)}; }
#pragma unroll 4
        for (int i = 16; i < 32; ++i) z[fphys(tid + i * NTHREADS)] = (f32x2){0.f, 0.f};
        __syncthreads();
        fft_fwd(z, tid); fft_pair_mul(z, hs + (size_t)ch * HSPEC_LD, tid); __syncthreads(); fft_inv(z, tid);
        f32x2* y1g = (f32x2*)(c.ws + WS_Y1) + (size_t)ch * (NX / 2);
#pragma unroll 4
        for (int i = 0; i < 16; ++i) { const int m = tid + i * NTHREADS; const f32x2 cv = z[fphys(m)]; const unsigned w = x1p[m], wv = vp[m];
            const f32x2 y = (f32x2){bflo(w) * (cv[0] + sk0 * bflo(wv)), bfhi(w) * (cv[1] + sk0 * bfhi(wv))};
            z[fphys(m)] = y; y1g[m] = y; }
#pragma unroll 4
        for (int i = 16; i < 32; ++i) z[fphys(tid + i * NTHREADS)] = (f32x2){0.f, 0.f};
        __syncthreads();
        fft_fwd(z, tid); fft_pair_mul(z, hs + (size_t)(512 + ch) * HSPEC_LD, tid); __syncthreads(); fft_inv(z, tid);
#pragma unroll 4
        for (int i = 0; i < 16; ++i) { const int m = tid + i * NTHREADS; const f32x2 cv = z[fphys(m)]; const unsigned w = x2p[m]; const f32x2 y1 = y1g[m];
            yT[(size_t)ch * (NX / 2) + m] = cvtpk(bflo(w) * (cv[0] + sk1 * y1[0]), bfhi(w) * (cv[1] + sk1 * y1[1])); }
        __syncthreads();
    }
}

__device__ __forceinline__ void phase_r3(const Ctx& c, int j) {
    PREF P = *c.p; const bf16_t* proj = (const bf16_t*)(c.ws + WS_PROJ); const bf16_t* spv = (const bf16_t*)(c.ws + WS_SPREV); bf16_t* cat = (bf16_t*)(c.ws + WS_CAT);
    LAS unsigned char* R0 = c.lds; LAS unsigned char* R1 = c.lds + 34816; LAS unsigned char* R2 = c.lds + 69632;
    for (int u = c.bid; u < 130 * 4; u += c.G) {
        const int tid = opaque(c.tid), lane = tid & 63, r32 = lane & 31, hi = lane >> 5, w = __builtin_amdgcn_readfirstlane(tid >> 6), wr2 = w >> 2, wc = w & 3;
        const int m = u >> 2, h = u & 3; const size_t row0 = (size_t)m * 128;
        const float lgf = ret_log2g(P.in[10] + j * 8, 0, h), lgb = ret_log2g(P.in[10] + j * 8, 1, h);
        {   const int jj = tid >> 2;
            for (int c8 = (tid & 3) * 8; c8 < 128; c8 += 32) {
                *(LAS u32x4*)(R0 + jj * P136 + c8 * 2) = *(const u32x4*)(proj + (row0 + jj) * AB_IN + h * 128 + c8);
                *(LAS u32x4*)(R1 + jj * P136 + c8 * 2) = *(const u32x4*)(proj + (row0 + jj) * AB_IN + 512 + h * 128 + c8); } }
        stage_T(tid, R2, proj + row0 * AB_IN + 1024 + h * 256, AB_IN, 256, nullptr);
        __syncthreads();
        f32x16 s[2] = {(f32x16){}, (f32x16){}};
#pragma unroll
        for (int ks = 0; ks < 8; ++ks) { const bf16x8 b = ldfrag(R1, P136, 32 * wc + r32, ks * 32 + hi * 16);
#pragma unroll
            for (int mi = 0; mi < 2; ++mi) { const bf16x8 a = ldfrag(R0, P136, 64 * wr2 + 32 * mi + r32, ks * 32 + hi * 16); s[mi] = __builtin_amdgcn_mfma_f32_32x32x16_bf16(a, b, s[mi], 0, 0, 0); } }
        __syncthreads();
#pragma unroll
        for (int mi = 0; mi < 2; ++mi)
#pragma unroll
            for (int r = 0; r < 16; ++r) { const int i = 64 * wr2 + 32 * mi + crow(r, hi), jc = 32 * wc + r32, rel = i - jc;
                const float dcy = (rel > 0) ? exp2f((float)rel * lgf) : ((rel < 0) ? exp2f((float)(-rel) * lgb) : 2.0f);
                *(LAS bf16_t*)(R1 + i * P136 + jc * 2) = f2bf(s[mi][r] * dcy); }
        __syncthreads();
        f32x16 o[2][2];
#pragma unroll
        for (int mi = 0; mi < 2; ++mi)
#pragma unroll
            for (int ni = 0; ni < 2; ++ni) o[mi][ni] = (f32x16){};
#pragma unroll
        for (int ks = 0; ks < 8; ++ks) { bf16x8 a[2], b[2];
#pragma unroll
            for (int q = 0; q < 2; ++q) { a[q] = ldfrag(R1, P136, 64 * wr2 + 32 * q + r32, ks * 32 + hi * 16); b[q] = ldfrag(R2, P136, 64 * wc + 32 * q + r32, ks * 32 + hi * 16); }
#pragma unroll
            for (int mi = 0; mi < 2; ++mi)
#pragma unroll
                for (int ni = 0; ni < 2; ++ni) o[mi][ni] = __builtin_amdgcn_mfma_f32_32x32x16_bf16(a[mi], b[ni], o[mi][ni], 0, 0, 0); }
        __syncthreads();
#pragma unroll 1
        for (int dir = 0; dir < 2; ++dir) {
            {   const int jj = tid >> 2; const float qd = (dir == 0) ? exp2f((float)(jj + 1) * lgf) : exp2f((float)(128 - jj) * lgb);
                for (int c8 = (tid & 3) * 8; c8 < 128; c8 += 32) { const u32x4 v = *(const LAS u32x4*)(R0 + jj * P136 + c8 * 2); u32x4 wv;
                    wv.x = cvtpk(bflo(v.x) * qd, bfhi(v.x) * qd); wv.y = cvtpk(bflo(v.y) * qd, bfhi(v.y) * qd); wv.z = cvtpk(bflo(v.z) * qd, bfhi(v.z) * qd); wv.w = cvtpk(bflo(v.w) * qd, bfhi(v.w) * qd);
                    *(LAS u32x4*)(R1 + jj * P136 + c8 * 2) = wv; } }
            {   const bf16_t* sp = spv + ((size_t)(m * 4 + h) * 2 + dir) * 32768;
                for (int idx = tid; idx < 256 * 16; idx += NTHREADS) { const int e = idx >> 4, c8 = (idx & 15) * 8; *(LAS u32x4*)(R2 + e * P136 + c8 * 2) = *(const u32x4*)(sp + e * 128 + c8); } }
            __syncthreads();
#pragma unroll
            for (int ks = 0; ks < 8; ++ks) { bf16x8 a[2], b[2];
#pragma unroll
                for (int q = 0; q < 2; ++q) { a[q] = ldfrag(R1, P136, 64 * wr2 + 32 * q + r32, ks * 32 + hi * 16); b[q] = ldfrag(R2, P136, 64 * wc + 32 * q + r32, ks * 32 + hi * 16); }
#pragma unroll
                for (int mi = 0; mi < 2; ++mi)
#pragma unroll
                    for (int ni = 0; ni < 2; ++ni) o[mi][ni] = __builtin_amdgcn_mfma_f32_32x32x16_bf16(a[mi], b[ni], o[mi][ni], 0, 0, 0); }
            __syncthreads();
        }
        for (int idx = tid; idx < 128 * 32; idx += NTHREADS) { const int i = idx >> 5, c8 = (idx & 31) * 8; *(LAS u32x4*)(R2 + i * 528 + c8 * 2) = *(const u32x4*)(proj + (row0 + i) * AB_IN + 2048 + h * 256 + c8); }
        LAS float* st = (LAS float*)R0;
#pragma unroll
        for (int mi = 0; mi < 2; ++mi)
#pragma unroll
            for (int r = 0; r < 16; ++r) { float sm = o[mi][0][r] + o[mi][1][r], sq = o[mi][0][r] * o[mi][0][r] + o[mi][1][r] * o[mi][1][r];
#pragma unroll
                for (int off = 16; off >= 1; off >>= 1) { sm += __shfl_xor(sm, off); sq += __shfl_xor(sq, off); }
                if (r32 == 0) { const int i = 64 * wr2 + 32 * mi + crow(r, hi); st[(i * 4 + wc) * 2 + 0] = sm; st[(i * 4 + wc) * 2 + 1] = sq; } }
        __syncthreads();
#pragma unroll
        for (int mi = 0; mi < 2; ++mi)
#pragma unroll
            for (int r = 0; r < 16; ++r) { const int i = 64 * wr2 + 32 * mi + crow(r, hi); float sm = 0.f, sq = 0.f;
#pragma unroll
                for (int q = 0; q < 4; ++q) { sm += st[(i * 4 + q) * 2 + 0]; sq += st[(i * 4 + q) * 2 + 1]; }
                const float mu = sm * (1.0f / 256.f), var = fmaxf(sq * (1.0f / 256.f) - mu * mu, 0.f), rstd = rsqrtf(var + EPS);
#pragma unroll
                for (int ni = 0; ni < 2; ++ni) { const int e = 64 * wc + 32 * ni + r32; LAS bf16_t* pg = (LAS bf16_t*)(R2 + i * 528 + e * 2); const float g = bf2f(*pg);
                    *pg = f2bf((o[mi][ni][r] - mu) * rstd * siluf(g)); } }
        __syncthreads();
        for (int idx = tid; idx < 128 * 32; idx += NTHREADS) { const int i = idx >> 5, c8 = (idx & 31) * 8; *(u32x4*)(cat + (row0 + i) * AB_CAT + h * 256 + c8) = *(const LAS u32x4*)(R2 + i * 528 + c8 * 2); }
        __syncthreads();
    }
}

__device__ __forceinline__ void phase_hytrans(const Ctx& c) {
    const bf16_t* yT = (const bf16_t*)(c.ws + WS_YT); bf16_t* cat = (bf16_t*)(c.ws + WS_CAT);
    LAS bf16_t* t = (LAS bf16_t*)c.lds;
    const int tid = c.tid;
    for (int u = c.bid; u < 256 * 8; u += c.G) {
        const int t0 = (u >> 3) * 64, ch0 = (u & 7) * 64;
        {   const int ch = tid >> 3, t8 = (tid & 7) * 8; const u32x4 v = *(const u32x4*)(yT + (size_t)(ch0 + ch) * NX + t0 + t8); const unsigned wv[4] = {v.x, v.y, v.z, v.w};
#pragma unroll
            for (int q = 0; q < 4; ++q) { t[ch * 66 + t8 + 2 * q] = (bf16_t)(wv[q] & 0xffffu); t[ch * 66 + t8 + 2 * q + 1] = (bf16_t)(wv[q] >> 16); } }
        __syncthreads();
        {   const int tt = tid >> 3, c8 = (tid & 7) * 8; unsigned short e[8];
#pragma unroll
            for (int q = 0; q < 8; ++q) e[q] = t[(c8 + q) * 66 + tt];
            u32x4 wv; wv.x = e[0] | ((unsigned)e[1] << 16); wv.y = e[2] | ((unsigned)e[3] << 16); wv.z = e[4] | ((unsigned)e[5] << 16); wv.w = e[6] | ((unsigned)e[7] << 16);
            *(u32x4*)(cat + (size_t)(NC + t0 + tt) * AB_CAT + 1024 + ch0 + c8) = wv; }
        __syncthreads();
    }
}

__device__ __forceinline__ void phase_hyctx(const Ctx& c, int j) {
    PREF P = *c.p; const bf16_t* proj = (const bf16_t*)(c.ws + WS_PROJ); bf16_t* cat = (bf16_t*)(c.ws + WS_CAT);
    const float* hid2c = (const float*)(c.ws + WS_HID2C); const float* w3 = P.in[19] + (size_t)j * 64 * 2048;
    const float* cw = P.in[11] + (size_t)j * 3 * 1536; const float* cb = P.in[12] + (size_t)j * 1536; const float* skip = P.in[20] + (size_t)j * 2 * 512;
    LAS float* raw = (LAS float*)c.lds;
    LAS float* ser = raw + 3 * 258;
    LAS float* flt = ser + 3 * 256;
    LAS float* yy = flt + 4 * 256;
    const int tid = c.tid;
    for (int ch = c.bid; ch < 512; ch += c.G) {
        for (int idx = tid; idx < 3 * 258; idx += NTHREADS) { const int s = idx / 258, r = idx % 258, t = r - 1; raw[idx] = (t >= 0 && t < 256) ? bf2f(proj[(size_t)t * AB_IN + 3072 + s * 512 + ch]) : 0.f; }
        {
            const int t = tid & 255, hf = tid >> 8; const float tn = (float)t * (1.0f / 255.0f);
            const float delta = 3.0701134573253945f + (15.350567286626972f - 3.0701134573253945f) * ((float)ch * (1.0f / 511.0f)); const float win = __expf(-tn * delta);
            float a0 = 0.f, a1 = 0.f; const int col0 = (2 * hf) * 512 + ch, col1 = (2 * hf + 1) * 512 + ch;
            for (int k = 0; k < 64; ++k) { const float hv = hid2c[t * 64 + k]; a0 += hv * w3[(size_t)k * 2048 + col0]; a1 += hv * w3[(size_t)k * 2048 + col1]; }
            flt[(2 * hf) * 256 + t] = a0 * win; flt[(2 * hf + 1) * 256 + t] = a1 * win; }
        __syncthreads();
        for (int idx = tid; idx < 3 * 256; idx += NTHREADS) { const int s = idx >> 8, t = idx & 255, cg = s * 512 + ch;
            ser[idx] = raw[s * 258 + t] * cw[cg] + raw[s * 258 + t + 1] * cw[1536 + cg] + raw[s * 258 + t + 2] * cw[3072 + cg] + cb[cg]; }
        __syncthreads();
        if (tid < 256) { const int t = tid; float a = 0.f;
            for (int s = 0; s <= t; ++s) a += flt[0 * 256 + (t - s)] * ser[s];
            for (int s = t + 1; s < 256; ++s) a += flt[1 * 256 + (s - t)] * ser[s];
            yy[t] = ser[256 + t] * (a + skip[ch] * ser[t]); }
        __syncthreads();
        if (tid < 256) { const int t = tid; float a = 0.f;
            for (int s = 0; s <= t; ++s) a += flt[2 * 256 + (t - s)] * yy[s];
            for (int s = t + 1; s < 256; ++s) a += flt[3 * 256 + (s - t)] * yy[s];
            cat[(size_t)t * AB_CAT + 1024 + ch] = f2bf(ser[512 + t] * (a + skip[512 + ch] * yy[t])); }
        __syncthreads();
    }
}
namespace da2 {
constexpr int KSLOT = 16384, VSLOT = 16384, NSLOT = 3;
constexpr int LDS_K = 0, LDS_V = NSLOT * KSLOT, LDS_WS = LDS_V + NSLOT * VSLOT;
#define D2_SBAR() __builtin_amdgcn_sched_barrier(0)
#define D2_WAIT_BAR(N) asm volatile("s_waitcnt vmcnt(" #N ") lgkmcnt(0)\n\ts_barrier" ::: "memory")
typedef short v4i16_t __attribute__((ext_vector_type(4)));
typedef LAS const char* lcp;
__device__ __forceinline__ void glds16(const void* gsrc, unsigned lds_dst) { unsigned keep;
    asm volatile("s_mov_b32 %0, m0\n\ts_mov_b32 m0, %2\n\ts_nop 0\n\tglobal_load_lds_dwordx4 %1, off\n\ts_mov_b32 m0, %0" : "=&s"(keep) : "v"(gsrc), "s"(lds_dst) : "memory"); }
__device__ __forceinline__ unsigned cvtpk_s(float lo, float hi) { f32x2 v = {lo, hi}; bf16x2_t b = __builtin_convertvector(v, bf16x2_t); return __builtin_bit_cast(unsigned, b); }
__device__ __forceinline__ s16x4 vtr(lcp p) { return __builtin_bit_cast(s16x4, __builtin_amdgcn_ds_read_tr16_b64_v4i16((LAS v4i16_t*)p)); }
__device__ __forceinline__ void kload8(bf16x8* kf, lcp kp) {
    kf[0] = *(const LAS bf16x8*)(kp);        kf[1] = *(const LAS bf16x8*)(kp + 512);
    kf[2] = *(const LAS bf16x8*)(kp + 2048); kf[3] = *(const LAS bf16x8*)(kp + 2560);
    kf[4] = *(const LAS bf16x8*)(kp + 4096); kf[5] = *(const LAS bf16x8*)(kp + 4608);
    kf[6] = *(const LAS bf16x8*)(kp + 6144); kf[7] = *(const LAS bf16x8*)(kp + 6656); }

__device__ __forceinline__ bool attn_unit_dma(LAS char* lds, const bf16_t* proj, bf16_t* cat, int h, int qrow0, int nkeys, float lam, float oscale, const float* subln) {
    constexpr int LD = DA_IN;
    const int tid = opaque((int)threadIdx.x), wid = __builtin_amdgcn_readfirstlane(tid >> 6), lane = tid & 63, r32 = lane & 31, hi = lane >> 5, comp = wid >> 2, qw = wid & 3;
    const unsigned lds0 = (unsigned)(uintptr_t)lds;
    LAS float* wsf = (LAS float*)(lds + LDS_WS) + wid * 64;
    const bf16_t* Kh = proj + 1024 + h * 128; const bf16_t* Vh = proj + 2048 + h * 128;
    const bf16_t* ksrc0 = Kh + (size_t)lane * LD + wid * 8; const bf16_t* ksrc1 = ksrc0 + 64;
    const bf16_t* vsrc0 = Vh + (size_t)(16 * (wid & 3) + (lane >> 2)) * LD + (wid >> 2) * 32 + (lane & 3) * 8; const bf16_t* vsrc1 = vsrc0 + 64;
    const unsigned kdst = lds0 + LDS_K + wid * 1024, vdst = lds0 + LDS_V + wid * 1024;
#define D2_DMA_K(t, slot) do { glds16(ksrc0 + (size_t)(t) * 64 * LD, (unsigned)__builtin_amdgcn_readfirstlane(kdst + (slot))); glds16(ksrc1 + (size_t)(t) * 64 * LD, (unsigned)__builtin_amdgcn_readfirstlane(kdst + (slot) + 8192)); } while (0)
#define D2_DMA_V(t, slot) do { glds16(vsrc0 + (size_t)(t) * 64 * LD, (unsigned)__builtin_amdgcn_readfirstlane(vdst + (slot))); glds16(vsrc1 + (size_t)(t) * 64 * LD, (unsigned)__builtin_amdgcn_readfirstlane(vdst + (slot) + 8192)); } while (0)
    const lcp shm3 = (lcp)lds;
    const lcp kp0 = shm3 + LDS_K + comp * 8192 + hi * 1024 + r32 * 16;
    const lcp vp0 = shm3 + LDS_V + ((lane >> 4) & 1) * 32 + (lane & 3) * 8 + (4 * hi + ((lane & 15) >> 2)) * 64;
    const int NT = nkeys / 64;
    D2_DMA_K(0, 0); D2_DMA_V(0, 0); D2_DMA_K(1, KSLOT);
    bf16x8 qr[4];
    { const bf16_t* Qw = proj + (size_t)(qrow0 + qw * 32 + r32) * LD + h * 128 + comp * 64 + hi * 8;
#pragma unroll
      for (int d0 = 0; d0 < 4; ++d0) qr[d0] = *reinterpret_cast<const bf16x8*>(Qw + d0 * 16); }
    float l_reg = 0.f; f32x16 o[4]; o[0] = f32x16{}; o[1] = f32x16{}; o[2] = f32x16{}; o[3] = f32x16{};
    f32x16 pA0, pA1, pB0, pB1; bf16x8 kf[8];
    int sl_prev = 0, sl_cur = 0, sl_next = KSLOT;
#define D2_ROT() do { sl_prev = sl_cur; sl_cur = sl_next; sl_next = (sl_next == (NSLOT - 1) * KSLOT) ? 0 : sl_next + KSLOT; } while (0)
    D2_DMA_K(2, 2 * KSLOT);
    D2_WAIT_BAR(6);
    { const lcp kb = kp0;
      pA0 = f32x16{}; pA1 = f32x16{};
#pragma unroll
      for (int d0 = 0; d0 < 4; ++d0) { const bf16x8 b0 = *(const LAS bf16x8*)(kb + d0 * 2048), b1 = *(const LAS bf16x8*)(kb + d0 * 2048 + 512);
          pA0 = __builtin_amdgcn_mfma_f32_32x32x16_bf16(b0, qr[d0], pA0, 0, 0, 0); pA1 = __builtin_amdgcn_mfma_f32_32x32x16_bf16(b1, qr[d0], pA1, 0, 0, 0); }
#pragma unroll
      for (int r = 0; r < 16; ++r) { pA0[r] = __builtin_amdgcn_exp2f(pA0[r]); pA1[r] = __builtin_amdgcn_exp2f(pA1[r]); } }
    D2_WAIT_BAR(0);
    D2_DMA_K(3, 0); D2_DMA_V(1, VSLOT);
    D2_ROT();
    kload8(kf, kp0 + sl_cur);
    D2_WAIT_BAR(4);
    s16x4 vlo[8], vhi[8]; u32x4 pw0, pw1, pw2, pw3;
#define D2_PKW(P, B) cvtpk_s(P[B], P[B + 1])
#define D2_PAF(k) __builtin_bit_cast(bf16x8, pw##k)
#define D2_VFR(s) (bf16x8){vlo[s][0], vlo[s][1], vlo[s][2], vlo[s][3], vhi[s][0], vhi[s][1], vhi[s][2], vhi[s][3]}
#define D2_PIN(x) asm volatile("" : "+v"(x))
#define D2_VRD(s, i) do { vlo[s] = vtr(vp_ + (((i) >> 2) * 4096 + ((i) & 3) * 1024)); vhi[s] = vtr(vp_ + (((i) >> 2) * 4096 + ((i) & 3) * 1024 + 512)); } while (0)
#define D2_GAPA(MF, A0, A1, A2, A3, W0, W1, PW) do { MF; sacc += A0; sacc += A1; sacc += A2; sacc += A3; D2_PIN(sacc); W0; W1; D2_PIN(PW); D2_SBAR(); } while (0)
#define D2_EX(v) __builtin_amdgcn_exp2f(v)
#define D2_GAPB(MF, X, B) do { MF; X[B] = D2_EX(X[B]); X[B + 1] = D2_EX(X[B + 1]); D2_PIN(X); D2_SBAR(); } while (0)
#define D2_KRD(G, j) do { if (G) { kf[j] = *(const LAS bf16x8*)(kp0 + sl_next + ((j) >> 1) * 2048 + ((j) & 1) * 512); D2_SBAR(); } } while (0)
#define D2_ORD(j) ((((j) & 3) << 2) | ((j) >> 2))
#define D2_STEP(C0, C1, P0, P1, t, GK, GV, GL) do { D2_SBAR(); \
    const lcp vp_ = vp0 + sl_prev; \
    D2_VRD(0, D2_ORD(0)); D2_SBAR(); float sacc = (P0[0] + P0[1]); \
    D2_GAPA(C0 = __builtin_amdgcn_mfma_f32_32x32x16_bf16(kf[0], qr[0], f32x16{}, 0, 0, 0), P0[2], P0[3], P0[4], P0[5],     pw0[0] = D2_PKW(P0, 0), pw0[1] = D2_PKW(P0, 2), pw0); \
    D2_VRD(1, D2_ORD(1)); D2_SBAR(); D2_GAPA(C1 = __builtin_amdgcn_mfma_f32_32x32x16_bf16(kf[1], qr[0], f32x16{}, 0, 0, 0), P0[6], P0[7], P0[8], P0[9],     pw0[2] = D2_PKW(P0, 4), pw0[3] = D2_PKW(P0, 6), pw0); \
    D2_VRD(2, D2_ORD(2)); D2_SBAR(); D2_GAPA(C0 = __builtin_amdgcn_mfma_f32_32x32x16_bf16(kf[2], qr[1], C0, 0, 0, 0),       P0[10], P0[11], P0[12], P0[13], pw1[0] = D2_PKW(P0, 8), pw1[1] = D2_PKW(P0, 10), pw1); \
    D2_VRD(3, D2_ORD(3)); D2_SBAR(); D2_GAPA(C1 = __builtin_amdgcn_mfma_f32_32x32x16_bf16(kf[3], qr[1], C1, 0, 0, 0),       P0[14], P0[15], P1[0], P1[1],   pw1[2] = D2_PKW(P0, 12), pw1[3] = D2_PKW(P0, 14), pw1); \
    D2_VRD(4, D2_ORD(4)); D2_SBAR(); D2_GAPA(C0 = __builtin_amdgcn_mfma_f32_32x32x16_bf16(kf[4], qr[2], C0, 0, 0, 0),       P1[2], P1[3], P1[4], P1[5],     pw2[0] = D2_PKW(P1, 0), pw2[1] = D2_PKW(P1, 2), pw2); \
    D2_VRD(5, D2_ORD(5)); D2_SBAR(); D2_GAPA(C1 = __builtin_amdgcn_mfma_f32_32x32x16_bf16(kf[5], qr[2], C1, 0, 0, 0),       P1[6], P1[7], P1[8], P1[9],     pw2[2] = D2_PKW(P1, 4), pw2[3] = D2_PKW(P1, 6), pw2); \
    D2_VRD(6, D2_ORD(6)); D2_SBAR(); D2_GAPA(C0 = __builtin_amdgcn_mfma_f32_32x32x16_bf16(kf[6], qr[3], C0, 0, 0, 0),       P1[10], P1[11], P1[12], P1[13], pw3[0] = D2_PKW(P1, 8), pw3[1] = D2_PKW(P1, 10), pw3); \
    D2_VRD(7, D2_ORD(7)); D2_SBAR(); D2_GAPA(C1 = __builtin_amdgcn_mfma_f32_32x32x16_bf16(kf[7], qr[3], C1, 0, 0, 0),       P1[14], P1[15], 0.f, 0.f,       pw3[2] = D2_PKW(P1, 12), pw3[3] = D2_PKW(P1, 14), pw3); \
    l_reg += sacc; \
    if (GK) { D2_DMA_K((t) + 3, sl_cur); } if (GV) { D2_DMA_V((t) + 1, sl_next); } \
    D2_SBAR(); \
    D2_GAPB(o[0] = __builtin_amdgcn_mfma_f32_32x32x16_bf16(D2_PAF(0), D2_VFR(0), o[0], 0, 0, 0), C0, 0);  D2_VRD(0, D2_ORD(8));  D2_SBAR(); \
    D2_GAPB(o[1] = __builtin_amdgcn_mfma_f32_32x32x16_bf16(D2_PAF(0), D2_VFR(1), o[1], 0, 0, 0), C0, 2);  D2_VRD(1, D2_ORD(9));  D2_SBAR(); \
    D2_GAPB(o[2] = __builtin_amdgcn_mfma_f32_32x32x16_bf16(D2_PAF(0), D2_VFR(2), o[2], 0, 0, 0), C0, 4);  D2_VRD(2, D2_ORD(10)); D2_SBAR(); \
    D2_GAPB(o[3] = __builtin_amdgcn_mfma_f32_32x32x16_bf16(D2_PAF(0), D2_VFR(3), o[3], 0, 0, 0), C0, 6);  D2_VRD(3, D2_ORD(11)); D2_SBAR(); \
    D2_KRD(GL, 0); D2_GAPB(o[0] = __builtin_amdgcn_mfma_f32_32x32x16_bf16(D2_PAF(1), D2_VFR(4), o[0], 0, 0, 0), C0, 8);  D2_VRD(4, D2_ORD(12)); D2_SBAR(); \
    D2_KRD(GL, 1); D2_GAPB(o[1] = __builtin_amdgcn_mfma_f32_32x32x16_bf16(D2_PAF(1), D2_VFR(5), o[1], 0, 0, 0), C0, 10); D2_VRD(5, D2_ORD(13)); D2_SBAR(); \
    D2_KRD(GL, 2); D2_GAPB(o[2] = __builtin_amdgcn_mfma_f32_32x32x16_bf16(D2_PAF(1), D2_VFR(6), o[2], 0, 0, 0), C0, 12); D2_VRD(6, D2_ORD(14)); D2_SBAR(); \
    D2_KRD(GL, 3); D2_GAPB(o[3] = __builtin_amdgcn_mfma_f32_32x32x16_bf16(D2_PAF(1), D2_VFR(7), o[3], 0, 0, 0), C0, 14); D2_VRD(7, D2_ORD(15)); D2_SBAR(); \
    D2_KRD(GL, 4); D2_GAPB(o[0] = __builtin_amdgcn_mfma_f32_32x32x16_bf16(D2_PAF(2), D2_VFR(0), o[0], 0, 0, 0), C1, 0); \
    D2_KRD(GL, 5); D2_GAPB(o[1] = __builtin_amdgcn_mfma_f32_32x32x16_bf16(D2_PAF(2), D2_VFR(1), o[1], 0, 0, 0), C1, 2); \
    D2_KRD(GL, 6); D2_GAPB(o[2] = __builtin_amdgcn_mfma_f32_32x32x16_bf16(D2_PAF(2), D2_VFR(2), o[2], 0, 0, 0), C1, 4); \
    D2_KRD(GL, 7); D2_GAPB(o[3] = __builtin_amdgcn_mfma_f32_32x32x16_bf16(D2_PAF(2), D2_VFR(3), o[3], 0, 0, 0), C1, 6); \
    D2_GAPB(o[0] = __builtin_amdgcn_mfma_f32_32x32x16_bf16(D2_PAF(3), D2_VFR(4), o[0], 0, 0, 0), C1, 8); \
    D2_GAPB(o[1] = __builtin_amdgcn_mfma_f32_32x32x16_bf16(D2_PAF(3), D2_VFR(5), o[1], 0, 0, 0), C1, 10); \
    D2_GAPB(o[2] = __builtin_amdgcn_mfma_f32_32x32x16_bf16(D2_PAF(3), D2_VFR(6), o[2], 0, 0, 0), C1, 12); \
    D2_GAPB(o[3] = __builtin_amdgcn_mfma_f32_32x32x16_bf16(D2_PAF(3), D2_VFR(7), o[3], 0, 0, 0), C1, 14); \
    } while (0)
    int t = 1;
    for (; t + 5 < NT; t += 2) {
        D2_STEP(pB0, pB1, pA0, pA1, t, true, true, true);     D2_WAIT_BAR(4); D2_ROT();
        D2_STEP(pA0, pA1, pB0, pB1, t + 1, true, true, true); D2_WAIT_BAR(4); D2_ROT();
    }
#define D2_ENDW(tt) do { if ((tt) + 3 < NT) { D2_WAIT_BAR(4); } else if ((tt) + 2 < NT) { D2_WAIT_BAR(2); } else { D2_WAIT_BAR(0); } } while (0)
    for (; t + 1 < NT; t += 2) {
        D2_STEP(pB0, pB1, pA0, pA1, t, (t + 3 < NT), (t + 1 < NT), (t + 1 < NT));         D2_ENDW(t);     D2_ROT();
        D2_STEP(pA0, pA1, pB0, pB1, t + 1, (t + 4 < NT), (t + 2 < NT), (t + 2 < NT));     D2_ENDW(t + 1); D2_ROT();
    }
    D2_STEP(pB0, pB1, pA0, pA1, NT - 1, false, false, false);
    { float sacc = pB0[0] + pB0[1];
#pragma unroll
      for (int r = 2; r < 16; ++r) sacc += pB0[r];
#pragma unroll
      for (int r = 0; r < 16; ++r) sacc += pB1[r];
      l_reg += sacc;
      pw0 = (u32x4){D2_PKW(pB0, 0), D2_PKW(pB0, 2), D2_PKW(pB0, 4), D2_PKW(pB0, 6)}; pw1 = (u32x4){D2_PKW(pB0, 8), D2_PKW(pB0, 10), D2_PKW(pB0, 12), D2_PKW(pB0, 14)};
      pw2 = (u32x4){D2_PKW(pB1, 0), D2_PKW(pB1, 2), D2_PKW(pB1, 4), D2_PKW(pB1, 6)}; pw3 = (u32x4){D2_PKW(pB1, 8), D2_PKW(pB1, 10), D2_PKW(pB1, 12), D2_PKW(pB1, 14)};
      D2_SBAR();
      const lcp vp_ = vp0 + sl_cur;
#pragma unroll
      for (int d0 = 0; d0 < 4; ++d0) {
#pragma unroll
          for (int ks = 0; ks < 4; ++ks) { vlo[ks] = vtr(vp_ + (d0 * 4096 + ks * 1024)); vhi[ks] = vtr(vp_ + (d0 * 4096 + ks * 1024 + 512)); }
          o[d0] = __builtin_amdgcn_mfma_f32_32x32x16_bf16(D2_PAF(0), D2_VFR(0), o[d0], 0, 0, 0); o[d0] = __builtin_amdgcn_mfma_f32_32x32x16_bf16(D2_PAF(1), D2_VFR(1), o[d0], 0, 0, 0);
          o[d0] = __builtin_amdgcn_mfma_f32_32x32x16_bf16(D2_PAF(2), D2_VFR(2), o[d0], 0, 0, 0); o[d0] = __builtin_amdgcn_mfma_f32_32x32x16_bf16(D2_PAF(3), D2_VFR(3), o[d0], 0, 0, 0); } }
    { auto rr = __builtin_amdgcn_permlane32_swap(__float_as_uint(l_reg), __float_as_uint(l_reg), false, false); l_reg = __uint_as_float(rr[0]) + __uint_as_float(rr[1]); }
    if (hi == 0) wsf[32 + r32] = l_reg; asm volatile("s_waitcnt lgkmcnt(0)" ::: "memory");
    {
#pragma unroll
      for (int r = 0; r < 16; ++r) { const float rl = __builtin_amdgcn_rcpf(wsf[32 + crow(r, hi)]);
#pragma unroll
          for (int d0 = 0; d0 < 4; ++d0) o[d0][r] *= rl; } }
    const int bad = (l_reg > 1.0e-30f && l_reg < 1.0e30f) ? 0 : 1;
    LAS int* flg = (LAS int*)(lds + LDS_WS + 8 * 256);
    { const int anyb = (__ballot(bad) != 0ull) ? 1 : 0; if (lane == 0) flg[wid] = anyb; }
    __syncthreads();
    { int f = 0;
#pragma unroll
      for (int q = 0; q < 8; ++q) f |= flg[q];
      if (__builtin_amdgcn_readfirstlane(f)) { __syncthreads(); return false; } }
    LAS float* xb = (LAS float*)lds;
    if (comp == 1) {
#pragma unroll
        for (int d0 = 0; d0 < 4; ++d0)
#pragma unroll
            for (int r = 0; r < 16; ++r) xb[((qw * 64) + d0 * 16 + r) * 64 + lane] = o[d0][r];
    }
    __syncthreads();
    if (comp == 0) {
        float ssq[16];
#pragma unroll
        for (int r = 0; r < 16; ++r) ssq[r] = 0.f;
#pragma unroll
        for (int d0 = 0; d0 < 4; ++d0)
#pragma unroll
            for (int r = 0; r < 16; ++r) { const float x = o[d0][r] - lam * xb[((qw * 64) + d0 * 16 + r) * 64 + lane]; o[d0][r] = x; ssq[r] += x * x; }
#pragma unroll
        for (int r = 0; r < 16; ++r) {
#pragma unroll
            for (int off = 16; off >= 1; off >>= 1) ssq[r] += __shfl_xor(ssq[r], off);
            ssq[r] = rsqrtf(ssq[r] * (1.0f / 128.f) + 1e-5f) * oscale; }
        asm volatile("" ::: "memory");
        LAS char* stg = lds + qw * 16384;
#pragma unroll
        for (int d0 = 0; d0 < 4; ++d0) { const float g = subln[d0 * 32 + r32];
#pragma unroll
            for (int r = 0; r < 16; ++r) *(LAS bf16_t*)(stg + crow(r, hi) * 272 + (d0 * 32 + r32) * 2) = f2bf(o[d0][r] * ssq[r] * g); }
        asm volatile("s_waitcnt lgkmcnt(0)" ::: "memory");
        bf16_t* Ow = cat + (size_t)(qrow0 + qw * 32) * DA_W + h * 128;
#pragma unroll
        for (int q = 0; q < 8; ++q) { const int id = q * 64 + lane, row = id >> 4, c16 = id & 15; *(u32x4*)(Ow + (size_t)row * DA_W + c16 * 8) = *(const LAS u32x4*)(stg + row * 272 + c16 * 16); }
    }
    __syncthreads();
    return true;
#undef D2_DMA_K
#undef D2_DMA_V
#undef D2_ROT
#undef D2_STEP
#undef D2_ENDW
}
}
namespace da {
constexpr int KVBLK = 64;
constexpr int SHM_V = KVBLK * 128 * 2, SHM_K = KVBLK * 128 * 2;
constexpr float THR2 = 11.5f;
#define DA_KSWZ(row, colB) ((row) * 256 + ((colB) ^ (((row) & 7) << 4)))
#define DA_SBAR() __builtin_amdgcn_sched_barrier(0)
__device__ __forceinline__ unsigned cvtpk_a(float lo, float hi) { unsigned r; asm volatile("v_cvt_pk_bf16_f32 %0, %1, %2" : "=v"(r) : "v"(lo), "v"(hi)); return r; }
__device__ __forceinline__ void partialSM(f32x16& p0, f32x16& p1, float& m_reg, float& alpha) {
    float pmax = p0[0];
#pragma unroll
    for (int r = 1; r < 16; ++r) pmax = fmaxf(pmax, p0[r]);
#pragma unroll
    for (int r = 0; r < 16; ++r) pmax = fmaxf(pmax, p1[r]);
    { auto rr = __builtin_amdgcn_permlane32_swap(__float_as_uint(pmax), __float_as_uint(pmax), false, false); pmax = fmaxf(__uint_as_float(rr[0]), __uint_as_float(rr[1])); }
    float mn;
    if (__builtin_expect(__all(pmax - m_reg <= THR2), 1)) { mn = m_reg; alpha = 1.f; }
    else { mn = fmaxf(m_reg, pmax); alpha = __builtin_amdgcn_exp2f(m_reg - mn); m_reg = mn; }
#pragma unroll
    for (int r = 0; r < 16; ++r) { p0[r] -= mn; p1[r] -= mn; }
#pragma unroll
    for (int r = 0; r < 16; ++r) p0[r] = __builtin_amdgcn_exp2f(p0[r]);
}
__device__ __forceinline__ void partialSM_fast(f32x16& p0, f32x16& p1, float& l_reg) {
#pragma unroll
    for (int r = 0; r < 16; ++r) p0[r] = __builtin_amdgcn_exp2f(p0[r]);
#pragma unroll
    for (int r = 0; r < 16; ++r) p1[r] = __builtin_amdgcn_exp2f(p1[r]);
    float ps = 0;
#pragma unroll
    for (int r = 0; r < 16; ++r) ps += p0[r];
#pragma unroll
    for (int r = 0; r < 16; ++r) ps += p1[r];
    l_reg += ps;
}
__device__ __forceinline__ void finishSM_fast(f32x16& p0, f32x16& p1, bf16x8& pa0, bf16x8& pa1, bf16x8& pa2, bf16x8& pa3) {
#define DA_PK4(P, BASE, OUT) do { unsigned a0 = cvtpk_a(P[BASE + 0], P[BASE + 1]), a1 = cvtpk_a(P[BASE + 2], P[BASE + 3]);   \
    unsigned b0 = cvtpk_a(P[BASE + 4], P[BASE + 5]), b1 = cvtpk_a(P[BASE + 6], P[BASE + 7]);                              \
    auto r0 = __builtin_amdgcn_permlane32_swap(a0, b0, false, false); auto r1 = __builtin_amdgcn_permlane32_swap(a1, b1, false, false); \
    u32x4 w = {r0[0], r1[0], r0[1], r1[1]}; OUT = *reinterpret_cast<bf16x8*>(&w); } while (0)
    DA_PK4(p0, 0, pa0); DA_PK4(p0, 8, pa1); DA_PK4(p1, 0, pa2); DA_PK4(p1, 8, pa3);
#undef DA_PK4
}
__device__ __forceinline__ void finishSM(f32x16& p0, f32x16& p1, float alpha, float& l_reg, bf16x8& pa0, bf16x8& pa1, bf16x8& pa2, bf16x8& pa3) {
#pragma unroll
    for (int r = 0; r < 16; ++r) p1[r] = __builtin_amdgcn_exp2f(p1[r]);
    float ps = 0;
#pragma unroll
    for (int r = 0; r < 16; ++r) ps += p0[r];
#pragma unroll
    for (int r = 0; r < 16; ++r) ps += p1[r];
    { auto rr = __builtin_amdgcn_permlane32_swap(__float_as_uint(ps), __float_as_uint(ps), false, false); ps = __uint_as_float(rr[0]) + __uint_as_float(rr[1]); }
    l_reg = l_reg * alpha + ps;
#define DA_PK4(P, BASE, OUT) do { unsigned a0 = cvtpk_a(P[BASE + 0], P[BASE + 1]), a1 = cvtpk_a(P[BASE + 2], P[BASE + 3]);   \
    unsigned b0 = cvtpk_a(P[BASE + 4], P[BASE + 5]), b1 = cvtpk_a(P[BASE + 6], P[BASE + 7]);                              \
    auto r0 = __builtin_amdgcn_permlane32_swap(a0, b0, false, false); auto r1 = __builtin_amdgcn_permlane32_swap(a1, b1, false, false); \
    u32x4 w = {r0[0], r1[0], r0[1], r1[1]}; OUT = *reinterpret_cast<bf16x8*>(&w); } while (0)
    DA_PK4(p0, 0, pa0); DA_PK4(p0, 8, pa1); DA_PK4(p1, 0, pa2); DA_PK4(p1, 8, pa3);
#undef DA_PK4
}
__device__ __forceinline__ void qkt(f32x16& p0, f32x16& p1, const LAS char* Ks, const bf16x8* qr, int r32, int hi, int comp) {
    p0 = f32x16{}; p1 = f32x16{};
#pragma unroll
    for (int d0 = 0; d0 < 4; ++d0) { const int cb = (comp * 64 + d0 * 16 + hi * 8) * 2;
        const bf16x8 b0 = *(const LAS bf16x8*)(Ks + DA_KSWZ(r32, cb));
        const bf16x8 b1 = *(const LAS bf16x8*)(Ks + DA_KSWZ(32 + r32, cb));
        p0 = __builtin_amdgcn_mfma_f32_32x32x16_bf16(b0, qr[d0], p0, 0, 0, 0);
        p1 = __builtin_amdgcn_mfma_f32_32x32x16_bf16(b1, qr[d0], p1, 0, 0, 0); }
}
__device__ __forceinline__ int v_st(int k, int c) { const int kk = (k & ~0xC) | ((k & 4) << 1) | ((k & 8) >> 1); return ((kk >> 3) * 4 + (c >> 5)) * 512 + ((kk & 7) * 32 + (c & 31)) * 2; }
__device__ __forceinline__ int v_rd_base(int lane) { return ((lane & 3) << 3) | (((lane >> 2) & 3) << 6) | (((lane >> 4) & 1) << 5) | (((lane >> 5) & 1) << 8); }
constexpr int v_rd_off(int d0, int ks, int half) { return d0 * 512 + ks * 4096 + half * 2048; }
template <int OFF> __device__ __forceinline__ s16x4 tr_read(int vb) { s16x4 r; asm volatile("ds_read_b64_tr_b16 %0, %1 offset:%2" : "=&v"(r) : "v"(vb), "i"(OFF) : "memory"); return r; }
template <int D0> __device__ __forceinline__ void pv_one(f32x16& od, int vb, bf16x8 pa0, bf16x8 pa1, bf16x8 pa2, bf16x8 pa3) {
    const s16x4 l0 = tr_read<v_rd_off(D0, 0, 0)>(vb), h0 = tr_read<v_rd_off(D0, 0, 1)>(vb), l1 = tr_read<v_rd_off(D0, 1, 0)>(vb), h1 = tr_read<v_rd_off(D0, 1, 1)>(vb);
    const s16x4 l2 = tr_read<v_rd_off(D0, 2, 0)>(vb), h2 = tr_read<v_rd_off(D0, 2, 1)>(vb), l3 = tr_read<v_rd_off(D0, 3, 0)>(vb), h3 = tr_read<v_rd_off(D0, 3, 1)>(vb);
    asm volatile("s_waitcnt lgkmcnt(0)" ::: "memory"); DA_SBAR();
#define DA_PK(L, H) (bf16x8){L[0], L[1], L[2], L[3], H[0], H[1], H[2], H[3]}
    od = __builtin_amdgcn_mfma_f32_32x32x16_bf16(pa0, DA_PK(l0, h0), od, 0, 0, 0);
    od = __builtin_amdgcn_mfma_f32_32x32x16_bf16(pa1, DA_PK(l1, h1), od, 0, 0, 0);
    od = __builtin_amdgcn_mfma_f32_32x32x16_bf16(pa2, DA_PK(l2, h2), od, 0, 0, 0);
    od = __builtin_amdgcn_mfma_f32_32x32x16_bf16(pa3, DA_PK(l3, h3), od, 0, 0, 0);
#undef DA_PK
}
__device__ __forceinline__ void pv_d0(f32x16* o, int vb, bf16x8 pa0, bf16x8 pa1, bf16x8 pa2, bf16x8 pa3) {
    pv_one<0>(o[0], vb, pa0, pa1, pa2, pa3); pv_one<1>(o[1], vb, pa0, pa1, pa2, pa3); pv_one<2>(o[2], vb, pa0, pa1, pa2, pa3); pv_one<3>(o[3], vb, pa0, pa1, pa2, pa3);
}

#define DA_PKV(L, H) (bf16x8){L[0], L[1], L[2], L[3], H[0], H[1], H[2], H[3]}
#define DA_TRSET(D0, l0, h0, l1, h1, l2, h2, l3, h3) do { if (VAR == 3) { l0 = h0 = l1 = h1 = l2 = h2 = l3 = h3 = (s16x4){1, 2, 3, 4}; break; } l0 = tr_read<v_rd_off(D0, 0, 0)>(vb); h0 = tr_read<v_rd_off(D0, 0, 1)>(vb); l1 = tr_read<v_rd_off(D0, 1, 0)>(vb); h1 = tr_read<v_rd_off(D0, 1, 1)>(vb); \
    l2 = tr_read<v_rd_off(D0, 2, 0)>(vb); h2 = tr_read<v_rd_off(D0, 2, 1)>(vb); l3 = tr_read<v_rd_off(D0, 3, 0)>(vb); h3 = tr_read<v_rd_off(D0, 3, 1)>(vb); } while (0)
#define DA_EX2(P, I) do { if (VAR != 1) { P[I] = __builtin_amdgcn_exp2f(P[I]); P[I + 1] = __builtin_amdgcn_exp2f(P[I + 1]); } } while (0)
#define DA_MF(OD, A, B) do { if (VAR != 2) OD = __builtin_amdgcn_mfma_f32_32x32x16_bf16(A, B, OD, 0, 0, 0); else asm volatile("" :: "v"(B)); } while (0)
#define DA_BLK(OD, PA0, PA1, PA2, PA3, l0, h0, l1, h1, l2, h2, l3, h3, P, I) do { \
    DA_MF(OD, PA0, DA_PKV(l0, h0)); DA_EX2(P, I);     DA_SBAR(); \
    DA_MF(OD, PA1, DA_PKV(l1, h1)); DA_EX2(P, I + 2); DA_SBAR(); \
    DA_MF(OD, PA2, DA_PKV(l2, h2)); DA_EX2(P, I + 4); DA_SBAR(); \
    DA_MF(OD, PA3, DA_PKV(l3, h3)); DA_EX2(P, I + 6); DA_SBAR(); } while (0)
template <int VAR>
__device__ __forceinline__ void pv_fast(f32x16* o, int vb, bf16x8 pa0, bf16x8 pa1, bf16x8 pa2, bf16x8 pa3, f32x16& n0, f32x16& n1, float& l_reg) {
    s16x4 al0, ah0, al1, ah1, al2, ah2, al3, ah3, bl0, bh0, bl1, bh1, bl2, bh2, bl3, bh3;
    DA_TRSET(0, al0, ah0, al1, ah1, al2, ah2, al3, ah3);
    asm volatile("s_waitcnt lgkmcnt(0)" ::: "memory"); DA_SBAR();
    DA_TRSET(1, bl0, bh0, bl1, bh1, bl2, bh2, bl3, bh3); DA_SBAR();
    DA_BLK(o[0], pa0, pa1, pa2, pa3, al0, ah0, al1, ah1, al2, ah2, al3, ah3, n0, 0);
    asm volatile("s_waitcnt lgkmcnt(0)" ::: "memory"); DA_SBAR();
    DA_TRSET(2, al0, ah0, al1, ah1, al2, ah2, al3, ah3); DA_SBAR();
    DA_BLK(o[1], pa0, pa1, pa2, pa3, bl0, bh0, bl1, bh1, bl2, bh2, bl3, bh3, n0, 8);
    asm volatile("s_waitcnt lgkmcnt(0)" ::: "memory"); DA_SBAR();
    DA_TRSET(3, bl0, bh0, bl1, bh1, bl2, bh2, bl3, bh3); DA_SBAR();
    DA_BLK(o[2], pa0, pa1, pa2, pa3, al0, ah0, al1, ah1, al2, ah2, al3, ah3, n1, 0);
    asm volatile("s_waitcnt lgkmcnt(0)" ::: "memory"); DA_SBAR();
    DA_BLK(o[3], pa0, pa1, pa2, pa3, bl0, bh0, bl1, bh1, bl2, bh2, bl3, bh3, n1, 8);
    float ps = 0;
#pragma unroll
    for (int r = 0; r < 16; ++r) ps += n0[r];
#pragma unroll
    for (int r = 0; r < 16; ++r) ps += n1[r];
    l_reg += ps;
}
template <bool FAST, int VAR = 0>
__device__ __forceinline__ bool attn_unit(LAS char* lds, const bf16_t* proj, bf16_t* cat, int h, int qrow0, int nkeys, float lam, float oscale, const float* subln) {
    constexpr int LD = DA_IN;
    const int tid = opaque((int)threadIdx.x), wid = __builtin_amdgcn_readfirstlane(tid >> 6), lane = tid & 63, r32 = lane & 31, hi = lane >> 5, comp = wid >> 2, qw = wid & 3;
    LAS char* V_lds = lds; LAS char* K_lds = lds + 2 * SHM_V;
    LAS float* ws = (LAS float*)(lds + 2 * SHM_V + 2 * SHM_K) + wid * 64; LAS float* li_l = ws; LAS float* al_l = ws + 32;
    float m_reg = -1e30f, l_reg = 0; f32x16 o[4] = {}; bf16x8 qr[4];
    const bf16_t* Qw = proj + (size_t)(qrow0 + qw * 32 + r32) * LD + h * 128 + comp * 64 + hi * 8;
#pragma unroll
    for (int d0 = 0; d0 < 4; ++d0) qr[d0] = *reinterpret_cast<const bf16x8*>(Qw + d0 * 16);
    const bf16_t* Kh = proj + 1024 + h * 128; const bf16_t* Vh = proj + 2048 + h * 128;
    const int sr = tid >> 4, sc = (tid & 15) * 8, vst0 = v_st(sr, sc), vst1 = v_st(32 + sr, sc);
    const int vb0 = (int)(unsigned)(uintptr_t)V_lds + v_rd_base(lane);
    struct { bf16x8 vs0, vs1, ks0, ks1; } sr_[2];
#define DA_SLOAD(i, k0) do { if (VAR == 4) break; sr_[i].vs0 = *(const bf16x8*)(&Vh[(size_t)((k0) + sr) * LD + sc]); sr_[i].vs1 = *(const bf16x8*)(&Vh[(size_t)((k0) + 32 + sr) * LD + sc]); \
    sr_[i].ks0 = *(const bf16x8*)(&Kh[(size_t)((k0) + sr) * LD + sc]); sr_[i].ks1 = *(const bf16x8*)(&Kh[(size_t)((k0) + 32 + sr) * LD + sc]); } while (0)
#define DA_SWRITE(b, i) do { if (VAR == 4) break; *(LAS bf16x8*)(V_lds + (b) * SHM_V + vst0) = sr_[i].vs0; *(LAS bf16x8*)(V_lds + (b) * SHM_V + vst1) = sr_[i].vs1; const int kc = sc * 2; \
    *(LAS bf16x8*)(K_lds + (b) * SHM_K + DA_KSWZ(sr, kc)) = sr_[i].ks0; *(LAS bf16x8*)(K_lds + (b) * SHM_K + DA_KSWZ(32 + sr, kc)) = sr_[i].ks1; } while (0)
#define DA_SWAIT() asm volatile("s_waitcnt vmcnt(4)" ::: "memory")
#define DA_RESC(a) do { if (__any((a) < 1.f)) { if (hi == 0) al_l[r32] = (a); asm volatile("s_waitcnt lgkmcnt(0)" ::: "memory"); \
    _Pragma("unroll") for (int d = 0; d < 4; ++d) _Pragma("unroll") for (int r = 0; r < 16; ++r) o[d][r] *= al_l[crow(r, hi)]; } } while (0)
    f32x16 pA0, pA1, pB0, pB1; float alA, alB; bf16x8 pa0, pa1, pa2, pa3; const int NT = nkeys / KVBLK;
#define DA_PSM(P0, P1, AL) do { if (FAST) { partialSM_fast(P0, P1, l_reg); AL = 1.f; } else partialSM(P0, P1, m_reg, AL); } while (0)
#define DA_PVS(VB, P0, P1, AL) do { if (FAST) { pv_fast<VAR>(o, VB, pa0, pa1, pa2, pa3, P0, P1, l_reg); AL = 1.f; } else { pv_d0(o, VB, pa0, pa1, pa2, pa3); partialSM(P0, P1, m_reg, AL); } } while (0)
#define DA_FSM(P0, P1, AL) do { if (FAST) finishSM_fast(P0, P1, pa0, pa1, pa2, pa3); else finishSM(P0, P1, AL, l_reg, pa0, pa1, pa2, pa3); } while (0)
#define DA_RESCX(a) do { if (!FAST) { DA_RESC(a); } } while (0)
    DA_SLOAD(0, 0); asm volatile("s_waitcnt vmcnt(0)" ::: "memory"); DA_SWRITE(0, 0); __syncthreads();
    qkt(pA0, pA1, K_lds, qr, r32, hi, comp); DA_PSM(pA0, pA1, alA);
    DA_SLOAD(1, KVBLK); if (2 < NT) DA_SLOAD(0, 2 * KVBLK);
    DA_SWAIT(); DA_SWRITE(1, 1); __syncthreads();
#define DA_SYNC() do { if (VAR != 5) __syncthreads(); } while (0)
#define DA_QKT(P0, P1, KS) do { if (VAR != 6) qkt(P0, P1, KS, qr, r32, hi, comp); else { P0 = f32x16{}; P1 = f32x16{}; } } while (0)
    for (int j = 1; j + 1 < NT; j += 2) {
        DA_SBAR(); DA_QKT(pB0, pB1, K_lds + SHM_K);
        DA_FSM(pA0, pA1, alA); DA_SBAR();
        DA_SLOAD(1, (j + 2) * KVBLK); DA_SBAR();
        DA_PVS(vb0, pB0, pB1, alB);
        DA_SYNC(); DA_SWAIT(); DA_SWRITE(0, 0);
        DA_RESCX(alB); DA_SYNC();
        DA_SBAR(); DA_QKT(pA0, pA1, K_lds);
        DA_FSM(pB0, pB1, alB); DA_SBAR();
        { const int tn = (j + 3 < NT) ? (j + 3) : (NT - 1); DA_SLOAD(0, tn * KVBLK); } DA_SBAR();
        DA_PVS(vb0 + SHM_V, pA0, pA1, alA);
        DA_SYNC(); DA_SWAIT(); DA_SWRITE(1, 1);
        DA_RESCX(alA); DA_SYNC();
    }
    DA_SBAR(); qkt(pB0, pB1, K_lds + SHM_K, qr, r32, hi, comp);
    DA_FSM(pA0, pA1, alA); DA_SBAR();
    DA_PVS(vb0, pB0, pB1, alB);
    __syncthreads(); DA_RESCX(alB);
    DA_FSM(pB0, pB1, alB); DA_SBAR();
    pv_d0(o, vb0 + SHM_V, pa0, pa1, pa2, pa3);
#undef DA_PSM
#undef DA_FSM
#undef DA_PVS
#undef DA_SYNC
#undef DA_QKT
    if (FAST) { auto rr = __builtin_amdgcn_permlane32_swap(__float_as_uint(l_reg), __float_as_uint(l_reg), false, false); l_reg = __uint_as_float(rr[0]) + __uint_as_float(rr[1]); }
#undef DA_RESCX
    if (hi == 0) li_l[r32] = l_reg; asm volatile("s_waitcnt lgkmcnt(0)" ::: "memory");
    float rli[16];
#pragma unroll
    for (int r = 0; r < 16; ++r) rli[r] = __builtin_amdgcn_rcpf(li_l[crow(r, hi)]);
#pragma unroll
    for (int d0 = 0; d0 < 4; ++d0)
#pragma unroll
        for (int r = 0; r < 16; ++r) o[d0][r] *= rli[r];
    {   const int bad = (l_reg > 1.0e-30f && l_reg < 1.0e30f) ? 0 : 1;
        (void)bad; __syncthreads(); }
    LAS float* xb = (LAS float*)lds;
    if (comp == 1) {
#pragma unroll
        for (int d0 = 0; d0 < 4; ++d0)
#pragma unroll
            for (int r = 0; r < 16; ++r) xb[((qw * 64) + d0 * 16 + r) * 64 + lane] = o[d0][r];
    }
    __syncthreads();
    if (comp == 0) {
        float ssq[16];
#pragma unroll
        for (int r = 0; r < 16; ++r) ssq[r] = 0.f;
#pragma unroll
        for (int d0 = 0; d0 < 4; ++d0)
#pragma unroll
            for (int r = 0; r < 16; ++r) { const float x = o[d0][r] - lam * xb[((qw * 64) + d0 * 16 + r) * 64 + lane]; o[d0][r] = x; ssq[r] += x * x; }
#pragma unroll
        for (int r = 0; r < 16; ++r) {
#pragma unroll
            for (int off = 16; off >= 1; off >>= 1) ssq[r] += __shfl_xor(ssq[r], off);
            ssq[r] = rsqrtf(ssq[r] * (1.0f / 128.f) + 1e-5f) * oscale; }
        asm volatile("" ::: "memory");
        LAS char* stg = lds + qw * 16384;
#pragma unroll
        for (int d0 = 0; d0 < 4; ++d0) { const float g = subln[d0 * 32 + r32];
#pragma unroll
            for (int r = 0; r < 16; ++r) *(LAS bf16_t*)(stg + crow(r, hi) * 272 + (d0 * 32 + r32) * 2) = f2bf(o[d0][r] * ssq[r] * g); }
        asm volatile("s_waitcnt lgkmcnt(0)" ::: "memory");
        bf16_t* Ow = cat + (size_t)(qrow0 + qw * 32) * DA_W + h * 128;
#pragma unroll
        for (int q = 0; q < 8; ++q) { const int id = q * 64 + lane, row = id >> 4, c16 = id & 15; *(u32x4*)(Ow + (size_t)row * DA_W + c16 * 8) = *(const LAS u32x4*)(stg + row * 272 + c16 * 16); }
    }
    __syncthreads();
    return true;
#undef DA_SLOAD
#undef DA_SWRITE
#undef DA_SWAIT
#undef DA_RESC
}
}

__device__ __forceinline__ void phase_attn(const Ctx& c, int jj, bool with_ctx) {
    PREF P = *c.p; const bf16_t* proj = (const bf16_t*)(c.ws + WS_PROJ); bf16_t* cat = (bf16_t*)(c.ws + WS_CAT);
    const float lam = ((const float*)(c.ws + WS_MISC))[jj * 2 + 0], linit = ((const float*)(c.ws + WS_MISC))[jj * 2 + 1];
    const float* subln = P.in[24] + (size_t)jj * 128;
    const int nunits = 1024 + (with_ctx ? 16 : 0);
    unsigned failed = 0u; int it = 0;
#pragma unroll 1
    for (int L = c.bid; L < nunits; L += c.G, ++it) {
        int h, q0, nk;
        if (L < 1024) { h = L & 7; q0 = NC + (L >> 3) * 128; nk = NTOK; } else { const int i = L - 1024; h = i & 7; q0 = (i >> 3) * 128; nk = NC; }
        if (!da2::attn_unit_dma((LAS char*)c.lds, proj, cat, h, q0, nk, lam, 1.0f - linit, subln)) failed |= 1u << (it & 31);
    }
    failed = (unsigned)__builtin_amdgcn_readfirstlane((int)failed);
    if (failed) {
        it = 0;
#pragma unroll 1
        for (int L = c.bid; L < nunits; L += c.G, ++it) {
            if (!((failed >> (it & 31)) & 1u)) continue;
            int h, q0, nk;
            if (L < 1024) { h = L & 7; q0 = NC + (L >> 3) * 128; nk = NTOK; } else { const int i = L - 1024; h = i & 7; q0 = (i >> 3) * 128; nk = NC; }
            (void)da::attn_unit<false>((LAS char*)c.lds, proj, cat, h, q0, nk, lam, 1.0f - linit, subln);
        }
    }
}
__device__ __forceinline__ MoeTable moe_table(const Ctx& c, int layer, int ntok_l) {
    LAS int* tb = (LAS int*)(c.lds + LDS_MISC + 64); LAS int* cn = (LAS int*)(c.lds + LDS_MISC + 512);
    const unsigned* cg = (const unsigned*)(c.ws + WS_CTL) + CW_CNT + c.cnt_off + layer * 64;
    __syncthreads();
    if (c.tid == 0) { int t = 0;
        for (int e = 0; e < 65; ++e) { const int n = (e < 64) ? (int)cg[e] : ntok_l; cn[e] = n; tb[e] = t; t += (n + 255) >> 8; }
        tb[65] = t; }
    __syncthreads();
    MoeTable r; r.tb = tb; r.cn = cn; return r;
}

__device__ __forceinline__ void phase_cvt_experts(const Ctx& c, int layer) {
    PREF P = *c.p; unsigned char* ws = c.ws;
    const float* wg = P.in[27] + (size_t)layer * 64 * 1024 * 256; const float* wu = P.in[28] + (size_t)layer * 64 * 1024 * 256; const float* wd = P.in[29] + (size_t)layer * 64 * 256 * 1024;
    const float* sg = P.in[30] + (size_t)layer * 1024 * 256; const float* su = P.in[31] + (size_t)layer * 1024 * 256; const float* sd = P.in[32] + (size_t)layer * 256 * 1024;
    bf16_t* WGU = (bf16_t*)(ws + WS_WGU); bf16_t* WD = (bf16_t*)(ws + WS_WD);
    unsigned* ctr = (unsigned*)(ws + WS_CTL) + CW_CVTQ + c.cnt_off + layer;
    LAS int* qs = (LAS int*)(c.lds + LDS_MISC + 1024);
    const int NT_ = 65 * 96, CH = 4;
    for (;;) {
        __syncthreads();
        if (c.tid == 0) qs[0] = (int)__hip_atomic_fetch_add(ctr, (unsigned)CH, __ATOMIC_RELAXED, __HIP_MEMORY_SCOPE_AGENT);
        __syncthreads();
        const int u0 = qs[0]; if (u0 >= NT_) break;
        for (int u = u0; u < u0 + CH && u < NT_; ++u) {
            const int e = u / 96, r = u % 96, kind = r >> 5, q = r & 31;
            if (kind == 0) { const float* src = (e < 64) ? wg + (size_t)e * 1024 * 256 : sg; cvt_tile128(c, src, 256, (q >> 2) * 128, (q & 3) * 64, WGU + (size_t)e * 512 * 1024, 1024, RowGate()); }
            else if (kind == 1) { const float* src = (e < 64) ? wu + (size_t)e * 1024 * 256 : su; cvt_tile128(c, src, 256, (q >> 2) * 128, (q & 3) * 64, WGU + (size_t)e * 512 * 1024, 1024, RowUp()); }
            else { const float* src = (e < 64) ? wd + (size_t)e * 256 * 1024 : sd; cvt_tile128(c, src, 1024, (q >> 4) * 128, (q & 15) * 64, WD + (size_t)e * 1024 * 256, 256, RowDown()); }
        }
    }
}

__device__ __forceinline__ void phase_p6(const Ctx& c, int layer, int tok0) {
    PREF P = *c.p; unsigned char* ws = c.ws; const int tid = c.tid, lane = c.lane, w = c.wid;
    const int ntok_l = NTOK - tok0, tpb = (ntok_l + c.G - 1) / c.G;
    const int tb0 = tok0 + c.bid * tpb, tb1 = (tb0 + tpb < NTOK) ? tb0 + tpb : NTOK; const int nloc = (tb1 > tb0) ? tb1 - tb0 : 0;
    LAS float* lg = (LAS float*)c.lds;
    LAS int* che = (LAS int*)(c.lds + 81920); LAS float* chw = (LAS float*)(c.lds + 87040);
    LAS int* cntl = (LAS int*)(c.lds + 92160); LAS int* basel = (LAS int*)(c.lds + 92416);
    if (tid < 64) cntl[tid] = 0;
    const float* xres = (const float*)(ws + WS_XRES); bf16_t* hB = (bf16_t*)(ws + WS_H); bf16_t* hL = (bf16_t*)(ws + WS_HLO);
    const float* gain = P.in[7] + (size_t)layer * D; const float* modl = (const float*)(ws + WS_MOD) + (size_t)layer * 2 * 6144;
    const bf16_t* wrh = (const bf16_t*)(ws + WS_WR) + (size_t)(layer * 2 + 0) * 64 * 1024; const bf16_t* wrl = wrh + 64 * 1024;
    const float* rbias = P.in[26] + (size_t)layer * 64;
#ifndef DUP_TOK
#define DUP_TOK 1
#endif
#ifndef DUP_TOKA
#define DUP_TOKA 1
#endif
#ifndef DUP_TOKB
#define DUP_TOKB 1
#endif
    _Pragma("unroll 1") for (int rept_ = 0; rept_ < DUP_TOK; ++rept_) {
    _Pragma("unroll 1") for (int repa_ = 0; repa_ < DUP_TOKA; ++repa_) {
#pragma unroll 1
    for (int tl0 = w * 4; tl0 < nloc; tl0 += 32) {
        f32x4 v[4][4]; float ss[4];
#pragma unroll
        for (int t = 0; t < 4; ++t) { const int tl = (tl0 + t < nloc) ? tl0 + t : nloc - 1; const float* x = xres + (size_t)(tb0 + tl) * D; ss[t] = 0.f;
#pragma unroll
            for (int q = 0; q < 4; ++q) { v[t][q] = *(const f32x4*)(x + q * 256 + lane * 4); ss[t] += v[t][q][0] * v[t][q][0] + v[t][q][1] * v[t][q][1] + v[t][q][2] * v[t][q][2] + v[t][q][3] * v[t][q][3]; } }
        ss[0] = wave_sum(ss[0]); ss[1] = wave_sum(ss[1]); ss[2] = wave_sum(ss[2]); ss[3] = wave_sum(ss[3]);
#pragma unroll
        for (int t = 0; t < 4; ++t) { if (tl0 + t < nloc) { const int row = tb0 + tl0 + t; const float* m = modl + ((row < NC) ? 6144 : 0); const float rstd = rsqrtf(ss[t] * (1.0f / 1024.f) + EPS);
#pragma unroll
            for (int q = 0; q < 4; ++q) { const int col = q * 256 + lane * 4;
                const f32x4 g = *(const f32x4*)(gain + col), sc = *(const f32x4*)(m + 4 * 1024 + col), sh = *(const f32x4*)(m + 3 * 1024 + col);
                float o[4], lo_[4];
#pragma unroll
                for (int k = 0; k < 4; ++k) { o[k] = v[t][q][k] * rstd * g[k] * (1.0f + sc[k]) + sh[k]; lo_[k] = o[k] - bf2f(f2bf(o[k])); }
                u32x2 wv; wv.x = cvtpk(o[0], o[1]); wv.y = cvtpk(o[2], o[3]);
                *(u32x2*)(hB + (size_t)row * D + col) = wv;
                u32x2 wl; wl.x = cvtpk(lo_[0], lo_[1]); wl.y = cvtpk(lo_[2], lo_[3]);
                *(u32x2*)(hL + (size_t)row * D + col) = wl; } } }
    }
    asm volatile("s_waitcnt vmcnt(0)" ::: "memory");
    __syncthreads();
    }
    _Pragma("unroll 1") for (int repb_ = 0; repb_ < DUP_TOKB; ++repb_) {
    {
        const int etp = w & 1, kq = w >> 1, fr = lane & 15, fq = lane >> 4; const int nmt = (nloc + 15) >> 4;
        f32x4 acc[5][2];
#pragma unroll
        for (int mt = 0; mt < 5; ++mt) { acc[mt][0] = (f32x4){0.f, 0.f, 0.f, 0.f}; acc[mt][1] = (f32x4){0.f, 0.f, 0.f, 0.f}; }
        const bf16_t* bh = wrh + (size_t)(etp * 32 + fr) * 1024 + kq * 256 + fq * 8; const bf16_t* bl = wrl + (size_t)(etp * 32 + fr) * 1024 + kq * 256 + fq * 8;
        size_t arow[5];
#pragma unroll
        for (int mt = 0; mt < 5; ++mt) { int tl = mt * 16 + fr; tl = (tl < nloc) ? tl : (nloc > 0 ? nloc - 1 : 0); arow[mt] = (size_t)(tb0 + tl) * D + kq * 256 + fq * 8; }
#pragma unroll 2
        for (int ks = 0; ks < 8; ++ks) {
            const bf16x8 vbh0 = *(const bf16x8*)(bh + ks * 32), vbl0 = *(const bf16x8*)(bl + ks * 32);
            const bf16x8 vbh1 = *(const bf16x8*)(bh + 16 * 1024 + ks * 32), vbl1 = *(const bf16x8*)(bl + 16 * 1024 + ks * 32);
#pragma unroll
            for (int mt = 0; mt < 5; ++mt) { if (mt < nmt) {
                const bf16x8 ah = *(const bf16x8*)(hB + arow[mt] + ks * 32), al = *(const bf16x8*)(hL + arow[mt] + ks * 32);
                acc[mt][0] = __builtin_amdgcn_mfma_f32_16x16x32_bf16(ah, vbh0, acc[mt][0], 0, 0, 0);
                acc[mt][0] = __builtin_amdgcn_mfma_f32_16x16x32_bf16(ah, vbl0, acc[mt][0], 0, 0, 0);
                acc[mt][0] = __builtin_amdgcn_mfma_f32_16x16x32_bf16(al, vbh0, acc[mt][0], 0, 0, 0);
                acc[mt][1] = __builtin_amdgcn_mfma_f32_16x16x32_bf16(ah, vbh1, acc[mt][1], 0, 0, 0);
                acc[mt][1] = __builtin_amdgcn_mfma_f32_16x16x32_bf16(ah, vbl1, acc[mt][1], 0, 0, 0);
                acc[mt][1] = __builtin_amdgcn_mfma_f32_16x16x32_bf16(al, vbh1, acc[mt][1], 0, 0, 0); } } }
#pragma unroll
        for (int mt = 0; mt < 5; ++mt)
#pragma unroll
            for (int e2 = 0; e2 < 2; ++e2)
#pragma unroll
                for (int r = 0; r < 4; ++r) lg[(kq * 80 + mt * 16 + fq * 4 + r) * 64 + etp * 32 + e2 * 16 + fr] = acc[mt][e2][r];
    }
    __syncthreads();
    }
    }
#pragma unroll 1
    for (int tl = w; tl < nloc; tl += 8) {
        const float logit = (lg[tl * 64 + lane] + lg[(80 + tl) * 64 + lane]) + (lg[(160 + tl) * 64 + lane] + lg[(240 + tl) * 64 + lane]);
        const float score = sigmoidf_(logit), choice = score + rbias[lane];
        float m1 = choice;
#pragma unroll
        for (int off = 1; off <= 4; off <<= 1) m1 = fmaxf(m1, __shfl_xor(m1, off));
        const unsigned long long bm = __ballot(choice == m1); const unsigned gb = (unsigned)(bm >> (lane & 56)) & 0xffu;
        const bool isfirst = ((lane & 7) == (__builtin_ctz(gb) & 7));
        float m2 = isfirst ? -INFINITY : choice;
#pragma unroll
        for (int off = 1; off <= 4; off <<= 1) m2 = fmaxf(m2, __shfl_xor(m2, off));
        const float gs = m1 + m2; const int g = lane >> 3; int grank = 0;
#pragma unroll
        for (int g2 = 0; g2 < 8; ++g2) { const float o = __shfl(gs, g2 * 8); grank += (o > gs || (o == gs && g2 < g)) ? 1 : 0; }
        const bool gsel = grank < 4; const float mc = gsel ? choice : -INFINITY; int erank = 0;
#pragma unroll 8
        for (int e2 = 0; e2 < 64; ++e2) { const float o = __shfl(mc, e2); erank += (o > mc || (o == mc && e2 < lane)) ? 1 : 0; }
        const bool sel = gsel && erank < 8;
        const float sw = wave_sum(sel ? score : 0.f);
        if (sel) { che[tl * 8 + erank] = lane; chw[tl * 8 + erank] = score / (sw + 1e-20f) * 2.5f; atomicAdd((int*)&cntl[lane], 1); }
    }
    __syncthreads();
    if (tid < 64) { const int n = cntl[tid]; unsigned* cg = (unsigned*)(ws + WS_CTL) + CW_CNT + c.cnt_off + layer * 64;
        basel[tid] = n ? (int)__hip_atomic_fetch_add(cg + tid, (unsigned)n, __ATOMIC_RELAXED, __HIP_MEMORY_SCOPE_AGENT) : 0; cntl[tid] = 0; }
    __syncthreads();
    int* ltok = (int*)(ws + WS_LTOK); float* lw = (float*)(ws + WS_LW); int* slot = (int*)(ws + WS_SLOT);
    for (int idx = tid; idx < nloc * 8; idx += NTHREADS) { const int tl = idx >> 3, e = che[idx]; const int pos = basel[e] + atomicAdd((int*)&cntl[e], 1);
        ltok[(size_t)e * NTOK + pos] = tb0 + tl; lw[(size_t)e * NTOK + pos] = chw[idx]; slot[(size_t)(tb0 + tl) * 8 + (idx & 7)] = (e << 20) | pos; }
    __syncthreads();
}

__device__ __forceinline__ void phase_p9(const Ctx& c, int layer, int tok0, const MoeTable& t) {
    PREF P = *c.p; unsigned char* ws = c.ws; const int lane = c.lane;
    float* xres = (float*)(ws + WS_XRES); const unsigned char* Y = (const unsigned char*)(ws + WS_YSLOT); const int* slot = (const int*)(ws + WS_SLOT);
    const float* modl = (const float*)(ws + WS_MOD) + (size_t)layer * 2 * 6144;
    const bool fin = (layer == DEPTH - 1);
    const float* gain = fin ? P.in[33] : P.in[6] + (size_t)(layer + 1) * D; const float* modn = (const float*)(ws + WS_MOD) + (size_t)(layer + 1) * 2 * 6144;
    bf16_t* hA = (bf16_t*)(ws + WS_H);
    const size_t shrow0 = (size_t)t.tb[64] * 256;
    const int col0 = lane * 16;
    for (int row = tok0 + c.bid * 8 + c.wid; row < NTOK; row += c.G * 8) {
        const int sl = (lane < 8) ? slot[(size_t)row * 8 + lane] : 0;
        float acc[16];
#pragma unroll
        for (int k = 0; k < 16; ++k) acc[k] = 0.f;
        u32x4 yv[9];
#pragma unroll
        for (int k = 0; k < 9; ++k) { size_t yr;
            if (k < 8) { const int s = __shfl(sl, k); yr = (size_t)t.tb[s >> 20] * 256 + (s & 0xfffff); } else yr = shrow0 + (size_t)(row - tok0);
            yv[k] = *(const u32x4*)(Y + yr * 1024 + col0); }
#pragma unroll
        for (int k = 0; k < 9; ++k) { const unsigned w4[4] = {yv[k].x, yv[k].y, yv[k].z, yv[k].w};
#pragma unroll
            for (int q = 0; q < 4; ++q) { const f32x2 a = __builtin_amdgcn_cvt_pk_f32_fp8((int)w4[q], false), b = __builtin_amdgcn_cvt_pk_f32_fp8((int)w4[q], true);
                acc[q * 4 + 0] += a[0]; acc[q * 4 + 1] += a[1]; acc[q * 4 + 2] += b[0]; acc[q * 4 + 3] += b[1]; } }
        const float* m = modl + ((row < NC) ? 6144 : 0) + 5 * 1024; float* x = xres + (size_t)row * D; float xn[16]; float ss = 0.f;
#pragma unroll
        for (int q = 0; q < 4; ++q) { const int col = col0 + q * 4; const f32x4 xv = *(const f32x4*)(x + col), g = *(const f32x4*)(m + col); f32x4 o;
#pragma unroll
            for (int k = 0; k < 4; ++k) { o[k] = xv[k] + g[k] * acc[q * 4 + k]; xn[q * 4 + k] = o[k]; ss += o[k] * o[k]; }
            *(f32x4*)(x + col) = o; }
        ss = wave_sum(ss); const float rstd = rsqrtf(ss * (1.0f / 1024.f) + EPS);
        if (fin) {
            float* out = P.out + (size_t)(row - NC) * D;
#pragma unroll
            for (int q = 0; q < 4; ++q) { const int col = col0 + q * 4; const f32x4 g = *(const f32x4*)(gain + col); f32x4 o;
#pragma unroll
                for (int k = 0; k < 4; ++k) o[k] = xn[q * 4 + k] * rstd * g[k];
                *(f32x4*)(out + col) = o; }
        } else {
            const float* mn = modn + ((row < NC) ? 6144 : 0); float o[16];
#pragma unroll
            for (int q = 0; q < 4; ++q) { const int col = col0 + q * 4; const f32x4 g = *(const f32x4*)(gain + col), sc = *(const f32x4*)(mn + 1024 + col), sh = *(const f32x4*)(mn + col);
#pragma unroll
                for (int k = 0; k < 4; ++k) o[q * 4 + k] = xn[q * 4 + k] * rstd * g[k] * (1.0f + sc[k]) + sh[k]; }
            u32x4 w0, w1; w0.x = cvtpk(o[0], o[1]); w0.y = cvtpk(o[2], o[3]); w0.z = cvtpk(o[4], o[5]); w0.w = cvtpk(o[6], o[7]);
            w1.x = cvtpk(o[8], o[9]); w1.y = cvtpk(o[10], o[11]); w1.z = cvtpk(o[12], o[13]); w1.w = cvtpk(o[14], o[15]);
            *(u32x4*)(hA + (size_t)row * D + col0) = w0; *(u32x4*)(hA + (size_t)row * D + col0 + 8) = w1;
        }
    }
}
#ifndef DUP_INPROJ
#define DUP_INPROJ 1
#endif
#ifndef DUP_ATTN
#define DUP_ATTN 1
#endif
#ifndef DUP_UP
#define DUP_UP 1
#endif
#ifndef DUP_DOWN
#define DUP_DOWN 1
#endif
#ifndef DUP_F
#define DUP_F 1
#endif
#ifndef DUP_HYCONV
#define DUP_HYCONV 1
#endif
#ifndef DUP_R1
#define DUP_R1 1
#endif
#ifndef DUP_R3
#define DUP_R3 1
#endif
#ifndef DUP_MISC
#define DUP_MISC 1
#endif
#ifndef DUP_PR
#define DUP_PR 1
#endif
#ifndef DUP_CVT
#define DUP_CVT 1
#endif
#define REPEAT(n) _Pragma("unroll 1") for (int rep_ = 0; rep_ < (n); ++rep_)
constexpr int NPHASE = 38;
__global__ void __launch_bounds__(NTHREADS, 2) fwd_kernel(Params prm) {
    extern __shared__ __attribute__((aligned(16))) unsigned char lds_raw[];
    const KParams kp0 = (KParams)__builtin_amdgcn_kernarg_segment_ptr();
    Ctx c; c.p = kp0; c.lds = (LAS unsigned char*)lds_raw; c.tid = threadIdx.x; c.lane = c.tid & 63; c.wid = __builtin_amdgcn_readfirstlane(c.tid >> 6); c.G = gridDim.x; c.bid = blockIdx.x; c.ws = kp0->ws;
    volatile LAS unsigned* misc = (volatile LAS unsigned*)(c.lds + LDS_MISC);
    if (c.tid < 4) misc[c.tid] = 0u;
    __syncthreads();
#ifdef PROBE_STOP
    const int lo = 0; int hi = PROBE_STOP; int cnt_off = 256;
#else
    const int lo = kp0->ph_lo, hi = kp0->ph_hi; const int cnt_off = 0;
#endif
    XcdBarrier bar; bar.bar = (unsigned*)(c.ws + WS_CTL) + CW_BAR; bar.x = 0; bar.st = misc;
    if (kp0->ph_hi - kp0->ph_lo > 1) bar = xcd_barrier_post((unsigned*)(c.ws + WS_CTL) + CW_BAR, misc);
#define IN(k) ((lo <= (k) && (k) < hi) && ((c.tid = opaque((int)threadIdx.x)), (c.lane = c.tid & 63), (c.wid = __builtin_amdgcn_readfirstlane(c.tid >> 6)), (c.p = opaque_kp(kp0)), (c.ws = c.p->ws), (ws = c.ws), (c.G = opaque_s((int)gridDim.x)), (c.bid = opaque_s((int)blockIdx.x)), true))
#define SEAM(k) do { if ((lo <= (k)) && ((k) + 1 < hi)) { bar.bar = (unsigned*)(opaque_kp(kp0)->ws + WS_CTL) + CW_BAR; xcd_barrier(bar); } } while (0)
    unsigned char* ws = c.ws;
#ifdef PROBE_STOP
#pragma unroll 1
    for (int pass = 0; pass < 2; ++pass) {
    if (pass == 1) { xcd_barrier(bar); hi = NPHASE; cnt_off = 0; }
#endif
    c.cnt_off = cnt_off;
#ifdef PROBE_STOP
    c.pass = pass;
#else
    c.pass = 1;
#endif
    if (IN(0)) { REPEAT(DUP_PR) phase_pr0(c); } SEAM(0);
    if (IN(1)) { REPEAT(DUP_PR) phase_pr1(c); } SEAM(1);
#pragma unroll 1
    for (int jj = 0; jj < 2; ++jj) {
        const int pb = 2 + jj * 18;
        { const int layer = 2 * jj;
        if (IN(pb + 0)) { REPEAT(DUP_F) phase_f1(c, jj); } SEAM(pb + 0);
        if (IN(pb + 1)) { REPEAT(DUP_F) phase_f2(c); } SEAM(pb + 1);
        if (IN(pb + 2)) {
            DenseSched S; S.init(ws + WS_H, (const bf16_t*)(ws + WS_WAB_IN) + (size_t)jj * AB_IN * 1024, 1024, 65, 18, 0, c.G, c.bid);
            EpiAbIn E{(bf16_t*)(ws + WS_PROJ), (const f32x2*)(ws + WS_ROPE)};
            REPEAT(DUP_INPROJ) pg8::gemm_phase<EpiAbIn, DenseSched, false>(c.lds, 1024, S, E); } SEAM(pb + 2);
        if (IN(pb + 3)) { REPEAT(DUP_R1) phase_r1(c, jj); REPEAT(DUP_MISC) phase_hyprep(c, jj); } SEAM(pb + 3);
        if (IN(pb + 4)) { REPEAT(DUP_HYCONV) phase_hyconv(c, jj); REPEAT(DUP_MISC) phase_scan(c, jj); } SEAM(pb + 4);
        if (IN(pb + 5)) { REPEAT(DUP_R3) phase_r3(c, jj); REPEAT(DUP_MISC) { phase_hytrans(c); phase_hyctx(c, jj); } } SEAM(pb + 5);
        if (IN(pb + 6)) {
            DenseSched S; S.init(ws + WS_CAT, (const bf16_t*)(ws + WS_WAB_OUT) + (size_t)jj * 1024 * AB_CAT, AB_CAT, 65, 4, 0, c.G, c.bid);
            EpiResid E{(float*)(ws + WS_XRES), (const float*)(ws + WS_MOD) + (size_t)layer * 2 * 6144};
            pg8::gemm_phase<EpiResid, DenseSched, false>(c.lds, AB_CAT, S, E);
            phase_cvt_experts(c, layer); } SEAM(pb + 6);
        if (IN(pb + 7)) { phase_p6(c, layer, 0); } SEAM(pb + 7);
        if (IN(pb + 8)) { const MoeTable t = moe_table(c, layer, NTOK);
            MoeUpSched S; S.t = t; S.H = (const char*)(ws + WS_H); S.W = (const char*)(ws + WS_WGU); S.ltok = (const int*)(ws + WS_LTOK); S.tok0 = 0; S.G = c.G; S.c = c.bid; S.nwg = t.tb[65] * 2;
            EpiSwiglu E{(bf16_t*)(ws + WS_ACT)};
            REPEAT(DUP_UP) pg8::gemm_phase<EpiSwiglu, MoeUpSched, true>(c.lds, 1024, S, E); } SEAM(pb + 8);
        if (IN(pb + 9)) { const MoeTable t = moe_table(c, layer, NTOK);
            MoeDownSched S; S.t = t; S.ACT = (const char*)(ws + WS_ACT); S.W = (const char*)(ws + WS_WD); S.G = c.G; S.c = c.bid; S.nwg = t.tb[65] * 4;
            EpiDown E{(unsigned char*)(ws + WS_YSLOT), (const float*)(ws + WS_LW), t, 0};
#ifdef PROBE_DOWN_NOEPI
            { EpiDown E0 = E; E0.skip = 1; pg8::gemm_phase<EpiDown, MoeDownSched, false>(c.lds, 256, S, E0); }
#endif
            REPEAT(DUP_DOWN) pg8::gemm_phase<EpiDown, MoeDownSched, false>(c.lds, 256, S, E); } SEAM(pb + 9);
        if (IN(pb + 10)) { const MoeTable t = moe_table(c, layer, NTOK); phase_p9(c, layer, 0, t); } SEAM(pb + 10);
        }
        { const int layer = 2 * jj + 1; const bool with_ctx = layer < DEPTH - 1; const int tok0 = with_ctx ? 0 : NC; const int pm0 = with_ctx ? 0 : 1;
        if (IN(pb + 11)) {
            DenseSched S; S.init(ws + WS_H, (const bf16_t*)(ws + WS_WDA_IN) + (size_t)jj * DA_IN * 1024, 1024, 65, 12, 0, c.G, c.bid);
            EpiDaIn E{(bf16_t*)(ws + WS_PROJ), (const f32x2*)(ws + WS_ROPE) + (256 * 32 + 64 * 32)};
            REPEAT(DUP_INPROJ) pg8::gemm_phase<EpiDaIn, DenseSched, false>(c.lds, 1024, S, E); } SEAM(pb + 11);
        if (IN(pb + 12)) { REPEAT(DUP_ATTN) phase_attn(c, jj, with_ctx); } SEAM(pb + 12);
        if (IN(pb + 13)) {
            DenseSched S; S.init(ws + WS_CAT, (const bf16_t*)(ws + WS_WDA_OUT) + (size_t)jj * 1024 * 1024, 1024, 65, 4, pm0, c.G, c.bid);
            EpiResid E{(float*)(ws + WS_XRES), (const float*)(ws + WS_MOD) + (size_t)layer * 2 * 6144};
            pg8::gemm_phase<EpiResid, DenseSched, false>(c.lds, 1024, S, E);
            phase_cvt_experts(c, layer); } SEAM(pb + 13);
        if (IN(pb + 14)) { phase_p6(c, layer, tok0); } SEAM(pb + 14);
        if (IN(pb + 15)) { const MoeTable t = moe_table(c, layer, NTOK - tok0);
            MoeUpSched S; S.t = t; S.H = (const char*)(ws + WS_H); S.W = (const char*)(ws + WS_WGU); S.ltok = (const int*)(ws + WS_LTOK); S.tok0 = tok0; S.G = c.G; S.c = c.bid; S.nwg = t.tb[65] * 2;
            EpiSwiglu E{(bf16_t*)(ws + WS_ACT)};
            REPEAT(DUP_UP) pg8::gemm_phase<EpiSwiglu, MoeUpSched, true>(c.lds, 1024, S, E); } SEAM(pb + 15);
        if (IN(pb + 16)) { const MoeTable t = moe_table(c, layer, NTOK - tok0);
            MoeDownSched S; S.t = t; S.ACT = (const char*)(ws + WS_ACT); S.W = (const char*)(ws + WS_WD); S.G = c.G; S.c = c.bid; S.nwg = t.tb[65] * 4;
            EpiDown E{(unsigned char*)(ws + WS_YSLOT), (const float*)(ws + WS_LW), t, 0};
#ifdef PROBE_DOWN_NOEPI
            { EpiDown E0 = E; E0.skip = 1; pg8::gemm_phase<EpiDown, MoeDownSched, false>(c.lds, 256, S, E0); }
#endif
            REPEAT(DUP_DOWN) pg8::gemm_phase<EpiDown, MoeDownSched, false>(c.lds, 256, S, E); } SEAM(pb + 16);
        if (IN(pb + 17)) { const MoeTable t = moe_table(c, layer, NTOK - tok0); phase_p9(c, layer, tok0, t); } SEAM(pb + 17);
        }
    }
#ifdef PROBE_STOP
    }
#endif
#undef IN
#undef SEAM
}

#ifdef DBG_K
__global__ void dbg_dump(const unsigned* w, size_t nwords, float* out, int nout) {
    for (int i = blockIdx.x * blockDim.x + threadIdx.x; i < nout; i += gridDim.x * blockDim.x) { unsigned h = 0;
        for (size_t q = i; q < nwords; q += (size_t)nout) { unsigned x = w[q]; x ^= x >> 16; x *= 0x7feb352du; x ^= x >> 15; x *= 0x846ca68bu; x ^= x >> 16; h += x; }
        out[i] = (float)(h & 0xFFFFFu); }
}
#endif
#ifndef MK_SPLIT
#define MK_SPLIT 0
#endif
extern "C" void kernel_launch(void* const* d_in, const int* in_sizes, int n_in, void* d_out, int out_size, void* d_ws, size_t ws_size, hipStream_t stream) {
    static int grid = 0;
    if (grid == 0) {
        if (n_in != 34 || out_size != NX * D || ws_size < WS_END) { fprintf(stderr, "kernel_launch: unexpected shapes: n_in %d out %d ws %zu (need %zu)\n", n_in, out_size, ws_size, (size_t)WS_END); grid = -1; return; }
        int dev = 0, cus = 0, per_cu = 0;
        if (hipGetDevice(&dev) != hipSuccess || hipDeviceGetAttribute(&cus, hipDeviceAttributeMultiprocessorCount, dev) != hipSuccess) { grid = -1; return; }
        if (hipFuncSetAttribute((const void*)fwd_kernel, hipFuncAttributeMaxDynamicSharedMemorySize, LDS_BYTES) != hipSuccess) { fprintf(stderr, "kernel_launch: hipFuncSetAttribute failed\n"); grid = -1; return; }
        if (hipOccupancyMaxActiveBlocksPerMultiprocessor(&per_cu, (const void*)fwd_kernel, NTHREADS, LDS_BYTES) != hipSuccess || per_cu < 1) { fprintf(stderr, "kernel_launch: occupancy query says %d\n", per_cu); grid = -1; return; }
        grid = cus;
        if (grid > 256) grid = 256;
        grid &= ~7;
    }
    if (grid <= 0) return;
    (void)hipMemsetAsync((char*)d_ws + WS_CTL, 0, CTL_ZERO_BYTES, stream);
    Params p{};
    for (int i = 0; i < 34; ++i) p.in[i] = (const float*)d_in[i];
    p.out = (float*)d_out; p.ws = (unsigned char*)d_ws;
#ifdef DBG_K
    for (int k = 0; k <= DBG_K; ++k) { p.ph_lo = k; p.ph_hi = k + 1; hipLaunchKernelGGL(fwd_kernel, dim3(grid), dim3(NTHREADS), LDS_BYTES, stream, p); }
    hipLaunchKernelGGL(dbg_dump, dim3(1024), dim3(256), 0, stream, (const unsigned*)((const char*)d_ws + (size_t)(DBG_OFF)), (size_t)(DBG_BYTES) / 4, (float*)d_out, out_size);
#elif MK_SPLIT
    for (int k = 0; k < NPHASE; ++k) { p.ph_lo = k; p.ph_hi = k + 1; hipLaunchKernelGGL(fwd_kernel, dim3(grid), dim3(NTHREADS), LDS_BYTES, stream, p); }
#else
    p.ph_lo = 0; p.ph_hi = NPHASE;
    hipLaunchKernelGGL(fwd_kernel, dim3(grid), dim3(NTHREADS), LDS_BYTES, stream, p);
#endif
    const hipError_t le = hipPeekAtLastError();
    if (le != hipSuccess) fprintf(stderr, "kernel_launch: launch failed: %s\n", hipGetErrorName(le));
}
```

```cpp
#include <hip/hip_runtime.h>
#include <cstdio>
#include <cstdint>
#include <cmath>

#define LAS __attribute__((address_space(3)))
typedef unsigned short bf16_t;
typedef short bf16x8 __attribute__((ext_vector_type(8)));
typedef short s16x4 __attribute__((ext_vector_type(4)));
typedef float f32x2 __attribute__((ext_vector_type(2)));
typedef float f32x4 __attribute__((ext_vector_type(4)));
typedef float f32x16 __attribute__((ext_vector_type(16)));
typedef unsigned u32x2 __attribute__((ext_vector_type(2)));
typedef unsigned u32x4 __attribute__((ext_vector_type(4)));
typedef __bf16 bf16x2_t __attribute__((ext_vector_type(2)));

constexpr int D = 1024, NC = 256, NX = 16384, NTOK = NC + NX, DEPTH = 4;
constexpr int AB_IN = 4608, AB_CAT = 1536, DA_IN = 3072, DA_W = 1024;
constexpr int NEXP = 64, TOPK = 8, EDIM = 256;
constexpr int FFT_M = 16384;
constexpr int HSPEC_LD = 16400;
constexpr float EPS = 1e-6f;

__device__ __forceinline__ unsigned cvtpk(float lo, float hi) { f32x2 v = {lo, hi}; bf16x2_t b = __builtin_convertvector(v, bf16x2_t); return __builtin_bit_cast(unsigned, b); }
__device__ __forceinline__ bf16_t f2bf(float x) { return (bf16_t)(cvtpk(x, 0.f) & 0xffffu); }
__device__ __forceinline__ float bf2f(bf16_t b) { return __uint_as_float(((unsigned)b) << 16); }
__device__ __forceinline__ float bflo(unsigned w) { return __uint_as_float(w << 16); }
__device__ __forceinline__ float bfhi(unsigned w) { return __uint_as_float(w & 0xffff0000u); }
__device__ __forceinline__ float siluf(float x) { return x / (1.0f + __expf(-x)); }
__device__ __forceinline__ float sigmoidf_(float x) { return 1.0f / (1.0f + __expf(-x)); }
__device__ __forceinline__ int opaque(int x) { asm volatile("" : "+v"(x)); return x; }
__device__ __forceinline__ int opaque_s(int x) { asm volatile("" : "+s"(x)); return x; }
template <class T> __device__ __forceinline__ T* opaque_p(T* p) { asm volatile("" : "+s"(p)); return p; }
__device__ __forceinline__ float wave_sum(float v) {
#pragma unroll
    for (int o = 32; o >= 1; o >>= 1) v += __shfl_xor(v, o);
    return v;
}

#define XB_TMO      128
#define XB_XCNT(j)  (256  + 64 * (j))
#define XB_XSUB(j)  (1280 + 64 * (j))
#define XB_XGEN(j)  (2304 + 64 * (j))
#define XB_TOP      3328
#define XB_TOPGEN   3392
#define XCD_BAR_WORDS 3456
#define XB_SPIN_CAP (1u << 18)

__device__ __forceinline__ unsigned xb_ld(unsigned* p)              { return __hip_atomic_load(p, __ATOMIC_RELAXED, __HIP_MEMORY_SCOPE_AGENT); }
__device__ __forceinline__ unsigned xb_add(unsigned* p, unsigned v) { return __hip_atomic_fetch_add(p, v, __ATOMIC_RELAXED, __HIP_MEMORY_SCOPE_AGENT); }
__device__ __forceinline__ unsigned xb_xcc_id() { return (unsigned)__builtin_amdgcn_s_getreg((3 << 11) | 20) & 0xFu; }
#define XB_SPIN(cond, bar) do { unsigned _sp = 0; while (cond) { __builtin_amdgcn_s_sleep(1); \
    if ((++_sp & 255u) == 0u) { if (xb_ld(&(bar)[XB_TMO])) break; if (_sp > XB_SPIN_CAP) { atomicAdd(&(bar)[XB_TMO], 1u); break; } } } } while (0)

struct XcdBarrier { unsigned* bar; unsigned x; volatile LAS unsigned* st; };

__device__ __forceinline__ XcdBarrier xcd_barrier_post(unsigned* bar, volatile LAS unsigned* st) {
    XcdBarrier b; b.bar = bar; b.x = xb_xcc_id(); b.st = st;
    if (threadIdx.x == 0) (void)xb_add(&bar[XB_XCNT(b.x)], 1u);
    return b;
}
__device__ __forceinline__ void xcd_barrier_complete(unsigned* bar, unsigned x, unsigned& nloc, unsigned& nx) {
    const unsigned G = gridDim.x * gridDim.y * gridDim.z;
    unsigned sum, cnt, mine, sp = 0u;
    for (;;) {
        sum = 0u; cnt = 0u; mine = 0u;
#pragma unroll
        for (unsigned j = 0; j < 16; ++j) { const unsigned c = xb_ld(&bar[XB_XCNT(j)]); sum += c; cnt += (c > 0u) ? 1u : 0u; mine = (j == x) ? c : mine; }
        if (sum == G) break;
        __builtin_amdgcn_s_sleep(1);
        if ((++sp & 255u) == 0u) { if (xb_ld(&bar[XB_TMO])) break; if (sp > XB_SPIN_CAP) { atomicAdd(&bar[XB_TMO], 1u); break; } }
    }
    nloc = mine > 0u ? mine : 1u; nx = cnt > 0u ? cnt : 1u;
}
__device__ __forceinline__ void xcd_barrier(const XcdBarrier& b) {
    asm volatile("s_waitcnt vmcnt(0)" ::: "memory");
    __syncthreads();
    if (threadIdx.x == 0) {
        unsigned* bar = b.bar;
        __builtin_amdgcn_s_waitcnt(0);
        unsigned nloc = b.st[0], nx = b.st[1];
        if (nloc == 0u) { xcd_barrier_complete(bar, b.x, nloc, nx); b.st[0] = nloc; b.st[1] = nx; }
        const unsigned old = xb_add(&bar[XB_XSUB(b.x)], 1u);
        const unsigned gen = old / nloc;
        if (old + 1u == (gen + 1u) * nloc) {
            __builtin_amdgcn_fence(__ATOMIC_RELEASE, "agent");
            asm volatile("s_waitcnt vmcnt(0)" ::: "memory");
            const unsigned og = xb_add(&bar[XB_TOP], 1u);
            const unsigned tg = og / nx;
            if (og + 1u == (tg + 1u) * nx) xb_add(&bar[XB_TOPGEN], 1u);
            else XB_SPIN(xb_ld(&bar[XB_TOPGEN]) == tg, bar);
            __builtin_amdgcn_fence(__ATOMIC_ACQUIRE, "agent");
            xb_add(&bar[XB_XGEN(b.x)], 1u);
            asm volatile("s_waitcnt vmcnt(0)" ::: "memory");
        } else {
            XB_SPIN(xb_ld(&bar[XB_XGEN(b.x)]) == gen, bar);
            __builtin_amdgcn_fence(__ATOMIC_ACQUIRE, "agent");
            asm volatile("s_waitcnt vmcnt(0)" ::: "memory");
        }
    }
    __syncthreads();
}

namespace pg8 {
constexpr int BM = 256, BK = 64, HALF = 128, HTB = HALF * BK * 2, STAGE_BYTES = 8 * HTB;
__host__ __device__ __forceinline__ int lds_byte(int r, int c) { const int st = (r >> 4) * 2 + (c >> 5), rr = r & 15, cc = c & 31, ob = rr * 64 + cc * 2; return st * 1024 + (ob ^ (((ob >> 9) & 1) << 5)); }
__host__ __device__ __forceinline__ void stage_rc(int b, int& R, int& C) { const int st = b / 1024, sb = b % 1024, swz = sb ^ (((sb >> 9) & 1) << 5); R = (st >> 1) * 16 + swz / 64; C = (st & 1) * 32 + (swz % 64) / 2; }
__host__ __device__ __forceinline__ int perm32(int rho) { const int n = rho >> 4, i = rho & 15; return 8 * (i >> 2) + 4 * n + (i & 3); }

struct Unit { const char* A; const char* B; int pm, pn, e, aux; };

template <class Epi, class Sched, bool GATHER>
__device__ __forceinline__ void gemm_phase(LAS unsigned char* lds, const int K_, const Sched& S, const Epi& E) {
    int K = K_; asm volatile("" : "+s"(K));
    const int tid = opaque((int)threadIdx.x), wid = __builtin_amdgcn_readfirstlane(tid >> 6), lane = tid & 63, wr = wid >> 2, wc = wid & 3, fr = lane & 15, fq = lane >> 4;
    const int nt = K / BK;
    int Rr[2], Cc[2];
    unsigned voffB[2], vAc[2][2], vAn[2][2];
    const size_t kstep = (size_t)(BK * 2);
    const size_t hstep = (size_t)HALF * K * 2;
#pragma unroll
    for (int i = 0; i < 2; ++i) { int R, C; stage_rc(tid * 16 + i * 8192, R, C); Rr[i] = R; Cc[i] = C; const int Rb = Epi::PERM ? ((R & ~31) + perm32(R & 31)) : R;
        voffB[i] = (unsigned)(Rb * K + C) * 2u; vAc[0][i] = (unsigned)(R * K + C) * 2u; vAc[1][i] = vAc[0][i] + (unsigned)hstep; vAn[0][i] = vAc[0][i]; vAn[1][i] = vAc[1][i]; }
    const unsigned ldsw = (unsigned)wid * 1024u;
    const int aoff = lds_byte(wr * 64 + fr, fq * 8), boff = lds_byte(wc * 32 + fr, fq * 8);
#define PG8_SA(b, h) (((b) * 2 + (h)) * HTB)
#define PG8_SB(b, h) ((4 + (b) * 2 + (h)) * HTB)
#define PG8_STAGE(bufoff, gbase, voff) do { _Pragma("unroll") for (int _i = 0; _i < 2; ++_i) \
        __builtin_amdgcn_global_load_lds((const unsigned*)((const char*)(gbase) + (voff)[_i]), (LAS unsigned*)(lds + (bufoff) + ldsw + _i * 8192), 16, 0, 0); } while (0)
#define PG8_LDA(dst, b, h) do { _Pragma("unroll") for (int m = 0; m < 4; ++m) _Pragma("unroll") for (int k = 0; k < 2; ++k) dst[m][k] = *(const LAS bf16x8*)(lds + PG8_SA(b, h) + aoff + m * 2048 + k * 1024); } while (0)
#define PG8_LDB(dst, b, h) do { _Pragma("unroll") for (int n = 0; n < 2; ++n) _Pragma("unroll") for (int k = 0; k < 2; ++k) dst[n][k] = *(const LAS bf16x8*)(lds + PG8_SB(b, h) + boff + n * 2048 + k * 1024); } while (0)
#define PG8_MMA(ai, bj, At, Bt) do { __builtin_amdgcn_s_setprio(1); _Pragma("unroll") for (int m = 0; m < 4; ++m) _Pragma("unroll") for (int n = 0; n < 2; ++n) _Pragma("unroll") for (int k = 0; k < 2; ++k) \
        acc[ai][bj][m][n] = __builtin_amdgcn_mfma_f32_16x16x32_bf16(Bt[n][k], At[m][k], acc[ai][bj][m][n], 0, 0, 0); __builtin_amdgcn_s_setprio(0); } while (0)
#define PG8_WAIT_V(n) asm volatile("s_waitcnt vmcnt(" #n ")" ::: "memory")
#define PG8_WAIT_L(n) asm volatile("s_waitcnt lgkmcnt(" #n ")" ::: "memory")
#define PG8_BAR __builtin_amdgcn_s_barrier()
#define PG8_SCHED __builtin_amdgcn_sched_barrier(0)
    Unit cur, nxt; int ui = 0;
    if (!S.next(0, cur)) return;
    if (GATHER) { S.offsets(cur, Rr, Cc, vAc); }
    f32x4 acc[2][2][4][2];
#pragma unroll
    for (int a = 0; a < 2; ++a)
#pragma unroll
        for (int b = 0; b < 2; ++b)
#pragma unroll
            for (int m = 0; m < 4; ++m)
#pragma unroll
                for (int n = 0; n < 2; ++n) acc[a][b][m][n] = (f32x4){0.f, 0.f, 0.f, 0.f};
    bf16x8 At[4][2], B0[2][2], B1[2][2];
    const char* cA = cur.A; const char* cB = cur.B;
    PG8_STAGE(PG8_SB(0, 0), cB, voffB); PG8_STAGE(PG8_SA(0, 0), cA, vAc[0]); PG8_STAGE(PG8_SB(0, 1), cB + hstep, voffB); PG8_STAGE(PG8_SA(0, 1), cA, vAc[1]);
    if (wr == 1) PG8_BAR;
    PG8_WAIT_V(4); PG8_BAR;
    PG8_STAGE(PG8_SB(1, 0), cB + kstep, voffB); PG8_STAGE(PG8_SA(1, 0), cA + kstep, vAc[0]); PG8_STAGE(PG8_SB(1, 1), cB + hstep + kstep, voffB);
    PG8_WAIT_V(6); PG8_BAR;
    for (;;) {
        const bool has_next = S.next(ui + 1, nxt);
        const char* nA = has_next ? nxt.A : cA; const char* nB = has_next ? nxt.B : cB;
        if (GATHER) { if (has_next) S.offsets(nxt, Rr, Cc, vAn); else { vAn[0][0] = vAc[0][0]; vAn[0][1] = vAc[0][1]; vAn[1][0] = vAc[1][0]; vAn[1][1] = vAc[1][1]; } }
        for (int t = 0; t < nt; t += 2) {
            const bool last = (t == nt - 2);
            const char* a1 = cA + (size_t)(t + 1) * kstep;
            const char* a2 = last ? nA : cA + (size_t)(t + 2) * kstep; const char* b2 = last ? nB : cB + (size_t)(t + 2) * kstep;
            const char* a3 = a2 + kstep; const char* b3 = b2 + kstep;
            unsigned v2[2][2];
            if (GATHER) { v2[0][0] = last ? vAn[0][0] : vAc[0][0]; v2[0][1] = last ? vAn[0][1] : vAc[0][1]; v2[1][0] = last ? vAn[1][0] : vAc[1][0]; v2[1][1] = last ? vAn[1][1] : vAc[1][1]; }
            else { v2[0][0] = vAc[0][0]; v2[0][1] = vAc[0][1]; v2[1][0] = vAc[1][0]; v2[1][1] = vAc[1][1]; }
            PG8_LDB(B0, 0, 0); PG8_SCHED; PG8_LDA(At, 0, 0); PG8_STAGE(PG8_SA(1, 1), a1, vAc[1]);
            PG8_WAIT_L(8); PG8_BAR; PG8_WAIT_L(0); PG8_MMA(0, 0, At, B0); PG8_BAR; PG8_SCHED;
            PG8_LDB(B1, 0, 1); PG8_STAGE(PG8_SB(0, 0), b2, voffB);
            PG8_BAR; PG8_WAIT_L(0); PG8_MMA(0, 1, At, B1); PG8_BAR;
            PG8_LDA(At, 0, 1); PG8_STAGE(PG8_SA(0, 0), a2, v2[0]);
            PG8_BAR; PG8_WAIT_L(0); PG8_MMA(1, 0, At, B0); PG8_BAR; PG8_SCHED;
            PG8_STAGE(PG8_SB(0, 1), b2 + hstep, voffB);
            PG8_WAIT_V(6); PG8_BAR; PG8_MMA(1, 1, At, B1); PG8_BAR;
            PG8_LDB(B0, 1, 0); PG8_SCHED; PG8_LDA(At, 1, 0); PG8_STAGE(PG8_SA(0, 1), a2, v2[1]);
            PG8_WAIT_L(8); PG8_BAR; PG8_WAIT_L(0); PG8_MMA(0, 0, At, B0); PG8_BAR; PG8_SCHED;
            PG8_LDB(B1, 1, 1); PG8_STAGE(PG8_SB(1, 0), b3, voffB);
            PG8_BAR; PG8_WAIT_L(0); PG8_MMA(0, 1, At, B1); PG8_BAR;
            PG8_LDA(At, 1, 1); PG8_STAGE(PG8_SA(1, 0), a3, v2[0]);
            PG8_BAR; PG8_WAIT_L(0); PG8_MMA(1, 0, At, B0); PG8_BAR; PG8_SCHED;
            PG8_STAGE(PG8_SB(1, 1), b3 + hstep, voffB);
            PG8_WAIT_V(6); PG8_BAR; PG8_MMA(1, 1, At, B1); PG8_BAR;
        }
        E(acc, cur, wr, wc, fr, fq);
        if (!has_next) break;
#pragma unroll
        for (int a = 0; a < 2; ++a)
#pragma unroll
            for (int b = 0; b < 2; ++b)
#pragma unroll
                for (int m = 0; m < 4; ++m)
#pragma unroll
                    for (int n = 0; n < 2; ++n) acc[a][b][m][n] = (f32x4){0.f, 0.f, 0.f, 0.f};
        cur = nxt; cA = nA; cB = nB; ++ui;
        if (GATHER) { vAc[0][0] = vAn[0][0]; vAc[0][1] = vAn[0][1]; vAc[1][0] = vAn[1][0]; vAc[1][1] = vAn[1][1]; }
    }
    PG8_WAIT_V(0);
    if (wr == 0) PG8_BAR;
    PG8_BAR;
#undef PG8_SA
#undef PG8_SB
#undef PG8_STAGE
#undef PG8_LDA
#undef PG8_LDB
#undef PG8_MMA
#undef PG8_WAIT_V
#undef PG8_WAIT_L
#undef PG8_BAR
#undef PG8_SCHED
}
}
constexpr size_t MiB = 1u << 20;
constexpr size_t WS_CTL = 0, CTL_ZERO_BYTES = 1 * MiB;
constexpr size_t WS_MOD = 1 * MiB;
constexpr size_t WS_ROPE = WS_MOD + 256 * 1024;
constexpr size_t WS_MISC = WS_ROPE + 256 * 1024;
constexpr size_t WS_WAB_IN = 2 * MiB;
constexpr size_t WS_WAB_OUT = 20 * MiB;
constexpr size_t WS_WDA_IN = 26 * MiB;
constexpr size_t WS_WDA_OUT = 38 * MiB;
constexpr size_t WS_WR = 42 * MiB;
constexpr size_t WS_W3T = 43 * MiB;
constexpr size_t WS_HID2C = WS_W3T + 512 * 1024;
constexpr size_t WS_WGU = 44 * MiB;
constexpr size_t WS_WD = 109 * MiB;
constexpr size_t WS_XRES = 142 * MiB;
constexpr size_t WS_H = 207 * MiB;
constexpr size_t WS_LTOK = 240 * MiB;
constexpr size_t WS_LW = WS_LTOK + 5 * MiB;
constexpr size_t WS_SLOT = WS_LW + 5 * MiB;
constexpr size_t WS_SLOTW = WS_SLOT + 1 * MiB;
constexpr size_t WS_U = 252 * MiB;
constexpr size_t WS_PROJ = WS_U;
constexpr size_t WS_TAPS = WS_U;
constexpr size_t WS_CAT = WS_U + 147 * MiB;
constexpr size_t WS_UPD = WS_U + 196 * MiB;
constexpr size_t WS_SPREV = WS_U + 261 * MiB;
constexpr size_t WS_UT = WS_U + 326 * MiB;
constexpr size_t WS_YT = WS_U + 374 * MiB;
constexpr size_t WS_HSPEC = WS_U + 390 * MiB;
constexpr size_t WS_Y1 = WS_U + 519 * MiB;
constexpr size_t WS_MIX_END = WS_U + 551 * MiB;
constexpr int MAX_TILES = 649;
constexpr size_t WS_ACT = WS_U;
constexpr size_t WS_YSLOT = WS_U + 82 * MiB;
constexpr size_t WS_HLO = WS_YSLOT;
constexpr size_t WS_END = WS_U + 551 * MiB;
static_assert(WS_YSLOT + (size_t)MAX_TILES * 256 * 1024 * 2 <= WS_END, "moe view");
static_assert(WS_HSPEC + (size_t)2 * 512 * HSPEC_LD * 8 <= WS_MIX_END, "mixer view");

constexpr int CW_BAR = 1024;
constexpr int CW_CNT = 8192;
constexpr int CW_ERR = 16;
constexpr int CW_CVTQ = 9216;

constexpr int LDS_BIG = 139264;
constexpr int LDS_MISC = LDS_BIG;
constexpr int LDS_BYTES = LDS_BIG + 16384;
constexpr int NTHREADS = 512;

struct Params {
    const float* in[34];
    float* out;
    unsigned char* ws;
    int ph_lo, ph_hi;
};

typedef const __attribute__((address_space(4))) Params* KParams;
#define PREF const __attribute__((address_space(4))) Params&
__device__ __forceinline__ KParams opaque_kp(KParams p) { asm volatile("" : "+s"(p)); return p; }
struct Ctx {
    KParams p;
    LAS unsigned char* lds;
    int tid, lane, wid, G, bid, cnt_off, pass;
    unsigned char* ws;
};

template <class RowMap>
__device__ __forceinline__ void cvt_tile(const Ctx& c, const float* src, int ldn, int k0, int n0, bf16_t* dst, int ldk, const RowMap& rm) {
    LAS float* t = (LAS float*)c.lds;
    const int tid = c.tid;
    {   const int kr = tid >> 4, nc = (tid & 15) * 4;
#pragma unroll
        for (int h = 0; h < 2; ++h) { const f32x4 v = *(const f32x4*)(src + (size_t)(k0 + kr + 32 * h) * ldn + n0 + nc);
            t[(kr + 32 * h) * 65 + nc + 0] = v[0]; t[(kr + 32 * h) * 65 + nc + 1] = v[1]; t[(kr + 32 * h) * 65 + nc + 2] = v[2]; t[(kr + 32 * h) * 65 + nc + 3] = v[3]; } }
    __syncthreads();
    {   const int n = tid >> 3, k8 = (tid & 7) * 8; float f[8];
#pragma unroll
        for (int j = 0; j < 8; ++j) f[j] = t[(k8 + j) * 65 + n];
        u32x4 w; w.x = cvtpk(f[0], f[1]); w.y = cvtpk(f[2], f[3]); w.z = cvtpk(f[4], f[5]); w.w = cvtpk(f[6], f[7]);
        *(u32x4*)(dst + (size_t)rm(n0 + n) * ldk + k0 + k8) = w; }
    __syncthreads();
}
template <class RowMap>
__device__ __forceinline__ void cvt_tile128(const Ctx& c, const float* src, int ldn, int k0, int n0, bf16_t* dst, int ldk, const RowMap& rm) {
    LAS float* t = (LAS float*)c.lds;
    const int tid = c.tid;
    {   const int kr = tid >> 4, nc = (tid & 15) * 4;
#pragma unroll
        for (int h = 0; h < 4; ++h) { const f32x4 v = *(const f32x4*)(src + (size_t)(k0 + kr + 32 * h) * ldn + n0 + nc);
            t[(kr + 32 * h) * 65 + nc + 0] = v[0]; t[(kr + 32 * h) * 65 + nc + 1] = v[1]; t[(kr + 32 * h) * 65 + nc + 2] = v[2]; t[(kr + 32 * h) * 65 + nc + 3] = v[3]; } }
    __syncthreads();
    {   const int k8 = (tid & 15) * 8;
#pragma unroll
        for (int h = 0; h < 2; ++h) { const int n = (tid >> 4) + 32 * h; float f[8];
#pragma unroll
            for (int j = 0; j < 8; ++j) f[j] = t[(k8 + j) * 65 + n];
            u32x4 w; w.x = cvtpk(f[0], f[1]); w.y = cvtpk(f[2], f[3]); w.z = cvtpk(f[4], f[5]); w.w = cvtpk(f[6], f[7]);
            *(u32x4*)(dst + (size_t)rm(n0 + n) * ldk + k0 + k8) = w; } }
    __syncthreads();
}
struct RowId { __device__ __forceinline__ int operator()(int n) const { return n; } };
struct RowAbIn { __device__ __forceinline__ int operator()(int n) const { if (n >= 1024) return n; const int d = n & 127; return (n & ~127) + ((d < 64) ? 2 * d : 2 * (d - 64) + 1); } };
struct RowDaIn { __device__ __forceinline__ int operator()(int n) const { if (n >= 2048) return n; const int d = n & 63; return (n & ~63) + ((d < 32) ? 2 * d : 2 * (d - 32) + 1); } };
struct RowGate { __device__ __forceinline__ int operator()(int n) const { return (n >> 7) * 256 + (n & 127); } };
struct RowDown { __device__ __forceinline__ int operator()(int n) const { return (n & ~255) + 128 * ((n >> 3) & 1) + 32 * ((n >> 6) & 3) + 8 * ((n >> 4) & 3) + (n & 7); } };
struct RowUp   { __device__ __forceinline__ int operator()(int n) const { return (n >> 7) * 256 + 128 + (n & 127); } };

__device__ __forceinline__ void cvt_router_tile(const Ctx& c, const float* src, int k0, bf16_t* dhi, bf16_t* dlo) {
    LAS float* t = (LAS float*)c.lds; const int tid = c.tid;
    {   const int kr = tid >> 4, nc = (tid & 15) * 4;
#pragma unroll
        for (int h = 0; h < 2; ++h) { const f32x4 v = *(const f32x4*)(src + (size_t)(k0 + kr + 32 * h) * 64 + nc);
            t[(kr + 32 * h) * 65 + nc + 0] = v[0]; t[(kr + 32 * h) * 65 + nc + 1] = v[1]; t[(kr + 32 * h) * 65 + nc + 2] = v[2]; t[(kr + 32 * h) * 65 + nc + 3] = v[3]; } }
    __syncthreads();
    {   const int n = tid >> 3, k8 = (tid & 7) * 8; float f[8], g[8];
#pragma unroll
        for (int j = 0; j < 8; ++j) { f[j] = t[(k8 + j) * 65 + n]; const float h = bf2f(f2bf(f[j])); g[j] = f[j] - h; f[j] = h; }
        u32x4 w; w.x = cvtpk(f[0], f[1]); w.y = cvtpk(f[2], f[3]); w.z = cvtpk(f[4], f[5]); w.w = cvtpk(f[6], f[7]);
        *(u32x4*)(dhi + (size_t)n * 1024 + k0 + k8) = w;
        w.x = cvtpk(g[0], g[1]); w.y = cvtpk(g[2], g[3]); w.z = cvtpk(g[4], g[5]); w.w = cvtpk(g[6], g[7]);
        *(u32x4*)(dlo + (size_t)n * 1024 + k0 + k8) = w; }
    __syncthreads();
}

__device__ __forceinline__ void phase_pr0(const Ctx& c) {
    PREF P = *c.p; unsigned char* ws = c.ws;
    const int T_ABIN = 2 * 16 * 72, T_ABOUT = 2 * 24 * 16, T_DAIN = 2 * 16 * 48, T_DAOUT = 2 * 16 * 16, T_R = 4 * 16, T_W3 = 2 * 1 * 32;
    const int T_ALL = T_ABIN + T_ABOUT + T_DAIN + T_DAOUT + T_R + T_W3;
    for (int u = c.bid; u < T_ALL; u += c.G) {
        int v = u;
        if (v < T_ABIN) { const int j = v / (16 * 72), r = v % (16 * 72), kt = r / 72, ntile = r % 72;
            cvt_tile(c, P.in[8] + (size_t)j * 1024 * AB_IN, AB_IN, kt * 64, ntile * 64, (bf16_t*)(ws + WS_WAB_IN) + (size_t)j * AB_IN * 1024, 1024, RowAbIn()); continue; }
        v -= T_ABIN;
        if (v < T_ABOUT) { const int j = v / (24 * 16), r = v % (24 * 16), kt = r / 16, ntile = r % 16;
            cvt_tile(c, P.in[9] + (size_t)j * AB_CAT * 1024, 1024, kt * 64, ntile * 64, (bf16_t*)(ws + WS_WAB_OUT) + (size_t)j * 1024 * AB_CAT, AB_CAT, RowId()); continue; }
        v -= T_ABOUT;
        if (v < T_DAIN) { const int j = v / (16 * 48), r = v % (16 * 48), kt = r / 48, ntile = r % 48;
            cvt_tile(c, P.in[21] + (size_t)j * 1024 * DA_IN, DA_IN, kt * 64, ntile * 64, (bf16_t*)(ws + WS_WDA_IN) + (size_t)j * DA_IN * 1024, 1024, RowDaIn()); continue; }
        v -= T_DAIN;
        if (v < T_DAOUT) { const int j = v / (16 * 16), r = v % (16 * 16), kt = r / 16, ntile = r % 16;
            cvt_tile(c, P.in[22] + (size_t)j * 1024 * 1024, 1024, kt * 64, ntile * 64, (bf16_t*)(ws + WS_WDA_OUT) + (size_t)j * 1024 * 1024, 1024, RowId()); continue; }
        v -= T_DAOUT;
        if (v < T_R) { const int i = v / 16, kt = v % 16;
            cvt_router_tile(c, P.in[25] + (size_t)i * 1024 * 64, kt * 64, (bf16_t*)(ws + WS_WR) + (size_t)(i * 2 + 0) * 64 * 1024, (bf16_t*)(ws + WS_WR) + (size_t)(i * 2 + 1) * 64 * 1024); continue; }
        v -= T_R;
        { const int j = v / 32, ntile = v % 32;
            cvt_tile(c, P.in[19] + (size_t)j * 64 * 2048, 2048, 0, ntile * 64, (bf16_t*)(ws + WS_W3T) + (size_t)j * 2048 * 64, 64, RowId()); }
    }
    {
        LAS float* red = (LAS float*)c.lds;
        for (int u = c.bid; u < 192; u += c.G) {
            const int i = u / 48, j0 = (u % 48) * 128, col = c.tid & 127, kg = c.tid >> 7;
            const float* w = P.in[4] + (size_t)i * 1024 * 6144 + j0 + col;
            float a0 = 0.f, a1 = 0.f;
#pragma unroll 8
            for (int k = kg * 256; k < kg * 256 + 256; ++k) { const float wv = w[(size_t)k * 6144]; a0 += siluf(P.in[1][k]) * wv; a1 += siluf(P.in[3][k]) * wv; }
            red[(kg * 2 + 0) * 128 + col] = a0; red[(kg * 2 + 1) * 128 + col] = a1;
            __syncthreads();
            if (c.tid < 256) { const int s = c.tid >> 7; float v = 0.f;
#pragma unroll
                for (int g = 0; g < 4; ++g) v += red[(g * 2 + s) * 128 + col];
                ((float*)(ws + WS_MOD))[(size_t)(i * 2 + s) * 6144 + j0 + col] = v + P.in[5][(size_t)i * 6144 + j0 + col]; }
            __syncthreads();
        }
    }
    {
        f32x2* rt = (f32x2*)(ws + WS_ROPE);
        const int NRR = 256 * 32, NRC = 64 * 32, NDR = 256 * 16, NDC = 64 * 16;
        for (int idx = c.bid * NTHREADS + c.tid; idx < NRR + NRC + NDR + NDC; idx += c.G * NTHREADS) {
            int v = idx; float pos, inv;
            if (v < NRR) { pos = (float)(v >> 5); inv = powf(10000.f, -(float)(v & 31) / 32.f); }
            else if ((v -= NRR) < NRC) { pos = (float)(v >> 5); inv = powf(10000.f, -(float)(v & 31) / 32.f); }
            else if ((v -= NRC) < NDR) { pos = (float)(v >> 4); inv = powf(10000.f, -(float)(v & 15) / 16.f); }
            else { v -= NDR; pos = (float)(v >> 4); inv = powf(10000.f, -(float)(v & 15) / 16.f); }
            const float ang = pos * inv;
            rt[idx] = (f32x2){cosf(ang), sinf(ang)};
        }
    }
    if (c.bid == 0 && c.wid < 2) {
        const int j = c.wid; const float* lam = P.in[23] + (size_t)j * 4 * 64;
        float a = lam[c.lane] * lam[64 + c.lane], b = lam[128 + c.lane] * lam[192 + c.lane];
        a = wave_sum(a); b = wave_sum(b);
        const float linit = 0.8f - 0.6f * expf(-0.3f * (float)(2 * j + 1));
        if (c.lane == 0) { ((float*)(ws + WS_MISC))[j * 2 + 0] = expf(a) - expf(b) + linit; ((float*)(ws + WS_MISC))[j * 2 + 1] = linit; }
    }
}

__device__ __forceinline__ void norm_rows(const Ctx& c, int layer, int which  , const float* gain, int row_lo, int row_hi, const float* xsrc_lat, const float* xsrc_ctx, bf16_t* dst) {
    const float* mod = (const float*)(c.ws + WS_MOD) + (size_t)layer * 2 * 6144;
    const int sh_off = which ? 3 * 1024 : 0, sc_off = which ? 4 * 1024 : 1024;
    for (int row = row_lo + c.bid * 8 + c.wid; row < row_hi; row += c.G * 8) {
        const float* x = (row < NC) ? (xsrc_ctx + (size_t)row * D) : (xsrc_lat + (size_t)(row - NC) * D);
        const float* m = mod + ((row < NC) ? 6144 : 0);
        f32x4 v[4]; float ss = 0.f;
#pragma unroll
        for (int q = 0; q < 4; ++q) { v[q] = *(const f32x4*)(x + q * 256 + c.lane * 4); ss += v[q][0] * v[q][0] + v[q][1] * v[q][1] + v[q][2] * v[q][2] + v[q][3] * v[q][3]; }
        ss = wave_sum(ss);
        const float rstd = rsqrtf(ss * (1.0f / 1024.f) + EPS);
#pragma unroll
        for (int q = 0; q < 4; ++q) { const int col = q * 256 + c.lane * 4;
            const f32x4 g = *(const f32x4*)(gain + col), sc = *(const f32x4*)(m + sc_off + col), sh = *(const f32x4*)(m + sh_off + col);
            float o[4];
#pragma unroll
            for (int j = 0; j < 4; ++j) o[j] = v[q][j] * rstd * g[j] * (1.0f + sc[j]) + sh[j];
            u32x2 w; w.x = cvtpk(o[0], o[1]); w.y = cvtpk(o[2], o[3]);
            *(u32x2*)(dst + (size_t)row * D + col) = w; }
    }
}

__device__ __forceinline__ void phase_pr1(const Ctx& c) {
    PREF P = *c.p;
    float* xres = (float*)(c.ws + WS_XRES);
    for (size_t i = (size_t)c.bid * NTHREADS + c.tid; i < (size_t)NTOK * D / 4; i += (size_t)c.G * NTHREADS) {
        const size_t e = i * 4; const f32x4 v = (e < (size_t)NC * D) ? *(const f32x4*)(P.in[2] + e) : *(const f32x4*)(P.in[0] + (e - (size_t)NC * D));
        *(f32x4*)(xres + e) = v; }
    norm_rows(c, 0, 0, P.in[6], 0, NTOK, P.in[0], P.in[2], (bf16_t*)(c.ws + WS_H));
}
__device__ __forceinline__ int xcd_remap(int L, int n) { const int q = n / 8, r = n % 8, x = L % 8, off = L / 8; return (x < r ? x * (q + 1) : r * (q + 1) + (x - r) * q) + off; }

struct DenseSched {
    const char* A; const char* Bt; int K, nM, nN, pm0, G, c, nwg;
    __device__ __forceinline__ void init(const void* A_, const void* Bt_, int K_, int nM_, int nN_, int pm0_, int G_, int c_) { A = (const char*)A_; Bt = (const char*)Bt_; K = K_; nM = nM_ - pm0_; nN = nN_; pm0 = pm0_; G = G_; c = c_; nwg = nM * nN; }
    __device__ __forceinline__ bool next(int i, pg8::Unit& u) const {
        const long L = (long)i * G + c; if (L >= nwg) return false;
        const int wgid = xcd_remap((int)L, nwg);
        const int WGM = 8, nig = WGM * nN, gid = wgid / nig, fm = gid * WGM, gsz = (nM - fm) < WGM ? (nM - fm) : WGM;
        u.pm = pm0 + fm + ((wgid % nig) % gsz); u.pn = (wgid % nig) / gsz; u.e = 0; u.aux = 0;
        u.A = A + (size_t)u.pm * 256 * K * 2; u.B = Bt + (size_t)u.pn * 256 * K * 2; return true;
    }
    __device__ __forceinline__ void offsets(const pg8::Unit&, const int (&)[2], const int (&)[2], unsigned (&)[2][2]) const {}
};

struct MoeTable { const LAS int* tb; const LAS int* cn; };
__device__ __forceinline__ int moe_find(const MoeTable& t, int T) { int e = 0;
#pragma unroll 1
    for (int s = 64; s >= 1; s >>= 1) { if (e + s <= 64 && t.tb[e + s] <= T) e += s; } return e; }

struct MoeUpSched {
    MoeTable t; const char* H; const char* W; const int* ltok; int tok0, G, c, nwg;
    __device__ __forceinline__ bool next(int i, pg8::Unit& u) const {
        const long L = (long)i * G + c; if (L >= nwg) return false;
        const int id = xcd_remap((int)L, nwg); const int T = id >> 1; u.pn = id & 1; u.pm = T; u.e = moe_find(t, T); u.aux = T - t.tb[u.e];
        u.A = H; u.B = W + ((size_t)u.e * 512 + (size_t)u.pn * 256) * 1024 * 2; return true;
    }
    __device__ __forceinline__ void offsets(const pg8::Unit& u, const int (&Rr)[2], const int (&Cc)[2], unsigned (&vo)[2][2]) const {
        const int cnt = t.cn[u.e];
#pragma unroll
        for (int h = 0; h < 2; ++h)
#pragma unroll
            for (int i = 0; i < 2; ++i) { const int pos = u.aux * 256 + h * 128 + Rr[i]; int tok;
                if (u.e == 64) tok = tok0 + (pos < cnt ? pos : 0); else tok = (pos < cnt) ? ltok[(size_t)u.e * NTOK + pos] : tok0;
                vo[h][i] = (unsigned)(tok * 1024 + Cc[i]) * 2u; }
    }
};
struct MoeDownSched {
    MoeTable t; const char* ACT; const char* W; int G, c, nwg;
    __device__ __forceinline__ bool next(int i, pg8::Unit& u) const {
        const long L = (long)i * G + c; if (L >= nwg) return false;
        const int id = xcd_remap((int)L, nwg); const int T = id >> 2; u.pn = id & 3; u.pm = T; u.e = moe_find(t, T); u.aux = T - t.tb[u.e];
        u.A = ACT + (size_t)T * 256 * 256 * 2; u.B = W + ((size_t)u.e * 1024 + (size_t)u.pn * 256) * 256 * 2; return true;
    }
    __device__ __forceinline__ void offsets(const pg8::Unit&, const int (&)[2], const int (&)[2], unsigned (&)[2][2]) const {}
};

__device__ __forceinline__ void rope8(f32x4& v0, f32x4& v1, const f32x2* cs) {
    const f32x4 t0 = *(const f32x4*)(cs), t1 = *(const f32x4*)(cs + 2);
    float a, b;
    a = v0[0]; b = v0[1]; v0[0] = a * t0[0] - b * t0[1]; v0[1] = b * t0[0] + a * t0[1];
    a = v0[2]; b = v0[3]; v0[2] = a * t0[2] - b * t0[3]; v0[3] = b * t0[2] + a * t0[3];
    a = v1[0]; b = v1[1]; v1[0] = a * t1[0] - b * t1[1]; v1[1] = b * t1[0] + a * t1[1];
    a = v1[2]; b = v1[3]; v1[2] = a * t1[2] - b * t1[3]; v1[3] = b * t1[2] + a * t1[3];
}
struct EpiAbIn {
    static constexpr bool PERM = true;
    bf16_t* O; const f32x2* rope;
    __device__ __forceinline__ void operator()(const f32x4 (&acc)[2][2][4][2], const pg8::Unit& u, int wr, int wc, int fr, int fq) const {
        const int row0 = u.pm * 256 + wr * 64 + fr, colt = u.pn * 256 + wc * 32 + 8 * fq;
        const bool qk = u.pn < 4, lat = u.pm >= 1; const float ksc = (u.pn >= 2 && u.pn < 4) ? 0.08838834764831845f : 1.0f;
#pragma unroll
        for (int ai = 0; ai < 2; ++ai)
#pragma unroll
            for (int m = 0; m < 4; ++m) { const int row = row0 + ai * 128 + m * 16; bf16_t* rowp = O + (size_t)row * AB_IN + colt; const int t = row - NC;
#pragma unroll
                for (int bj = 0; bj < 2; ++bj) { f32x4 v0 = acc[ai][bj][m][0], v1 = acc[ai][bj][m][1];
                    if (qk) { if (lat) { const int p0 = ((colt + bj * 128) & 127) >> 1;
                            const f32x2* cs = (p0 < 32) ? rope + (size_t)(t >> 6) * 32 + p0 : rope + 256 * 32 + (size_t)(t & 63) * 32 + (p0 - 32);
                            rope8(v0, v1, cs); }
                        v0 *= ksc; v1 *= ksc; }
                    u32x4 w; w.x = cvtpk(v0[0], v0[1]); w.y = cvtpk(v0[2], v0[3]); w.z = cvtpk(v1[0], v1[1]); w.w = cvtpk(v1[2], v1[3]);
                    *(u32x4*)(rowp + bj * 128) = w; } }
    }
};
struct EpiDaIn {
    static constexpr bool PERM = true;
    bf16_t* O; const f32x2* rope;
    __device__ __forceinline__ void operator()(const f32x4 (&acc)[2][2][4][2], const pg8::Unit& u, int wr, int wc, int fr, int fq) const {
        const int row0 = u.pm * 256 + wr * 64 + fr, colt = u.pn * 256 + wc * 32 + 8 * fq;
        const bool qk = u.pn < 8, lat = u.pm >= 1; const float qsc = (u.pn < 4) ? 0.125f * 1.4426950408889634f : 1.0f;
#pragma unroll
        for (int ai = 0; ai < 2; ++ai)
#pragma unroll
            for (int m = 0; m < 4; ++m) { const int row = row0 + ai * 128 + m * 16; bf16_t* rowp = O + (size_t)row * DA_IN + colt; const int t = row - NC;
#pragma unroll
                for (int bj = 0; bj < 2; ++bj) { f32x4 v0 = acc[ai][bj][m][0], v1 = acc[ai][bj][m][1];
                    if (qk) { if (lat) { const int p0 = ((colt + bj * 128) & 63) >> 1;
                            const f32x2* cs = (p0 < 16) ? rope + (size_t)(t >> 6) * 16 + p0 : rope + 256 * 16 + (size_t)(t & 63) * 16 + (p0 - 16);
                            rope8(v0, v1, cs); }
                        v0 *= qsc; v1 *= qsc; }
                    u32x4 w; w.x = cvtpk(v0[0], v0[1]); w.y = cvtpk(v0[2], v0[3]); w.z = cvtpk(v1[0], v1[1]); w.w = cvtpk(v1[2], v1[3]);
                    *(u32x4*)(rowp + bj * 128) = w; } }
    }
};
struct EpiResid {
    static constexpr bool PERM = false;
    float* X; const float* mod;
    __device__ __forceinline__ void operator()(const f32x4 (&acc)[2][2][4][2], const pg8::Unit& u, int wr, int wc, int fr, int fq) const {
        const int row0 = u.pm * 256 + wr * 64 + fr, col0 = u.pn * 256 + wc * 32 + 4 * fq;
        const float* g = mod + ((u.pm == 0) ? 6144 : 0) + 2 * 1024;
        f32x4 gv[2][2];
#pragma unroll
        for (int bj = 0; bj < 2; ++bj)
#pragma unroll
            for (int n = 0; n < 2; ++n) gv[bj][n] = *(const f32x4*)(g + col0 + bj * 128 + n * 16);
#pragma unroll
        for (int ai = 0; ai < 2; ++ai)
#pragma unroll
            for (int m = 0; m < 4; ++m) { float* rowp = X + (size_t)(row0 + ai * 128 + m * 16) * D + col0;
#pragma unroll
                for (int bj = 0; bj < 2; ++bj)
#pragma unroll
                    for (int n = 0; n < 2; ++n) { f32x4* p = (f32x4*)(rowp + bj * 128 + n * 16); *p = *p + gv[bj][n] * acc[ai][bj][m][n]; } }
    }
};
struct EpiSwiglu {
    static constexpr bool PERM = true;
    bf16_t* ACT;
    __device__ __forceinline__ void operator()(const f32x4 (&acc)[2][2][4][2], const pg8::Unit& u, int wr, int wc, int fr, int fq) const {
        const int row0 = u.pm * 256 + wr * 64 + fr, col0 = u.pn * 128 + wc * 32 + 8 * fq;
#pragma unroll
        for (int ai = 0; ai < 2; ++ai)
#pragma unroll
            for (int m = 0; m < 4; ++m) { bf16_t* rowp = ACT + (size_t)(row0 + ai * 128 + m * 16) * 256 + col0; float o[8];
#pragma unroll
                for (int n = 0; n < 2; ++n)
#pragma unroll
                    for (int j = 0; j < 4; ++j) { const float g = acc[ai][0][m][n][j], up = acc[ai][1][m][n][j]; o[n * 4 + j] = siluf(g) * up; }
                u32x4 w; w.x = cvtpk(o[0], o[1]); w.y = cvtpk(o[2], o[3]); w.z = cvtpk(o[4], o[5]); w.w = cvtpk(o[6], o[7]);
                *(u32x4*)rowp = w; }
    }
};
struct EpiDown {
    static constexpr bool PERM = true;
    unsigned char* Y; const float* lw; MoeTable t; int skip;
    __device__ __forceinline__ void operator()(const f32x4 (&acc)[2][2][4][2], const pg8::Unit& u, int wr, int wc, int fr, int fq) const {
        if (skip) { asm volatile("" :: "v"(acc[0][0][0][0]), "v"(acc[1][1][3][1])); return; }
        const int r0 = wr * 64 + fr, col0 = u.pn * 256 + wc * 64 + 16 * fq; const int cnt = t.cn[u.e];
        float wv[2][4];
#pragma unroll
        for (int ai = 0; ai < 2; ++ai)
#pragma unroll
            for (int m = 0; m < 4; ++m) { const int pos = u.aux * 256 + r0 + ai * 128 + m * 16; const int pc = (pos < cnt) ? pos : 0;
                const float x = (u.e == 64) ? 1.0f : lw[(size_t)u.e * NTOK + pc]; wv[ai][m] = (u.e == 64 || pos < cnt) ? x : 0.0f; }
#pragma unroll
        for (int ai = 0; ai < 2; ++ai)
#pragma unroll
            for (int m = 0; m < 4; ++m) { const int r = r0 + ai * 128 + m * 16; const float w_ = wv[ai][m];
                unsigned char* rowp = Y + (size_t)(u.pm * 256 + r) * 1024 + col0; u32x4 w;
#pragma unroll
                for (int bj = 0; bj < 2; ++bj) { const f32x4 v0 = acc[ai][bj][m][0] * w_, v1 = acc[ai][bj][m][1] * w_; int lo = 0, hi = 0;
                    lo = __builtin_amdgcn_cvt_pk_fp8_f32(v0[0], v0[1], lo, false); lo = __builtin_amdgcn_cvt_pk_fp8_f32(v0[2], v0[3], lo, true);
                    hi = __builtin_amdgcn_cvt_pk_fp8_f32(v1[0], v1[1], hi, false); hi = __builtin_amdgcn_cvt_pk_fp8_f32(v1[2], v1[3], hi, true);
                    if (bj == 0) { w.x = (unsigned)lo; w.y = (unsigned)hi; } else { w.z = (unsigned)lo; w.w = (unsigned)hi; } }
                *(u32x4*)rowp = w; }
    }
};
__device__ __forceinline__ int fphys(int i) { return i + ((i >> 6) << 2); }
__device__ __forceinline__ int brev14(int x) { return (int)(__brev((unsigned)x) >> 18); }
__device__ __forceinline__ int brevK(int s, int K) { return (int)(__brev((unsigned)s) >> (32 - K)); }
__device__ __forceinline__ void cmul(float& ar, float& ai, float br, float bi) { const float r = ar * br - ai * bi, i = ar * bi + ai * br; ar = r; ai = i; }
__device__ __forceinline__ constexpr float tw16c(int k) { return (k & 15) == 0 ? 1.f : (k & 15) == 1 ? 0.9238795325112867f : (k & 15) == 2 ? 0.7071067811865476f : (k & 15) == 3 ? 0.3826834323650898f : (k & 15) == 4 ? 0.f :
    (k & 15) == 5 ? -0.3826834323650898f : (k & 15) == 6 ? -0.7071067811865476f : (k & 15) == 7 ? -0.9238795325112867f : (k & 15) == 8 ? -1.f : (k & 15) == 9 ? -0.9238795325112867f : (k & 15) == 10 ? -0.7071067811865476f :
    (k & 15) == 11 ? -0.3826834323650898f : (k & 15) == 12 ? 0.f : (k & 15) == 13 ? 0.3826834323650898f : (k & 15) == 14 ? 0.7071067811865476f : 0.9238795325112867f; }
__device__ __forceinline__ constexpr float tw16s(int k) { return tw16c(k + 12); }

template <int LOGN, int K, bool INV>
__device__ __forceinline__ void fft_pass(LAS f32x2* z, int tid) {
    constexpr int R = 1 << K, LOGST = LOGN - K, ST = 1 << LOGST;
#pragma unroll 1
    for (int g = tid; g < FFT_M / R; g += NTHREADS) {
        const int b = g >> LOGST, j = g & (ST - 1), base = (b << LOGN) + j;
        float xr[R], xi[R];
#pragma unroll
        for (int q = 0; q < R; ++q) { const f32x2 v = z[fphys(base + (q << LOGST))]; xr[q] = v[0]; xi[q] = v[1]; }
        float wr_[R], wi_[R];
        if (LOGST > 0) {
            const float fr = (float)j * (1.0f / (float)(1 << LOGN));
            wr_[0] = 1.f; wi_[0] = 0.f;
#pragma unroll
            for (int bit = 1; bit < R; bit <<= 1) { const float a = fr * (float)bit; wr_[bit] = __builtin_amdgcn_cosf(a); wi_[bit] = INV ? __builtin_amdgcn_sinf(a) : -__builtin_amdgcn_sinf(a); }
#pragma unroll
            for (int r = 3; r < R; ++r) { if ((r & (r - 1)) != 0) { const int hb = 1 << (31 - __builtin_clz(r)); wr_[r] = wr_[hb]; wi_[r] = wi_[hb]; cmul(wr_[r], wi_[r], wr_[r - hb], wi_[r - hb]); } }
        }
        if (!INV) {
#pragma unroll
            for (int s = 0; s < K; ++s) { const int half = R >> (s + 1);
#pragma unroll
                for (int a = 0; a < R; ++a) if ((a & half) == 0) {
                    const int o = a & (half - 1); const int ti = o * (8 / half);
                    const float ur = xr[a], ui = xi[a], vr = xr[a + half], vi = xi[a + half];
                    xr[a] = ur + vr; xi[a] = ui + vi;
                    float dr = ur - vr, di = ui - vi;
                    if (half >= 1 && o != 0) cmul(dr, di, tw16c(ti), -tw16s(ti));
                    xr[a + half] = dr; xi[a + half] = di; } }
            if (LOGST > 0) {
#pragma unroll
                for (int s = 1; s < R; ++s) { const int r = brevK(s, K); cmul(xr[s], xi[s], wr_[r], wi_[r]); } }
        } else {
            if (LOGST > 0) {
#pragma unroll
                for (int s = 1; s < R; ++s) { const int r = brevK(s, K); cmul(xr[s], xi[s], wr_[r], wi_[r]); } }
#pragma unroll
            for (int s = K - 1; s >= 0; --s) { const int half = R >> (s + 1);
#pragma unroll
                for (int a = 0; a < R; ++a) if ((a & half) == 0) {
                    const int o = a & (half - 1); const int ti = o * (8 / half);
                    const float ur = xr[a], ui = xi[a]; float vr = xr[a + half], vi = xi[a + half];
                    if (o != 0) cmul(vr, vi, tw16c(ti), tw16s(ti));
                    xr[a] = ur + vr; xi[a] = ui + vi; xr[a + half] = ur - vr; xi[a + half] = ui - vi; } }
        }
#pragma unroll
        for (int q = 0; q < R; ++q) z[fphys(base + (q << LOGST))] = (f32x2){xr[q], xi[q]};
    }
}
__device__ __forceinline__ void fft_fwd(LAS f32x2* z, int tid) {
    fft_pass<14, 4, false>(z, tid); __syncthreads();
    fft_pass<10, 4, false>(z, tid); __syncthreads();
    fft_pass<6, 4, false>(z, tid);  __syncthreads();
    fft_pass<2, 2, false>(z, tid);  __syncthreads();
}
__device__ __forceinline__ void fft_inv(LAS f32x2* z, int tid) {
    fft_pass<2, 2, true>(z, tid);  __syncthreads();
    fft_pass<6, 4, true>(z, tid);  __syncthreads();
    fft_pass<10, 4, true>(z, tid); __syncthreads();
    fft_pass<14, 4, true>(z, tid); __syncthreads();
}
__device__ __forceinline__ f32x2 hs_ld(const unsigned* Hs, int k) { const unsigned w = Hs[k]; return (f32x2){bflo(w), bfhi(w)}; }
__device__ __forceinline__ void fft_pair_mul(LAS f32x2* z, const unsigned* Hs, int tid) {
    constexpr int M = FFT_M;
#pragma unroll 1
    for (int k = tid; k <= M / 2; k += NTHREADS) {
        if (k == 0) {
            const f32x2 z0 = z[0]; const float X0 = z0[0] + z0[1], XM = z0[0] - z0[1];
            const float Y0 = X0 * hs_ld(Hs, 0)[0], YM = XM * hs_ld(Hs, M)[0];
            z[0] = (f32x2){0.5f * (Y0 + YM), 0.5f * (Y0 - YM)};
        } else {
            const int p1 = fphys(brev14(k)), p2 = fphys(brev14(M - k));
            const f32x2 zk = z[p1], zm = z[p2]; const f32x2 hk = hs_ld(Hs, k), hm = hs_ld(Hs, M - k);
            const float Er = 0.5f * (zk[0] + zm[0]), Ei = 0.5f * (zk[1] - zm[1]);
            const float Dr = 0.5f * (zk[0] - zm[0]), Di = 0.5f * (zk[1] + zm[1]);
            const float Or = Di, Oi = -Dr;
            const float a = (float)k * (1.0f / (float)(2 * M));
            const float wr = __builtin_amdgcn_cosf(a), wi = -__builtin_amdgcn_sinf(a);
            const float wOr = wr * Or - wi * Oi, wOi = wr * Oi + wi * Or;
            const float Xkr = Er + wOr, Xki = Ei + wOi;
            const float Xmr = Er - wOr, Xmi = -(Ei - wOi);
            const float Ykr = Xkr * hk[0] - Xki * hk[1], Yki = Xkr * hk[1] + Xki * hk[0];
            const float Ymr = Xmr * hm[0] - Xmi * hm[1], Ymi = Xmr * hm[1] + Xmi * hm[0];
            const float Yer = 0.5f * (Ykr + Ymr), Yei = 0.5f * (Yki - Ymi);
            const float Fr = 0.5f * (Ykr - Ymr), Fi = 0.5f * (Yki + Ymi);
            const float Yor = Fr * wr + Fi * wi, Yoi = Fi * wr - Fr * wi;
            z[p1] = (f32x2){Yer - Yoi, Yei + Yor};
            if (p2 != p1) z[p2] = (f32x2){Yer + Yoi, -Yei + Yor};
        }
    }
}
__device__ __forceinline__ void fft_unpack_store(const LAS f32x2* z, unsigned* Hs, float sc, int tid) {
    constexpr int M = FFT_M;
#pragma unroll 1
    for (int k = tid; k <= M / 2; k += NTHREADS) {
        if (k == 0) { const f32x2 z0 = z[0]; Hs[0] = cvtpk((z0[0] + z0[1]) * sc, 0.f); Hs[M] = cvtpk((z0[0] - z0[1]) * sc, 0.f); }
        else {
            const f32x2 zk = z[fphys(brev14(k))], zm = z[fphys(brev14(M - k))];
            const float Er = 0.5f * (zk[0] + zm[0]), Ei = 0.5f * (zk[1] - zm[1]);
            const float Dr = 0.5f * (zk[0] - zm[0]), Di = 0.5f * (zk[1] + zm[1]);
            const float Or = Di, Oi = -Dr;
            const float a = (float)k * (1.0f / (float)(2 * M));
            const float wr = __builtin_amdgcn_cosf(a), wi = -__builtin_amdgcn_sinf(a);
            const float wOr = wr * Or - wi * Oi, wOi = wr * Oi + wi * Or;
            Hs[k] = cvtpk((Er + wOr) * sc, (Ei + wOi) * sc);
            if (k != M - k) Hs[M - k] = cvtpk((Er - wOr) * sc, -(Ei - wOi) * sc);
        }
    }
}
__device__ __forceinline__ int crow(int r, int hi) { return (r & 3) + 8 * (r >> 2) + 4 * hi; }
__device__ __forceinline__ bf16x8 ldfrag(const LAS unsigned char* base, int pitch, int row, int kbyte) { return *(const LAS bf16x8*)(base + row * pitch + kbyte); }
constexpr int P136 = 272;

__device__ __forceinline__ float ret_log2g(const float* decay_logit, int dir, int h) { const float x = decay_logit[dir * 4 + h]; return -log1pf(expf(-x)) * 1.4426950408889634f; }

__device__ __forceinline__ void phase_f1(const Ctx& c, int j) {
    PREF P = *c.p;
    const float* w1 = P.in[13] + (size_t)j * 33 * 64; const float* b1 = P.in[14] + j * 64; const float* f1 = P.in[15] + j * 64;
    const float* w2 = P.in[16] + (size_t)j * 64 * 64; const float* b2 = P.in[17] + j * 64; const float* f2 = P.in[18] + j * 64;
    const bf16_t* w3t = (const bf16_t*)(c.ws + WS_W3T) + (size_t)j * 2048 * 64;
    bf16_t* taps = (bf16_t*)(c.ws + WS_TAPS); float* hid2c = (float*)(c.ws + WS_HID2C);
    LAS float* zs = (LAS float*)c.lds;
    LAS float* h1s = (LAS float*)(c.lds + 18432);
    LAS float* w1s = (LAS float*)(c.lds + 51712);
    LAS float* w2s = (LAS float*)(c.lds + 60160);
    LAS unsigned char* hb = c.lds + 76544;
    LAS unsigned char* as = c.lds + 94976;
    for (int u = c.bid; u < 130; u += c.G) {
        const int tid = opaque(c.tid);
        const bool isctx = u >= 128; const int L = isctx ? 256 : 16384; const int t0 = isctx ? (u - 128) * 128 : u * 128;
        for (int i = tid; i < 33 * 64; i += NTHREADS) w1s[i] = w1[i];
        for (int i = tid; i < 64 * 64; i += NTHREADS) w2s[i] = w2[i];
        {
            const int tl = tid >> 2, part = tid & 3; const float t = (float)(t0 + tl);
            if (part == 0) zs[tl * 36 + 0] = t / (float)(L - 1);
#pragma unroll
            for (int q = 0; q < 4; ++q) { const int b = part * 4 + q; const float band = 1e-4f + (float)b * ((15.0f - 1e-4f) / 15.0f);
                const float ang = (6.283185307179586f / (float)L) * t * band;
                zs[tl * 36 + 1 + b] = __cosf(ang); zs[tl * 36 + 17 + b] = -__sinf(ang); }
        }
        __syncthreads();
        {   const int tl = tid >> 2, og = (tid & 3) * 16; float a[16];
#pragma unroll
            for (int o = 0; o < 16; ++o) a[o] = b1[og + o];
#pragma unroll 1
            for (int f = 0; f < 33; ++f) { const float zv = zs[tl * 36 + f];
#pragma unroll
                for (int o = 0; o < 16; ++o) a[o] += zv * w1s[f * 64 + og + o]; }
#pragma unroll
            for (int o = 0; o < 16; ++o) h1s[tl * 65 + og + o] = __sinf(f1[og + o] * a[o]);
        }
        __syncthreads();
        {   const int tl = tid >> 2, og = (tid & 3) * 16; float a[16];
#pragma unroll
            for (int o = 0; o < 16; ++o) a[o] = b2[og + o];
#pragma unroll 1
            for (int k = 0; k < 64; ++k) { const float hv = h1s[tl * 65 + k];
#pragma unroll
                for (int o = 0; o < 16; ++o) a[o] += hv * w2s[k * 64 + og + o]; }
#pragma unroll
            for (int o = 0; o < 16; ++o) a[o] = __sinf(f2[og + o] * a[o]);
            if (isctx) {
#pragma unroll
                for (int o = 0; o < 16; ++o) hid2c[(size_t)(t0 + tl) * 64 + og + o] = a[o];
            } else {
#pragma unroll
                for (int o = 0; o < 16; o += 2) *(LAS unsigned*)(hb + tl * 144 + (og + o) * 2) = cvtpk(a[o], a[o + 1]);
            }
        }
        __syncthreads();
        if (!isctx) {
            const int lane = tid & 63, r32 = lane & 31, hi = lane >> 5, w = __builtin_amdgcn_readfirstlane(tid >> 6);
#pragma unroll 1
            for (int cc = 0; cc < 8; ++cc) {
                {   const int row = tid >> 1, hf = tid & 1; const u32x4* src = (const u32x4*)(w3t + (size_t)(cc * 256 + row) * 64 + hf * 32);
#pragma unroll
                    for (int q = 0; q < 4; ++q) *(LAS u32x4*)(as + row * 144 + hf * 64 + q * 16) = src[q]; }
                __syncthreads();
                f32x16 acc[4];
#pragma unroll
                for (int ni = 0; ni < 4; ++ni) acc[ni] = (f32x16){};
#pragma unroll
                for (int ks = 0; ks < 4; ++ks) { const bf16x8 a = ldfrag(as, 144, 32 * w + r32, ks * 32 + hi * 16);
#pragma unroll
                    for (int ni = 0; ni < 4; ++ni) { const bf16x8 b = ldfrag(hb, 144, 32 * ni + r32, ks * 32 + hi * 16); acc[ni] = __builtin_amdgcn_mfma_f32_32x32x16_bf16(a, b, acc[ni], 0, 0, 0); } }
#pragma unroll
                for (int ni = 0; ni < 4; ++ni) { const int t = t0 + 32 * ni + r32; const float tn = (float)t * (1.0f / 16383.0f);
#pragma unroll
                    for (int r = 0; r < 16; ++r) { const int fc = cc * 256 + 32 * w + crow(r, hi); const int ch = fc & 511;
                        const float delta = 3.0701134573253945f + (15.350567286626972f - 3.0701134573253945f) * ((float)ch * (1.0f / 511.0f));
                        taps[(size_t)fc * 16384 + t] = f2bf(acc[ni][r] * __expf(-tn * delta)); } }
                __syncthreads();
            }
        }
        __syncthreads();
    }
}

__device__ __forceinline__ void phase_f2(const Ctx& c) {
    const bf16_t* taps = (const bf16_t*)(c.ws + WS_TAPS); unsigned* hs = (unsigned*)(c.ws + WS_HSPEC);
    LAS f32x2* z = (LAS f32x2*)c.lds;
    for (int u = c.bid; u < 1024; u += c.G) {
        const int tid = opaque(c.tid);
        const int o = u >> 9, ch = u & 511;
        const bf16_t* hf = taps + (size_t)(o * 1024 + ch) * 16384; const bf16_t* hbk = taps + (size_t)(o * 1024 + 512 + ch) * 16384;
#pragma unroll 4
        for (int i = 0; i < 32; ++i) { const int m = tid + i * NTHREADS; f32x2 v;
            if (m < 8192) { const unsigned w = *(const unsigned*)(hf + 2 * m); v = (f32x2){bflo(w), bfhi(w)}; }
            else if (m == 8192) v = (f32x2){0.f, bf2f(hbk[16383])};
            else { const int s = 32768 - 2 * m; v = (f32x2){bf2f(hbk[s]), bf2f(hbk[s - 1])}; }
            z[fphys(m)] = v; }
        __syncthreads();
        fft_fwd(z, tid);
        fft_unpack_store(z, hs + (size_t)u * HSPEC_LD, 1.0f / (float)FFT_M, tid);
        __syncthreads();
    }
}

__device__ __forceinline__ void stage_T(const int tid, LAS unsigned char* dstT, const bf16_t* src, int ld, int ncols, const float* rowscale  ) {
    const int j = tid >> 2;
    for (int c8 = (tid & 3) * 8; c8 < ncols; c8 += 32) {
        const u32x4 v = *(const u32x4*)(src + (size_t)j * ld + c8); const unsigned w[4] = {v.x, v.y, v.z, v.w};
#pragma unroll
        for (int q = 0; q < 4; ++q) { *(LAS bf16_t*)(dstT + (c8 + 2 * q) * P136 + j * 2) = (bf16_t)(w[q] & 0xffffu); *(LAS bf16_t*)(dstT + (c8 + 2 * q + 1) * P136 + j * 2) = (bf16_t)(w[q] >> 16); }
    }
}
__device__ __forceinline__ void phase_r1(const Ctx& c, int j) {
    PREF P = *c.p; const bf16_t* proj = (const bf16_t*)(c.ws + WS_PROJ); bf16_t* upd = (bf16_t*)(c.ws + WS_UPD);
    LAS unsigned char* VT = c.lds; LAS unsigned char* KF = c.lds + 69632; LAS unsigned char* KB = c.lds + 104448;
    for (int u = c.bid; u < 130 * 4; u += c.G) {
        const int tid = opaque(c.tid), lane = tid & 63, r32 = lane & 31, hi = lane >> 5, w = __builtin_amdgcn_readfirstlane(tid >> 6);
        const int m = u >> 2, h = u & 3; const size_t row0 = (size_t)m * 128;
        const float lgf = ret_log2g(P.in[10] + j * 8, 0, h), lgb = ret_log2g(P.in[10] + j * 8, 1, h);
        stage_T(tid, VT, proj + row0 * AB_IN + 1024 + h * 256, AB_IN, 256, nullptr);
        {   const int jj = tid >> 2; const float sf = exp2f((float)(127 - jj) * lgf), sb = exp2f((float)jj * lgb);
            for (int c8 = (tid & 3) * 8; c8 < 128; c8 += 32) {
                const u32x4 v = *(const u32x4*)(proj + (row0 + jj) * AB_IN + 512 + h * 128 + c8); const unsigned wv[4] = {v.x, v.y, v.z, v.w};
#pragma unroll
                for (int q = 0; q < 4; ++q) { const float lo = bflo(wv[q]), hi_ = bfhi(wv[q]);
                    *(LAS bf16_t*)(KF + (c8 + 2 * q) * P136 + jj * 2) = f2bf(lo * sf); *(LAS bf16_t*)(KF + (c8 + 2 * q + 1) * P136 + jj * 2) = f2bf(hi_ * sf);
                    *(LAS bf16_t*)(KB + (c8 + 2 * q) * P136 + jj * 2) = f2bf(lo * sb); *(LAS bf16_t*)(KB + (c8 + 2 * q + 1) * P136 + jj * 2) = f2bf(hi_ * sb); } } }
        __syncthreads();
#pragma unroll 1
        for (int dir = 0; dir < 2; ++dir) {
            const LAS unsigned char* KX = dir ? KB : KF;
            f32x16 af[4];
#pragma unroll
            for (int n = 0; n < 4; ++n) af[n] = (f32x16){};
#pragma unroll
            for (int ks = 0; ks < 8; ++ks) { const bf16x8 a = ldfrag(VT, P136, 32 * w + r32, ks * 32 + hi * 16);
#pragma unroll
                for (int n = 0; n < 4; ++n) { const bf16x8 bf_ = ldfrag(KX, P136, 32 * n + r32, ks * 32 + hi * 16); af[n] = __builtin_amdgcn_mfma_f32_32x32x16_bf16(a, bf_, af[n], 0, 0, 0); } }
            bf16_t* of = upd + ((size_t)(m * 4 + h) * 2 + dir) * 32768;
#pragma unroll
            for (int n = 0; n < 4; ++n)
#pragma unroll
                for (int r = 0; r < 16; ++r) { const int e = 32 * w + crow(r, hi), d = 32 * n + r32; of[e * 128 + d] = f2bf(af[n][r]); }
        }
        __syncthreads();
    }
}

__device__ __forceinline__ void phase_hyprep(const Ctx& c, int j) {
    PREF P = *c.p; const bf16_t* proj = (const bf16_t*)(c.ws + WS_PROJ); bf16_t* uT = (bf16_t*)(c.ws + WS_UT);
    const float* cw = P.in[11] + (size_t)j * 3 * 1536; const float* cb = P.in[12] + (size_t)j * 1536;
    LAS float* t = (LAS float*)c.lds;
    const int tid = c.tid;
    for (int u = c.bid; u < 256 * 24; u += c.G) {
        const int tt = u / 24, ct = u % 24, t0 = tt * 64, ch0 = ct * 64;
        for (int idx = tid; idx < 66 * 8; idx += NTHREADS) { const int r = idx >> 3, c8 = (idx & 7) * 8; const int tg = t0 - 1 + r;
            u32x4 v = (u32x4){0u, 0u, 0u, 0u};
            if (tg >= 0 && tg < NX) v = *(const u32x4*)(proj + (size_t)(NC + tg) * AB_IN + 3072 + ch0 + c8);
            const unsigned wv[4] = {v.x, v.y, v.z, v.w};
#pragma unroll
            for (int q = 0; q < 4; ++q) { t[r * 65 + c8 + 2 * q] = bflo(wv[q]); t[r * 65 + c8 + 2 * q + 1] = bfhi(wv[q]); } }
        __syncthreads();
        {   const int ch = tid >> 3, t8 = (tid & 7) * 8; const int chg = ch0 + ch;
            const float w0 = cw[chg], w1 = cw[1536 + chg], w2 = cw[3072 + chg], bb = cb[chg]; float o[8];
#pragma unroll
            for (int q = 0; q < 8; ++q) o[q] = t[(t8 + q) * 65 + ch] * w0 + t[(t8 + q + 1) * 65 + ch] * w1 + t[(t8 + q + 2) * 65 + ch] * w2 + bb;
            u32x4 wv; wv.x = cvtpk(o[0], o[1]); wv.y = cvtpk(o[2], o[3]); wv.z = cvtpk(o[4], o[5]); wv.w = cvtpk(o[6], o[7]);
            *(u32x4*)(uT + (size_t)chg * NX + t0 + t8) = wv; }
        __syncthreads();
    }
}

__device__ __forceinline__ void phase_scan(const Ctx& c, int j) {
    PREF P = *c.p; const unsigned* upd = (const unsigned*)(c.ws + WS_UPD); unsigned* sp = (unsigned*)(c.ws + WS_SPREV);
    for (int idx = c.bid * NTHREADS + c.tid; idx < 4 * 2 * 16384; idx += c.G * NTHREADS) {
        const int h = idx >> 15, dir = (idx >> 14) & 1, pr = idx & 16383;
        const float g = exp2f(128.0f * ret_log2g(P.in[10] + j * 8, dir, h));
        float s0 = 0.f, s1 = 0.f;
        const size_t base = (size_t)(h * 2 + dir) * 16384 + pr, mstride = (size_t)4 * 2 * 16384;
#pragma unroll 1
        for (int it = 0; it < 130; it += 10) {
            unsigned uv[10]; int mm[10];
#pragma unroll
            for (int q = 0; q < 10; ++q) { const int s = it + q; mm[q] = (dir == 0) ? s : (s < 2 ? 1 - s : 131 - s); uv[q] = upd[base + (size_t)mm[q] * mstride]; }
#pragma unroll
            for (int q = 0; q < 10; ++q) { sp[base + (size_t)mm[q] * mstride] = cvtpk(s0, s1); s0 = g * s0 + bflo(uv[q]); s1 = g * s1 + bfhi(uv[q]); }
        }
    }
}
__device__ __forceinline__ void phase_hyconv(const Ctx& c, int j) {
    PREF P = *c.p; const unsigned* uT = (const unsigned*)(c.ws + WS_UT); unsigned* yT = (unsigned*)(c.ws + WS_YT);
    const unsigned* hs = (const unsigned*)(c.ws + WS_HSPEC); const float* skip = P.in[20] + (size_t)j * 2 * 512;
    LAS f32x2* z = (LAS f32x2*)c.lds;
    for (int ch = c.bid; ch < 512; ch += c.G) {
        const int tid = opaque(c.tid);
        const unsigned* vp = uT + (size_t)ch * (NX / 2); const unsigned* x1p = uT + (size_t)(512 + ch) * (NX / 2); const unsigned* x2p = uT + (size_t)(1024 + ch) * (NX / 2);
        const float sk0 = skip[ch], sk1 = skip[512 + ch];
#pragma unroll 4
        for (int i = 0; i < 16; ++i) { const int m = tid + i * NTHREADS; const unsigned w = vp[m]; z[fphys(m)] = (f32x2){bflo(w), bfhi(w)}; }
#pragma unroll 4
        for (int i = 16; i < 32; ++i) z[fphys(tid + i * NTHREADS)] = (f32x2){0.f, 0.f};
        __syncthreads();
        fft_fwd(z, tid); fft_pair_mul(z, hs + (size_t)ch * HSPEC_LD, tid); __syncthreads(); fft_inv(z, tid);
        f32x2* y1g = (f32x2*)(c.ws + WS_Y1) + (size_t)ch * (NX / 2);
#pragma unroll 4
        for (int i = 0; i < 16; ++i) { const int m = tid + i * NTHREADS; const f32x2 cv = z[fphys(m)]; const unsigned w = x1p[m], wv = vp[m];
            const f32x2 y = (f32x2){bflo(w) * (cv[0] + sk0 * bflo(wv)), bfhi(w) * (cv[1] + sk0 * bfhi(wv))};
            z[fphys(m)] = y; y1g[m] = y; }
#pragma unroll 4
        for (int i = 16; i < 32; ++i) z[fphys(tid + i * NTHREADS)] = (f32x2){0.f, 0.f};
        __syncthreads();
        fft_fwd(z, tid); fft_pair_mul(z, hs + (size_t)(512 + ch) * HSPEC_LD, tid); __syncthreads(); fft_inv(z, tid);
#pragma unroll 4
        for (int i = 0; i < 16; ++i) { const int m = tid + i * NTHREADS; const f32x2 cv = z[fphys(m)]; const unsigned w = x2p[m]; const f32x2 y1 = y1g[m];
            yT[(size_t)ch * (NX / 2) + m] = cvtpk(bflo(w) * (cv[0] + sk1 * y1[0]), bfhi(w) * (cv[1] + sk1 * y1[1])); }
        __syncthreads();
    }
}

__device__ __forceinline__ void phase_r3(const Ctx& c, int j) {
    PREF P = *c.p; const bf16_t* proj = (const bf16_t*)(c.ws + WS_PROJ); const bf16_t* spv = (const bf16_t*)(c.ws + WS_SPREV); bf16_t* cat = (bf16_t*)(c.ws + WS_CAT);
    LAS unsigned char* R0 = c.lds; LAS unsigned char* R1 = c.lds + 34816; LAS unsigned char* R2 = c.lds + 69632;
    for (int u = c.bid; u < 130 * 4; u += c.G) {
        const int tid = opaque(c.tid), lane = tid & 63, r32 = lane & 31, hi = lane >> 5, w = __builtin_amdgcn_readfirstlane(tid >> 6), wr2 = w >> 2, wc = w & 3;
        const int m = u >> 2, h = u & 3; const size_t row0 = (size_t)m * 128;
        const float lgf = ret_log2g(P.in[10] + j * 8, 0, h), lgb = ret_log2g(P.in[10] + j * 8, 1, h);
        {   const int jj = tid >> 2;
            for (int c8 = (tid & 3) * 8; c8 < 128; c8 += 32) {
                *(LAS u32x4*)(R0 + jj * P136 + c8 * 2) = *(const u32x4*)(proj + (row0 + jj) * AB_IN + h * 128 + c8);
                *(LAS u32x4*)(R1 + jj * P136 + c8 * 2) = *(const u32x4*)(proj + (row0 + jj) * AB_IN + 512 + h * 128 + c8); } }
        stage_T(tid, R2, proj + row0 * AB_IN + 1024 + h * 256, AB_IN, 256, nullptr);
        __syncthreads();
        f32x16 s[2] = {(f32x16){}, (f32x16){}};
#pragma unroll
        for (int ks = 0; ks < 8; ++ks) { const bf16x8 b = ldfrag(R1, P136, 32 * wc + r32, ks * 32 + hi * 16);
#pragma unroll
            for (int mi = 0; mi < 2; ++mi) { const bf16x8 a = ldfrag(R0, P136, 64 * wr2 + 32 * mi + r32, ks * 32 + hi * 16); s[mi] = __builtin_amdgcn_mfma_f32_32x32x16_bf16(a, b, s[mi], 0, 0, 0); } }
        __syncthreads();
#pragma unroll
        for (int mi = 0; mi < 2; ++mi)
#pragma unroll
            for (int r = 0; r < 16; ++r) { const int i = 64 * wr2 + 32 * mi + crow(r, hi), jc = 32 * wc + r32, rel = i - jc;
                const float dcy = (rel > 0) ? exp2f((float)rel * lgf) : ((rel < 0) ? exp2f((float)(-rel) * lgb) : 2.0f);
                *(LAS bf16_t*)(R1 + i * P136 + jc * 2) = f2bf(s[mi][r] * dcy); }
        __syncthreads();
        f32x16 o[2][2];
#pragma unroll
        for (int mi = 0; mi < 2; ++mi)
#pragma unroll
            for (int ni = 0; ni < 2; ++ni) o[mi][ni] = (f32x16){};
#pragma unroll
        for (int ks = 0; ks < 8; ++ks) { bf16x8 a[2], b[2];
#pragma unroll
            for (int q = 0; q < 2; ++q) { a[q] = ldfrag(R1, P136, 64 * wr2 + 32 * q + r32, ks * 32 + hi * 16); b[q] = ldfrag(R2, P136, 64 * wc + 32 * q + r32, ks * 32 + hi * 16); }
#pragma unroll
            for (int mi = 0; mi < 2; ++mi)
#pragma unroll
                for (int ni = 0; ni < 2; ++ni) o[mi][ni] = __builtin_amdgcn_mfma_f32_32x32x16_bf16(a[mi], b[ni], o[mi][ni], 0, 0, 0); }
        __syncthreads();
#pragma unroll 1
        for (int dir = 0; dir < 2; ++dir) {
            {   const int jj = tid >> 2; const float qd = (dir == 0) ? exp2f((float)(jj + 1) * lgf) : exp2f((float)(128 - jj) * lgb);
                for (int c8 = (tid & 3) * 8; c8 < 128; c8 += 32) { const u32x4 v = *(const LAS u32x4*)(R0 + jj * P136 + c8 * 2); u32x4 wv;
                    wv.x = cvtpk(bflo(v.x) * qd, bfhi(v.x) * qd); wv.y = cvtpk(bflo(v.y) * qd, bfhi(v.y) * qd); wv.z = cvtpk(bflo(v.z) * qd, bfhi(v.z) * qd); wv.w = cvtpk(bflo(v.w) * qd, bfhi(v.w) * qd);
                    *(LAS u32x4*)(R1 + jj * P136 + c8 * 2) = wv; } }
            {   const bf16_t* sp = spv + ((size_t)(m * 4 + h) * 2 + dir) * 32768;
                for (int idx = tid; idx < 256 * 16; idx += NTHREADS) { const int e = idx >> 4, c8 = (idx & 15) * 8; *(LAS u32x4*)(R2 + e * P136 + c8 * 2) = *(const u32x4*)(sp + e * 128 + c8); } }
            __syncthreads();
#pragma unroll
            for (int ks = 0; ks < 8; ++ks) { bf16x8 a[2], b[2];
#pragma unroll
                for (int q = 0; q < 2; ++q) { a[q] = ldfrag(R1, P136, 64 * wr2 + 32 * q + r32, ks * 32 + hi * 16); b[q] = ldfrag(R2, P136, 64 * wc + 32 * q + r32, ks * 32 + hi * 16); }
#pragma unroll
                for (int mi = 0; mi < 2; ++mi)
#pragma unroll
                    for (int ni = 0; ni < 2; ++ni) o[mi][ni] = __builtin_amdgcn_mfma_f32_32x32x16_bf16(a[mi], b[ni], o[mi][ni], 0, 0, 0); }
            __syncthreads();
        }
        for (int idx = tid; idx < 128 * 32; idx += NTHREADS) { const int i = idx >> 5, c8 = (idx & 31) * 8; *(LAS u32x4*)(R2 + i * 528 + c8 * 2) = *(const u32x4*)(proj + (row0 + i) * AB_IN + 2048 + h * 256 + c8); }
        LAS float* st = (LAS float*)R0;
#pragma unroll
        for (int mi = 0; mi < 2; ++mi)
#pragma unroll
            for (int r = 0; r < 16; ++r) { float sm = o[mi][0][r] + o[mi][1][r], sq = o[mi][0][r] * o[mi][0][r] + o[mi][1][r] * o[mi][1][r];
#pragma unroll
                for (int off = 16; off >= 1; off >>= 1) { sm += __shfl_xor(sm, off); sq += __shfl_xor(sq, off); }
                if (r32 == 0) { const int i = 64 * wr2 + 32 * mi + crow(r, hi); st[(i * 4 + wc) * 2 + 0] = sm; st[(i * 4 + wc) * 2 + 1] = sq; } }
        __syncthreads();
#pragma unroll
        for (int mi = 0; mi < 2; ++mi)
#pragma unroll
            for (int r = 0; r < 16; ++r) { const int i = 64 * wr2 + 32 * mi + crow(r, hi); float sm = 0.f, sq = 0.f;
#pragma unroll
                for (int q = 0; q < 4; ++q) { sm += st[(i * 4 + q) * 2 + 0]; sq += st[(i * 4 + q) * 2 + 1]; }
                const float mu = sm * (1.0f / 256.f), var = fmaxf(sq * (1.0f / 256.f) - mu * mu, 0.f), rstd = rsqrtf(var + EPS);
#pragma unroll
                for (int ni = 0; ni < 2; ++ni) { const int e = 64 * wc + 32 * ni + r32; LAS bf16_t* pg = (LAS bf16_t*)(R2 + i * 528 + e * 2); const float g = bf2f(*pg);
                    *pg = f2bf((o[mi][ni][r] - mu) * rstd * siluf(g)); } }
        __syncthreads();
        for (int idx = tid; idx < 128 * 32; idx += NTHREADS) { const int i = idx >> 5, c8 = (idx & 31) * 8; *(u32x4*)(cat + (row0 + i) * AB_CAT + h * 256 + c8) = *(const LAS u32x4*)(R2 + i * 528 + c8 * 2); }
        __syncthreads();
    }
}

__device__ __forceinline__ void phase_hytrans(const Ctx& c) {
    const bf16_t* yT = (const bf16_t*)(c.ws + WS_YT); bf16_t* cat = (bf16_t*)(c.ws + WS_CAT);
    LAS bf16_t* t = (LAS bf16_t*)c.lds;
    const int tid = c.tid;
    if (c.bid < 8) return;
    for (int u = c.bid - 8; u < 256 * 8; u += c.G - 8) {
        const int t0 = (u >> 3) * 64, ch0 = (u & 7) * 64;
        {   const int ch = tid >> 3, t8 = (tid & 7) * 8; const u32x4 v = *(const u32x4*)(yT + (size_t)(ch0 + ch) * NX + t0 + t8); const unsigned wv[4] = {v.x, v.y, v.z, v.w};
#pragma unroll
            for (int q = 0; q < 4; ++q) { t[ch * 66 + t8 + 2 * q] = (bf16_t)(wv[q] & 0xffffu); t[ch * 66 + t8 + 2 * q + 1] = (bf16_t)(wv[q] >> 16); } }
        __syncthreads();
        {   const int tt = tid >> 3, c8 = (tid & 7) * 8; unsigned short e[8];
#pragma unroll
            for (int q = 0; q < 8; ++q) e[q] = t[(c8 + q) * 66 + tt];
            u32x4 wv; wv.x = e[0] | ((unsigned)e[1] << 16); wv.y = e[2] | ((unsigned)e[3] << 16); wv.z = e[4] | ((unsigned)e[5] << 16); wv.w = e[6] | ((unsigned)e[7] << 16);
            *(u32x4*)(cat + (size_t)(NC + t0 + tt) * AB_CAT + 1024 + ch0 + c8) = wv; }
        __syncthreads();
    }
}

__device__ __forceinline__ void phase_hyctx(const Ctx& c, int j) {
    PREF P = *c.p; const bf16_t* proj = (const bf16_t*)(c.ws + WS_PROJ); bf16_t* cat = (bf16_t*)(c.ws + WS_CAT);
    const float* hid2c = (const float*)(c.ws + WS_HID2C); const float* w3 = P.in[19] + (size_t)j * 64 * 2048;
    const float* cw = P.in[11] + (size_t)j * 3 * 1536; const float* cb = P.in[12] + (size_t)j * 1536; const float* skip = P.in[20] + (size_t)j * 2 * 512;
    LAS float* raw = (LAS float*)c.lds;
    LAS float* ser = raw + 3 * 258 * 8;
    LAS float* flt = ser + 3 * 256 * 8;
    LAS float* yy = flt + 4 * 256 * 8;
    LAS float* w3s = yy + 256 * 8;
    const int tid = c.tid;
    if (c.bid < 8) return;
    for (int u = c.bid - 8; u < 64; u += c.G - 8) {
        const int ch0 = u * 8;
        for (int idx = tid; idx < 3 * 258; idx += NTHREADS) { const int s = idx / 258, r = idx % 258, t = r - 1; u32x4 v = (u32x4){0u, 0u, 0u, 0u};
            if (t >= 0 && t < 256) v = *(const u32x4*)(proj + (size_t)t * AB_IN + 3072 + s * 512 + ch0);
            LAS float* d = raw + (size_t)idx * 8; d[0] = bflo(v.x); d[1] = bfhi(v.x); d[2] = bflo(v.y); d[3] = bfhi(v.y); d[4] = bflo(v.z); d[5] = bfhi(v.z); d[6] = bflo(v.w); d[7] = bfhi(v.w); }
        for (int idx = tid; idx < 64 * 4 * 2; idx += NTHREADS) { const int k = idx >> 3, f = (idx >> 1) & 3, hh = idx & 1; *(LAS f32x4*)(w3s + (k * 4 + f) * 8 + hh * 4) = *(const f32x4*)(w3 + (size_t)k * 2048 + f * 512 + ch0 + hh * 4); }
        __syncthreads();
        {
            const int t = tid & 255, fh = tid >> 8; const float tn = (float)t * (1.0f / 255.0f);
            float a[2][8];
#pragma unroll
            for (int q = 0; q < 16; ++q) a[q >> 3][q & 7] = 0.f;
#pragma unroll 4
            for (int k = 0; k < 64; ++k) { const float hv = hid2c[t * 64 + k];
#pragma unroll
                for (int f2 = 0; f2 < 2; ++f2) { const f32x4 w0 = *(const LAS f32x4*)(w3s + (k * 4 + 2 * fh + f2) * 8), w1 = *(const LAS f32x4*)(w3s + (k * 4 + 2 * fh + f2) * 8 + 4);
#pragma unroll
                    for (int e = 0; e < 4; ++e) { a[f2][e] += hv * w0[e]; a[f2][4 + e] += hv * w1[e]; } } }
#pragma unroll
            for (int f2 = 0; f2 < 2; ++f2)
#pragma unroll
                for (int e = 0; e < 8; ++e) { const float delta = 3.0701134573253945f + (15.350567286626972f - 3.0701134573253945f) * ((float)(ch0 + e) * (1.0f / 511.0f));
                    flt[((2 * fh + f2) * 256 + t) * 8 + e] = a[f2][e] * __expf(-tn * delta); } }
        for (int idx = tid; idx < 3 * 256 * 8; idx += NTHREADS) { const int e = idx & 7, t = (idx >> 3) & 255, s = idx >> 11, cg = s * 512 + ch0 + e;
            ser[idx] = raw[(s * 258 + t) * 8 + e] * cw[cg] + raw[(s * 258 + t + 1) * 8 + e] * cw[1536 + cg] + raw[(s * 258 + t + 2) * 8 + e] * cw[3072 + cg] + cb[cg]; }
        __syncthreads();
        {   const int t = tid & 255, e0 = (tid >> 8) * 4; f32x4 a = (f32x4){0.f, 0.f, 0.f, 0.f};
            for (int s = 0; s <= t; ++s) a += *(const LAS f32x4*)(flt + (0 * 256 + (t - s)) * 8 + e0) * *(const LAS f32x4*)(ser + s * 8 + e0);
            for (int s = t + 1; s < 256; ++s) a += *(const LAS f32x4*)(flt + (1 * 256 + (s - t)) * 8 + e0) * *(const LAS f32x4*)(ser + s * 8 + e0);
            const f32x4 vv = *(const LAS f32x4*)(ser + t * 8 + e0), x1 = *(const LAS f32x4*)(ser + (256 + t) * 8 + e0), sk = *(const f32x4*)(skip + ch0 + e0);
            *(LAS f32x4*)(yy + t * 8 + e0) = x1 * (a + sk * vv); }
        __syncthreads();
        {   const int t = tid & 255, e0 = (tid >> 8) * 4; f32x4 a = (f32x4){0.f, 0.f, 0.f, 0.f};
            for (int s = 0; s <= t; ++s) a += *(const LAS f32x4*)(flt + (2 * 256 + (t - s)) * 8 + e0) * *(const LAS f32x4*)(yy + s * 8 + e0);
            for (int s = t + 1; s < 256; ++s) a += *(const LAS f32x4*)(flt + (3 * 256 + (s - t)) * 8 + e0) * *(const LAS f32x4*)(yy + s * 8 + e0);
            const f32x4 y1 = *(const LAS f32x4*)(yy + t * 8 + e0), x2 = *(const LAS f32x4*)(ser + (512 + t) * 8 + e0), sk = *(const f32x4*)(skip + 512 + ch0 + e0);
            const f32x4 o = x2 * (a + sk * y1); u32x2 wv; wv.x = cvtpk(o[0], o[1]); wv.y = cvtpk(o[2], o[3]);
            *(u32x2*)(cat + (size_t)t * AB_CAT + 1024 + ch0 + e0) = wv; }
        __syncthreads();
    }
}
namespace da2 {
constexpr int KSLOT = 16384, VSLOT = 16384, NSLOT = 3;
constexpr int LDS_K = 0, LDS_V = NSLOT * KSLOT, LDS_WS = LDS_V + NSLOT * VSLOT;
#define D2_SBAR() __builtin_amdgcn_sched_barrier(0)
#define D2_WAIT_BAR(N) asm volatile("s_waitcnt vmcnt(" #N ") lgkmcnt(0)\n\ts_barrier" ::: "memory")
typedef short v4i16_t __attribute__((ext_vector_type(4)));
typedef LAS const char* lcp;
__device__ __forceinline__ void glds16(const void* gsrc, unsigned lds_dst) { unsigned keep;
    asm volatile("s_mov_b32 %0, m0\n\ts_mov_b32 m0, %2\n\ts_nop 0\n\tglobal_load_lds_dwordx4 %1, off\n\ts_mov_b32 m0, %0" : "=&s"(keep) : "v"(gsrc), "s"(lds_dst) : "memory"); }
__device__ __forceinline__ unsigned cvtpk_s(float lo, float hi) { f32x2 v = {lo, hi}; bf16x2_t b = __builtin_convertvector(v, bf16x2_t); return __builtin_bit_cast(unsigned, b); }
__device__ __forceinline__ s16x4 vtr(lcp p) { return __builtin_bit_cast(s16x4, __builtin_amdgcn_ds_read_tr16_b64_v4i16((LAS v4i16_t*)p)); }
__device__ __forceinline__ void kload8(bf16x8* kf, lcp kp) {
    kf[0] = *(const LAS bf16x8*)(kp);        kf[1] = *(const LAS bf16x8*)(kp + 512);
    kf[2] = *(const LAS bf16x8*)(kp + 2048); kf[3] = *(const LAS bf16x8*)(kp + 2560);
    kf[4] = *(const LAS bf16x8*)(kp + 4096); kf[5] = *(const LAS bf16x8*)(kp + 4608);
    kf[6] = *(const LAS bf16x8*)(kp + 6144); kf[7] = *(const LAS bf16x8*)(kp + 6656); }

__device__ __forceinline__ bool attn_unit_dma(LAS char* lds, const bf16_t* proj, bf16_t* cat, int h, int qrow0, int nkeys, float lam, float oscale, const float* subln) {
    constexpr int LD = DA_IN;
    const int tid = opaque((int)threadIdx.x), wid = __builtin_amdgcn_readfirstlane(tid >> 6), lane = tid & 63, r32 = lane & 31, hi = lane >> 5, comp = wid >> 2, qw = wid & 3;
    const unsigned lds0 = (unsigned)(uintptr_t)lds;
    LAS float* wsf = (LAS float*)(lds + LDS_WS) + wid * 64;
    const bf16_t* Kh = proj + 1024 + h * 128; const bf16_t* Vh = proj + 2048 + h * 128;
    const bf16_t* ksrc0 = Kh + (size_t)lane * LD + wid * 8; const bf16_t* ksrc1 = ksrc0 + 64;
    const bf16_t* vsrc0 = Vh + (size_t)(16 * (wid & 3) + (lane >> 2)) * LD + (wid >> 2) * 32 + (lane & 3) * 8; const bf16_t* vsrc1 = vsrc0 + 64;
    const unsigned kdst = lds0 + LDS_K + wid * 1024, vdst = lds0 + LDS_V + wid * 1024;
#define D2_DMA_K(t, slot) do { glds16(ksrc0 + (size_t)(t) * 64 * LD, (unsigned)__builtin_amdgcn_readfirstlane(kdst + (slot))); glds16(ksrc1 + (size_t)(t) * 64 * LD, (unsigned)__builtin_amdgcn_readfirstlane(kdst + (slot) + 8192)); } while (0)
#define D2_DMA_V(t, slot) do { glds16(vsrc0 + (size_t)(t) * 64 * LD, (unsigned)__builtin_amdgcn_readfirstlane(vdst + (slot))); glds16(vsrc1 + (size_t)(t) * 64 * LD, (unsigned)__builtin_amdgcn_readfirstlane(vdst + (slot) + 8192)); } while (0)
    const lcp shm3 = (lcp)lds;
    const lcp kp0 = shm3 + LDS_K + comp * 8192 + hi * 1024 + r32 * 16;
    const lcp vp0 = shm3 + LDS_V + ((lane >> 4) & 1) * 32 + (lane & 3) * 8 + (4 * hi + ((lane & 15) >> 2)) * 64;
    const int NT = nkeys / 64;
    D2_DMA_K(0, 0); D2_DMA_V(0, 0); D2_DMA_K(1, KSLOT);
    bf16x8 qr[4];
    { const bf16_t* Qw = proj + (size_t)(qrow0 + qw * 32 + r32) * LD + h * 128 + comp * 64 + hi * 8;
#pragma unroll
      for (int d0 = 0; d0 < 4; ++d0) qr[d0] = *reinterpret_cast<const bf16x8*>(Qw + d0 * 16); }
    float l_reg = 0.f; f32x16 o[4]; o[0] = f32x16{}; o[1] = f32x16{}; o[2] = f32x16{}; o[3] = f32x16{};
    f32x16 pA0, pA1, pB0, pB1; bf16x8 kf[8];
    int sl_prev = 0, sl_cur = 0, sl_next = KSLOT;
#define D2_ROT() do { sl_prev = sl_cur; sl_cur = sl_next; sl_next = (sl_next == (NSLOT - 1) * KSLOT) ? 0 : sl_next + KSLOT; } while (0)
    D2_DMA_K(2, 2 * KSLOT);
    D2_WAIT_BAR(6);
    { const lcp kb = kp0;
      pA0 = f32x16{}; pA1 = f32x16{};
#pragma unroll
      for (int d0 = 0; d0 < 4; ++d0) { const bf16x8 b0 = *(const LAS bf16x8*)(kb + d0 * 2048), b1 = *(const LAS bf16x8*)(kb + d0 * 2048 + 512);
          pA0 = __builtin_amdgcn_mfma_f32_32x32x16_bf16(b0, qr[d0], pA0, 0, 0, 0); pA1 = __builtin_amdgcn_mfma_f32_32x32x16_bf16(b1, qr[d0], pA1, 0, 0, 0); }
#pragma unroll
      for (int r = 0; r < 16; ++r) { pA0[r] = __builtin_amdgcn_exp2f(pA0[r]); pA1[r] = __builtin_amdgcn_exp2f(pA1[r]); } }
    D2_WAIT_BAR(0);
    D2_DMA_K(3, 0); D2_DMA_V(1, VSLOT);
    D2_ROT();
    kload8(kf, kp0 + sl_cur);
    D2_WAIT_BAR(4);
    s16x4 vlo[8], vhi[8]; u32x4 pw0, pw1, pw2, pw3;
#define D2_PKW(P, B) cvtpk_s(P[B], P[B + 1])
#define D2_PAF(k) __builtin_bit_cast(bf16x8, pw##k)
#define D2_VFR(s) (bf16x8){vlo[s][0], vlo[s][1], vlo[s][2], vlo[s][3], vhi[s][0], vhi[s][1], vhi[s][2], vhi[s][3]}
#define D2_PIN(x) asm volatile("" : "+v"(x))
#define D2_VRD(s, i) do { vlo[s] = vtr(vp_ + (((i) >> 2) * 4096 + ((i) & 3) * 1024)); vhi[s] = vtr(vp_ + (((i) >> 2) * 4096 + ((i) & 3) * 1024 + 512)); } while (0)
#define D2_GAPA(MF, A0, A1, A2, A3, W0, W1, PW) do { MF; sacc += A0; sacc += A1; sacc += A2; sacc += A3; D2_PIN(sacc); W0; W1; D2_PIN(PW); D2_SBAR(); } while (0)
#define D2_EX(v) __builtin_amdgcn_exp2f(v)
#define D2_GAPB(MF, X, B) do { MF; X[B] = D2_EX(X[B]); X[B + 1] = D2_EX(X[B + 1]); D2_PIN(X); D2_SBAR(); } while (0)
#define D2_KRD(G, j) do { if (G) { kf[j] = *(const LAS bf16x8*)(kp0 + sl_next + ((j) >> 1) * 2048 + ((j) & 1) * 512); D2_SBAR(); } } while (0)
#define D2_ORD(j) ((((j) & 3) << 2) | ((j) >> 2))
#define D2_STEP(C0, C1, P0, P1, t, GK, GV, GL) do { D2_SBAR(); \
    const lcp vp_ = vp0 + sl_prev; \
    D2_VRD(0, D2_ORD(0)); D2_SBAR(); float sacc = (P0[0] + P0[1]); \
    D2_GAPA(C0 = __builtin_amdgcn_mfma_f32_32x32x16_bf16(kf[0], qr[0], f32x16{}, 0, 0, 0), P0[2], P0[3], P0[4], P0[5],     pw0[0] = D2_PKW(P0, 0), pw0[1] = D2_PKW(P0, 2), pw0); \
    D2_VRD(1, D2_ORD(1)); D2_SBAR(); D2_GAPA(C1 = __builtin_amdgcn_mfma_f32_32x32x16_bf16(kf[1], qr[0], f32x16{}, 0, 0, 0), P0[6], P0[7], P0[8], P0[9],     pw0[2] = D2_PKW(P0, 4), pw0[3] = D2_PKW(P0, 6), pw0); \
    D2_VRD(2, D2_ORD(2)); D2_SBAR(); D2_GAPA(C0 = __builtin_amdgcn_mfma_f32_32x32x16_bf16(kf[2], qr[1], C0, 0, 0, 0),       P0[10], P0[11], P0[12], P0[13], pw1[0] = D2_PKW(P0, 8), pw1[1] = D2_PKW(P0, 10), pw1); \
    D2_VRD(3, D2_ORD(3)); D2_SBAR(); D2_GAPA(C1 = __builtin_amdgcn_mfma_f32_32x32x16_bf16(kf[3], qr[1], C1, 0, 0, 0),       P0[14], P0[15], P1[0], P1[1],   pw1[2] = D2_PKW(P0, 12), pw1[3] = D2_PKW(P0, 14), pw1); \
    D2_VRD(4, D2_ORD(4)); D2_SBAR(); D2_GAPA(C0 = __builtin_amdgcn_mfma_f32_32x32x16_bf16(kf[4], qr[2], C0, 0, 0, 0),       P1[2], P1[3], P1[4], P1[5],     pw2[0] = D2_PKW(P1, 0), pw2[1] = D2_PKW(P1, 2), pw2); \
    D2_VRD(5, D2_ORD(5)); D2_SBAR(); D2_GAPA(C1 = __builtin_amdgcn_mfma_f32_32x32x16_bf16(kf[5], qr[2], C1, 0, 0, 0),       P1[6], P1[7], P1[8], P1[9],     pw2[2] = D2_PKW(P1, 4), pw2[3] = D2_PKW(P1, 6), pw2); \
    D2_VRD(6, D2_ORD(6)); D2_SBAR(); D2_GAPA(C0 = __builtin_amdgcn_mfma_f32_32x32x16_bf16(kf[6], qr[3], C0, 0, 0, 0),       P1[10], P1[11], P1[12], P1[13], pw3[0] = D2_PKW(P1, 8), pw3[1] = D2_PKW(P1, 10), pw3); \
    D2_VRD(7, D2_ORD(7)); D2_SBAR(); D2_GAPA(C1 = __builtin_amdgcn_mfma_f32_32x32x16_bf16(kf[7], qr[3], C1, 0, 0, 0),       P1[14], P1[15], 0.f, 0.f,       pw3[2] = D2_PKW(P1, 12), pw3[3] = D2_PKW(P1, 14), pw3); \
    l_reg += sacc; \
    if (GK) { D2_DMA_K((t) + 3, sl_cur); } if (GV) { D2_DMA_V((t) + 1, sl_next); } \
    D2_SBAR(); \
    D2_GAPB(o[0] = __builtin_amdgcn_mfma_f32_32x32x16_bf16(D2_PAF(0), D2_VFR(0), o[0], 0, 0, 0), C0, 0);  D2_VRD(0, D2_ORD(8));  D2_SBAR(); \
    D2_GAPB(o[1] = __builtin_amdgcn_mfma_f32_32x32x16_bf16(D2_PAF(0), D2_VFR(1), o[1], 0, 0, 0), C0, 2);  D2_VRD(1, D2_ORD(9));  D2_SBAR(); \
    D2_GAPB(o[2] = __builtin_amdgcn_mfma_f32_32x32x16_bf16(D2_PAF(0), D2_VFR(2), o[2], 0, 0, 0), C0, 4);  D2_VRD(2, D2_ORD(10)); D2_SBAR(); \
    D2_GAPB(o[3] = __builtin_amdgcn_mfma_f32_32x32x16_bf16(D2_PAF(0), D2_VFR(3), o[3], 0, 0, 0), C0, 6);  D2_VRD(3, D2_ORD(11)); D2_SBAR(); \
    D2_KRD(GL, 0); D2_GAPB(o[0] = __builtin_amdgcn_mfma_f32_32x32x16_bf16(D2_PAF(1), D2_VFR(4), o[0], 0, 0, 0), C0, 8);  D2_VRD(4, D2_ORD(12)); D2_SBAR(); \
    D2_KRD(GL, 1); D2_GAPB(o[1] = __builtin_amdgcn_mfma_f32_32x32x16_bf16(D2_PAF(1), D2_VFR(5), o[1], 0, 0, 0), C0, 10); D2_VRD(5, D2_ORD(13)); D2_SBAR(); \
    D2_KRD(GL, 2); D2_GAPB(o[2] = __builtin_amdgcn_mfma_f32_32x32x16_bf16(D2_PAF(1), D2_VFR(6), o[2], 0, 0, 0), C0, 12); D2_VRD(6, D2_ORD(14)); D2_SBAR(); \
    D2_KRD(GL, 3); D2_GAPB(o[3] = __builtin_amdgcn_mfma_f32_32x32x16_bf16(D2_PAF(1), D2_VFR(7), o[3], 0, 0, 0), C0, 14); D2_VRD(7, D2_ORD(15)); D2_SBAR(); \
    D2_KRD(GL, 4); D2_GAPB(o[0] = __builtin_amdgcn_mfma_f32_32x32x16_bf16(D2_PAF(2), D2_VFR(0), o[0], 0, 0, 0), C1, 0); \
    D2_KRD(GL, 5); D2_GAPB(o[1] = __builtin_amdgcn_mfma_f32_32x32x16_bf16(D2_PAF(2), D2_VFR(1), o[1], 0, 0, 0), C1, 2); \
    D2_KRD(GL, 6); D2_GAPB(o[2] = __builtin_amdgcn_mfma_f32_32x32x16_bf16(D2_PAF(2), D2_VFR(2), o[2], 0, 0, 0), C1, 4); \
    D2_KRD(GL, 7); D2_GAPB(o[3] = __builtin_amdgcn_mfma_f32_32x32x16_bf16(D2_PAF(2), D2_VFR(3), o[3], 0, 0, 0), C1, 6); \
    D2_GAPB(o[0] = __builtin_amdgcn_mfma_f32_32x32x16_bf16(D2_PAF(3), D2_VFR(4), o[0], 0, 0, 0), C1, 8); \
    D2_GAPB(o[1] = __builtin_amdgcn_mfma_f32_32x32x16_bf16(D2_PAF(3), D2_VFR(5), o[1], 0, 0, 0), C1, 10); \
    D2_GAPB(o[2] = __builtin_amdgcn_mfma_f32_32x32x16_bf16(D2_PAF(3), D2_VFR(6), o[2], 0, 0, 0), C1, 12); \
    D2_GAPB(o[3] = __builtin_amdgcn_mfma_f32_32x32x16_bf16(D2_PAF(3), D2_VFR(7), o[3], 0, 0, 0), C1, 14); \
    } while (0)
    int t = 1;
    for (; t + 5 < NT; t += 2) {
        D2_STEP(pB0, pB1, pA0, pA1, t, true, true, true);     D2_WAIT_BAR(4); D2_ROT();
        D2_STEP(pA0, pA1, pB0, pB1, t + 1, true, true, true); D2_WAIT_BAR(4); D2_ROT();
    }
#define D2_ENDW(tt) do { if ((tt) + 3 < NT) { D2_WAIT_BAR(4); } else if ((tt) + 2 < NT) { D2_WAIT_BAR(2); } else { D2_WAIT_BAR(0); } } while (0)
    for (; t + 1 < NT; t += 2) {
        D2_STEP(pB0, pB1, pA0, pA1, t, (t + 3 < NT), (t + 1 < NT), (t + 1 < NT));         D2_ENDW(t);     D2_ROT();
        D2_STEP(pA0, pA1, pB0, pB1, t + 1, (t + 4 < NT), (t + 2 < NT), (t + 2 < NT));     D2_ENDW(t + 1); D2_ROT();
    }
    D2_STEP(pB0, pB1, pA0, pA1, NT - 1, false, false, false);
    { float sacc = pB0[0] + pB0[1];
#pragma unroll
      for (int r = 2; r < 16; ++r) sacc += pB0[r];
#pragma unroll
      for (int r = 0; r < 16; ++r) sacc += pB1[r];
      l_reg += sacc;
      pw0 = (u32x4){D2_PKW(pB0, 0), D2_PKW(pB0, 2), D2_PKW(pB0, 4), D2_PKW(pB0, 6)}; pw1 = (u32x4){D2_PKW(pB0, 8), D2_PKW(pB0, 10), D2_PKW(pB0, 12), D2_PKW(pB0, 14)};
      pw2 = (u32x4){D2_PKW(pB1, 0), D2_PKW(pB1, 2), D2_PKW(pB1, 4), D2_PKW(pB1, 6)}; pw3 = (u32x4){D2_PKW(pB1, 8), D2_PKW(pB1, 10), D2_PKW(pB1, 12), D2_PKW(pB1, 14)};
      D2_SBAR();
      const lcp vp_ = vp0 + sl_cur;
#pragma unroll
      for (int d0 = 0; d0 < 4; ++d0) {
#pragma unroll
          for (int ks = 0; ks < 4; ++ks) { vlo[ks] = vtr(vp_ + (d0 * 4096 + ks * 1024)); vhi[ks] = vtr(vp_ + (d0 * 4096 + ks * 1024 + 512)); }
          o[d0] = __builtin_amdgcn_mfma_f32_32x32x16_bf16(D2_PAF(0), D2_VFR(0), o[d0], 0, 0, 0); o[d0] = __builtin_amdgcn_mfma_f32_32x32x16_bf16(D2_PAF(1), D2_VFR(1), o[d0], 0, 0, 0);
          o[d0] = __builtin_amdgcn_mfma_f32_32x32x16_bf16(D2_PAF(2), D2_VFR(2), o[d0], 0, 0, 0); o[d0] = __builtin_amdgcn_mfma_f32_32x32x16_bf16(D2_PAF(3), D2_VFR(3), o[d0], 0, 0, 0); } }
    { auto rr = __builtin_amdgcn_permlane32_swap(__float_as_uint(l_reg), __float_as_uint(l_reg), false, false); l_reg = __uint_as_float(rr[0]) + __uint_as_float(rr[1]); }
    if (hi == 0) wsf[32 + r32] = l_reg; asm volatile("s_waitcnt lgkmcnt(0)" ::: "memory");
    {
#pragma unroll
      for (int r = 0; r < 16; ++r) { const float rl = __builtin_amdgcn_rcpf(wsf[32 + crow(r, hi)]);
#pragma unroll
          for (int d0 = 0; d0 < 4; ++d0) o[d0][r] *= rl; } }
    const int bad = (l_reg > 1.0e-30f && l_reg < 1.0e30f) ? 0 : 1;
    LAS int* flg = (LAS int*)(lds + LDS_WS + 8 * 256);
    { const int anyb = (__ballot(bad) != 0ull) ? 1 : 0; if (lane == 0) flg[wid] = anyb; }
    __syncthreads();
    { int f = 0;
#pragma unroll
      for (int q = 0; q < 8; ++q) f |= flg[q];
      if (__builtin_amdgcn_readfirstlane(f)) { __syncthreads(); return false; } }
    LAS float* xb = (LAS float*)lds;
    if (comp == 1) {
#pragma unroll
        for (int d0 = 0; d0 < 4; ++d0)
#pragma unroll
            for (int r = 0; r < 16; ++r) xb[((qw * 64) + d0 * 16 + r) * 64 + lane] = o[d0][r];
    }
    __syncthreads();
    if (comp == 0) {
        float ssq[16];
#pragma unroll
        for (int r = 0; r < 16; ++r) ssq[r] = 0.f;
#pragma unroll
        for (int d0 = 0; d0 < 4; ++d0)
#pragma unroll
            for (int r = 0; r < 16; ++r) { const float x = o[d0][r] - lam * xb[((qw * 64) + d0 * 16 + r) * 64 + lane]; o[d0][r] = x; ssq[r] += x * x; }
#pragma unroll
        for (int r = 0; r < 16; ++r) {
#pragma unroll
            for (int off = 16; off >= 1; off >>= 1) ssq[r] += __shfl_xor(ssq[r], off);
            ssq[r] = rsqrtf(ssq[r] * (1.0f / 128.f) + 1e-5f) * oscale; }
        asm volatile("" ::: "memory");
        LAS char* stg = lds + qw * 16384;
#pragma unroll
        for (int d0 = 0; d0 < 4; ++d0) { const float g = subln[d0 * 32 + r32];
#pragma unroll
            for (int r = 0; r < 16; ++r) *(LAS bf16_t*)(stg + crow(r, hi) * 272 + (d0 * 32 + r32) * 2) = f2bf(o[d0][r] * ssq[r] * g); }
        asm volatile("s_waitcnt lgkmcnt(0)" ::: "memory");
        bf16_t* Ow = cat + (size_t)(qrow0 + qw * 32) * DA_W + h * 128;
#pragma unroll
        for (int q = 0; q < 8; ++q) { const int id = q * 64 + lane, row = id >> 4, c16 = id & 15; *(u32x4*)(Ow + (size_t)row * DA_W + c16 * 8) = *(const LAS u32x4*)(stg + row * 272 + c16 * 16); }
    }
    __syncthreads();
    return true;
#undef D2_DMA_K
#undef D2_DMA_V
#undef D2_ROT
#undef D2_STEP
#undef D2_ENDW
}
}
namespace da {
constexpr int KVBLK = 64;
constexpr int SHM_V = KVBLK * 128 * 2, SHM_K = KVBLK * 128 * 2;
constexpr float THR2 = 11.5f;
#define DA_KSWZ(row, colB) ((row) * 256 + ((colB) ^ (((row) & 7) << 4)))
#define DA_SBAR() __builtin_amdgcn_sched_barrier(0)
__device__ __forceinline__ unsigned cvtpk_a(float lo, float hi) { unsigned r; asm volatile("v_cvt_pk_bf16_f32 %0, %1, %2" : "=v"(r) : "v"(lo), "v"(hi)); return r; }
__device__ __forceinline__ void partialSM(f32x16& p0, f32x16& p1, float& m_reg, float& alpha) {
    float pmax = p0[0];
#pragma unroll
    for (int r = 1; r < 16; ++r) pmax = fmaxf(pmax, p0[r]);
#pragma unroll
    for (int r = 0; r < 16; ++r) pmax = fmaxf(pmax, p1[r]);
    { auto rr = __builtin_amdgcn_permlane32_swap(__float_as_uint(pmax), __float_as_uint(pmax), false, false); pmax = fmaxf(__uint_as_float(rr[0]), __uint_as_float(rr[1])); }
    float mn;
    if (__builtin_expect(__all(pmax - m_reg <= THR2), 1)) { mn = m_reg; alpha = 1.f; }
    else { mn = fmaxf(m_reg, pmax); alpha = __builtin_amdgcn_exp2f(m_reg - mn); m_reg = mn; }
#pragma unroll
    for (int r = 0; r < 16; ++r) { p0[r] -= mn; p1[r] -= mn; }
#pragma unroll
    for (int r = 0; r < 16; ++r) p0[r] = __builtin_amdgcn_exp2f(p0[r]);
}
__device__ __forceinline__ void partialSM_fast(f32x16& p0, f32x16& p1, float& l_reg) {
#pragma unroll
    for (int r = 0; r < 16; ++r) p0[r] = __builtin_amdgcn_exp2f(p0[r]);
#pragma unroll
    for (int r = 0; r < 16; ++r) p1[r] = __builtin_amdgcn_exp2f(p1[r]);
    float ps = 0;
#pragma unroll
    for (int r = 0; r < 16; ++r) ps += p0[r];
#pragma unroll
    for (int r = 0; r < 16; ++r) ps += p1[r];
    l_reg += ps;
}
__device__ __forceinline__ void finishSM_fast(f32x16& p0, f32x16& p1, bf16x8& pa0, bf16x8& pa1, bf16x8& pa2, bf16x8& pa3) {
#define DA_PK4(P, BASE, OUT) do { unsigned a0 = cvtpk_a(P[BASE + 0], P[BASE + 1]), a1 = cvtpk_a(P[BASE + 2], P[BASE + 3]);   \
    unsigned b0 = cvtpk_a(P[BASE + 4], P[BASE + 5]), b1 = cvtpk_a(P[BASE + 6], P[BASE + 7]);                              \
    auto r0 = __builtin_amdgcn_permlane32_swap(a0, b0, false, false); auto r1 = __builtin_amdgcn_permlane32_swap(a1, b1, false, false); \
    u32x4 w = {r0[0], r1[0], r0[1], r1[1]}; OUT = *reinterpret_cast<bf16x8*>(&w); } while (0)
    DA_PK4(p0, 0, pa0); DA_PK4(p0, 8, pa1); DA_PK4(p1, 0, pa2); DA_PK4(p1, 8, pa3);
#undef DA_PK4
}
__device__ __forceinline__ void finishSM(f32x16& p0, f32x16& p1, float alpha, float& l_reg, bf16x8& pa0, bf16x8& pa1, bf16x8& pa2, bf16x8& pa3) {
#pragma unroll
    for (int r = 0; r < 16; ++r) p1[r] = __builtin_amdgcn_exp2f(p1[r]);
    float ps = 0;
#pragma unroll
    for (int r = 0; r < 16; ++r) ps += p0[r];
#pragma unroll
    for (int r = 0; r < 16; ++r) ps += p1[r];
    { auto rr = __builtin_amdgcn_permlane32_swap(__float_as_uint(ps), __float_as_uint(ps), false, false); ps = __uint_as_float(rr[0]) + __uint_as_float(rr[1]); }
    l_reg = l_reg * alpha + ps;
#define DA_PK4(P, BASE, OUT) do { unsigned a0 = cvtpk_a(P[BASE + 0], P[BASE + 1]), a1 = cvtpk_a(P[BASE + 2], P[BASE + 3]);   \
    unsigned b0 = cvtpk_a(P[BASE + 4], P[BASE + 5]), b1 = cvtpk_a(P[BASE + 6], P[BASE + 7]);                              \
    auto r0 = __builtin_amdgcn_permlane32_swap(a0, b0, false, false); auto r1 = __builtin_amdgcn_permlane32_swap(a1, b1, false, false); \
    u32x4 w = {r0[0], r1[0], r0[1], r1[1]}; OUT = *reinterpret_cast<bf16x8*>(&w); } while (0)
    DA_PK4(p0, 0, pa0); DA_PK4(p0, 8, pa1); DA_PK4(p1, 0, pa2); DA_PK4(p1, 8, pa3);
#undef DA_PK4
}
__device__ __forceinline__ void qkt(f32x16& p0, f32x16& p1, const LAS char* Ks, const bf16x8* qr, int r32, int hi, int comp) {
    p0 = f32x16{}; p1 = f32x16{};
#pragma unroll
    for (int d0 = 0; d0 < 4; ++d0) { const int cb = (comp * 64 + d0 * 16 + hi * 8) * 2;
        const bf16x8 b0 = *(const LAS bf16x8*)(Ks + DA_KSWZ(r32, cb));
        const bf16x8 b1 = *(const LAS bf16x8*)(Ks + DA_KSWZ(32 + r32, cb));
        p0 = __builtin_amdgcn_mfma_f32_32x32x16_bf16(b0, qr[d0], p0, 0, 0, 0);
        p1 = __builtin_amdgcn_mfma_f32_32x32x16_bf16(b1, qr[d0], p1, 0, 0, 0); }
}
__device__ __forceinline__ int v_st(int k, int c) { const int kk = (k & ~0xC) | ((k & 4) << 1) | ((k & 8) >> 1); return ((kk >> 3) * 4 + (c >> 5)) * 512 + ((kk & 7) * 32 + (c & 31)) * 2; }
__device__ __forceinline__ int v_rd_base(int lane) { return ((lane & 3) << 3) | (((lane >> 2) & 3) << 6) | (((lane >> 4) & 1) << 5) | (((lane >> 5) & 1) << 8); }
constexpr int v_rd_off(int d0, int ks, int half) { return d0 * 512 + ks * 4096 + half * 2048; }
template <int OFF> __device__ __forceinline__ s16x4 tr_read(int vb) { s16x4 r; asm volatile("ds_read_b64_tr_b16 %0, %1 offset:%2" : "=&v"(r) : "v"(vb), "i"(OFF) : "memory"); return r; }
template <int D0> __device__ __forceinline__ void pv_one(f32x16& od, int vb, bf16x8 pa0, bf16x8 pa1, bf16x8 pa2, bf16x8 pa3) {
    const s16x4 l0 = tr_read<v_rd_off(D0, 0, 0)>(vb), h0 = tr_read<v_rd_off(D0, 0, 1)>(vb), l1 = tr_read<v_rd_off(D0, 1, 0)>(vb), h1 = tr_read<v_rd_off(D0, 1, 1)>(vb);
    const s16x4 l2 = tr_read<v_rd_off(D0, 2, 0)>(vb), h2 = tr_read<v_rd_off(D0, 2, 1)>(vb), l3 = tr_read<v_rd_off(D0, 3, 0)>(vb), h3 = tr_read<v_rd_off(D0, 3, 1)>(vb);
    asm volatile("s_waitcnt lgkmcnt(0)" ::: "memory"); DA_SBAR();
#define DA_PK(L, H) (bf16x8){L[0], L[1], L[2], L[3], H[0], H[1], H[2], H[3]}
    od = __builtin_amdgcn_mfma_f32_32x32x16_bf16(pa0, DA_PK(l0, h0), od, 0, 0, 0);
    od = __builtin_amdgcn_mfma_f32_32x32x16_bf16(pa1, DA_PK(l1, h1), od, 0, 0, 0);
    od = __builtin_amdgcn_mfma_f32_32x32x16_bf16(pa2, DA_PK(l2, h2), od, 0, 0, 0);
    od = __builtin_amdgcn_mfma_f32_32x32x16_bf16(pa3, DA_PK(l3, h3), od, 0, 0, 0);
#undef DA_PK
}
__device__ __forceinline__ void pv_d0(f32x16* o, int vb, bf16x8 pa0, bf16x8 pa1, bf16x8 pa2, bf16x8 pa3) {
    pv_one<0>(o[0], vb, pa0, pa1, pa2, pa3); pv_one<1>(o[1], vb, pa0, pa1, pa2, pa3); pv_one<2>(o[2], vb, pa0, pa1, pa2, pa3); pv_one<3>(o[3], vb, pa0, pa1, pa2, pa3);
}

#define DA_PKV(L, H) (bf16x8){L[0], L[1], L[2], L[3], H[0], H[1], H[2], H[3]}
#define DA_TRSET(D0, l0, h0, l1, h1, l2, h2, l3, h3) do { if (VAR == 3) { l0 = h0 = l1 = h1 = l2 = h2 = l3 = h3 = (s16x4){1, 2, 3, 4}; break; } l0 = tr_read<v_rd_off(D0, 0, 0)>(vb); h0 = tr_read<v_rd_off(D0, 0, 1)>(vb); l1 = tr_read<v_rd_off(D0, 1, 0)>(vb); h1 = tr_read<v_rd_off(D0, 1, 1)>(vb); \
    l2 = tr_read<v_rd_off(D0, 2, 0)>(vb); h2 = tr_read<v_rd_off(D0, 2, 1)>(vb); l3 = tr_read<v_rd_off(D0, 3, 0)>(vb); h3 = tr_read<v_rd_off(D0, 3, 1)>(vb); } while (0)
#define DA_EX2(P, I) do { if (VAR != 1) { P[I] = __builtin_amdgcn_exp2f(P[I]); P[I + 1] = __builtin_amdgcn_exp2f(P[I + 1]); } } while (0)
#define DA_MF(OD, A, B) do { if (VAR != 2) OD = __builtin_amdgcn_mfma_f32_32x32x16_bf16(A, B, OD, 0, 0, 0); else asm volatile("" :: "v"(B)); } while (0)
#define DA_BLK(OD, PA0, PA1, PA2, PA3, l0, h0, l1, h1, l2, h2, l3, h3, P, I) do { \
    DA_MF(OD, PA0, DA_PKV(l0, h0)); DA_EX2(P, I);     DA_SBAR(); \
    DA_MF(OD, PA1, DA_PKV(l1, h1)); DA_EX2(P, I + 2); DA_SBAR(); \
    DA_MF(OD, PA2, DA_PKV(l2, h2)); DA_EX2(P, I + 4); DA_SBAR(); \
    DA_MF(OD, PA3, DA_PKV(l3, h3)); DA_EX2(P, I + 6); DA_SBAR(); } while (0)
template <int VAR>
__device__ __forceinline__ void pv_fast(f32x16* o, int vb, bf16x8 pa0, bf16x8 pa1, bf16x8 pa2, bf16x8 pa3, f32x16& n0, f32x16& n1, float& l_reg) {
    s16x4 al0, ah0, al1, ah1, al2, ah2, al3, ah3, bl0, bh0, bl1, bh1, bl2, bh2, bl3, bh3;
    DA_TRSET(0, al0, ah0, al1, ah1, al2, ah2, al3, ah3);
    asm volatile("s_waitcnt lgkmcnt(0)" ::: "memory"); DA_SBAR();
    DA_TRSET(1, bl0, bh0, bl1, bh1, bl2, bh2, bl3, bh3); DA_SBAR();
    DA_BLK(o[0], pa0, pa1, pa2, pa3, al0, ah0, al1, ah1, al2, ah2, al3, ah3, n0, 0);
    asm volatile("s_waitcnt lgkmcnt(0)" ::: "memory"); DA_SBAR();
    DA_TRSET(2, al0, ah0, al1, ah1, al2, ah2, al3, ah3); DA_SBAR();
    DA_BLK(o[1], pa0, pa1, pa2, pa3, bl0, bh0, bl1, bh1, bl2, bh2, bl3, bh3, n0, 8);
    asm volatile("s_waitcnt lgkmcnt(0)" ::: "memory"); DA_SBAR();
    DA_TRSET(3, bl0, bh0, bl1, bh1, bl2, bh2, bl3, bh3); DA_SBAR();
    DA_BLK(o[2], pa0, pa1, pa2, pa3, al0, ah0, al1, ah1, al2, ah2, al3, ah3, n1, 0);
    asm volatile("s_waitcnt lgkmcnt(0)" ::: "memory"); DA_SBAR();
    DA_BLK(o[3], pa0, pa1, pa2, pa3, bl0, bh0, bl1, bh1, bl2, bh2, bl3, bh3, n1, 8);
    float ps = 0;
#pragma unroll
    for (int r = 0; r < 16; ++r) ps += n0[r];
#pragma unroll
    for (int r = 0; r < 16; ++r) ps += n1[r];
    l_reg += ps;
}
template <bool FAST, int VAR = 0>
__device__ __forceinline__ bool attn_unit(LAS char* lds, const bf16_t* proj, bf16_t* cat, int h, int qrow0, int nkeys, float lam, float oscale, const float* subln) {
    constexpr int LD = DA_IN;
    const int tid = opaque((int)threadIdx.x), wid = __builtin_amdgcn_readfirstlane(tid >> 6), lane = tid & 63, r32 = lane & 31, hi = lane >> 5, comp = wid >> 2, qw = wid & 3;
    LAS char* V_lds = lds; LAS char* K_lds = lds + 2 * SHM_V;
    LAS float* ws = (LAS float*)(lds + 2 * SHM_V + 2 * SHM_K) + wid * 64; LAS float* li_l = ws; LAS float* al_l = ws + 32;
    float m_reg = -1e30f, l_reg = 0; f32x16 o[4] = {}; bf16x8 qr[4];
    const bf16_t* Qw = proj + (size_t)(qrow0 + qw * 32 + r32) * LD + h * 128 + comp * 64 + hi * 8;
#pragma unroll
    for (int d0 = 0; d0 < 4; ++d0) qr[d0] = *reinterpret_cast<const bf16x8*>(Qw + d0 * 16);
    const bf16_t* Kh = proj + 1024 + h * 128; const bf16_t* Vh = proj + 2048 + h * 128;
    const int sr = tid >> 4, sc = (tid & 15) * 8, vst0 = v_st(sr, sc), vst1 = v_st(32 + sr, sc);
    const int vb0 = (int)(unsigned)(uintptr_t)V_lds + v_rd_base(lane);
    struct { bf16x8 vs0, vs1, ks0, ks1; } sr_[2];
#define DA_SLOAD(i, k0) do { if (VAR == 4) break; sr_[i].vs0 = *(const bf16x8*)(&Vh[(size_t)((k0) + sr) * LD + sc]); sr_[i].vs1 = *(const bf16x8*)(&Vh[(size_t)((k0) + 32 + sr) * LD + sc]); \
    sr_[i].ks0 = *(const bf16x8*)(&Kh[(size_t)((k0) + sr) * LD + sc]); sr_[i].ks1 = *(const bf16x8*)(&Kh[(size_t)((k0) + 32 + sr) * LD + sc]); } while (0)
#define DA_SWRITE(b, i) do { if (VAR == 4) break; *(LAS bf16x8*)(V_lds + (b) * SHM_V + vst0) = sr_[i].vs0; *(LAS bf16x8*)(V_lds + (b) * SHM_V + vst1) = sr_[i].vs1; const int kc = sc * 2; \
    *(LAS bf16x8*)(K_lds + (b) * SHM_K + DA_KSWZ(sr, kc)) = sr_[i].ks0; *(LAS bf16x8*)(K_lds + (b) * SHM_K + DA_KSWZ(32 + sr, kc)) = sr_[i].ks1; } while (0)
#define DA_SWAIT() asm volatile("s_waitcnt vmcnt(4)" ::: "memory")
#define DA_RESC(a) do { if (__any((a) < 1.f)) { if (hi == 0) al_l[r32] = (a); asm volatile("s_waitcnt lgkmcnt(0)" ::: "memory"); \
    _Pragma("unroll") for (int d = 0; d < 4; ++d) _Pragma("unroll") for (int r = 0; r < 16; ++r) o[d][r] *= al_l[crow(r, hi)]; } } while (0)
    f32x16 pA0, pA1, pB0, pB1; float alA, alB; bf16x8 pa0, pa1, pa2, pa3; const int NT = nkeys / KVBLK;
#define DA_PSM(P0, P1, AL) do { if (FAST) { partialSM_fast(P0, P1, l_reg); AL = 1.f; } else partialSM(P0, P1, m_reg, AL); } while (0)
#define DA_PVS(VB, P0, P1, AL) do { if (FAST) { pv_fast<VAR>(o, VB, pa0, pa1, pa2, pa3, P0, P1, l_reg); AL = 1.f; } else { pv_d0(o, VB, pa0, pa1, pa2, pa3); partialSM(P0, P1, m_reg, AL); } } while (0)
#define DA_FSM(P0, P1, AL) do { if (FAST) finishSM_fast(P0, P1, pa0, pa1, pa2, pa3); else finishSM(P0, P1, AL, l_reg, pa0, pa1, pa2, pa3); } while (0)
#define DA_RESCX(a) do { if (!FAST) { DA_RESC(a); } } while (0)
    DA_SLOAD(0, 0); asm volatile("s_waitcnt vmcnt(0)" ::: "memory"); DA_SWRITE(0, 0); __syncthreads();
    qkt(pA0, pA1, K_lds, qr, r32, hi, comp); DA_PSM(pA0, pA1, alA);
    DA_SLOAD(1, KVBLK); if (2 < NT) DA_SLOAD(0, 2 * KVBLK);
    DA_SWAIT(); DA_SWRITE(1, 1); __syncthreads();
#define DA_SYNC() do { if (VAR != 5) __syncthreads(); } while (0)
#define DA_QKT(P0, P1, KS) do { if (VAR != 6) qkt(P0, P1, KS, qr, r32, hi, comp); else { P0 = f32x16{}; P1 = f32x16{}; } } while (0)
    for (int j = 1; j + 1 < NT; j += 2) {
        DA_SBAR(); DA_QKT(pB0, pB1, K_lds + SHM_K);
        DA_FSM(pA0, pA1, alA); DA_SBAR();
        DA_SLOAD(1, (j + 2) * KVBLK); DA_SBAR();
        DA_PVS(vb0, pB0, pB1, alB);
        DA_SYNC(); DA_SWAIT(); DA_SWRITE(0, 0);
        DA_RESCX(alB); DA_SYNC();
        DA_SBAR(); DA_QKT(pA0, pA1, K_lds);
        DA_FSM(pB0, pB1, alB); DA_SBAR();
        { const int tn = (j + 3 < NT) ? (j + 3) : (NT - 1); DA_SLOAD(0, tn * KVBLK); } DA_SBAR();
        DA_PVS(vb0 + SHM_V, pA0, pA1, alA);
        DA_SYNC(); DA_SWAIT(); DA_SWRITE(1, 1);
        DA_RESCX(alA); DA_SYNC();
    }
    DA_SBAR(); qkt(pB0, pB1, K_lds + SHM_K, qr, r32, hi, comp);
    DA_FSM(pA0, pA1, alA); DA_SBAR();
    DA_PVS(vb0, pB0, pB1, alB);
    __syncthreads(); DA_RESCX(alB);
    DA_FSM(pB0, pB1, alB); DA_SBAR();
    pv_d0(o, vb0 + SHM_V, pa0, pa1, pa2, pa3);
#undef DA_PSM
#undef DA_FSM
#undef DA_PVS
#undef DA_SYNC
#undef DA_QKT
    if (FAST) { auto rr = __builtin_amdgcn_permlane32_swap(__float_as_uint(l_reg), __float_as_uint(l_reg), false, false); l_reg = __uint_as_float(rr[0]) + __uint_as_float(rr[1]); }
#undef DA_RESCX
    if (hi == 0) li_l[r32] = l_reg; asm volatile("s_waitcnt lgkmcnt(0)" ::: "memory");
    float rli[16];
#pragma unroll
    for (int r = 0; r < 16; ++r) rli[r] = __builtin_amdgcn_rcpf(li_l[crow(r, hi)]);
#pragma unroll
    for (int d0 = 0; d0 < 4; ++d0)
#pragma unroll
        for (int r = 0; r < 16; ++r) o[d0][r] *= rli[r];
    {   const int bad = (l_reg > 1.0e-30f && l_reg < 1.0e30f) ? 0 : 1;
        (void)bad; __syncthreads(); }
    LAS float* xb = (LAS float*)lds;
    if (comp == 1) {
#pragma unroll
        for (int d0 = 0; d0 < 4; ++d0)
#pragma unroll
            for (int r = 0; r < 16; ++r) xb[((qw * 64) + d0 * 16 + r) * 64 + lane] = o[d0][r];
    }
    __syncthreads();
    if (comp == 0) {
        float ssq[16];
#pragma unroll
        for (int r = 0; r < 16; ++r) ssq[r] = 0.f;
#pragma unroll
        for (int d0 = 0; d0 < 4; ++d0)
#pragma unroll
            for (int r = 0; r < 16; ++r) { const float x = o[d0][r] - lam * xb[((qw * 64) + d0 * 16 + r) * 64 + lane]; o[d0][r] = x; ssq[r] += x * x; }
#pragma unroll
        for (int r = 0; r < 16; ++r) {
#pragma unroll
            for (int off = 16; off >= 1; off >>= 1) ssq[r] += __shfl_xor(ssq[r], off);
            ssq[r] = rsqrtf(ssq[r] * (1.0f / 128.f) + 1e-5f) * oscale; }
        asm volatile("" ::: "memory");
        LAS char* stg = lds + qw * 16384;
#pragma unroll
        for (int d0 = 0; d0 < 4; ++d0) { const float g = subln[d0 * 32 + r32];
#pragma unroll
            for (int r = 0; r < 16; ++r) *(LAS bf16_t*)(stg + crow(r, hi) * 272 + (d0 * 32 + r32) * 2) = f2bf(o[d0][r] * ssq[r] * g); }
        asm volatile("s_waitcnt lgkmcnt(0)" ::: "memory");
        bf16_t* Ow = cat + (size_t)(qrow0 + qw * 32) * DA_W + h * 128;
#pragma unroll
        for (int q = 0; q < 8; ++q) { const int id = q * 64 + lane, row = id >> 4, c16 = id & 15; *(u32x4*)(Ow + (size_t)row * DA_W + c16 * 8) = *(const LAS u32x4*)(stg + row * 272 + c16 * 16); }
    }
    __syncthreads();
    return true;
#undef DA_SLOAD
#undef DA_SWRITE
#undef DA_SWAIT
#undef DA_RESC
}
}

__device__ __forceinline__ void phase_attn(const Ctx& c, int jj, bool with_ctx) {
    PREF P = *c.p; const bf16_t* proj = (const bf16_t*)(c.ws + WS_PROJ); bf16_t* cat = (bf16_t*)(c.ws + WS_CAT);
    const float lam = ((const float*)(c.ws + WS_MISC))[jj * 2 + 0], linit = ((const float*)(c.ws + WS_MISC))[jj * 2 + 1];
    const float* subln = P.in[24] + (size_t)jj * 128;
    const int nunits = 1024 + (with_ctx ? 16 : 0);
    unsigned failed = 0u; int it = 0;
#pragma unroll 1
    for (int L = c.bid; L < nunits; L += c.G, ++it) {
        int h, q0, nk;
        if (L < 1024) { h = L & 7; q0 = NC + (L >> 3) * 128; nk = NTOK; } else { const int i = L - 1024; h = i & 7; q0 = (i >> 3) * 128; nk = NC; }
        if (!da2::attn_unit_dma((LAS char*)c.lds, proj, cat, h, q0, nk, lam, 1.0f - linit, subln)) failed |= 1u << (it & 31);
    }
    failed = (unsigned)__builtin_amdgcn_readfirstlane((int)failed);
    if (failed) {
        it = 0;
#pragma unroll 1
        for (int L = c.bid; L < nunits; L += c.G, ++it) {
            if (!((failed >> (it & 31)) & 1u)) continue;
            int h, q0, nk;
            if (L < 1024) { h = L & 7; q0 = NC + (L >> 3) * 128; nk = NTOK; } else { const int i = L - 1024; h = i & 7; q0 = (i >> 3) * 128; nk = NC; }
            (void)da::attn_unit<false>((LAS char*)c.lds, proj, cat, h, q0, nk, lam, 1.0f - linit, subln);
        }
    }
}
__device__ __forceinline__ MoeTable moe_table(const Ctx& c, int layer, int ntok_l) {
    LAS int* tb = (LAS int*)(c.lds + LDS_MISC + 64); LAS int* cn = (LAS int*)(c.lds + LDS_MISC + 512);
    const unsigned* cg = (const unsigned*)(c.ws + WS_CTL) + CW_CNT + c.cnt_off + layer * 64;
    __syncthreads();
    if (c.tid == 0) { int t = 0;
        for (int e = 0; e < 65; ++e) { const int n = (e < 64) ? (int)cg[e] : ntok_l; cn[e] = n; tb[e] = t; t += (n + 255) >> 8; }
        tb[65] = t; }
    __syncthreads();
    MoeTable r; r.tb = tb; r.cn = cn; return r;
}

__device__ __forceinline__ void phase_cvt_experts(const Ctx& c, int layer) {
    PREF P = *c.p; unsigned char* ws = c.ws;
    const float* wg = P.in[27] + (size_t)layer * 64 * 1024 * 256; const float* wu = P.in[28] + (size_t)layer * 64 * 1024 * 256; const float* wd = P.in[29] + (size_t)layer * 64 * 256 * 1024;
    const float* sg = P.in[30] + (size_t)layer * 1024 * 256; const float* su = P.in[31] + (size_t)layer * 1024 * 256; const float* sd = P.in[32] + (size_t)layer * 256 * 1024;
    bf16_t* WGU = (bf16_t*)(ws + WS_WGU); bf16_t* WD = (bf16_t*)(ws + WS_WD);
    unsigned* ctr = (unsigned*)(ws + WS_CTL) + CW_CVTQ + c.cnt_off + layer;
    LAS int* qs = (LAS int*)(c.lds + LDS_MISC + 1024);
    const int NT_ = 65 * 96, CH = 4;
    for (;;) {
        __syncthreads();
        if (c.tid == 0) qs[0] = (int)__hip_atomic_fetch_add(ctr, (unsigned)CH, __ATOMIC_RELAXED, __HIP_MEMORY_SCOPE_AGENT);
        __syncthreads();
        const int u0 = qs[0]; if (u0 >= NT_) break;
        for (int u = u0; u < u0 + CH && u < NT_; ++u) {
            const int e = u / 96, r = u % 96, kind = r >> 5, q = r & 31;
            if (kind == 0) { const float* src = (e < 64) ? wg + (size_t)e * 1024 * 256 : sg; cvt_tile128(c, src, 256, (q >> 2) * 128, (q & 3) * 64, WGU + (size_t)e * 512 * 1024, 1024, RowGate()); }
            else if (kind == 1) { const float* src = (e < 64) ? wu + (size_t)e * 1024 * 256 : su; cvt_tile128(c, src, 256, (q >> 2) * 128, (q & 3) * 64, WGU + (size_t)e * 512 * 1024, 1024, RowUp()); }
            else { const float* src = (e < 64) ? wd + (size_t)e * 256 * 1024 : sd; cvt_tile128(c, src, 1024, (q >> 4) * 128, (q & 15) * 64, WD + (size_t)e * 1024 * 256, 256, RowDown()); }
        }
    }
}

__device__ __forceinline__ void phase_p6(const Ctx& c, int layer, int tok0) {
    PREF P = *c.p; unsigned char* ws = c.ws; const int tid = c.tid, lane = c.lane, w = c.wid;
    const int ntok_l = NTOK - tok0, tpb = (ntok_l + c.G - 1) / c.G;
    const int tb0 = tok0 + c.bid * tpb, tb1 = (tb0 + tpb < NTOK) ? tb0 + tpb : NTOK; const int nloc = (tb1 > tb0) ? tb1 - tb0 : 0;
    LAS float* lg = (LAS float*)c.lds;
    LAS int* che = (LAS int*)(c.lds + 81920); LAS float* chw = (LAS float*)(c.lds + 87040);
    LAS int* cntl = (LAS int*)(c.lds + 92160); LAS int* basel = (LAS int*)(c.lds + 92416);
    if (tid < 64) cntl[tid] = 0;
    const float* xres = (const float*)(ws + WS_XRES); bf16_t* hB = (bf16_t*)(ws + WS_H); bf16_t* hL = (bf16_t*)(ws + WS_HLO);
    const float* gain = P.in[7] + (size_t)layer * D; const float* modl = (const float*)(ws + WS_MOD) + (size_t)layer * 2 * 6144;
    const bf16_t* wrh = (const bf16_t*)(ws + WS_WR) + (size_t)(layer * 2 + 0) * 64 * 1024; const bf16_t* wrl = wrh + 64 * 1024;
    const float* rbias = P.in[26] + (size_t)layer * 64;
#ifndef DUP_TOK
#define DUP_TOK 1
#endif
#ifndef DUP_TOKA
#define DUP_TOKA 1
#endif
#ifndef DUP_TOKB
#define DUP_TOKB 1
#endif
    _Pragma("unroll 1") for (int rept_ = 0; rept_ < DUP_TOK; ++rept_) {
    _Pragma("unroll 1") for (int repa_ = 0; repa_ < DUP_TOKA; ++repa_) {
#pragma unroll 1
    for (int tl0 = w * 4; tl0 < nloc; tl0 += 32) {
        f32x4 v[4][4]; float ss[4];
#pragma unroll
        for (int t = 0; t < 4; ++t) { const int tl = (tl0 + t < nloc) ? tl0 + t : nloc - 1; const float* x = xres + (size_t)(tb0 + tl) * D; ss[t] = 0.f;
#pragma unroll
            for (int q = 0; q < 4; ++q) { v[t][q] = *(const f32x4*)(x + q * 256 + lane * 4); ss[t] += v[t][q][0] * v[t][q][0] + v[t][q][1] * v[t][q][1] + v[t][q][2] * v[t][q][2] + v[t][q][3] * v[t][q][3]; } }
        ss[0] = wave_sum(ss[0]); ss[1] = wave_sum(ss[1]); ss[2] = wave_sum(ss[2]); ss[3] = wave_sum(ss[3]);
#pragma unroll
        for (int t = 0; t < 4; ++t) { if (tl0 + t < nloc) { const int row = tb0 + tl0 + t; const float* m = modl + ((row < NC) ? 6144 : 0); const float rstd = rsqrtf(ss[t] * (1.0f / 1024.f) + EPS);
#pragma unroll
            for (int q = 0; q < 4; ++q) { const int col = q * 256 + lane * 4;
                const f32x4 g = *(const f32x4*)(gain + col), sc = *(const f32x4*)(m + 4 * 1024 + col), sh = *(const f32x4*)(m + 3 * 1024 + col);
                float o[4], lo_[4];
#pragma unroll
                for (int k = 0; k < 4; ++k) { o[k] = v[t][q][k] * rstd * g[k] * (1.0f + sc[k]) + sh[k]; lo_[k] = o[k] - bf2f(f2bf(o[k])); }
                u32x2 wv; wv.x = cvtpk(o[0], o[1]); wv.y = cvtpk(o[2], o[3]);
                *(u32x2*)(hB + (size_t)row * D + col) = wv;
                u32x2 wl; wl.x = cvtpk(lo_[0], lo_[1]); wl.y = cvtpk(lo_[2], lo_[3]);
                *(u32x2*)(hL + (size_t)row * D + col) = wl; } } }
    }
    asm volatile("s_waitcnt vmcnt(0)" ::: "memory");
    __syncthreads();
    }
    _Pragma("unroll 1") for (int repb_ = 0; repb_ < DUP_TOKB; ++repb_) {
    {
        const int etp = w & 1, kq = w >> 1, fr = lane & 15, fq = lane >> 4; const int nmt = (nloc + 15) >> 4;
        f32x4 acc[5][2];
#pragma unroll
        for (int mt = 0; mt < 5; ++mt) { acc[mt][0] = (f32x4){0.f, 0.f, 0.f, 0.f}; acc[mt][1] = (f32x4){0.f, 0.f, 0.f, 0.f}; }
        const bf16_t* bh = wrh + (size_t)(etp * 32 + fr) * 1024 + kq * 256 + fq * 8; const bf16_t* bl = wrl + (size_t)(etp * 32 + fr) * 1024 + kq * 256 + fq * 8;
        size_t arow[5];
#pragma unroll
        for (int mt = 0; mt < 5; ++mt) { int tl = mt * 16 + fr; tl = (tl < nloc) ? tl : (nloc > 0 ? nloc - 1 : 0); arow[mt] = (size_t)(tb0 + tl) * D + kq * 256 + fq * 8; }
#pragma unroll 2
        for (int ks = 0; ks < 8; ++ks) {
            const bf16x8 vbh0 = *(const bf16x8*)(bh + ks * 32), vbl0 = *(const bf16x8*)(bl + ks * 32);
            const bf16x8 vbh1 = *(const bf16x8*)(bh + 16 * 1024 + ks * 32), vbl1 = *(const bf16x8*)(bl + 16 * 1024 + ks * 32);
#pragma unroll
            for (int mt = 0; mt < 5; ++mt) { if (mt < nmt) {
                const bf16x8 ah = *(const bf16x8*)(hB + arow[mt] + ks * 32), al = *(const bf16x8*)(hL + arow[mt] + ks * 32);
                acc[mt][0] = __builtin_amdgcn_mfma_f32_16x16x32_bf16(ah, vbh0, acc[mt][0], 0, 0, 0);
                acc[mt][0] = __builtin_amdgcn_mfma_f32_16x16x32_bf16(ah, vbl0, acc[mt][0], 0, 0, 0);
                acc[mt][0] = __builtin_amdgcn_mfma_f32_16x16x32_bf16(al, vbh0, acc[mt][0], 0, 0, 0);
                acc[mt][1] = __builtin_amdgcn_mfma_f32_16x16x32_bf16(ah, vbh1, acc[mt][1], 0, 0, 0);
                acc[mt][1] = __builtin_amdgcn_mfma_f32_16x16x32_bf16(ah, vbl1, acc[mt][1], 0, 0, 0);
                acc[mt][1] = __builtin_amdgcn_mfma_f32_16x16x32_bf16(al, vbh1, acc[mt][1], 0, 0, 0); } } }
#pragma unroll
        for (int mt = 0; mt < 5; ++mt)
#pragma unroll
            for (int e2 = 0; e2 < 2; ++e2)
#pragma unroll
                for (int r = 0; r < 4; ++r) lg[(kq * 80 + mt * 16 + fq * 4 + r) * 64 + etp * 32 + e2 * 16 + fr] = acc[mt][e2][r];
    }
    __syncthreads();
    }
    }
#pragma unroll 1
    for (int tl = w; tl < nloc; tl += 8) {
        const float logit = (lg[tl * 64 + lane] + lg[(80 + tl) * 64 + lane]) + (lg[(160 + tl) * 64 + lane] + lg[(240 + tl) * 64 + lane]);
        const float score = sigmoidf_(logit), choice = score + rbias[lane];
        float m1 = choice;
#pragma unroll
        for (int off = 1; off <= 4; off <<= 1) m1 = fmaxf(m1, __shfl_xor(m1, off));
        const unsigned long long bm = __ballot(choice == m1); const unsigned gb = (unsigned)(bm >> (lane & 56)) & 0xffu;
        const bool isfirst = ((lane & 7) == (__builtin_ctz(gb) & 7));
        float m2 = isfirst ? -INFINITY : choice;
#pragma unroll
        for (int off = 1; off <= 4; off <<= 1) m2 = fmaxf(m2, __shfl_xor(m2, off));
        const float gs = m1 + m2; const int g = lane >> 3; int grank = 0;
#pragma unroll
        for (int g2 = 0; g2 < 8; ++g2) { const float o = __shfl(gs, g2 * 8); grank += (o > gs || (o == gs && g2 < g)) ? 1 : 0; }
        const bool gsel = grank < 4; const float mc = gsel ? choice : -INFINITY; int erank = 0;
#pragma unroll 8
        for (int e2 = 0; e2 < 64; ++e2) { const float o = __shfl(mc, e2); erank += (o > mc || (o == mc && e2 < lane)) ? 1 : 0; }
        const bool sel = gsel && erank < 8;
        const float sw = wave_sum(sel ? score : 0.f);
        if (sel) { che[tl * 8 + erank] = lane; chw[tl * 8 + erank] = score / (sw + 1e-20f) * 2.5f; atomicAdd((int*)&cntl[lane], 1); }
    }
    __syncthreads();
    if (tid < 64) { const int n = cntl[tid]; unsigned* cg = (unsigned*)(ws + WS_CTL) + CW_CNT + c.cnt_off + layer * 64;
        basel[tid] = n ? (int)__hip_atomic_fetch_add(cg + tid, (unsigned)n, __ATOMIC_RELAXED, __HIP_MEMORY_SCOPE_AGENT) : 0; cntl[tid] = 0; }
    __syncthreads();
    int* ltok = (int*)(ws + WS_LTOK); float* lw = (float*)(ws + WS_LW); int* slot = (int*)(ws + WS_SLOT);
    for (int idx = tid; idx < nloc * 8; idx += NTHREADS) { const int tl = idx >> 3, e = che[idx]; const int pos = basel[e] + atomicAdd((int*)&cntl[e], 1);
        ltok[(size_t)e * NTOK + pos] = tb0 + tl; lw[(size_t)e * NTOK + pos] = chw[idx]; slot[(size_t)(tb0 + tl) * 8 + (idx & 7)] = (e << 20) | pos; }
    __syncthreads();
}

__device__ __forceinline__ void phase_p9(const Ctx& c, int layer, int tok0, const MoeTable& t) {
    PREF P = *c.p; unsigned char* ws = c.ws; const int lane = c.lane;
    float* xres = (float*)(ws + WS_XRES); const unsigned char* Y = (const unsigned char*)(ws + WS_YSLOT); const int* slot = (const int*)(ws + WS_SLOT);
    const float* modl = (const float*)(ws + WS_MOD) + (size_t)layer * 2 * 6144;
    const bool fin = (layer == DEPTH - 1);
    const float* gain = fin ? P.in[33] : P.in[6] + (size_t)(layer + 1) * D; const float* modn = (const float*)(ws + WS_MOD) + (size_t)(layer + 1) * 2 * 6144;
    bf16_t* hA = (bf16_t*)(ws + WS_H);
    const size_t shrow0 = (size_t)t.tb[64] * 256;
    const int col0 = lane * 16;
    for (int row = tok0 + c.bid * 8 + c.wid; row < NTOK; row += c.G * 8) {
        const int sl = (lane < 8) ? slot[(size_t)row * 8 + lane] : 0;
        float acc[16];
#pragma unroll
        for (int k = 0; k < 16; ++k) acc[k] = 0.f;
        u32x4 yv[9];
#pragma unroll
        for (int k = 0; k < 9; ++k) { size_t yr;
            if (k < 8) { const int s = __shfl(sl, k); yr = (size_t)t.tb[s >> 20] * 256 + (s & 0xfffff); } else yr = shrow0 + (size_t)(row - tok0);
            yv[k] = *(const u32x4*)(Y + yr * 1024 + col0); }
#pragma unroll
        for (int k = 0; k < 9; ++k) { const unsigned w4[4] = {yv[k].x, yv[k].y, yv[k].z, yv[k].w};
#pragma unroll
            for (int q = 0; q < 4; ++q) { const f32x2 a = __builtin_amdgcn_cvt_pk_f32_fp8((int)w4[q], false), b = __builtin_amdgcn_cvt_pk_f32_fp8((int)w4[q], true);
                acc[q * 4 + 0] += a[0]; acc[q * 4 + 1] += a[1]; acc[q * 4 + 2] += b[0]; acc[q * 4 + 3] += b[1]; } }
        const float* m = modl + ((row < NC) ? 6144 : 0) + 5 * 1024; float* x = xres + (size_t)row * D; float xn[16]; float ss = 0.f;
#pragma unroll
        for (int q = 0; q < 4; ++q) { const int col = col0 + q * 4; const f32x4 xv = *(const f32x4*)(x + col), g = *(const f32x4*)(m + col); f32x4 o;
#pragma unroll
            for (int k = 0; k < 4; ++k) { o[k] = xv[k] + g[k] * acc[q * 4 + k]; xn[q * 4 + k] = o[k]; ss += o[k] * o[k]; }
            *(f32x4*)(x + col) = o; }
        ss = wave_sum(ss); const float rstd = rsqrtf(ss * (1.0f / 1024.f) + EPS);
        if (fin) {
            float* out = P.out + (size_t)(row - NC) * D;
#pragma unroll
            for (int q = 0; q < 4; ++q) { const int col = col0 + q * 4; const f32x4 g = *(const f32x4*)(gain + col); f32x4 o;
#pragma unroll
                for (int k = 0; k < 4; ++k) o[k] = xn[q * 4 + k] * rstd * g[k];
                *(f32x4*)(out + col) = o; }
        } else {
            const float* mn = modn + ((row < NC) ? 6144 : 0); float o[16];
#pragma unroll
            for (int q = 0; q < 4; ++q) { const int col = col0 + q * 4; const f32x4 g = *(const f32x4*)(gain + col), sc = *(const f32x4*)(mn + 1024 + col), sh = *(const f32x4*)(mn + col);
#pragma unroll
                for (int k = 0; k < 4; ++k) o[q * 4 + k] = xn[q * 4 + k] * rstd * g[k] * (1.0f + sc[k]) + sh[k]; }
            u32x4 w0, w1; w0.x = cvtpk(o[0], o[1]); w0.y = cvtpk(o[2], o[3]); w0.z = cvtpk(o[4], o[5]); w0.w = cvtpk(o[6], o[7]);
            w1.x = cvtpk(o[8], o[9]); w1.y = cvtpk(o[10], o[11]); w1.z = cvtpk(o[12], o[13]); w1.w = cvtpk(o[14], o[15]);
            *(u32x4*)(hA + (size_t)row * D + col0) = w0; *(u32x4*)(hA + (size_t)row * D + col0 + 8) = w1;
        }
    }
}
#ifndef DUP_INPROJ
#define DUP_INPROJ 1
#endif
#ifndef DUP_ATTN
#define DUP_ATTN 1
#endif
#ifndef DUP_UP
#define DUP_UP 1
#endif
#ifndef DUP_DOWN
#define DUP_DOWN 1
#endif
#ifndef DUP_F
#define DUP_F 1
#endif
#ifndef DUP_HYCONV
#define DUP_HYCONV 1
#endif
#ifndef DUP_R1
#define DUP_R1 1
#endif
#ifndef DUP_R3
#define DUP_R3 1
#endif
#ifndef DUP_MISC
#define DUP_MISC 1
#endif
#ifndef DUP_PR
#define DUP_PR 1
#endif
#ifndef DUP_CVT
#define DUP_CVT 1
#endif
#define REPEAT(n) _Pragma("unroll 1") for (int rep_ = 0; rep_ < (n); ++rep_)
constexpr int NPHASE = 38;
__global__ void __launch_bounds__(NTHREADS, 2) fwd_kernel(Params prm) {
    extern __shared__ __attribute__((aligned(16))) unsigned char lds_raw[];
    const KParams kp0 = (KParams)__builtin_amdgcn_kernarg_segment_ptr();
    Ctx c; c.p = kp0; c.lds = (LAS unsigned char*)lds_raw; c.tid = threadIdx.x; c.lane = c.tid & 63; c.wid = __builtin_amdgcn_readfirstlane(c.tid >> 6); c.G = gridDim.x; c.bid = blockIdx.x; c.ws = kp0->ws;
    volatile LAS unsigned* misc = (volatile LAS unsigned*)(c.lds + LDS_MISC);
    if (c.tid < 4) misc[c.tid] = 0u;
    __syncthreads();
#ifdef PROBE_STOP
    const int lo = 0; int hi = PROBE_STOP; int cnt_off = 256;
#else
    const int lo = kp0->ph_lo, hi = kp0->ph_hi; const int cnt_off = 0;
#endif
    XcdBarrier bar; bar.bar = (unsigned*)(c.ws + WS_CTL) + CW_BAR; bar.x = 0; bar.st = misc;
    if (kp0->ph_hi - kp0->ph_lo > 1) bar = xcd_barrier_post((unsigned*)(c.ws + WS_CTL) + CW_BAR, misc);
#define IN(k) ((lo <= (k) && (k) < hi) && ((c.tid = opaque((int)threadIdx.x)), (c.lane = c.tid & 63), (c.wid = __builtin_amdgcn_readfirstlane(c.tid >> 6)), (c.p = opaque_kp(kp0)), (c.ws = c.p->ws), (ws = c.ws), (c.G = opaque_s((int)gridDim.x)), (c.bid = opaque_s((int)blockIdx.x)), true))
#define SEAM(k) do { if ((lo <= (k)) && ((k) + 1 < hi)) { bar.bar = (unsigned*)(opaque_kp(kp0)->ws + WS_CTL) + CW_BAR; xcd_barrier(bar); } } while (0)
    unsigned char* ws = c.ws;
#ifdef PROBE_STOP
#pragma unroll 1
    for (int pass = 0; pass < 2; ++pass) {
    if (pass == 1) { xcd_barrier(bar); hi = NPHASE; cnt_off = 0; }
#endif
    c.cnt_off = cnt_off;
#ifdef PROBE_STOP
    c.pass = pass;
#else
    c.pass = 1;
#endif
    if (IN(0)) { REPEAT(DUP_PR) phase_pr0(c); } SEAM(0);
    if (IN(1)) { REPEAT(DUP_PR) phase_pr1(c); } SEAM(1);
#pragma unroll 1
    for (int jj = 0; jj < 2; ++jj) {
        const int pb = 2 + jj * 18;
        { const int layer = 2 * jj;
        if (IN(pb + 0)) { REPEAT(DUP_F) phase_f1(c, jj); } SEAM(pb + 0);
        if (IN(pb + 1)) { REPEAT(DUP_F) phase_f2(c); } SEAM(pb + 1);
        if (IN(pb + 2)) {
            DenseSched S; S.init(ws + WS_H, (const bf16_t*)(ws + WS_WAB_IN) + (size_t)jj * AB_IN * 1024, 1024, 65, 18, 0, c.G, c.bid);
            EpiAbIn E{(bf16_t*)(ws + WS_PROJ), (const f32x2*)(ws + WS_ROPE)};
            REPEAT(DUP_INPROJ) pg8::gemm_phase<EpiAbIn, DenseSched, false>(c.lds, 1024, S, E); } SEAM(pb + 2);
        if (IN(pb + 3)) { REPEAT(DUP_R1) phase_r1(c, jj); REPEAT(DUP_MISC) phase_hyprep(c, jj); } SEAM(pb + 3);
        if (IN(pb + 4)) { REPEAT(DUP_HYCONV) phase_hyconv(c, jj); REPEAT(DUP_MISC) phase_scan(c, jj); } SEAM(pb + 4);
        if (IN(pb + 5)) { REPEAT(DUP_R3) phase_r3(c, jj); REPEAT(DUP_MISC) { phase_hytrans(c); phase_hyctx(c, jj); } } SEAM(pb + 5);
        if (IN(pb + 6)) {
            DenseSched S; S.init(ws + WS_CAT, (const bf16_t*)(ws + WS_WAB_OUT) + (size_t)jj * 1024 * AB_CAT, AB_CAT, 65, 4, 0, c.G, c.bid);
            EpiResid E{(float*)(ws + WS_XRES), (const float*)(ws + WS_MOD) + (size_t)layer * 2 * 6144};
            pg8::gemm_phase<EpiResid, DenseSched, false>(c.lds, AB_CAT, S, E);
            phase_cvt_experts(c, layer); } SEAM(pb + 6);
        if (IN(pb + 7)) { phase_p6(c, layer, 0); } SEAM(pb + 7);
        if (IN(pb + 8)) { const MoeTable t = moe_table(c, layer, NTOK);
            MoeUpSched S; S.t = t; S.H = (const char*)(ws + WS_H); S.W = (const char*)(ws + WS_WGU); S.ltok = (const int*)(ws + WS_LTOK); S.tok0 = 0; S.G = c.G; S.c = c.bid; S.nwg = t.tb[65] * 2;
            EpiSwiglu E{(bf16_t*)(ws + WS_ACT)};
            REPEAT(DUP_UP) pg8::gemm_phase<EpiSwiglu, MoeUpSched, true>(c.lds, 1024, S, E); } SEAM(pb + 8);
        if (IN(pb + 9)) { const MoeTable t = moe_table(c, layer, NTOK);
            MoeDownSched S; S.t = t; S.ACT = (const char*)(ws + WS_ACT); S.W = (const char*)(ws + WS_WD); S.G = c.G; S.c = c.bid; S.nwg = t.tb[65] * 4;
            EpiDown E{(unsigned char*)(ws + WS_YSLOT), (const float*)(ws + WS_LW), t, 0};
#ifdef PROBE_DOWN_NOEPI
            { EpiDown E0 = E; E0.skip = 1; pg8::gemm_phase<EpiDown, MoeDownSched, false>(c.lds, 256, S, E0); }
#endif
            REPEAT(DUP_DOWN) pg8::gemm_phase<EpiDown, MoeDownSched, false>(c.lds, 256, S, E); } SEAM(pb + 9);
        if (IN(pb + 10)) { const MoeTable t = moe_table(c, layer, NTOK); phase_p9(c, layer, 0, t); } SEAM(pb + 10);
        }
        { const int layer = 2 * jj + 1; const bool with_ctx = layer < DEPTH - 1; const int tok0 = with_ctx ? 0 : NC; const int pm0 = with_ctx ? 0 : 1;
        if (IN(pb + 11)) {
            DenseSched S; S.init(ws + WS_H, (const bf16_t*)(ws + WS_WDA_IN) + (size_t)jj * DA_IN * 1024, 1024, 65, 12, 0, c.G, c.bid);
            EpiDaIn E{(bf16_t*)(ws + WS_PROJ), (const f32x2*)(ws + WS_ROPE) + (256 * 32 + 64 * 32)};
            REPEAT(DUP_INPROJ) pg8::gemm_phase<EpiDaIn, DenseSched, false>(c.lds, 1024, S, E); } SEAM(pb + 11);
        if (IN(pb + 12)) { REPEAT(DUP_ATTN) phase_attn(c, jj, with_ctx); } SEAM(pb + 12);
        if (IN(pb + 13)) {
            DenseSched S; S.init(ws + WS_CAT, (const bf16_t*)(ws + WS_WDA_OUT) + (size_t)jj * 1024 * 1024, 1024, 65, 4, pm0, c.G, c.bid);
            EpiResid E{(float*)(ws + WS_XRES), (const float*)(ws + WS_MOD) + (size_t)layer * 2 * 6144};
            pg8::gemm_phase<EpiResid, DenseSched, false>(c.lds, 1024, S, E);
            phase_cvt_experts(c, layer); } SEAM(pb + 13);
        if (IN(pb + 14)) { phase_p6(c, layer, tok0); } SEAM(pb + 14);
        if (IN(pb + 15)) { const MoeTable t = moe_table(c, layer, NTOK - tok0);
            MoeUpSched S; S.t = t; S.H = (const char*)(ws + WS_H); S.W = (const char*)(ws + WS_WGU); S.ltok = (const int*)(ws + WS_LTOK); S.tok0 = tok0; S.G = c.G; S.c = c.bid; S.nwg = t.tb[65] * 2;
            EpiSwiglu E{(bf16_t*)(ws + WS_ACT)};
            REPEAT(DUP_UP) pg8::gemm_phase<EpiSwiglu, MoeUpSched, true>(c.lds, 1024, S, E); } SEAM(pb + 15);
        if (IN(pb + 16)) { const MoeTable t = moe_table(c, layer, NTOK - tok0);
            MoeDownSched S; S.t = t; S.ACT = (const char*)(ws + WS_ACT); S.W = (const char*)(ws + WS_WD); S.G = c.G; S.c = c.bid; S.nwg = t.tb[65] * 4;
            EpiDown E{(unsigned char*)(ws + WS_YSLOT), (const float*)(ws + WS_LW), t, 0};
#ifdef PROBE_DOWN_NOEPI
            { EpiDown E0 = E; E0.skip = 1; pg8::gemm_phase<EpiDown, MoeDownSched, false>(c.lds, 256, S, E0); }
#endif
            REPEAT(DUP_DOWN) pg8::gemm_phase<EpiDown, MoeDownSched, false>(c.lds, 256, S, E); } SEAM(pb + 16);
        if (IN(pb + 17)) { const MoeTable t = moe_table(c, layer, NTOK - tok0); phase_p9(c, layer, tok0, t); } SEAM(pb + 17);
        }
    }
#ifdef PROBE_STOP
    }
#endif
#undef IN
#undef SEAM
}

#ifdef DBG_K
__global__ void dbg_dump(const unsigned* w, size_t nwords, float* out, int nout) {
    for (int i = blockIdx.x * blockDim.x + threadIdx.x; i < nout; i += gridDim.x * blockDim.x) { unsigned h = 0;
        for (size_t q = i; q < nwords; q += (size_t)nout) { unsigned x = w[q]; x ^= x >> 16; x *= 0x7feb352du; x ^= x >> 15; x *= 0x846ca68bu; x ^= x >> 16; h += x; }
        out[i] = (float)(h & 0xFFFFFu); }
}
#endif
#ifndef MK_SPLIT
#define MK_SPLIT 0
#endif
extern "C" void kernel_launch(void* const* d_in, const int* in_sizes, int n_in, void* d_out, int out_size, void* d_ws, size_t ws_size, hipStream_t stream) {
    static int grid = 0;
    if (grid == 0) {
        if (n_in != 34 || out_size != NX * D || ws_size < WS_END) { fprintf(stderr, "kernel_launch: unexpected shapes: n_in %d out %d ws %zu (need %zu)\n", n_in, out_size, ws_size, (size_t)WS_END); grid = -1; return; }
        int dev = 0, cus = 0, per_cu = 0;
        if (hipGetDevice(&dev) != hipSuccess || hipDeviceGetAttribute(&cus, hipDeviceAttributeMultiprocessorCount, dev) != hipSuccess) { grid = -1; return; }
        if (hipFuncSetAttribute((const void*)fwd_kernel, hipFuncAttributeMaxDynamicSharedMemorySize, LDS_BYTES) != hipSuccess) { fprintf(stderr, "kernel_launch: hipFuncSetAttribute failed\n"); grid = -1; return; }
        if (hipOccupancyMaxActiveBlocksPerMultiprocessor(&per_cu, (const void*)fwd_kernel, NTHREADS, LDS_BYTES) != hipSuccess || per_cu < 1) { fprintf(stderr, "kernel_launch: occupancy query says %d\n", per_cu); grid = -1; return; }
        grid = cus;
        if (grid > 256) grid = 256;
        grid &= ~7;
    }
    if (grid <= 0) return;
    (void)hipMemsetAsync((char*)d_ws + WS_CTL, 0, CTL_ZERO_BYTES, stream);
    Params p{};
    for (int i = 0; i < 34; ++i) p.in[i] = (const float*)d_in[i];
    p.out = (float*)d_out; p.ws = (unsigned char*)d_ws;
#ifdef DBG_K
    for (int k = 0; k <= DBG_K; ++k) { p.ph_lo = k; p.ph_hi = k + 1; hipLaunchKernelGGL(fwd_kernel, dim3(grid), dim3(NTHREADS), LDS_BYTES, stream, p); }
    hipLaunchKernelGGL(dbg_dump, dim3(1024), dim3(256), 0, stream, (const unsigned*)((const char*)d_ws + (size_t)(DBG_OFF)), (size_t)(DBG_BYTES) / 4, (float*)d_out, out_size);
#elif MK_SPLIT
    for (int k = 0; k < NPHASE; ++k) { p.ph_lo = k; p.ph_hi = k + 1; hipLaunchKernelGGL(fwd_kernel, dim3(grid), dim3(NTHREADS), LDS_BYTES, stream, p); }
#else
    p.ph_lo = 0; p.ph_hi = NPHASE;
    hipLaunchKernelGGL(fwd_kernel, dim3(grid), dim3(NTHREADS), LDS_BYTES, stream, p);
#endif
    const hipError_t le = hipPeekAtLastError();
    if (le != hipSuccess) fprintf(stderr, "kernel_launch: launch failed: %s\n", hipGetErrorName(le));
}
```

```cpp
#include <hip/hip_runtime.h>
#include <cstdio>
#include <cstdint>
#include <cmath>

#define LAS __attribute__((address_space(3)))
typedef unsigned short bf16_t;
typedef short bf16x8 __attribute__((ext_vector_type(8)));
typedef short s16x4 __attribute__((ext_vector_type(4)));
typedef float f32x2 __attribute__((ext_vector_type(2)));
typedef float f32x4 __attribute__((ext_vector_type(4)));
typedef float f32x16 __attribute__((ext_vector_type(16)));
typedef unsigned u32x2 __attribute__((ext_vector_type(2)));
typedef unsigned u32x4 __attribute__((ext_vector_type(4)));
typedef __bf16 bf16x2_t __attribute__((ext_vector_type(2)));

constexpr int D = 1024, NC = 256, NX = 16384, NTOK = NC + NX, DEPTH = 4;
constexpr int AB_IN = 4608, AB_CAT = 1536, DA_IN = 3072, DA_W = 1024;
constexpr int NEXP = 64, TOPK = 8, EDIM = 256;
constexpr int FFT_M = 16384;
constexpr int HSPEC_LD = 16400;
constexpr float EPS = 1e-6f;

__device__ __forceinline__ unsigned cvtpk(float lo, float hi) { f32x2 v = {lo, hi}; bf16x2_t b = __builtin_convertvector(v, bf16x2_t); return __builtin_bit_cast(unsigned, b); }
__device__ __forceinline__ bf16_t f2bf(float x) { return (bf16_t)(cvtpk(x, 0.f) & 0xffffu); }
__device__ __forceinline__ float bf2f(bf16_t b) { return __uint_as_float(((unsigned)b) << 16); }
__device__ __forceinline__ float bflo(unsigned w) { return __uint_as_float(w << 16); }
__device__ __forceinline__ float bfhi(unsigned w) { return __uint_as_float(w & 0xffff0000u); }
__device__ __forceinline__ float siluf(float x) { return x / (1.0f + __expf(-x)); }
__device__ __forceinline__ float sigmoidf_(float x) { return 1.0f / (1.0f + __expf(-x)); }
__device__ __forceinline__ int opaque(int x) { asm volatile("" : "+v"(x)); return x; }
__device__ __forceinline__ int opaque_s(int x) { asm volatile("" : "+s"(x)); return x; }
template <class T> __device__ __forceinline__ T* opaque_p(T* p) { asm volatile("" : "+s"(p)); return p; }
__device__ __forceinline__ float wave_sum(float v) {
#pragma unroll
    for (int o = 32; o >= 1; o >>= 1) v += __shfl_xor(v, o);
    return v;
}

#define XB_TMO      128
#define XB_XCNT(j)  (256  + 64 * (j))
#define XB_XSUB(j)  (1280 + 64 * (j))
#define XB_XGEN(j)  (2304 + 64 * (j))
#define XB_TOP      3328
#define XB_TOPGEN   3392
#define XCD_BAR_WORDS 3456
#define XB_SPIN_CAP (1u << 18)

__device__ __forceinline__ unsigned xb_ld(unsigned* p)              { return __hip_atomic_load(p, __ATOMIC_RELAXED, __HIP_MEMORY_SCOPE_AGENT); }
__device__ __forceinline__ unsigned xb_add(unsigned* p, unsigned v) { return __hip_atomic_fetch_add(p, v, __ATOMIC_RELAXED, __HIP_MEMORY_SCOPE_AGENT); }
__device__ __forceinline__ unsigned xb_xcc_id() { return (unsigned)__builtin_amdgcn_s_getreg((3 << 11) | 20) & 0xFu; }
#define XB_SPIN(cond, bar) do { unsigned _sp = 0; while (cond) { __builtin_amdgcn_s_sleep(1); \
    if ((++_sp & 255u) == 0u) { if (xb_ld(&(bar)[XB_TMO])) break; if (_sp > XB_SPIN_CAP) { atomicAdd(&(bar)[XB_TMO], 1u); break; } } } } while (0)

struct XcdBarrier { unsigned* bar; unsigned x; volatile LAS unsigned* st; };

__device__ __forceinline__ XcdBarrier xcd_barrier_post(unsigned* bar, volatile LAS unsigned* st) {
    XcdBarrier b; b.bar = bar; b.x = xb_xcc_id(); b.st = st;
    if (threadIdx.x == 0) (void)xb_add(&bar[XB_XCNT(b.x)], 1u);
    return b;
}
__device__ __forceinline__ void xcd_barrier_complete(unsigned* bar, unsigned x, unsigned& nloc, unsigned& nx) {
    const unsigned G = gridDim.x * gridDim.y * gridDim.z;
    unsigned sum, cnt, mine, sp = 0u;
    for (;;) {
        sum = 0u; cnt = 0u; mine = 0u;
#pragma unroll
        for (unsigned j = 0; j < 16; ++j) { const unsigned c = xb_ld(&bar[XB_XCNT(j)]); sum += c; cnt += (c > 0u) ? 1u : 0u; mine = (j == x) ? c : mine; }
        if (sum == G) break;
        __builtin_amdgcn_s_sleep(1);
        if ((++sp & 255u) == 0u) { if (xb_ld(&bar[XB_TMO])) break; if (sp > XB_SPIN_CAP) { atomicAdd(&bar[XB_TMO], 1u); break; } }
    }
    nloc = mine > 0u ? mine : 1u; nx = cnt > 0u ? cnt : 1u;
}
__device__ __forceinline__ void xcd_barrier(const XcdBarrier& b) {
    asm volatile("s_waitcnt vmcnt(0)" ::: "memory");
    __syncthreads();
    if (threadIdx.x == 0) {
        unsigned* bar = b.bar;
        __builtin_amdgcn_s_waitcnt(0);
        unsigned nloc = b.st[0], nx = b.st[1];
        if (nloc == 0u) { xcd_barrier_complete(bar, b.x, nloc, nx); b.st[0] = nloc; b.st[1] = nx; }
        const unsigned old = xb_add(&bar[XB_XSUB(b.x)], 1u);
        const unsigned gen = old / nloc;
        if (old + 1u == (gen + 1u) * nloc) {
            __builtin_amdgcn_fence(__ATOMIC_RELEASE, "agent");
            asm volatile("s_waitcnt vmcnt(0)" ::: "memory");
            const unsigned og = xb_add(&bar[XB_TOP], 1u);
            const unsigned tg = og / nx;
            if (og + 1u == (tg + 1u) * nx) xb_add(&bar[XB_TOPGEN], 1u);
            else XB_SPIN(xb_ld(&bar[XB_TOPGEN]) == tg, bar);
            __builtin_amdgcn_fence(__ATOMIC_ACQUIRE, "agent");
            xb_add(&bar[XB_XGEN(b.x)], 1u);
            asm volatile("s_waitcnt vmcnt(0)" ::: "memory");
        } else {
            XB_SPIN(xb_ld(&bar[XB_XGEN(b.x)]) == gen, bar);
            __builtin_amdgcn_fence(__ATOMIC_ACQUIRE, "agent");
            asm volatile("s_waitcnt vmcnt(0)" ::: "memory");
        }
    }
    __syncthreads();
}

namespace pg8 {
constexpr int BM = 256, BK = 64, HALF = 128, HTB = HALF * BK * 2, STAGE_BYTES = 8 * HTB;
__host__ __device__ __forceinline__ int lds_byte(int r, int c) { const int st = (r >> 4) * 2 + (c >> 5), rr = r & 15, cc = c & 31, ob = rr * 64 + cc * 2; return st * 1024 + (ob ^ (((ob >> 9) & 1) << 5)); }
__host__ __device__ __forceinline__ void stage_rc(int b, int& R, int& C) { const int st = b / 1024, sb = b % 1024, swz = sb ^ (((sb >> 9) & 1) << 5); R = (st >> 1) * 16 + swz / 64; C = (st & 1) * 32 + (swz % 64) / 2; }
__host__ __device__ __forceinline__ int perm32(int rho) { const int n = rho >> 4, i = rho & 15; return 8 * (i >> 2) + 4 * n + (i & 3); }

struct Unit { const char* A; const char* B; int pm, pn, e, aux; };

template <class Epi, class Sched, bool GATHER>
__device__ __forceinline__ void gemm_phase(LAS unsigned char* lds, const int K_, const Sched& S, const Epi& E) {
    int K = K_; asm volatile("" : "+s"(K));
    const int tid = opaque((int)threadIdx.x), wid = __builtin_amdgcn_readfirstlane(tid >> 6), lane = tid & 63, wr = wid >> 2, wc = wid & 3, fr = lane & 15, fq = lane >> 4;
    const int nt = K / BK;
    int Rr[2], Cc[2];
    unsigned voffB[2], vAc[2][2], vAn[2][2];
    const size_t kstep = (size_t)(BK * 2);
    const size_t hstep = (size_t)HALF * K * 2;
#pragma unroll
    for (int i = 0; i < 2; ++i) { int R, C; stage_rc(tid * 16 + i * 8192, R, C); Rr[i] = R; Cc[i] = C; const int Rb = Epi::PERM ? ((R & ~31) + perm32(R & 31)) : R;
        voffB[i] = (unsigned)(Rb * K + C) * 2u; vAc[0][i] = (unsigned)(R * K + C) * 2u; vAc[1][i] = vAc[0][i] + (unsigned)hstep; vAn[0][i] = vAc[0][i]; vAn[1][i] = vAc[1][i]; }
    const unsigned ldsw = (unsigned)wid * 1024u;
    const int aoff = lds_byte(wr * 64 + fr, fq * 8), boff = lds_byte(wc * 32 + fr, fq * 8);
#define PG8_SA(b, h) (((b) * 2 + (h)) * HTB)
#define PG8_SB(b, h) ((4 + (b) * 2 + (h)) * HTB)
#define PG8_STAGE(bufoff, gbase, voff) do { _Pragma("unroll") for (int _i = 0; _i < 2; ++_i) \
        __builtin_amdgcn_global_load_lds((const unsigned*)((const char*)(gbase) + (voff)[_i]), (LAS unsigned*)(lds + (bufoff) + ldsw + _i * 8192), 16, 0, 0); } while (0)
#define PG8_LDA(dst, b, h) do { _Pragma("unroll") for (int m = 0; m < 4; ++m) _Pragma("unroll") for (int k = 0; k < 2; ++k) dst[m][k] = *(const LAS bf16x8*)(lds + PG8_SA(b, h) + aoff + m * 2048 + k * 1024); } while (0)
#define PG8_LDB(dst, b, h) do { _Pragma("unroll") for (int n = 0; n < 2; ++n) _Pragma("unroll") for (int k = 0; k < 2; ++k) dst[n][k] = *(const LAS bf16x8*)(lds + PG8_SB(b, h) + boff + n * 2048 + k * 1024); } while (0)
#define PG8_MMA(ai, bj, At, Bt) do { __builtin_amdgcn_s_setprio(1); _Pragma("unroll") for (int m = 0; m < 4; ++m) _Pragma("unroll") for (int n = 0; n < 2; ++n) _Pragma("unroll") for (int k = 0; k < 2; ++k) \
        acc[ai][bj][m][n] = __builtin_amdgcn_mfma_f32_16x16x32_bf16(Bt[n][k], At[m][k], acc[ai][bj][m][n], 0, 0, 0); __builtin_amdgcn_s_setprio(0); } while (0)
#define PG8_WAIT_V(n) asm volatile("s_waitcnt vmcnt(" #n ")" ::: "memory")
#define PG8_WAIT_L(n) asm volatile("s_waitcnt lgkmcnt(" #n ")" ::: "memory")
#define PG8_BAR __builtin_amdgcn_s_barrier()
#define PG8_SCHED __builtin_amdgcn_sched_barrier(0)
    Unit cur, nxt; int ui = 0;
    if (!S.next(0, cur)) return;
    if (GATHER) { S.offsets(cur, Rr, Cc, vAc); }
    f32x4 acc[2][2][4][2];
#pragma unroll
    for (int a = 0; a < 2; ++a)
#pragma unroll
        for (int b = 0; b < 2; ++b)
#pragma unroll
            for (int m = 0; m < 4; ++m)
#pragma unroll
                for (int n = 0; n < 2; ++n) acc[a][b][m][n] = (f32x4){0.f, 0.f, 0.f, 0.f};
    bf16x8 At[4][2], B0[2][2], B1[2][2];
    const char* cA = cur.A; const char* cB = cur.B;
    PG8_STAGE(PG8_SB(0, 0), cB, voffB); PG8_STAGE(PG8_SA(0, 0), cA, vAc[0]); PG8_STAGE(PG8_SB(0, 1), cB + hstep, voffB); PG8_STAGE(PG8_SA(0, 1), cA, vAc[1]);
    if (wr == 1) PG8_BAR;
    PG8_WAIT_V(4); PG8_BAR;
    PG8_STAGE(PG8_SB(1, 0), cB + kstep, voffB); PG8_STAGE(PG8_SA(1, 0), cA + kstep, vAc[0]); PG8_STAGE(PG8_SB(1, 1), cB + hstep + kstep, voffB);
    PG8_WAIT_V(6); PG8_BAR;
    for (;;) {
        float pre[8]; E.pre(cur, wr, fr, pre);
        const bool has_next = S.next(ui + 1, nxt);
        const char* nA = has_next ? nxt.A : cA; const char* nB = has_next ? nxt.B : cB;
        if (GATHER) { if (has_next) S.offsets(nxt, Rr, Cc, vAn); else { vAn[0][0] = vAc[0][0]; vAn[0][1] = vAc[0][1]; vAn[1][0] = vAc[1][0]; vAn[1][1] = vAc[1][1]; } }
        for (int t = 0; t < nt; t += 2) {
            const bool last = (t == nt - 2);
            const char* a1 = cA + (size_t)(t + 1) * kstep;
            const char* a2 = last ? nA : cA + (size_t)(t + 2) * kstep; const char* b2 = last ? nB : cB + (size_t)(t + 2) * kstep;
            const char* a3 = a2 + kstep; const char* b3 = b2 + kstep;
            unsigned v2[2][2];
            if (GATHER) { v2[0][0] = last ? vAn[0][0] : vAc[0][0]; v2[0][1] = last ? vAn[0][1] : vAc[0][1]; v2[1][0] = last ? vAn[1][0] : vAc[1][0]; v2[1][1] = last ? vAn[1][1] : vAc[1][1]; }
            else { v2[0][0] = vAc[0][0]; v2[0][1] = vAc[0][1]; v2[1][0] = vAc[1][0]; v2[1][1] = vAc[1][1]; }
            PG8_LDB(B0, 0, 0); PG8_SCHED; PG8_LDA(At, 0, 0); PG8_STAGE(PG8_SA(1, 1), a1, vAc[1]);
            PG8_WAIT_L(8); PG8_BAR; PG8_WAIT_L(0); PG8_MMA(0, 0, At, B0); PG8_BAR; PG8_SCHED;
            PG8_LDB(B1, 0, 1); PG8_STAGE(PG8_SB(0, 0), b2, voffB);
            PG8_BAR; PG8_WAIT_L(0); PG8_MMA(0, 1, At, B1); PG8_BAR;
            PG8_LDA(At, 0, 1); PG8_STAGE(PG8_SA(0, 0), a2, v2[0]);
            PG8_BAR; PG8_WAIT_L(0); PG8_MMA(1, 0, At, B0); PG8_BAR; PG8_SCHED;
            PG8_STAGE(PG8_SB(0, 1), b2 + hstep, voffB);
            PG8_WAIT_V(6); PG8_BAR; PG8_MMA(1, 1, At, B1); PG8_BAR;
            PG8_LDB(B0, 1, 0); PG8_SCHED; PG8_LDA(At, 1, 0); PG8_STAGE(PG8_SA(0, 1), a2, v2[1]);
            PG8_WAIT_L(8); PG8_BAR; PG8_WAIT_L(0); PG8_MMA(0, 0, At, B0); PG8_BAR; PG8_SCHED;
            PG8_LDB(B1, 1, 1); PG8_STAGE(PG8_SB(1, 0), b3, voffB);
            PG8_BAR; PG8_WAIT_L(0); PG8_MMA(0, 1, At, B1); PG8_BAR;
            PG8_LDA(At, 1, 1); PG8_STAGE(PG8_SA(1, 0), a3, v2[0]);
            PG8_BAR; PG8_WAIT_L(0); PG8_MMA(1, 0, At, B0); PG8_BAR; PG8_SCHED;
            PG8_STAGE(PG8_SB(1, 1), b3 + hstep, voffB);
            PG8_WAIT_V(6); PG8_BAR; PG8_MMA(1, 1, At, B1); PG8_BAR;
        }
        E(acc, cur, wr, wc, fr, fq, pre);
        if (!has_next) break;
#pragma unroll
        for (int a = 0; a < 2; ++a)
#pragma unroll
            for (int b = 0; b < 2; ++b)
#pragma unroll
                for (int m = 0; m < 4; ++m)
#pragma unroll
                    for (int n = 0; n < 2; ++n) acc[a][b][m][n] = (f32x4){0.f, 0.f, 0.f, 0.f};
        cur = nxt; cA = nA; cB = nB; ++ui;
        if (GATHER) { vAc[0][0] = vAn[0][0]; vAc[0][1] = vAn[0][1]; vAc[1][0] = vAn[1][0]; vAc[1][1] = vAn[1][1]; }
    }
    PG8_WAIT_V(0);
    if (wr == 0) PG8_BAR;
    PG8_BAR;
#undef PG8_SA
#undef PG8_SB
#undef PG8_STAGE
#undef PG8_LDA
#undef PG8_LDB
#undef PG8_MMA
#undef PG8_WAIT_V
#undef PG8_WAIT_L
#undef PG8_BAR
#undef PG8_SCHED
}
}
constexpr size_t MiB = 1u << 20;
constexpr size_t WS_CTL = 0, CTL_ZERO_BYTES = 1 * MiB;
constexpr size_t WS_MOD = 1 * MiB;
constexpr size_t WS_ROPE = WS_MOD + 256 * 1024;
constexpr size_t WS_MISC = WS_ROPE + 256 * 1024;
constexpr size_t WS_WAB_IN = 2 * MiB;
constexpr size_t WS_WAB_OUT = 20 * MiB;
constexpr size_t WS_WDA_IN = 26 * MiB;
constexpr size_t WS_WDA_OUT = 38 * MiB;
constexpr size_t WS_WR = 42 * MiB;
constexpr size_t WS_W3T = 43 * MiB;
constexpr size_t WS_HID2C = WS_W3T + 512 * 1024;
constexpr size_t WS_WGU = 44 * MiB;
constexpr size_t WS_WD = 109 * MiB;
constexpr size_t WS_XRES = 142 * MiB;
constexpr size_t WS_H = 207 * MiB;
constexpr size_t WS_LTOK = 240 * MiB;
constexpr size_t WS_LW = WS_LTOK + 5 * MiB;
constexpr size_t WS_SLOT = WS_LW + 5 * MiB;
constexpr size_t WS_SLOTW = WS_SLOT + 1 * MiB;
constexpr size_t WS_U = 252 * MiB;
constexpr size_t WS_PROJ = WS_U;
constexpr size_t WS_TAPS = WS_U;
constexpr size_t WS_CAT = WS_U + 147 * MiB;
constexpr size_t WS_UPD = WS_U + 196 * MiB;
constexpr size_t WS_SPREV = WS_U + 261 * MiB;
constexpr size_t WS_UT = WS_U + 326 * MiB;
constexpr size_t WS_YT = WS_U + 374 * MiB;
constexpr size_t WS_HSPEC = WS_U + 390 * MiB;
constexpr size_t WS_Y1 = WS_U + 519 * MiB;
constexpr size_t WS_MIX_END = WS_U + 551 * MiB;
constexpr int MAX_TILES = 649;
constexpr size_t WS_ACT = WS_U;
constexpr size_t WS_YSLOT = WS_U + 82 * MiB;
constexpr size_t WS_HLO = WS_YSLOT;
constexpr size_t WS_END = WS_U + 551 * MiB;
static_assert(WS_YSLOT + (size_t)MAX_TILES * 256 * 1024 * 2 <= WS_END, "moe view");
static_assert(WS_HSPEC + (size_t)2 * 512 * HSPEC_LD * 8 <= WS_MIX_END, "mixer view");

constexpr int CW_BAR = 1024;
constexpr int CW_CNT = 8192;
constexpr int CW_ERR = 16;
constexpr int CW_CVTQ = 9216;

constexpr int LDS_BIG = 139264;
constexpr int LDS_MISC = LDS_BIG;
constexpr int LDS_BYTES = LDS_BIG + 16384;
constexpr int NTHREADS = 512;

struct Params {
    const float* in[34];
    float* out;
    unsigned char* ws;
    int ph_lo, ph_hi;
};

typedef const __attribute__((address_space(4))) Params* KParams;
#define PREF const __attribute__((address_space(4))) Params&
__device__ __forceinline__ KParams opaque_kp(KParams p) { asm volatile("" : "+s"(p)); return p; }
struct Ctx {
    KParams p;
    LAS unsigned char* lds;
    int tid, lane, wid, G, bid, cnt_off, pass;
    unsigned char* ws;
};

template <class RowMap>
__device__ __forceinline__ void cvt_tile(const Ctx& c, const float* src, int ldn, int k0, int n0, bf16_t* dst, int ldk, const RowMap& rm) {
    LAS float* t = (LAS float*)c.lds;
    const int tid = c.tid;
    {   const int kr = tid >> 4, nc = (tid & 15) * 4;
#pragma unroll
        for (int h = 0; h < 2; ++h) { const f32x4 v = *(const f32x4*)(src + (size_t)(k0 + kr + 32 * h) * ldn + n0 + nc);
            t[(kr + 32 * h) * 65 + nc + 0] = v[0]; t[(kr + 32 * h) * 65 + nc + 1] = v[1]; t[(kr + 32 * h) * 65 + nc + 2] = v[2]; t[(kr + 32 * h) * 65 + nc + 3] = v[3]; } }
    __syncthreads();
    {   const int n = tid >> 3, k8 = (tid & 7) * 8; float f[8];
#pragma unroll
        for (int j = 0; j < 8; ++j) f[j] = t[(k8 + j) * 65 + n];
        u32x4 w; w.x = cvtpk(f[0], f[1]); w.y = cvtpk(f[2], f[3]); w.z = cvtpk(f[4], f[5]); w.w = cvtpk(f[6], f[7]);
        *(u32x4*)(dst + (size_t)rm(n0 + n) * ldk + k0 + k8) = w; }
    __syncthreads();
}
template <class RowMap>
__device__ __forceinline__ void cvt_tile128(const Ctx& c, const float* src, int ldn, int k0, int n0, bf16_t* dst, int ldk, const RowMap& rm) {
    LAS float* t = (LAS float*)c.lds;
    const int tid = c.tid;
    {   const int kr = tid >> 4, nc = (tid & 15) * 4;
#pragma unroll
        for (int h = 0; h < 4; ++h) { const f32x4 v = *(const f32x4*)(src + (size_t)(k0 + kr + 32 * h) * ldn + n0 + nc);
            t[(kr + 32 * h) * 65 + nc + 0] = v[0]; t[(kr + 32 * h) * 65 + nc + 1] = v[1]; t[(kr + 32 * h) * 65 + nc + 2] = v[2]; t[(kr + 32 * h) * 65 + nc + 3] = v[3]; } }
    __syncthreads();
    {   const int k8 = (tid & 15) * 8;
#pragma unroll
        for (int h = 0; h < 2; ++h) { const int n = (tid >> 4) + 32 * h; float f[8];
#pragma unroll
            for (int j = 0; j < 8; ++j) f[j] = t[(k8 + j) * 65 + n];
            u32x4 w; w.x = cvtpk(f[0], f[1]); w.y = cvtpk(f[2], f[3]); w.z = cvtpk(f[4], f[5]); w.w = cvtpk(f[6], f[7]);
            *(u32x4*)(dst + (size_t)rm(n0 + n) * ldk + k0 + k8) = w; } }
    __syncthreads();
}
struct RowId { __device__ __forceinline__ int operator()(int n) const { return n; } };
struct RowAbIn { __device__ __forceinline__ int operator()(int n) const { if (n >= 1024) return n; const int d = n & 127; return (n & ~127) + ((d < 64) ? 2 * d : 2 * (d - 64) + 1); } };
struct RowDaIn { __device__ __forceinline__ int operator()(int n) const { if (n >= 2048) return n; const int d = n & 63; return (n & ~63) + ((d < 32) ? 2 * d : 2 * (d - 32) + 1); } };
struct RowGate { __device__ __forceinline__ int operator()(int n) const { return (n >> 7) * 256 + (n & 127); } };
struct RowDown { __device__ __forceinline__ int operator()(int n) const { return (n & ~255) + 128 * ((n >> 3) & 1) + 32 * ((n >> 6) & 3) + 8 * ((n >> 4) & 3) + (n & 7); } };
struct RowUp   { __device__ __forceinline__ int operator()(int n) const { return (n >> 7) * 256 + 128 + (n & 127); } };

__device__ __forceinline__ void cvt_router_tile(const Ctx& c, const float* src, int k0, bf16_t* dhi, bf16_t* dlo) {
    LAS float* t = (LAS float*)c.lds; const int tid = c.tid;
    {   const int kr = tid >> 4, nc = (tid & 15) * 4;
#pragma unroll
        for (int h = 0; h < 2; ++h) { const f32x4 v = *(const f32x4*)(src + (size_t)(k0 + kr + 32 * h) * 64 + nc);
            t[(kr + 32 * h) * 65 + nc + 0] = v[0]; t[(kr + 32 * h) * 65 + nc + 1] = v[1]; t[(kr + 32 * h) * 65 + nc + 2] = v[2]; t[(kr + 32 * h) * 65 + nc + 3] = v[3]; } }
    __syncthreads();
    {   const int n = tid >> 3, k8 = (tid & 7) * 8; float f[8], g[8];
#pragma unroll
        for (int j = 0; j < 8; ++j) { f[j] = t[(k8 + j) * 65 + n]; const float h = bf2f(f2bf(f[j])); g[j] = f[j] - h; f[j] = h; }
        u32x4 w; w.x = cvtpk(f[0], f[1]); w.y = cvtpk(f[2], f[3]); w.z = cvtpk(f[4], f[5]); w.w = cvtpk(f[6], f[7]);
        *(u32x4*)(dhi + (size_t)n * 1024 + k0 + k8) = w;
        w.x = cvtpk(g[0], g[1]); w.y = cvtpk(g[2], g[3]); w.z = cvtpk(g[4], g[5]); w.w = cvtpk(g[6], g[7]);
        *(u32x4*)(dlo + (size_t)n * 1024 + k0 + k8) = w; }
    __syncthreads();
}

__device__ __forceinline__ void phase_pr0(const Ctx& c) {
    PREF P = *c.p; unsigned char* ws = c.ws;
    const int T_ABIN = 2 * 16 * 72, T_ABOUT = 2 * 24 * 16, T_DAIN = 2 * 16 * 48, T_DAOUT = 2 * 16 * 16, T_R = 4 * 16, T_W3 = 2 * 1 * 32;
    const int T_ALL = T_ABIN + T_ABOUT + T_DAIN + T_DAOUT + T_R + T_W3;
    for (int u = c.bid; u < T_ALL; u += c.G) {
        int v = u;
        if (v < T_ABIN) { const int j = v / (16 * 72), r = v % (16 * 72), kt = r / 72, ntile = r % 72;
            cvt_tile(c, P.in[8] + (size_t)j * 1024 * AB_IN, AB_IN, kt * 64, ntile * 64, (bf16_t*)(ws + WS_WAB_IN) + (size_t)j * AB_IN * 1024, 1024, RowAbIn()); continue; }
        v -= T_ABIN;
        if (v < T_ABOUT) { const int j = v / (24 * 16), r = v % (24 * 16), kt = r / 16, ntile = r % 16;
            cvt_tile(c, P.in[9] + (size_t)j * AB_CAT * 1024, 1024, kt * 64, ntile * 64, (bf16_t*)(ws + WS_WAB_OUT) + (size_t)j * 1024 * AB_CAT, AB_CAT, RowId()); continue; }
        v -= T_ABOUT;
        if (v < T_DAIN) { const int j = v / (16 * 48), r = v % (16 * 48), kt = r / 48, ntile = r % 48;
            cvt_tile(c, P.in[21] + (size_t)j * 1024 * DA_IN, DA_IN, kt * 64, ntile * 64, (bf16_t*)(ws + WS_WDA_IN) + (size_t)j * DA_IN * 1024, 1024, RowDaIn()); continue; }
        v -= T_DAIN;
        if (v < T_DAOUT) { const int j = v / (16 * 16), r = v % (16 * 16), kt = r / 16, ntile = r % 16;
            cvt_tile(c, P.in[22] + (size_t)j * 1024 * 1024, 1024, kt * 64, ntile * 64, (bf16_t*)(ws + WS_WDA_OUT) + (size_t)j * 1024 * 1024, 1024, RowId()); continue; }
        v -= T_DAOUT;
        if (v < T_R) { const int i = v / 16, kt = v % 16;
            cvt_router_tile(c, P.in[25] + (size_t)i * 1024 * 64, kt * 64, (bf16_t*)(ws + WS_WR) + (size_t)(i * 2 + 0) * 64 * 1024, (bf16_t*)(ws + WS_WR) + (size_t)(i * 2 + 1) * 64 * 1024); continue; }
        v -= T_R;
        { const int j = v / 32, ntile = v % 32;
            cvt_tile(c, P.in[19] + (size_t)j * 64 * 2048, 2048, 0, ntile * 64, (bf16_t*)(ws + WS_W3T) + (size_t)j * 2048 * 64, 64, RowId()); }
    }
    {
        LAS float* red = (LAS float*)c.lds;
        for (int u = c.bid; u < 192; u += c.G) {
            const int i = u / 48, j0 = (u % 48) * 128, col = c.tid & 127, kg = c.tid >> 7;
            const float* w = P.in[4] + (size_t)i * 1024 * 6144 + j0 + col;
            float a0 = 0.f, a1 = 0.f;
#pragma unroll 8
            for (int k = kg * 256; k < kg * 256 + 256; ++k) { const float wv = w[(size_t)k * 6144]; a0 += siluf(P.in[1][k]) * wv; a1 += siluf(P.in[3][k]) * wv; }
            red[(kg * 2 + 0) * 128 + col] = a0; red[(kg * 2 + 1) * 128 + col] = a1;
            __syncthreads();
            if (c.tid < 256) { const int s = c.tid >> 7; float v = 0.f;
#pragma unroll
                for (int g = 0; g < 4; ++g) v += red[(g * 2 + s) * 128 + col];
                ((float*)(ws + WS_MOD))[(size_t)(i * 2 + s) * 6144 + j0 + col] = v + P.in[5][(size_t)i * 6144 + j0 + col]; }
            __syncthreads();
        }
    }
    {
        f32x2* rt = (f32x2*)(ws + WS_ROPE);
        const int NRR = 256 * 32, NRC = 64 * 32, NDR = 256 * 16, NDC = 64 * 16;
        for (int idx = c.bid * NTHREADS + c.tid; idx < NRR + NRC + NDR + NDC; idx += c.G * NTHREADS) {
            int v = idx; float pos, inv;
            if (v < NRR) { pos = (float)(v >> 5); inv = powf(10000.f, -(float)(v & 31) / 32.f); }
            else if ((v -= NRR) < NRC) { pos = (float)(v >> 5); inv = powf(10000.f, -(float)(v & 31) / 32.f); }
            else if ((v -= NRC) < NDR) { pos = (float)(v >> 4); inv = powf(10000.f, -(float)(v & 15) / 16.f); }
            else { v -= NDR; pos = (float)(v >> 4); inv = powf(10000.f, -(float)(v & 15) / 16.f); }
            const float ang = pos * inv;
            rt[idx] = (f32x2){cosf(ang), sinf(ang)};
        }
    }
    if (c.bid == 0 && c.wid < 2) {
        const int j = c.wid; const float* lam = P.in[23] + (size_t)j * 4 * 64;
        float a = lam[c.lane] * lam[64 + c.lane], b = lam[128 + c.lane] * lam[192 + c.lane];
        a = wave_sum(a); b = wave_sum(b);
        const float linit = 0.8f - 0.6f * expf(-0.3f * (float)(2 * j + 1));
        if (c.lane == 0) { ((float*)(ws + WS_MISC))[j * 2 + 0] = expf(a) - expf(b) + linit; ((float*)(ws + WS_MISC))[j * 2 + 1] = linit; }
    }
}

__device__ __forceinline__ void norm_rows(const Ctx& c, int layer, int which  , const float* gain, int row_lo, int row_hi, const float* xsrc_lat, const float* xsrc_ctx, bf16_t* dst) {
    const float* mod = (const float*)(c.ws + WS_MOD) + (size_t)layer * 2 * 6144;
    const int sh_off = which ? 3 * 1024 : 0, sc_off = which ? 4 * 1024 : 1024;
    for (int row = row_lo + c.bid * 8 + c.wid; row < row_hi; row += c.G * 8) {
        const float* x = (row < NC) ? (xsrc_ctx + (size_t)row * D) : (xsrc_lat + (size_t)(row - NC) * D);
        const float* m = mod + ((row < NC) ? 6144 : 0);
        f32x4 v[4]; float ss = 0.f;
#pragma unroll
        for (int q = 0; q < 4; ++q) { v[q] = *(const f32x4*)(x + q * 256 + c.lane * 4); ss += v[q][0] * v[q][0] + v[q][1] * v[q][1] + v[q][2] * v[q][2] + v[q][3] * v[q][3]; }
        ss = wave_sum(ss);
        const float rstd = rsqrtf(ss * (1.0f / 1024.f) + EPS);
#pragma unroll
        for (int q = 0; q < 4; ++q) { const int col = q * 256 + c.lane * 4;
            const f32x4 g = *(const f32x4*)(gain + col), sc = *(const f32x4*)(m + sc_off + col), sh = *(const f32x4*)(m + sh_off + col);
            float o[4];
#pragma unroll
            for (int j = 0; j < 4; ++j) o[j] = v[q][j] * rstd * g[j] * (1.0f + sc[j]) + sh[j];
            u32x2 w; w.x = cvtpk(o[0], o[1]); w.y = cvtpk(o[2], o[3]);
            *(u32x2*)(dst + (size_t)row * D + col) = w; }
    }
}

__device__ __forceinline__ void phase_pr1(const Ctx& c) {
    PREF P = *c.p;
    float* xres = (float*)(c.ws + WS_XRES);
    for (size_t i = (size_t)c.bid * NTHREADS + c.tid; i < (size_t)NTOK * D / 4; i += (size_t)c.G * NTHREADS) {
        const size_t e = i * 4; const f32x4 v = (e < (size_t)NC * D) ? *(const f32x4*)(P.in[2] + e) : *(const f32x4*)(P.in[0] + (e - (size_t)NC * D));
        *(f32x4*)(xres + e) = v; }
    norm_rows(c, 0, 0, P.in[6], 0, NTOK, P.in[0], P.in[2], (bf16_t*)(c.ws + WS_H));
}
__device__ __forceinline__ int xcd_remap(int L, int n) { const int q = n / 8, r = n % 8, x = L % 8, off = L / 8; return (x < r ? x * (q + 1) : r * (q + 1) + (x - r) * q) + off; }

struct DenseSched {
    const char* A; const char* Bt; int K, nM, nN, pm0, G, c, nwg;
    __device__ __forceinline__ void init(const void* A_, const void* Bt_, int K_, int nM_, int nN_, int pm0_, int G_, int c_) { A = (const char*)A_; Bt = (const char*)Bt_; K = K_; nM = nM_ - pm0_; nN = nN_; pm0 = pm0_; G = G_; c = c_; nwg = nM * nN; }
    __device__ __forceinline__ bool next(int i, pg8::Unit& u) const {
        const long L = (long)i * G + c; if (L >= nwg) return false;
        const int wgid = xcd_remap((int)L, nwg);
        const int WGM = 8, nig = WGM * nN, gid = wgid / nig, fm = gid * WGM, gsz = (nM - fm) < WGM ? (nM - fm) : WGM;
        u.pm = pm0 + fm + ((wgid % nig) % gsz); u.pn = (wgid % nig) / gsz; u.e = 0; u.aux = 0;
        u.A = A + (size_t)u.pm * 256 * K * 2; u.B = Bt + (size_t)u.pn * 256 * K * 2; return true;
    }
    __device__ __forceinline__ void offsets(const pg8::Unit&, const int (&)[2], const int (&)[2], unsigned (&)[2][2]) const {}
};

struct MoeTable { const LAS int* tb; const LAS int* cn; };
__device__ __forceinline__ int moe_find(const MoeTable& t, int T) { int e = 0;
#pragma unroll 1
    for (int s = 64; s >= 1; s >>= 1) { if (e + s <= 64 && t.tb[e + s] <= T) e += s; } return e; }

struct MoeUpSched {
    MoeTable t; const char* H; const char* W; const int* ltok; int tok0, G, c, nwg;
    __device__ __forceinline__ bool next(int i, pg8::Unit& u) const {
        const long L = (long)i * G + c; if (L >= nwg) return false;
        const int id = xcd_remap((int)L, nwg); const int T = id >> 1; u.pn = id & 1; u.pm = T; u.e = moe_find(t, T); u.aux = T - t.tb[u.e];
        u.A = H; u.B = W + ((size_t)u.e * 512 + (size_t)u.pn * 256) * 1024 * 2; return true;
    }
    __device__ __forceinline__ void offsets(const pg8::Unit& u, const int (&Rr)[2], const int (&Cc)[2], unsigned (&vo)[2][2]) const {
        const int cnt = t.cn[u.e];
#pragma unroll
        for (int h = 0; h < 2; ++h)
#pragma unroll
            for (int i = 0; i < 2; ++i) { const int pos = u.aux * 256 + h * 128 + Rr[i]; int tok;
                if (u.e == 64) tok = tok0 + (pos < cnt ? pos : 0); else tok = (pos < cnt) ? ltok[(size_t)u.e * NTOK + pos] : tok0;
                vo[h][i] = (unsigned)(tok * 1024 + Cc[i]) * 2u; }
    }
};
struct MoeDownSched {
    MoeTable t; const char* ACT; const char* W; int G, c, nwg;
    __device__ __forceinline__ bool next(int i, pg8::Unit& u) const {
        const long L = (long)i * G + c; if (L >= nwg) return false;
        const int id = xcd_remap((int)L, nwg); const int T = id >> 2; u.pn = id & 3; u.pm = T; u.e = moe_find(t, T); u.aux = T - t.tb[u.e];
        u.A = ACT + (size_t)T * 256 * 256 * 2; u.B = W + ((size_t)u.e * 1024 + (size_t)u.pn * 256) * 256 * 2; return true;
    }
    __device__ __forceinline__ void offsets(const pg8::Unit&, const int (&)[2], const int (&)[2], unsigned (&)[2][2]) const {}
};

__device__ __forceinline__ void rope8(f32x4& v0, f32x4& v1, const f32x2* cs) {
    const f32x4 t0 = *(const f32x4*)(cs), t1 = *(const f32x4*)(cs + 2);
    float a, b;
    a = v0[0]; b = v0[1]; v0[0] = a * t0[0] - b * t0[1]; v0[1] = b * t0[0] + a * t0[1];
    a = v0[2]; b = v0[3]; v0[2] = a * t0[2] - b * t0[3]; v0[3] = b * t0[2] + a * t0[3];
    a = v1[0]; b = v1[1]; v1[0] = a * t1[0] - b * t1[1]; v1[1] = b * t1[0] + a * t1[1];
    a = v1[2]; b = v1[3]; v1[2] = a * t1[2] - b * t1[3]; v1[3] = b * t1[2] + a * t1[3];
}
struct EpiAbIn {
    static constexpr bool PERM = true;
    __device__ __forceinline__ void pre(const pg8::Unit&, int, int, float (&)[8]) const {}
    bf16_t* O; const f32x2* rope;
    __device__ __forceinline__ void operator()(const f32x4 (&acc)[2][2][4][2], const pg8::Unit& u, int wr, int wc, int fr, int fq, const float (&pre)[8]) const {
        const int row0 = u.pm * 256 + wr * 64 + fr, colt = u.pn * 256 + wc * 32 + 8 * fq;
        const bool qk = u.pn < 4, lat = u.pm >= 1; const float ksc = (u.pn >= 2 && u.pn < 4) ? 0.08838834764831845f : 1.0f;
#pragma unroll
        for (int ai = 0; ai < 2; ++ai)
#pragma unroll
            for (int m = 0; m < 4; ++m) { const int row = row0 + ai * 128 + m * 16; bf16_t* rowp = O + (size_t)row * AB_IN + colt; const int t = row - NC;
#pragma unroll
                for (int bj = 0; bj < 2; ++bj) { f32x4 v0 = acc[ai][bj][m][0], v1 = acc[ai][bj][m][1];
                    if (qk) { if (lat) { const int p0 = ((colt + bj * 128) & 127) >> 1;
                            const f32x2* cs = (p0 < 32) ? rope + (size_t)(t >> 6) * 32 + p0 : rope + 256 * 32 + (size_t)(t & 63) * 32 + (p0 - 32);
                            rope8(v0, v1, cs); }
                        v0 *= ksc; v1 *= ksc; }
                    u32x4 w; w.x = cvtpk(v0[0], v0[1]); w.y = cvtpk(v0[2], v0[3]); w.z = cvtpk(v1[0], v1[1]); w.w = cvtpk(v1[2], v1[3]);
                    *(u32x4*)(rowp + bj * 128) = w; } }
    }
};
struct EpiDaIn {
    static constexpr bool PERM = true;
    __device__ __forceinline__ void pre(const pg8::Unit&, int, int, float (&)[8]) const {}
    bf16_t* O; const f32x2* rope;
    __device__ __forceinline__ void operator()(const f32x4 (&acc)[2][2][4][2], const pg8::Unit& u, int wr, int wc, int fr, int fq, const float (&pre)[8]) const {
        const int row0 = u.pm * 256 + wr * 64 + fr, colt = u.pn * 256 + wc * 32 + 8 * fq;
        const bool qk = u.pn < 8, lat = u.pm >= 1; const float qsc = (u.pn < 4) ? 0.125f * 1.4426950408889634f : 1.0f;
#pragma unroll
        for (int ai = 0; ai < 2; ++ai)
#pragma unroll
            for (int m = 0; m < 4; ++m) { const int row = row0 + ai * 128 + m * 16; bf16_t* rowp = O + (size_t)row * DA_IN + colt; const int t = row - NC;
#pragma unroll
                for (int bj = 0; bj < 2; ++bj) { f32x4 v0 = acc[ai][bj][m][0], v1 = acc[ai][bj][m][1];
                    if (qk) { if (lat) { const int p0 = ((colt + bj * 128) & 63) >> 1;
                            const f32x2* cs = (p0 < 16) ? rope + (size_t)(t >> 6) * 16 + p0 : rope + 256 * 16 + (size_t)(t & 63) * 16 + (p0 - 16);
                            rope8(v0, v1, cs); }
                        v0 *= qsc; v1 *= qsc; }
                    u32x4 w; w.x = cvtpk(v0[0], v0[1]); w.y = cvtpk(v0[2], v0[3]); w.z = cvtpk(v1[0], v1[1]); w.w = cvtpk(v1[2], v1[3]);
                    *(u32x4*)(rowp + bj * 128) = w; } }
    }
};
struct EpiResid {
    static constexpr bool PERM = false;
    __device__ __forceinline__ void pre(const pg8::Unit&, int, int, float (&)[8]) const {}
    float* X; const float* mod;
    __device__ __forceinline__ void operator()(const f32x4 (&acc)[2][2][4][2], const pg8::Unit& u, int wr, int wc, int fr, int fq, const float (&pre)[8]) const {
        const int row0 = u.pm * 256 + wr * 64 + fr, col0 = u.pn * 256 + wc * 32 + 4 * fq;
        const float* g = mod + ((u.pm == 0) ? 6144 : 0) + 2 * 1024;
        f32x4 gv[2][2];
#pragma unroll
        for (int bj = 0; bj < 2; ++bj)
#pragma unroll
            for (int n = 0; n < 2; ++n) gv[bj][n] = *(const f32x4*)(g + col0 + bj * 128 + n * 16);
#pragma unroll
        for (int ai = 0; ai < 2; ++ai)
#pragma unroll
            for (int m = 0; m < 4; ++m) { float* rowp = X + (size_t)(row0 + ai * 128 + m * 16) * D + col0;
#pragma unroll
                for (int bj = 0; bj < 2; ++bj)
#pragma unroll
                    for (int n = 0; n < 2; ++n) { f32x4* p = (f32x4*)(rowp + bj * 128 + n * 16); *p = *p + gv[bj][n] * acc[ai][bj][m][n]; } }
    }
};
struct EpiSwiglu {
    static constexpr bool PERM = true;
    __device__ __forceinline__ void pre(const pg8::Unit& u, int wr, int fr, float (&pre)[8]) const {
        const int r0 = wr * 64 + fr; const int cnt = t.cn[u.e];
#pragma unroll
        for (int q = 0; q < 8; ++q) { const int pos = u.aux * 256 + r0 + (q >> 2) * 128 + (q & 3) * 16; const int pc = (pos < cnt) ? pos : 0;
            const float x = (u.e == 64) ? 1.0f : lw[(size_t)u.e * NTOK + pc]; pre[q] = (pos < cnt) ? x : 0.0f; }
    }
    bf16_t* ACT; const float* lw; MoeTable t;
    __device__ __forceinline__ void operator()(const f32x4 (&acc)[2][2][4][2], const pg8::Unit& u, int wr, int wc, int fr, int fq, const float (&pre)[8]) const {
        const int r0 = wr * 64 + fr, row0 = u.pm * 256 + r0, col0 = u.pn * 128 + wc * 32 + 8 * fq;
#pragma unroll
        for (int ai = 0; ai < 2; ++ai)
#pragma unroll
            for (int m = 0; m < 4; ++m) { bf16_t* rowp = ACT + (size_t)(row0 + ai * 128 + m * 16) * 256 + col0; float o[8]; const float w_ = pre[ai * 4 + m];
#pragma unroll
                for (int n = 0; n < 2; ++n)
#pragma unroll
                    for (int j = 0; j < 4; ++j) { const float g = acc[ai][0][m][n][j], up = acc[ai][1][m][n][j]; o[n * 4 + j] = siluf(g) * up * w_; }
                u32x4 w; w.x = cvtpk(o[0], o[1]); w.y = cvtpk(o[2], o[3]); w.z = cvtpk(o[4], o[5]); w.w = cvtpk(o[6], o[7]);
                *(u32x4*)rowp = w; }
    }
};
struct EpiDown {
    static constexpr bool PERM = true;
    __device__ __forceinline__ void pre(const pg8::Unit&, int, int, float (&)[8]) const {}
    unsigned char* Y; const float* lw; MoeTable t; int skip;
    __device__ __forceinline__ void operator()(const f32x4 (&acc)[2][2][4][2], const pg8::Unit& u, int wr, int wc, int fr, int fq, const float (&pre)[8]) const {
        if (skip) { asm volatile("" :: "v"(acc[0][0][0][0]), "v"(acc[1][1][3][1])); return; }
        const int r0 = wr * 64 + fr, col0 = u.pn * 256 + wc * 64 + 16 * fq;
#pragma unroll
        for (int ai = 0; ai < 2; ++ai)
#pragma unroll
            for (int m = 0; m < 4; ++m) { const int r = r0 + ai * 128 + m * 16; const float w_ = 1.0f;
                unsigned char* rowp = Y + (size_t)(u.pm * 256 + r) * 1024 + col0; u32x4 w;
#pragma unroll
                for (int bj = 0; bj < 2; ++bj) { const f32x4 v0 = acc[ai][bj][m][0] * w_, v1 = acc[ai][bj][m][1] * w_; int lo = 0, hi = 0;
                    lo = __builtin_amdgcn_cvt_pk_fp8_f32(v0[0], v0[1], lo, false); lo = __builtin_amdgcn_cvt_pk_fp8_f32(v0[2], v0[3], lo, true);
                    hi = __builtin_amdgcn_cvt_pk_fp8_f32(v1[0], v1[1], hi, false); hi = __builtin_amdgcn_cvt_pk_fp8_f32(v1[2], v1[3], hi, true);
                    if (bj == 0) { w.x = (unsigned)lo; w.y = (unsigned)hi; } else { w.z = (unsigned)lo; w.w = (unsigned)hi; } }
                *(u32x4*)rowp = w; }
    }
};
__device__ __forceinline__ int fphys(int i) { return i + ((i >> 6) << 2); }
__device__ __forceinline__ int brev14(int x) { return (int)(__brev((unsigned)x) >> 18); }
__device__ __forceinline__ int brevK(int s, int K) { return (int)(__brev((unsigned)s) >> (32 - K)); }
__device__ __forceinline__ void cmul(float& ar, float& ai, float br, float bi) { const float r = ar * br - ai * bi, i = ar * bi + ai * br; ar = r; ai = i; }
__device__ __forceinline__ constexpr float tw16c(int k) { return (k & 15) == 0 ? 1.f : (k & 15) == 1 ? 0.9238795325112867f : (k & 15) == 2 ? 0.7071067811865476f : (k & 15) == 3 ? 0.3826834323650898f : (k & 15) == 4 ? 0.f :
    (k & 15) == 5 ? -0.3826834323650898f : (k & 15) == 6 ? -0.7071067811865476f : (k & 15) == 7 ? -0.9238795325112867f : (k & 15) == 8 ? -1.f : (k & 15) == 9 ? -0.9238795325112867f : (k & 15) == 10 ? -0.7071067811865476f :
    (k & 15) == 11 ? -0.3826834323650898f : (k & 15) == 12 ? 0.f : (k & 15) == 13 ? 0.3826834323650898f : (k & 15) == 14 ? 0.7071067811865476f : 0.9238795325112867f; }
__device__ __forceinline__ constexpr float tw16s(int k) { return tw16c(k + 12); }

template <int LOGN, int K, bool INV>
__device__ __forceinline__ void fft_pass(LAS f32x2* z, int tid) {
    constexpr int R = 1 << K, LOGST = LOGN - K, ST = 1 << LOGST;
#pragma unroll 1
    for (int g = tid; g < FFT_M / R; g += NTHREADS) {
        const int b = g >> LOGST, j = g & (ST - 1), base = (b << LOGN) + j;
        float xr[R], xi[R];
#pragma unroll
        for (int q = 0; q < R; ++q) { const f32x2 v = z[fphys(base + (q << LOGST))]; xr[q] = v[0]; xi[q] = v[1]; }
        float wr_[R], wi_[R];
        if (LOGST > 0) {
            const float fr = (float)j * (1.0f / (float)(1 << LOGN));
            wr_[0] = 1.f; wi_[0] = 0.f;
#pragma unroll
            for (int bit = 1; bit < R; bit <<= 1) { const float a = fr * (float)bit; wr_[bit] = __builtin_amdgcn_cosf(a); wi_[bit] = INV ? __builtin_amdgcn_sinf(a) : -__builtin_amdgcn_sinf(a); }
#pragma unroll
            for (int r = 3; r < R; ++r) { if ((r & (r - 1)) != 0) { const int hb = 1 << (31 - __builtin_clz(r)); wr_[r] = wr_[hb]; wi_[r] = wi_[hb]; cmul(wr_[r], wi_[r], wr_[r - hb], wi_[r - hb]); } }
        }
        if (!INV) {
#pragma unroll
            for (int s = 0; s < K; ++s) { const int half = R >> (s + 1);
#pragma unroll
                for (int a = 0; a < R; ++a) if ((a & half) == 0) {
                    const int o = a & (half - 1); const int ti = o * (8 / half);
                    const float ur = xr[a], ui = xi[a], vr = xr[a + half], vi = xi[a + half];
                    xr[a] = ur + vr; xi[a] = ui + vi;
                    float dr = ur - vr, di = ui - vi;
                    if (half >= 1 && o != 0) cmul(dr, di, tw16c(ti), -tw16s(ti));
                    xr[a + half] = dr; xi[a + half] = di; } }
            if (LOGST > 0) {
#pragma unroll
                for (int s = 1; s < R; ++s) { const int r = brevK(s, K); cmul(xr[s], xi[s], wr_[r], wi_[r]); } }
        } else {
            if (LOGST > 0) {
#pragma unroll
                for (int s = 1; s < R; ++s) { const int r = brevK(s, K); cmul(xr[s], xi[s], wr_[r], wi_[r]); } }
#pragma unroll
            for (int s = K - 1; s >= 0; --s) { const int half = R >> (s + 1);
#pragma unroll
                for (int a = 0; a < R; ++a) if ((a & half) == 0) {
                    const int o = a & (half - 1); const int ti = o * (8 / half);
                    const float ur = xr[a], ui = xi[a]; float vr = xr[a + half], vi = xi[a + half];
                    if (o != 0) cmul(vr, vi, tw16c(ti), tw16s(ti));
                    xr[a] = ur + vr; xi[a] = ui + vi; xr[a + half] = ur - vr; xi[a + half] = ui - vi; } }
        }
#pragma unroll
        for (int q = 0; q < R; ++q) z[fphys(base + (q << LOGST))] = (f32x2){xr[q], xi[q]};
    }
}
__device__ __forceinline__ void fft_fwd(LAS f32x2* z, int tid) {
    fft_pass<14, 4, false>(z, tid); __syncthreads();
    fft_pass<10, 4, false>(z, tid); __syncthreads();
    fft_pass<6, 4, false>(z, tid);  __syncthreads();
    fft_pass<2, 2, false>(z, tid);  __syncthreads();
}
__device__ __forceinline__ void fft_inv(LAS f32x2* z, int tid) {
    fft_pass<2, 2, true>(z, tid);  __syncthreads();
    fft_pass<6, 4, true>(z, tid);  __syncthreads();
    fft_pass<10, 4, true>(z, tid); __syncthreads();
    fft_pass<14, 4, true>(z, tid); __syncthreads();
}
__device__ __forceinline__ f32x2 hs_ld(const unsigned* Hs, int k) { const unsigned w = Hs[k]; return (f32x2){bflo(w), bfhi(w)}; }
__device__ __forceinline__ void fft_pair_mul(LAS f32x2* z, const unsigned* Hs, int tid) {
    constexpr int M = FFT_M;
#pragma unroll 1
    for (int k = tid; k <= M / 2; k += NTHREADS) {
        if (k == 0) {
            const f32x2 z0 = z[0]; const float X0 = z0[0] + z0[1], XM = z0[0] - z0[1];
            const float Y0 = X0 * hs_ld(Hs, 0)[0], YM = XM * hs_ld(Hs, M)[0];
            z[0] = (f32x2){0.5f * (Y0 + YM), 0.5f * (Y0 - YM)};
        } else {
            const int p1 = fphys(brev14(k)), p2 = fphys(brev14(M - k));
            const f32x2 zk = z[p1], zm = z[p2]; const f32x2 hk = hs_ld(Hs, k), hm = hs_ld(Hs, M - k);
            const float Er = 0.5f * (zk[0] + zm[0]), Ei = 0.5f * (zk[1] - zm[1]);
            const float Dr = 0.5f * (zk[0] - zm[0]), Di = 0.5f * (zk[1] + zm[1]);
            const float Or = Di, Oi = -Dr;
            const float a = (float)k * (1.0f / (float)(2 * M));
            const float wr = __builtin_amdgcn_cosf(a), wi = -__builtin_amdgcn_sinf(a);
            const float wOr = wr * Or - wi * Oi, wOi = wr * Oi + wi * Or;
            const float Xkr = Er + wOr, Xki = Ei + wOi;
            const float Xmr = Er - wOr, Xmi = -(Ei - wOi);
            const float Ykr = Xkr * hk[0] - Xki * hk[1], Yki = Xkr * hk[1] + Xki * hk[0];
            const float Ymr = Xmr * hm[0] - Xmi * hm[1], Ymi = Xmr * hm[1] + Xmi * hm[0];
            const float Yer = 0.5f * (Ykr + Ymr), Yei = 0.5f * (Yki - Ymi);
            const float Fr = 0.5f * (Ykr - Ymr), Fi = 0.5f * (Yki + Ymi);
            const float Yor = Fr * wr + Fi * wi, Yoi = Fi * wr - Fr * wi;
            z[p1] = (f32x2){Yer - Yoi, Yei + Yor};
            if (p2 != p1) z[p2] = (f32x2){Yer + Yoi, -Yei + Yor};
        }
    }
}
__device__ __forceinline__ void fft_unpack_store(const LAS f32x2* z, unsigned* Hs, float sc, int tid) {
    constexpr int M = FFT_M;
#pragma unroll 1
    for (int k = tid; k <= M / 2; k += NTHREADS) {
        if (k == 0) { const f32x2 z0 = z[0]; Hs[0] = cvtpk((z0[0] + z0[1]) * sc, 0.f); Hs[M] = cvtpk((z0[0] - z0[1]) * sc, 0.f); }
        else {
            const f32x2 zk = z[fphys(brev14(k))], zm = z[fphys(brev14(M - k))];
            const float Er = 0.5f * (zk[0] + zm[0]), Ei = 0.5f * (zk[1] - zm[1]);
            const float Dr = 0.5f * (zk[0] - zm[0]), Di = 0.5f * (zk[1] + zm[1]);
            const float Or = Di, Oi = -Dr;
            const float a = (float)k * (1.0f / (float)(2 * M));
            const float wr = __builtin_amdgcn_cosf(a), wi = -__builtin_amdgcn_sinf(a);
            const float wOr = wr * Or - wi * Oi, wOi = wr * Oi + wi * Or;
            Hs[k] = cvtpk((Er + wOr) * sc, (Ei + wOi) * sc);
            if (k != M - k) Hs[M - k] = cvtpk((Er - wOr) * sc, -(Ei - wOi) * sc);
        }
    }
}
__device__ __forceinline__ int crow(int r, int hi) { return (r & 3) + 8 * (r >> 2) + 4 * hi; }
__device__ __forceinline__ bf16x8 ldfrag(const LAS unsigned char* base, int pitch, int row, int kbyte) { return *(const LAS bf16x8*)(base + row * pitch + kbyte); }
constexpr int P136 = 272;

__device__ __forceinline__ float ret_log2g(const float* decay_logit, int dir, int h) { const float x = decay_logit[dir * 4 + h]; return -log1pf(expf(-x)) * 1.4426950408889634f; }

__device__ __forceinline__ void phase_f1(const Ctx& c, int j) {
    PREF P = *c.p;
    const float* w1 = P.in[13] + (size_t)j * 33 * 64; const float* b1 = P.in[14] + j * 64; const float* f1 = P.in[15] + j * 64;
    const float* w2 = P.in[16] + (size_t)j * 64 * 64; const float* b2 = P.in[17] + j * 64; const float* f2 = P.in[18] + j * 64;
    const bf16_t* w3t = (const bf16_t*)(c.ws + WS_W3T) + (size_t)j * 2048 * 64;
    bf16_t* taps = (bf16_t*)(c.ws + WS_TAPS); float* hid2c = (float*)(c.ws + WS_HID2C);
    LAS float* zs = (LAS float*)c.lds;
    LAS float* h1s = (LAS float*)(c.lds + 18432);
    LAS float* w1s = (LAS float*)(c.lds + 51712);
    LAS float* w2s = (LAS float*)(c.lds + 60160);
    LAS unsigned char* hb = c.lds + 76544;
    LAS unsigned char* as = c.lds + 94976;
    for (int u = c.bid; u < 130; u += c.G) {
        const int tid = opaque(c.tid);
        const bool isctx = u >= 128; const int L = isctx ? 256 : 16384; const int t0 = isctx ? (u - 128) * 128 : u * 128;
        for (int i = tid; i < 33 * 64; i += NTHREADS) w1s[i] = w1[i];
        for (int i = tid; i < 64 * 64; i += NTHREADS) w2s[i] = w2[i];
        {
            const int tl = tid >> 2, part = tid & 3; const float t = (float)(t0 + tl);
            if (part == 0) zs[tl * 36 + 0] = t / (float)(L - 1);
#pragma unroll
            for (int q = 0; q < 4; ++q) { const int b = part * 4 + q; const float band = 1e-4f + (float)b * ((15.0f - 1e-4f) / 15.0f);
                const float ang = (6.283185307179586f / (float)L) * t * band;
                zs[tl * 36 + 1 + b] = __cosf(ang); zs[tl * 36 + 17 + b] = -__sinf(ang); }
        }
        __syncthreads();
        {   const int tl = tid >> 2, og = (tid & 3) * 16; float a[16];
#pragma unroll
            for (int o = 0; o < 16; ++o) a[o] = b1[og + o];
#pragma unroll 1
            for (int f = 0; f < 33; ++f) { const float zv = zs[tl * 36 + f];
#pragma unroll
                for (int o = 0; o < 16; ++o) a[o] += zv * w1s[f * 64 + og + o]; }
#pragma unroll
            for (int o = 0; o < 16; ++o) h1s[tl * 65 + og + o] = __sinf(f1[og + o] * a[o]);
        }
        __syncthreads();
        {   const int tl = tid >> 2, og = (tid & 3) * 16; float a[16];
#pragma unroll
            for (int o = 0; o < 16; ++o) a[o] = b2[og + o];
#pragma unroll 1
            for (int k = 0; k < 64; ++k) { const float hv = h1s[tl * 65 + k];
#pragma unroll
                for (int o = 0; o < 16; ++o) a[o] += hv * w2s[k * 64 + og + o]; }
#pragma unroll
            for (int o = 0; o < 16; ++o) a[o] = __sinf(f2[og + o] * a[o]);
            if (isctx) {
#pragma unroll
                for (int o = 0; o < 16; ++o) hid2c[(size_t)(t0 + tl) * 64 + og + o] = a[o];
            } else {
#pragma unroll
                for (int o = 0; o < 16; o += 2) *(LAS unsigned*)(hb + tl * 144 + (og + o) * 2) = cvtpk(a[o], a[o + 1]);
            }
        }
        __syncthreads();
        if (!isctx) {
            const int lane = tid & 63, r32 = lane & 31, hi = lane >> 5, w = __builtin_amdgcn_readfirstlane(tid >> 6);
#pragma unroll 1
            for (int cc = 0; cc < 8; ++cc) {
                {   const int row = tid >> 1, hf = tid & 1; const u32x4* src = (const u32x4*)(w3t + (size_t)(cc * 256 + row) * 64 + hf * 32);
#pragma unroll
                    for (int q = 0; q < 4; ++q) *(LAS u32x4*)(as + row * 144 + hf * 64 + q * 16) = src[q]; }
                __syncthreads();
                f32x16 acc[4];
#pragma unroll
                for (int ni = 0; ni < 4; ++ni) acc[ni] = (f32x16){};
#pragma unroll
                for (int ks = 0; ks < 4; ++ks) { const bf16x8 a = ldfrag(as, 144, 32 * w + r32, ks * 32 + hi * 16);
#pragma unroll
                    for (int ni = 0; ni < 4; ++ni) { const bf16x8 b = ldfrag(hb, 144, 32 * ni + r32, ks * 32 + hi * 16); acc[ni] = __builtin_amdgcn_mfma_f32_32x32x16_bf16(a, b, acc[ni], 0, 0, 0); } }
#pragma unroll
                for (int ni = 0; ni < 4; ++ni) { const int t = t0 + 32 * ni + r32; const float tn = (float)t * (1.0f / 16383.0f);
#pragma unroll
                    for (int r = 0; r < 16; ++r) { const int fc = cc * 256 + 32 * w + crow(r, hi); const int ch = fc & 511;
                        const float delta = 3.0701134573253945f + (15.350567286626972f - 3.0701134573253945f) * ((float)ch * (1.0f / 511.0f));
                        taps[(size_t)fc * 16384 + t] = f2bf(acc[ni][r] * __expf(-tn * delta)); } }
                __syncthreads();
            }
        }
        __syncthreads();
    }
}

__device__ __forceinline__ void phase_f2(const Ctx& c) {
    const bf16_t* taps = (const bf16_t*)(c.ws + WS_TAPS); unsigned* hs = (unsigned*)(c.ws + WS_HSPEC);
    LAS f32x2* z = (LAS f32x2*)c.lds;
    for (int u = c.bid; u < 1024; u += c.G) {
        const int tid = opaque(c.tid);
        const int o = u >> 9, ch = u & 511;
        const bf16_t* hf = taps + (size_t)(o * 1024 + ch) * 16384; const bf16_t* hbk = taps + (size_t)(o * 1024 + 512 + ch) * 16384;
#pragma unroll 4
        for (int i = 0; i < 32; ++i) { const int m = tid + i * NTHREADS; f32x2 v;
            if (m < 8192) { const unsigned w = *(const unsigned*)(hf + 2 * m); v = (f32x2){bflo(w), bfhi(w)}; }
            else if (m == 8192) v = (f32x2){0.f, bf2f(hbk[16383])};
            else { const int s = 32768 - 2 * m; v = (f32x2){bf2f(hbk[s]), bf2f(hbk[s - 1])}; }
            z[fphys(m)] = v; }
        __syncthreads();
        fft_fwd(z, tid);
        fft_unpack_store(z, hs + (size_t)u * HSPEC_LD, 1.0f / (float)FFT_M, tid);
        __syncthreads();
    }
}

__device__ __forceinline__ void stage_T(const int tid, LAS unsigned char* dstT, const bf16_t* src, int ld, int ncols, const float* rowscale  ) {
    const int j = tid >> 2;
    for (int c8 = (tid & 3) * 8; c8 < ncols; c8 += 32) {
        const u32x4 v = *(const u32x4*)(src + (size_t)j * ld + c8); const unsigned w[4] = {v.x, v.y, v.z, v.w};
#pragma unroll
        for (int q = 0; q < 4; ++q) { *(LAS bf16_t*)(dstT + (c8 + 2 * q) * P136 + j * 2) = (bf16_t)(w[q] & 0xffffu); *(LAS bf16_t*)(dstT + (c8 + 2 * q + 1) * P136 + j * 2) = (bf16_t)(w[q] >> 16); }
    }
}
__device__ __forceinline__ void phase_r1(const Ctx& c, int j) {
    PREF P = *c.p; const bf16_t* proj = (const bf16_t*)(c.ws + WS_PROJ); bf16_t* upd = (bf16_t*)(c.ws + WS_UPD);
    LAS unsigned char* VT = c.lds; LAS unsigned char* KF = c.lds + 69632; LAS unsigned char* KB = c.lds + 104448;
    for (int u = c.bid; u < 130 * 4; u += c.G) {
        const int tid = opaque(c.tid), lane = tid & 63, r32 = lane & 31, hi = lane >> 5, w = __builtin_amdgcn_readfirstlane(tid >> 6);
        const int m = u >> 2, h = u & 3; const size_t row0 = (size_t)m * 128;
        const float lgf = ret_log2g(P.in[10] + j * 8, 0, h), lgb = ret_log2g(P.in[10] + j * 8, 1, h);
        stage_T(tid, VT, proj + row0 * AB_IN + 1024 + h * 256, AB_IN, 256, nullptr);
        {   const int jj = tid >> 2; const float sf = exp2f((float)(127 - jj) * lgf), sb = exp2f((float)jj * lgb);
            for (int c8 = (tid & 3) * 8; c8 < 128; c8 += 32) {
                const u32x4 v = *(const u32x4*)(proj + (row0 + jj) * AB_IN + 512 + h * 128 + c8); const unsigned wv[4] = {v.x, v.y, v.z, v.w};
#pragma unroll
                for (int q = 0; q < 4; ++q) { const float lo = bflo(wv[q]), hi_ = bfhi(wv[q]);
                    *(LAS bf16_t*)(KF + (c8 + 2 * q) * P136 + jj * 2) = f2bf(lo * sf); *(LAS bf16_t*)(KF + (c8 + 2 * q + 1) * P136 + jj * 2) = f2bf(hi_ * sf);
                    *(LAS bf16_t*)(KB + (c8 + 2 * q) * P136 + jj * 2) = f2bf(lo * sb); *(LAS bf16_t*)(KB + (c8 + 2 * q + 1) * P136 + jj * 2) = f2bf(hi_ * sb); } } }
        __syncthreads();
#pragma unroll 1
        for (int dir = 0; dir < 2; ++dir) {
            const LAS unsigned char* KX = dir ? KB : KF;
            f32x16 af[4];
#pragma unroll
            for (int n = 0; n < 4; ++n) af[n] = (f32x16){};
#pragma unroll
            for (int ks = 0; ks < 8; ++ks) { const bf16x8 a = ldfrag(VT, P136, 32 * w + r32, ks * 32 + hi * 16);
#pragma unroll
                for (int n = 0; n < 4; ++n) { const bf16x8 bf_ = ldfrag(KX, P136, 32 * n + r32, ks * 32 + hi * 16); af[n] = __builtin_amdgcn_mfma_f32_32x32x16_bf16(a, bf_, af[n], 0, 0, 0); } }
            bf16_t* of = upd + ((size_t)(m * 4 + h) * 2 + dir) * 32768;
#pragma unroll
            for (int n = 0; n < 4; ++n)
#pragma unroll
                for (int r = 0; r < 16; ++r) { const int e = 32 * w + crow(r, hi), d = 32 * n + r32; of[e * 128 + d] = f2bf(af[n][r]); }
        }
        __syncthreads();
    }
}

__device__ __forceinline__ void phase_hyprep(const Ctx& c, int j) {
    PREF P = *c.p; const bf16_t* proj = (const bf16_t*)(c.ws + WS_PROJ); bf16_t* uT = (bf16_t*)(c.ws + WS_UT);
    const float* cw = P.in[11] + (size_t)j * 3 * 1536; const float* cb = P.in[12] + (size_t)j * 1536;
    LAS float* t = (LAS float*)c.lds;
    const int tid = c.tid;
    for (int u = c.bid; u < 256 * 24; u += c.G) {
        const int tt = u / 24, ct = u % 24, t0 = tt * 64, ch0 = ct * 64;
        for (int idx = tid; idx < 66 * 8; idx += NTHREADS) { const int r = idx >> 3, c8 = (idx & 7) * 8; const int tg = t0 - 1 + r;
            u32x4 v = (u32x4){0u, 0u, 0u, 0u};
            if (tg >= 0 && tg < NX) v = *(const u32x4*)(proj + (size_t)(NC + tg) * AB_IN + 3072 + ch0 + c8);
            const unsigned wv[4] = {v.x, v.y, v.z, v.w};
#pragma unroll
            for (int q = 0; q < 4; ++q) { t[r * 65 + c8 + 2 * q] = bflo(wv[q]); t[r * 65 + c8 + 2 * q + 1] = bfhi(wv[q]); } }
        __syncthreads();
        {   const int ch = tid >> 3, t8 = (tid & 7) * 8; const int chg = ch0 + ch;
            const float w0 = cw[chg], w1 = cw[1536 + chg], w2 = cw[3072 + chg], bb = cb[chg]; float o[8];
#pragma unroll
            for (int q = 0; q < 8; ++q) o[q] = t[(t8 + q) * 65 + ch] * w0 + t[(t8 + q + 1) * 65 + ch] * w1 + t[(t8 + q + 2) * 65 + ch] * w2 + bb;
            u32x4 wv; wv.x = cvtpk(o[0], o[1]); wv.y = cvtpk(o[2], o[3]); wv.z = cvtpk(o[4], o[5]); wv.w = cvtpk(o[6], o[7]);
            *(u32x4*)(uT + (size_t)chg * NX + t0 + t8) = wv; }
        __syncthreads();
    }
}

__device__ __forceinline__ void phase_scan(const Ctx& c, int j) {
    PREF P = *c.p; const unsigned* upd = (const unsigned*)(c.ws + WS_UPD); unsigned* sp = (unsigned*)(c.ws + WS_SPREV);
    for (int idx = c.bid * NTHREADS + c.tid; idx < 4 * 2 * 16384; idx += c.G * NTHREADS) {
        const int h = idx >> 15, dir = (idx >> 14) & 1, pr = idx & 16383;
        const float g = exp2f(128.0f * ret_log2g(P.in[10] + j * 8, dir, h));
        float s0 = 0.f, s1 = 0.f;
        const size_t base = (size_t)(h * 2 + dir) * 16384 + pr, mstride = (size_t)4 * 2 * 16384;
#pragma unroll 1
        for (int it = 0; it < 130; it += 10) {
            unsigned uv[10]; int mm[10];
#pragma unroll
            for (int q = 0; q < 10; ++q) { const int s = it + q; mm[q] = (dir == 0) ? s : (s < 2 ? 1 - s : 131 - s); uv[q] = upd[base + (size_t)mm[q] * mstride]; }
#pragma unroll
            for (int q = 0; q < 10; ++q) { sp[base + (size_t)mm[q] * mstride] = cvtpk(s0, s1); s0 = g * s0 + bflo(uv[q]); s1 = g * s1 + bfhi(uv[q]); }
        }
    }
}
__device__ __forceinline__ void phase_hyconv(const Ctx& c, int j) {
    PREF P = *c.p; const unsigned* uT = (const unsigned*)(c.ws + WS_UT); unsigned* yT = (unsigned*)(c.ws + WS_YT);
    const unsigned* hs = (const unsigned*)(c.ws + WS_HSPEC); const float* skip = P.in[20] + (size_t)j * 2 * 512;
    LAS f32x2* z = (LAS f32x2*)c.lds;
    for (int ch = c.bid; ch < 512; ch += c.G) {
        const int tid = opaque(c.tid);
        const unsigned* vp = uT + (size_t)ch * (NX / 2); const unsigned* x1p = uT + (size_t)(512 + ch) * (NX / 2); const unsigned* x2p = uT + (size_t)(1024 + ch) * (NX / 2);
        const float sk0 = skip[ch], sk1 = skip[512 + ch];
#pragma unroll 4
        for (int i = 0; i < 16; ++i) { const int m = tid + i * NTHREADS; const unsigned w = vp[m]; z[fphys(m)] = (f32x2){bflo(w), bfhi(w)}; }
#pragma unroll 4
        for (int i = 16; i < 32; ++i) z[fphys(tid + i * NTHREADS)] = (f32x2){0.f, 0.f};
        __syncthreads();
        fft_fwd(z, tid); fft_pair_mul(z, hs + (size_t)ch * HSPEC_LD, tid); __syncthreads(); fft_inv(z, tid);
        f32x2* y1g = (f32x2*)(c.ws + WS_Y1) + (size_t)ch * (NX / 2);
#pragma unroll 4
        for (int i = 0; i < 16; ++i) { const int m = tid + i * NTHREADS; const f32x2 cv = z[fphys(m)]; const unsigned w = x1p[m], wv = vp[m];
            const f32x2 y = (f32x2){bflo(w) * (cv[0] + sk0 * bflo(wv)), bfhi(w) * (cv[1] + sk0 * bfhi(wv))};
            z[fphys(m)] = y; y1g[m] = y; }
#pragma unroll 4
        for (int i = 16; i < 32; ++i) z[fphys(tid + i * NTHREADS)] = (f32x2){0.f, 0.f};
        __syncthreads();
        fft_fwd(z, tid); fft_pair_mul(z, hs + (size_t)(512 + ch) * HSPEC_LD, tid); __syncthreads(); fft_inv(z, tid);
#pragma unroll 4
        for (int i = 0; i < 16; ++i) { const int m = tid + i * NTHREADS; const f32x2 cv = z[fphys(m)]; const unsigned w = x2p[m]; const f32x2 y1 = y1g[m];
            yT[(size_t)ch * (NX / 2) + m] = cvtpk(bflo(w) * (cv[0] + sk1 * y1[0]), bfhi(w) * (cv[1] + sk1 * y1[1])); }
        __syncthreads();
    }
}

__device__ __forceinline__ void phase_r3(const Ctx& c, int j) {
    PREF P = *c.p; const bf16_t* proj = (const bf16_t*)(c.ws + WS_PROJ); const bf16_t* spv = (const bf16_t*)(c.ws + WS_SPREV); bf16_t* cat = (bf16_t*)(c.ws + WS_CAT);
    LAS unsigned char* R0 = c.lds; LAS unsigned char* R1 = c.lds + 34816; LAS unsigned char* R2 = c.lds + 69632;
    for (int u = c.bid; u < 130 * 4; u += c.G) {
        const int tid = opaque(c.tid), lane = tid & 63, r32 = lane & 31, hi = lane >> 5, w = __builtin_amdgcn_readfirstlane(tid >> 6), wr2 = w >> 2, wc = w & 3;
        const int m = u >> 2, h = u & 3; const size_t row0 = (size_t)m * 128;
        const float lgf = ret_log2g(P.in[10] + j * 8, 0, h), lgb = ret_log2g(P.in[10] + j * 8, 1, h);
        {   const int jj = tid >> 2;
            for (int c8 = (tid & 3) * 8; c8 < 128; c8 += 32) {
                *(LAS u32x4*)(R0 + jj * P136 + c8 * 2) = *(const u32x4*)(proj + (row0 + jj) * AB_IN + h * 128 + c8);
                *(LAS u32x4*)(R1 + jj * P136 + c8 * 2) = *(const u32x4*)(proj + (row0 + jj) * AB_IN + 512 + h * 128 + c8); } }
        stage_T(tid, R2, proj + row0 * AB_IN + 1024 + h * 256, AB_IN, 256, nullptr);
        __syncthreads();
        f32x16 s[2] = {(f32x16){}, (f32x16){}};
#pragma unroll
        for (int ks = 0; ks < 8; ++ks) { const bf16x8 b = ldfrag(R1, P136, 32 * wc + r32, ks * 32 + hi * 16);
#pragma unroll
            for (int mi = 0; mi < 2; ++mi) { const bf16x8 a = ldfrag(R0, P136, 64 * wr2 + 32 * mi + r32, ks * 32 + hi * 16); s[mi] = __builtin_amdgcn_mfma_f32_32x32x16_bf16(a, b, s[mi], 0, 0, 0); } }
        __syncthreads();
#pragma unroll
        for (int mi = 0; mi < 2; ++mi)
#pragma unroll
            for (int r = 0; r < 16; ++r) { const int i = 64 * wr2 + 32 * mi + crow(r, hi), jc = 32 * wc + r32, rel = i - jc;
                const float dcy = (rel > 0) ? exp2f((float)rel * lgf) : ((rel < 0) ? exp2f((float)(-rel) * lgb) : 2.0f);
                *(LAS bf16_t*)(R1 + i * P136 + jc * 2) = f2bf(s[mi][r] * dcy); }
        __syncthreads();
        f32x16 o[2][2];
#pragma unroll
        for (int mi = 0; mi < 2; ++mi)
#pragma unroll
            for (int ni = 0; ni < 2; ++ni) o[mi][ni] = (f32x16){};
#pragma unroll
        for (int ks = 0; ks < 8; ++ks) { bf16x8 a[2], b[2];
#pragma unroll
            for (int q = 0; q < 2; ++q) { a[q] = ldfrag(R1, P136, 64 * wr2 + 32 * q + r32, ks * 32 + hi * 16); b[q] = ldfrag(R2, P136, 64 * wc + 32 * q + r32, ks * 32 + hi * 16); }
#pragma unroll
            for (int mi = 0; mi < 2; ++mi)
#pragma unroll
                for (int ni = 0; ni < 2; ++ni) o[mi][ni] = __builtin_amdgcn_mfma_f32_32x32x16_bf16(a[mi], b[ni], o[mi][ni], 0, 0, 0); }
        __syncthreads();
#pragma unroll 1
        for (int dir = 0; dir < 2; ++dir) {
            {   const int jj = tid >> 2; const float qd = (dir == 0) ? exp2f((float)(jj + 1) * lgf) : exp2f((float)(128 - jj) * lgb);
                for (int c8 = (tid & 3) * 8; c8 < 128; c8 += 32) { const u32x4 v = *(const LAS u32x4*)(R0 + jj * P136 + c8 * 2); u32x4 wv;
                    wv.x = cvtpk(bflo(v.x) * qd, bfhi(v.x) * qd); wv.y = cvtpk(bflo(v.y) * qd, bfhi(v.y) * qd); wv.z = cvtpk(bflo(v.z) * qd, bfhi(v.z) * qd); wv.w = cvtpk(bflo(v.w) * qd, bfhi(v.w) * qd);
                    *(LAS u32x4*)(R1 + jj * P136 + c8 * 2) = wv; } }
            {   const bf16_t* sp = spv + ((size_t)(m * 4 + h) * 2 + dir) * 32768;
                for (int idx = tid; idx < 256 * 16; idx += NTHREADS) { const int e = idx >> 4, c8 = (idx & 15) * 8; *(LAS u32x4*)(R2 + e * P136 + c8 * 2) = *(const u32x4*)(sp + e * 128 + c8); } }
            __syncthreads();
#pragma unroll
            for (int ks = 0; ks < 8; ++ks) { bf16x8 a[2], b[2];
#pragma unroll
                for (int q = 0; q < 2; ++q) { a[q] = ldfrag(R1, P136, 64 * wr2 + 32 * q + r32, ks * 32 + hi * 16); b[q] = ldfrag(R2, P136, 64 * wc + 32 * q + r32, ks * 32 + hi * 16); }
#pragma unroll
                for (int mi = 0; mi < 2; ++mi)
#pragma unroll
                    for (int ni = 0; ni < 2; ++ni) o[mi][ni] = __builtin_amdgcn_mfma_f32_32x32x16_bf16(a[mi], b[ni], o[mi][ni], 0, 0, 0); }
            __syncthreads();
        }
        for (int idx = tid; idx < 128 * 32; idx += NTHREADS) { const int i = idx >> 5, c8 = (idx & 31) * 8; *(LAS u32x4*)(R2 + i * 528 + c8 * 2) = *(const u32x4*)(proj + (row0 + i) * AB_IN + 2048 + h * 256 + c8); }
        LAS float* st = (LAS float*)R0;
#pragma unroll
        for (int mi = 0; mi < 2; ++mi)
#pragma unroll
            for (int r = 0; r < 16; ++r) { float sm = o[mi][0][r] + o[mi][1][r], sq = o[mi][0][r] * o[mi][0][r] + o[mi][1][r] * o[mi][1][r];
#pragma unroll
                for (int off = 16; off >= 1; off >>= 1) { sm += __shfl_xor(sm, off); sq += __shfl_xor(sq, off); }
                if (r32 == 0) { const int i = 64 * wr2 + 32 * mi + crow(r, hi); st[(i * 4 + wc) * 2 + 0] = sm; st[(i * 4 + wc) * 2 + 1] = sq; } }
        __syncthreads();
#pragma unroll
        for (int mi = 0; mi < 2; ++mi)
#pragma unroll
            for (int r = 0; r < 16; ++r) { const int i = 64 * wr2 + 32 * mi + crow(r, hi); float sm = 0.f, sq = 0.f;
#pragma unroll
                for (int q = 0; q < 4; ++q) { sm += st[(i * 4 + q) * 2 + 0]; sq += st[(i * 4 + q) * 2 + 1]; }
                const float mu = sm * (1.0f / 256.f), var = fmaxf(sq * (1.0f / 256.f) - mu * mu, 0.f), rstd = rsqrtf(var + EPS);
#pragma unroll
                for (int ni = 0; ni < 2; ++ni) { const int e = 64 * wc + 32 * ni + r32; LAS bf16_t* pg = (LAS bf16_t*)(R2 + i * 528 + e * 2); const float g = bf2f(*pg);
                    *pg = f2bf((o[mi][ni][r] - mu) * rstd * siluf(g)); } }
        __syncthreads();
        for (int idx = tid; idx < 128 * 32; idx += NTHREADS) { const int i = idx >> 5, c8 = (idx & 31) * 8; *(u32x4*)(cat + (row0 + i) * AB_CAT + h * 256 + c8) = *(const LAS u32x4*)(R2 + i * 528 + c8 * 2); }
        __syncthreads();
    }
}

__device__ __forceinline__ void phase_hytrans(const Ctx& c) {
    const bf16_t* yT = (const bf16_t*)(c.ws + WS_YT); bf16_t* cat = (bf16_t*)(c.ws + WS_CAT);
    LAS bf16_t* t = (LAS bf16_t*)c.lds;
    const int tid = c.tid;
    if (c.bid < 8) return;
    for (int u = c.bid - 8; u < 256 * 8; u += c.G - 8) {
        const int t0 = (u >> 3) * 64, ch0 = (u & 7) * 64;
        {   const int ch = tid >> 3, t8 = (tid & 7) * 8; const u32x4 v = *(const u32x4*)(yT + (size_t)(ch0 + ch) * NX + t0 + t8); const unsigned wv[4] = {v.x, v.y, v.z, v.w};
#pragma unroll
            for (int q = 0; q < 4; ++q) { t[ch * 66 + t8 + 2 * q] = (bf16_t)(wv[q] & 0xffffu); t[ch * 66 + t8 + 2 * q + 1] = (bf16_t)(wv[q] >> 16); } }
        __syncthreads();
        {   const int tt = tid >> 3, c8 = (tid & 7) * 8; unsigned short e[8];
#pragma unroll
            for (int q = 0; q < 8; ++q) e[q] = t[(c8 + q) * 66 + tt];
            u32x4 wv; wv.x = e[0] | ((unsigned)e[1] << 16); wv.y = e[2] | ((unsigned)e[3] << 16); wv.z = e[4] | ((unsigned)e[5] << 16); wv.w = e[6] | ((unsigned)e[7] << 16);
            *(u32x4*)(cat + (size_t)(NC + t0 + tt) * AB_CAT + 1024 + ch0 + c8) = wv; }
        __syncthreads();
    }
}

__device__ __forceinline__ void phase_hyctx(const Ctx& c, int j) {
    PREF P = *c.p; const bf16_t* proj = (const bf16_t*)(c.ws + WS_PROJ); bf16_t* cat = (bf16_t*)(c.ws + WS_CAT);
    const float* hid2c = (const float*)(c.ws + WS_HID2C); const float* w3 = P.in[19] + (size_t)j * 64 * 2048;
    const float* cw = P.in[11] + (size_t)j * 3 * 1536; const float* cb = P.in[12] + (size_t)j * 1536; const float* skip = P.in[20] + (size_t)j * 2 * 512;
    LAS float* raw = (LAS float*)c.lds;
    LAS float* ser = raw + 3 * 258 * 8;
    LAS float* flt = ser + 3 * 256 * 8;
    LAS float* yy = flt + 4 * 256 * 8;
    LAS float* w3s = yy + 256 * 8;
    const int tid = c.tid;
    if (c.bid < 8) return;
    for (int u = c.bid - 8; u < 64; u += c.G - 8) {
        const int ch0 = u * 8;
        for (int idx = tid; idx < 3 * 258; idx += NTHREADS) { const int s = idx / 258, r = idx % 258, t = r - 1; u32x4 v = (u32x4){0u, 0u, 0u, 0u};
            if (t >= 0 && t < 256) v = *(const u32x4*)(proj + (size_t)t * AB_IN + 3072 + s * 512 + ch0);
            LAS float* d = raw + (size_t)idx * 8; d[0] = bflo(v.x); d[1] = bfhi(v.x); d[2] = bflo(v.y); d[3] = bfhi(v.y); d[4] = bflo(v.z); d[5] = bfhi(v.z); d[6] = bflo(v.w); d[7] = bfhi(v.w); }
        for (int idx = tid; idx < 64 * 4 * 2; idx += NTHREADS) { const int k = idx >> 3, f = (idx >> 1) & 3, hh = idx & 1; *(LAS f32x4*)(w3s + (k * 4 + f) * 8 + hh * 4) = *(const f32x4*)(w3 + (size_t)k * 2048 + f * 512 + ch0 + hh * 4); }
        __syncthreads();
        {
            const int t = tid & 255, fh = tid >> 8; const float tn = (float)t * (1.0f / 255.0f);
            float a[2][8];
#pragma unroll
            for (int q = 0; q < 16; ++q) a[q >> 3][q & 7] = 0.f;
#pragma unroll 4
            for (int k = 0; k < 64; ++k) { const float hv = hid2c[t * 64 + k];
#pragma unroll
                for (int f2 = 0; f2 < 2; ++f2) { const f32x4 w0 = *(const LAS f32x4*)(w3s + (k * 4 + 2 * fh + f2) * 8), w1 = *(const LAS f32x4*)(w3s + (k * 4 + 2 * fh + f2) * 8 + 4);
#pragma unroll
                    for (int e = 0; e < 4; ++e) { a[f2][e] += hv * w0[e]; a[f2][4 + e] += hv * w1[e]; } } }
#pragma unroll
            for (int f2 = 0; f2 < 2; ++f2)
#pragma unroll
                for (int e = 0; e < 8; ++e) { const float delta = 3.0701134573253945f + (15.350567286626972f - 3.0701134573253945f) * ((float)(ch0 + e) * (1.0f / 511.0f));
                    flt[((2 * fh + f2) * 256 + t) * 8 + e] = a[f2][e] * __expf(-tn * delta); } }
        for (int idx = tid; idx < 3 * 256 * 8; idx += NTHREADS) { const int e = idx & 7, t = (idx >> 3) & 255, s = idx >> 11, cg = s * 512 + ch0 + e;
            ser[idx] = raw[(s * 258 + t) * 8 + e] * cw[cg] + raw[(s * 258 + t + 1) * 8 + e] * cw[1536 + cg] + raw[(s * 258 + t + 2) * 8 + e] * cw[3072 + cg] + cb[cg]; }
        __syncthreads();
        {   const int t = tid & 255, e0 = (tid >> 8) * 4; f32x4 a = (f32x4){0.f, 0.f, 0.f, 0.f};
            for (int s = 0; s <= t; ++s) a += *(const LAS f32x4*)(flt + (0 * 256 + (t - s)) * 8 + e0) * *(const LAS f32x4*)(ser + s * 8 + e0);
            for (int s = t + 1; s < 256; ++s) a += *(const LAS f32x4*)(flt + (1 * 256 + (s - t)) * 8 + e0) * *(const LAS f32x4*)(ser + s * 8 + e0);
            const f32x4 vv = *(const LAS f32x4*)(ser + t * 8 + e0), x1 = *(const LAS f32x4*)(ser + (256 + t) * 8 + e0), sk = *(const f32x4*)(skip + ch0 + e0);
            *(LAS f32x4*)(yy + t * 8 + e0) = x1 * (a + sk * vv); }
        __syncthreads();
        {   const int t = tid & 255, e0 = (tid >> 8) * 4; f32x4 a = (f32x4){0.f, 0.f, 0.f, 0.f};
            for (int s = 0; s <= t; ++s) a += *(const LAS f32x4*)(flt + (2 * 256 + (t - s)) * 8 + e0) * *(const LAS f32x4*)(yy + s * 8 + e0);
            for (int s = t + 1; s < 256; ++s) a += *(const LAS f32x4*)(flt + (3 * 256 + (s - t)) * 8 + e0) * *(const LAS f32x4*)(yy + s * 8 + e0);
            const f32x4 y1 = *(const LAS f32x4*)(yy + t * 8 + e0), x2 = *(const LAS f32x4*)(ser + (512 + t) * 8 + e0), sk = *(const f32x4*)(skip + 512 + ch0 + e0);
            const f32x4 o = x2 * (a + sk * y1); u32x2 wv; wv.x = cvtpk(o[0], o[1]); wv.y = cvtpk(o[2], o[3]);
            *(u32x2*)(cat + (size_t)t * AB_CAT + 1024 + ch0 + e0) = wv; }
        __syncthreads();
    }
}
namespace da2 {
constexpr int KSLOT = 16384, VSLOT = 16384, NSLOT = 3;
constexpr int LDS_K = 0, LDS_V = NSLOT * KSLOT, LDS_WS = LDS_V + NSLOT * VSLOT;
#define D2_SBAR() __builtin_amdgcn_sched_barrier(0)
#define D2_WAIT_BAR(N) asm volatile("s_waitcnt vmcnt(" #N ") lgkmcnt(0)\n\ts_barrier" ::: "memory")
typedef short v4i16_t __attribute__((ext_vector_type(4)));
typedef LAS const char* lcp;
__device__ __forceinline__ void glds16(const void* gsrc, unsigned lds_dst) { unsigned keep;
    asm volatile("s_mov_b32 %0, m0\n\ts_mov_b32 m0, %2\n\ts_nop 0\n\tglobal_load_lds_dwordx4 %1, off\n\ts_mov_b32 m0, %0" : "=&s"(keep) : "v"(gsrc), "s"(lds_dst) : "memory"); }
__device__ __forceinline__ unsigned cvtpk_s(float lo, float hi) { f32x2 v = {lo, hi}; bf16x2_t b = __builtin_convertvector(v, bf16x2_t); return __builtin_bit_cast(unsigned, b); }
__device__ __forceinline__ s16x4 vtr(lcp p) { return __builtin_bit_cast(s16x4, __builtin_amdgcn_ds_read_tr16_b64_v4i16((LAS v4i16_t*)p)); }
__device__ __forceinline__ void kload8(bf16x8* kf, lcp kp) {
    kf[0] = *(const LAS bf16x8*)(kp);        kf[1] = *(const LAS bf16x8*)(kp + 512);
    kf[2] = *(const LAS bf16x8*)(kp + 2048); kf[3] = *(const LAS bf16x8*)(kp + 2560);
    kf[4] = *(const LAS bf16x8*)(kp + 4096); kf[5] = *(const LAS bf16x8*)(kp + 4608);
    kf[6] = *(const LAS bf16x8*)(kp + 6144); kf[7] = *(const LAS bf16x8*)(kp + 6656); }

__device__ __forceinline__ bool attn_unit_dma(LAS char* lds, const bf16_t* proj, bf16_t* cat, int h, int qrow0, int nkeys, float lam, float oscale, const float* subln) {
    constexpr int LD = DA_IN;
    const int tid = opaque((int)threadIdx.x), wid = __builtin_amdgcn_readfirstlane(tid >> 6), lane = tid & 63, r32 = lane & 31, hi = lane >> 5, comp = wid >> 2, qw = wid & 3;
    const unsigned lds0 = (unsigned)(uintptr_t)lds;
    LAS float* wsf = (LAS float*)(lds + LDS_WS) + wid * 64;
    const bf16_t* Kh = proj + 1024 + h * 128; const bf16_t* Vh = proj + 2048 + h * 128;
    const bf16_t* ksrc0 = Kh + (size_t)lane * LD + wid * 8; const bf16_t* ksrc1 = ksrc0 + 64;
    const bf16_t* vsrc0 = Vh + (size_t)(16 * (wid & 3) + (lane >> 2)) * LD + (wid >> 2) * 32 + (lane & 3) * 8; const bf16_t* vsrc1 = vsrc0 + 64;
    const unsigned kdst = lds0 + LDS_K + wid * 1024, vdst = lds0 + LDS_V + wid * 1024;
#define D2_DMA_K(t, slot) do { glds16(ksrc0 + (size_t)(t) * 64 * LD, (unsigned)__builtin_amdgcn_readfirstlane(kdst + (slot))); glds16(ksrc1 + (size_t)(t) * 64 * LD, (unsigned)__builtin_amdgcn_readfirstlane(kdst + (slot) + 8192)); } while (0)
#define D2_DMA_V(t, slot) do { glds16(vsrc0 + (size_t)(t) * 64 * LD, (unsigned)__builtin_amdgcn_readfirstlane(vdst + (slot))); glds16(vsrc1 + (size_t)(t) * 64 * LD, (unsigned)__builtin_amdgcn_readfirstlane(vdst + (slot) + 8192)); } while (0)
    const lcp shm3 = (lcp)lds;
    const lcp kp0 = shm3 + LDS_K + comp * 8192 + hi * 1024 + r32 * 16;
    const lcp vp0 = shm3 + LDS_V + ((lane >> 4) & 1) * 32 + (lane & 3) * 8 + (4 * hi + ((lane & 15) >> 2)) * 64;
    const int NT = nkeys / 64;
    D2_DMA_K(0, 0); D2_DMA_V(0, 0); D2_DMA_K(1, KSLOT);
    bf16x8 qr[4];
    { const bf16_t* Qw = proj + (size_t)(qrow0 + qw * 32 + r32) * LD + h * 128 + comp * 64 + hi * 8;
#pragma unroll
      for (int d0 = 0; d0 < 4; ++d0) qr[d0] = *reinterpret_cast<const bf16x8*>(Qw + d0 * 16); }
    float l_reg = 0.f; f32x16 o[4]; o[0] = f32x16{}; o[1] = f32x16{}; o[2] = f32x16{}; o[3] = f32x16{};
    f32x16 pA0, pA1, pB0, pB1; bf16x8 kf[8];
    int sl_prev = 0, sl_cur = 0, sl_next = KSLOT;
#define D2_ROT() do { sl_prev = sl_cur; sl_cur = sl_next; sl_next = (sl_next == (NSLOT - 1) * KSLOT) ? 0 : sl_next + KSLOT; } while (0)
    D2_DMA_K(2, 2 * KSLOT);
    D2_WAIT_BAR(6);
    { const lcp kb = kp0;
      pA0 = f32x16{}; pA1 = f32x16{};
#pragma unroll
      for (int d0 = 0; d0 < 4; ++d0) { const bf16x8 b0 = *(const LAS bf16x8*)(kb + d0 * 2048), b1 = *(const LAS bf16x8*)(kb + d0 * 2048 + 512);
          pA0 = __builtin_amdgcn_mfma_f32_32x32x16_bf16(b0, qr[d0], pA0, 0, 0, 0); pA1 = __builtin_amdgcn_mfma_f32_32x32x16_bf16(b1, qr[d0], pA1, 0, 0, 0); }
#pragma unroll
      for (int r = 0; r < 16; ++r) { pA0[r] = __builtin_amdgcn_exp2f(pA0[r]); pA1[r] = __builtin_amdgcn_exp2f(pA1[r]); } }
    D2_WAIT_BAR(0);
    D2_DMA_K(3, 0); D2_DMA_V(1, VSLOT);
    D2_ROT();
    kload8(kf, kp0 + sl_cur);
    D2_WAIT_BAR(4);
    s16x4 vlo[8], vhi[8]; u32x4 pw0, pw1, pw2, pw3;
#define D2_PKW(P, B) cvtpk_s(P[B], P[B + 1])
#define D2_PAF(k) __builtin_bit_cast(bf16x8, pw##k)
#define D2_VFR(s) (bf16x8){vlo[s][0], vlo[s][1], vlo[s][2], vlo[s][3], vhi[s][0], vhi[s][1], vhi[s][2], vhi[s][3]}
#define D2_PIN(x) asm volatile("" : "+v"(x))
#define D2_VRD(s, i) do { vlo[s] = vtr(vp_ + (((i) >> 2) * 4096 + ((i) & 3) * 1024)); vhi[s] = vtr(vp_ + (((i) >> 2) * 4096 + ((i) & 3) * 1024 + 512)); } while (0)
#define D2_GAPA(MF, A0, A1, A2, A3, W0, W1, PW) do { MF; sacc += A0; sacc += A1; sacc += A2; sacc += A3; D2_PIN(sacc); W0; W1; D2_PIN(PW); D2_SBAR(); } while (0)
#define D2_EX(v) __builtin_amdgcn_exp2f(v)
#define D2_GAPB(MF, X, B) do { MF; X[B] = D2_EX(X[B]); X[B + 1] = D2_EX(X[B + 1]); D2_PIN(X); D2_SBAR(); } while (0)
#define D2_KRD(G, j) do { if (G) { kf[j] = *(const LAS bf16x8*)(kp0 + sl_next + ((j) >> 1) * 2048 + ((j) & 1) * 512); D2_SBAR(); } } while (0)
#define D2_ORD(j) ((((j) & 3) << 2) | ((j) >> 2))
#define D2_STEP(C0, C1, P0, P1, t, GK, GV, GL) do { D2_SBAR(); \
    const lcp vp_ = vp0 + sl_prev; \
    D2_VRD(0, D2_ORD(0)); D2_SBAR(); float sacc = (P0[0] + P0[1]); \
    D2_GAPA(C0 = __builtin_amdgcn_mfma_f32_32x32x16_bf16(kf[0], qr[0], f32x16{}, 0, 0, 0), P0[2], P0[3], P0[4], P0[5],     pw0[0] = D2_PKW(P0, 0), pw0[1] = D2_PKW(P0, 2), pw0); \
    D2_VRD(1, D2_ORD(1)); D2_SBAR(); D2_GAPA(C1 = __builtin_amdgcn_mfma_f32_32x32x16_bf16(kf[1], qr[0], f32x16{}, 0, 0, 0), P0[6], P0[7], P0[8], P0[9],     pw0[2] = D2_PKW(P0, 4), pw0[3] = D2_PKW(P0, 6), pw0); \
    D2_VRD(2, D2_ORD(2)); D2_SBAR(); D2_GAPA(C0 = __builtin_amdgcn_mfma_f32_32x32x16_bf16(kf[2], qr[1], C0, 0, 0, 0),       P0[10], P0[11], P0[12], P0[13], pw1[0] = D2_PKW(P0, 8), pw1[1] = D2_PKW(P0, 10), pw1); \
    D2_VRD(3, D2_ORD(3)); D2_SBAR(); D2_GAPA(C1 = __builtin_amdgcn_mfma_f32_32x32x16_bf16(kf[3], qr[1], C1, 0, 0, 0),       P0[14], P0[15], P1[0], P1[1],   pw1[2] = D2_PKW(P0, 12), pw1[3] = D2_PKW(P0, 14), pw1); \
    D2_VRD(4, D2_ORD(4)); D2_SBAR(); D2_GAPA(C0 = __builtin_amdgcn_mfma_f32_32x32x16_bf16(kf[4], qr[2], C0, 0, 0, 0),       P1[2], P1[3], P1[4], P1[5],     pw2[0] = D2_PKW(P1, 0), pw2[1] = D2_PKW(P1, 2), pw2); \
    D2_VRD(5, D2_ORD(5)); D2_SBAR(); D2_GAPA(C1 = __builtin_amdgcn_mfma_f32_32x32x16_bf16(kf[5], qr[2], C1, 0, 0, 0),       P1[6], P1[7], P1[8], P1[9],     pw2[2] = D2_PKW(P1, 4), pw2[3] = D2_PKW(P1, 6), pw2); \
    D2_VRD(6, D2_ORD(6)); D2_SBAR(); D2_GAPA(C0 = __builtin_amdgcn_mfma_f32_32x32x16_bf16(kf[6], qr[3], C0, 0, 0, 0),       P1[10], P1[11], P1[12], P1[13], pw3[0] = D2_PKW(P1, 8), pw3[1] = D2_PKW(P1, 10), pw3); \
    D2_VRD(7, D2_ORD(7)); D2_SBAR(); D2_GAPA(C1 = __builtin_amdgcn_mfma_f32_32x32x16_bf16(kf[7], qr[3], C1, 0, 0, 0),       P1[14], P1[15], 0.f, 0.f,       pw3[2] = D2_PKW(P1, 12), pw3[3] = D2_PKW(P1, 14), pw3); \
    l_reg += sacc; \
    if (GK) { D2_DMA_K((t) + 3, sl_cur); } if (GV) { D2_DMA_V((t) + 1, sl_next); } \
    D2_SBAR(); \
    D2_GAPB(o[0] = __builtin_amdgcn_mfma_f32_32x32x16_bf16(D2_PAF(0), D2_VFR(0), o[0], 0, 0, 0), C0, 0);  D2_VRD(0, D2_ORD(8));  D2_SBAR(); \
    D2_GAPB(o[1] = __builtin_amdgcn_mfma_f32_32x32x16_bf16(D2_PAF(0), D2_VFR(1), o[1], 0, 0, 0), C0, 2);  D2_VRD(1, D2_ORD(9));  D2_SBAR(); \
    D2_GAPB(o[2] = __builtin_amdgcn_mfma_f32_32x32x16_bf16(D2_PAF(0), D2_VFR(2), o[2], 0, 0, 0), C0, 4);  D2_VRD(2, D2_ORD(10)); D2_SBAR(); \
    D2_GAPB(o[3] = __builtin_amdgcn_mfma_f32_32x32x16_bf16(D2_PAF(0), D2_VFR(3), o[3], 0, 0, 0), C0, 6);  D2_VRD(3, D2_ORD(11)); D2_SBAR(); \
    D2_KRD(GL, 0); D2_GAPB(o[0] = __builtin_amdgcn_mfma_f32_32x32x16_bf16(D2_PAF(1), D2_VFR(4), o[0], 0, 0, 0), C0, 8);  D2_VRD(4, D2_ORD(12)); D2_SBAR(); \
    D2_KRD(GL, 1); D2_GAPB(o[1] = __builtin_amdgcn_mfma_f32_32x32x16_bf16(D2_PAF(1), D2_VFR(5), o[1], 0, 0, 0), C0, 10); D2_VRD(5, D2_ORD(13)); D2_SBAR(); \
    D2_KRD(GL, 2); D2_GAPB(o[2] = __builtin_amdgcn_mfma_f32_32x32x16_bf16(D2_PAF(1), D2_VFR(6), o[2], 0, 0, 0), C0, 12); D2_VRD(6, D2_ORD(14)); D2_SBAR(); \
    D2_KRD(GL, 3); D2_GAPB(o[3] = __builtin_amdgcn_mfma_f32_32x32x16_bf16(D2_PAF(1), D2_VFR(7), o[3], 0, 0, 0), C0, 14); D2_VRD(7, D2_ORD(15)); D2_SBAR(); \
    D2_KRD(GL, 4); D2_GAPB(o[0] = __builtin_amdgcn_mfma_f32_32x32x16_bf16(D2_PAF(2), D2_VFR(0), o[0], 0, 0, 0), C1, 0); \
    D2_KRD(GL, 5); D2_GAPB(o[1] = __builtin_amdgcn_mfma_f32_32x32x16_bf16(D2_PAF(2), D2_VFR(1), o[1], 0, 0, 0), C1, 2); \
    D2_KRD(GL, 6); D2_GAPB(o[2] = __builtin_amdgcn_mfma_f32_32x32x16_bf16(D2_PAF(2), D2_VFR(2), o[2], 0, 0, 0), C1, 4); \
    D2_KRD(GL, 7); D2_GAPB(o[3] = __builtin_amdgcn_mfma_f32_32x32x16_bf16(D2_PAF(2), D2_VFR(3), o[3], 0, 0, 0), C1, 6); \
    D2_GAPB(o[0] = __builtin_amdgcn_mfma_f32_32x32x16_bf16(D2_PAF(3), D2_VFR(4), o[0], 0, 0, 0), C1, 8); \
    D2_GAPB(o[1] = __builtin_amdgcn_mfma_f32_32x32x16_bf16(D2_PAF(3), D2_VFR(5), o[1], 0, 0, 0), C1, 10); \
    D2_GAPB(o[2] = __builtin_amdgcn_mfma_f32_32x32x16_bf16(D2_PAF(3), D2_VFR(6), o[2], 0, 0, 0), C1, 12); \
    D2_GAPB(o[3] = __builtin_amdgcn_mfma_f32_32x32x16_bf16(D2_PAF(3), D2_VFR(7), o[3], 0, 0, 0), C1, 14); \
    } while (0)
    int t = 1;
    for (; t + 5 < NT; t += 2) {
        D2_STEP(pB0, pB1, pA0, pA1, t, true, true, true);     D2_WAIT_BAR(4); D2_ROT();
        D2_STEP(pA0, pA1, pB0, pB1, t + 1, true, true, true); D2_WAIT_BAR(4); D2_ROT();
    }
#define D2_ENDW(tt) do { if ((tt) + 3 < NT) { D2_WAIT_BAR(4); } else if ((tt) + 2 < NT) { D2_WAIT_BAR(2); } else { D2_WAIT_BAR(0); } } while (0)
    for (; t + 1 < NT; t += 2) {
        D2_STEP(pB0, pB1, pA0, pA1, t, (t + 3 < NT), (t + 1 < NT), (t + 1 < NT));         D2_ENDW(t);     D2_ROT();
        D2_STEP(pA0, pA1, pB0, pB1, t + 1, (t + 4 < NT), (t + 2 < NT), (t + 2 < NT));     D2_ENDW(t + 1); D2_ROT();
    }
    D2_STEP(pB0, pB1, pA0, pA1, NT - 1, false, false, false);
    { float sacc = pB0[0] + pB0[1];
#pragma unroll
      for (int r = 2; r < 16; ++r) sacc += pB0[r];
#pragma unroll
      for (int r = 0; r < 16; ++r) sacc += pB1[r];
      l_reg += sacc;
      pw0 = (u32x4){D2_PKW(pB0, 0), D2_PKW(pB0, 2), D2_PKW(pB0, 4), D2_PKW(pB0, 6)}; pw1 = (u32x4){D2_PKW(pB0, 8), D2_PKW(pB0, 10), D2_PKW(pB0, 12), D2_PKW(pB0, 14)};
      pw2 = (u32x4){D2_PKW(pB1, 0), D2_PKW(pB1, 2), D2_PKW(pB1, 4), D2_PKW(pB1, 6)}; pw3 = (u32x4){D2_PKW(pB1, 8), D2_PKW(pB1, 10), D2_PKW(pB1, 12), D2_PKW(pB1, 14)};
      D2_SBAR();
      const lcp vp_ = vp0 + sl_cur;
#pragma unroll
      for (int d0 = 0; d0 < 4; ++d0) {
#pragma unroll
          for (int ks = 0; ks < 4; ++ks) { vlo[ks] = vtr(vp_ + (d0 * 4096 + ks * 1024)); vhi[ks] = vtr(vp_ + (d0 * 4096 + ks * 1024 + 512)); }
          o[d0] = __builtin_amdgcn_mfma_f32_32x32x16_bf16(D2_PAF(0), D2_VFR(0), o[d0], 0, 0, 0); o[d0] = __builtin_amdgcn_mfma_f32_32x32x16_bf16(D2_PAF(1), D2_VFR(1), o[d0], 0, 0, 0);
          o[d0] = __builtin_amdgcn_mfma_f32_32x32x16_bf16(D2_PAF(2), D2_VFR(2), o[d0], 0, 0, 0); o[d0] = __builtin_amdgcn_mfma_f32_32x32x16_bf16(D2_PAF(3), D2_VFR(3), o[d0], 0, 0, 0); } }
    { auto rr = __builtin_amdgcn_permlane32_swap(__float_as_uint(l_reg), __float_as_uint(l_reg), false, false); l_reg = __uint_as_float(rr[0]) + __uint_as_float(rr[1]); }
    if (hi == 0) wsf[32 + r32] = l_reg; asm volatile("s_waitcnt lgkmcnt(0)" ::: "memory");
    {
#pragma unroll
      for (int r = 0; r < 16; ++r) { const float rl = __builtin_amdgcn_rcpf(wsf[32 + crow(r, hi)]);
#pragma unroll
          for (int d0 = 0; d0 < 4; ++d0) o[d0][r] *= rl; } }
    const int bad = (l_reg > 1.0e-30f && l_reg < 1.0e30f) ? 0 : 1;
    LAS int* flg = (LAS int*)(lds + LDS_WS + 8 * 256);
    { const int anyb = (__ballot(bad) != 0ull) ? 1 : 0; if (lane == 0) flg[wid] = anyb; }
    __syncthreads();
    { int f = 0;
#pragma unroll
      for (int q = 0; q < 8; ++q) f |= flg[q];
      if (__builtin_amdgcn_readfirstlane(f)) { __syncthreads(); return false; } }
    LAS float* xb = (LAS float*)lds;
    if (comp == 1) {
#pragma unroll
        for (int d0 = 0; d0 < 4; ++d0)
#pragma unroll
            for (int r = 0; r < 16; ++r) xb[((qw * 64) + d0 * 16 + r) * 64 + lane] = o[d0][r];
    }
    __syncthreads();
    if (comp == 0) {
        float ssq[16];
#pragma unroll
        for (int r = 0; r < 16; ++r) ssq[r] = 0.f;
#pragma unroll
        for (int d0 = 0; d0 < 4; ++d0)
#pragma unroll
            for (int r = 0; r < 16; ++r) { const float x = o[d0][r] - lam * xb[((qw * 64) + d0 * 16 + r) * 64 + lane]; o[d0][r] = x; ssq[r] += x * x; }
#pragma unroll
        for (int r = 0; r < 16; ++r) {
#pragma unroll
            for (int off = 16; off >= 1; off >>= 1) ssq[r] += __shfl_xor(ssq[r], off);
            ssq[r] = rsqrtf(ssq[r] * (1.0f / 128.f) + 1e-5f) * oscale; }
        asm volatile("" ::: "memory");
        LAS char* stg = lds + qw * 16384;
#pragma unroll
        for (int d0 = 0; d0 < 4; ++d0) { const float g = subln[d0 * 32 + r32];
#pragma unroll
            for (int r = 0; r < 16; ++r) *(LAS bf16_t*)(stg + crow(r, hi) * 272 + (d0 * 32 + r32) * 2) = f2bf(o[d0][r] * ssq[r] * g); }
        asm volatile("s_waitcnt lgkmcnt(0)" ::: "memory");
        bf16_t* Ow = cat + (size_t)(qrow0 + qw * 32) * DA_W + h * 128;
#pragma unroll
        for (int q = 0; q < 8; ++q) { const int id = q * 64 + lane, row = id >> 4, c16 = id & 15; *(u32x4*)(Ow + (size_t)row * DA_W + c16 * 8) = *(const LAS u32x4*)(stg + row * 272 + c16 * 16); }
    }
    __syncthreads();
    return true;
#undef D2_DMA_K
#undef D2_DMA_V
#undef D2_ROT
#undef D2_STEP
#undef D2_ENDW
}
}
namespace da {
constexpr int KVBLK = 64;
constexpr int SHM_V = KVBLK * 128 * 2, SHM_K = KVBLK * 128 * 2;
constexpr float THR2 = 11.5f;
#define DA_KSWZ(row, colB) ((row) * 256 + ((colB) ^ (((row) & 7) << 4)))
#define DA_SBAR() __builtin_amdgcn_sched_barrier(0)
__device__ __forceinline__ unsigned cvtpk_a(float lo, float hi) { unsigned r; asm volatile("v_cvt_pk_bf16_f32 %0, %1, %2" : "=v"(r) : "v"(lo), "v"(hi)); return r; }
__device__ __forceinline__ void partialSM(f32x16& p0, f32x16& p1, float& m_reg, float& alpha) {
    float pmax = p0[0];
#pragma unroll
    for (int r = 1; r < 16; ++r) pmax = fmaxf(pmax, p0[r]);
#pragma unroll
    for (int r = 0; r < 16; ++r) pmax = fmaxf(pmax, p1[r]);
    { auto rr = __builtin_amdgcn_permlane32_swap(__float_as_uint(pmax), __float_as_uint(pmax), false, false); pmax = fmaxf(__uint_as_float(rr[0]), __uint_as_float(rr[1])); }
    float mn;
    if (__builtin_expect(__all(pmax - m_reg <= THR2), 1)) { mn = m_reg; alpha = 1.f; }
    else { mn = fmaxf(m_reg, pmax); alpha = __builtin_amdgcn_exp2f(m_reg - mn); m_reg = mn; }
#pragma unroll
    for (int r = 0; r < 16; ++r) { p0[r] -= mn; p1[r] -= mn; }
#pragma unroll
    for (int r = 0; r < 16; ++r) p0[r] = __builtin_amdgcn_exp2f(p0[r]);
}
__device__ __forceinline__ void partialSM_fast(f32x16& p0, f32x16& p1, float& l_reg) {
#pragma unroll
    for (int r = 0; r < 16; ++r) p0[r] = __builtin_amdgcn_exp2f(p0[r]);
#pragma unroll
    for (int r = 0; r < 16; ++r) p1[r] = __builtin_amdgcn_exp2f(p1[r]);
    float ps = 0;
#pragma unroll
    for (int r = 0; r < 16; ++r) ps += p0[r];
#pragma unroll
    for (int r = 0; r < 16; ++r) ps += p1[r];
    l_reg += ps;
}
__device__ __forceinline__ void finishSM_fast(f32x16& p0, f32x16& p1, bf16x8& pa0, bf16x8& pa1, bf16x8& pa2, bf16x8& pa3) {
#define DA_PK4(P, BASE, OUT) do { unsigned a0 = cvtpk_a(P[BASE + 0], P[BASE + 1]), a1 = cvtpk_a(P[BASE + 2], P[BASE + 3]);   \
    unsigned b0 = cvtpk_a(P[BASE + 4], P[BASE + 5]), b1 = cvtpk_a(P[BASE + 6], P[BASE + 7]);                              \
    auto r0 = __builtin_amdgcn_permlane32_swap(a0, b0, false, false); auto r1 = __builtin_amdgcn_permlane32_swap(a1, b1, false, false); \
    u32x4 w = {r0[0], r1[0], r0[1], r1[1]}; OUT = *reinterpret_cast<bf16x8*>(&w); } while (0)
    DA_PK4(p0, 0, pa0); DA_PK4(p0, 8, pa1); DA_PK4(p1, 0, pa2); DA_PK4(p1, 8, pa3);
#undef DA_PK4
}
__device__ __forceinline__ void finishSM(f32x16& p0, f32x16& p1, float alpha, float& l_reg, bf16x8& pa0, bf16x8& pa1, bf16x8& pa2, bf16x8& pa3) {
#pragma unroll
    for (int r = 0; r < 16; ++r) p1[r] = __builtin_amdgcn_exp2f(p1[r]);
    float ps = 0;
#pragma unroll
    for (int r = 0; r < 16; ++r) ps += p0[r];
#pragma unroll
    for (int r = 0; r < 16; ++r) ps += p1[r];
    { auto rr = __builtin_amdgcn_permlane32_swap(__float_as_uint(ps), __float_as_uint(ps), false, false); ps = __uint_as_float(rr[0]) + __uint_as_float(rr[1]); }
    l_reg = l_reg * alpha + ps;
#define DA_PK4(P, BASE, OUT) do { unsigned a0 = cvtpk_a(P[BASE + 0], P[BASE + 1]), a1 = cvtpk_a(P[BASE + 2], P[BASE + 3]);   \
    unsigned b0 = cvtpk_a(P[BASE + 4], P[BASE + 5]), b1 = cvtpk_a(P[BASE + 6], P[BASE + 7]);                              \
    auto r0 = __builtin_amdgcn_permlane32_swap(a0, b0, false, false); auto r1 = __builtin_amdgcn_permlane32_swap(a1, b1, false, false); \
    u32x4 w = {r0[0], r1[0], r0[1], r1[1]}; OUT = *reinterpret_cast<bf16x8*>(&w); } while (0)
    DA_PK4(p0, 0, pa0); DA_PK4(p0, 8, pa1); DA_PK4(p1, 0, pa2); DA_PK4(p1, 8, pa3);
#undef DA_PK4
}
__device__ __forceinline__ void qkt(f32x16& p0, f32x16& p1, const LAS char* Ks, const bf16x8* qr, int r32, int hi, int comp) {
    p0 = f32x16{}; p1 = f32x16{};
#pragma unroll
    for (int d0 = 0; d0 < 4; ++d0) { const int cb = (comp * 64 + d0 * 16 + hi * 8) * 2;
        const bf16x8 b0 = *(const LAS bf16x8*)(Ks + DA_KSWZ(r32, cb));
        const bf16x8 b1 = *(const LAS bf16x8*)(Ks + DA_KSWZ(32 + r32, cb));
        p0 = __builtin_amdgcn_mfma_f32_32x32x16_bf16(b0, qr[d0], p0, 0, 0, 0);
        p1 = __builtin_amdgcn_mfma_f32_32x32x16_bf16(b1, qr[d0], p1, 0, 0, 0); }
}
__device__ __forceinline__ int v_st(int k, int c) { const int kk = (k & ~0xC) | ((k & 4) << 1) | ((k & 8) >> 1); return ((kk >> 3) * 4 + (c >> 5)) * 512 + ((kk & 7) * 32 + (c & 31)) * 2; }
__device__ __forceinline__ int v_rd_base(int lane) { return ((lane & 3) << 3) | (((lane >> 2) & 3) << 6) | (((lane >> 4) & 1) << 5) | (((lane >> 5) & 1) << 8); }
constexpr int v_rd_off(int d0, int ks, int half) { return d0 * 512 + ks * 4096 + half * 2048; }
template <int OFF> __device__ __forceinline__ s16x4 tr_read(int vb) { s16x4 r; asm volatile("ds_read_b64_tr_b16 %0, %1 offset:%2" : "=&v"(r) : "v"(vb), "i"(OFF) : "memory"); return r; }
template <int D0> __device__ __forceinline__ void pv_one(f32x16& od, int vb, bf16x8 pa0, bf16x8 pa1, bf16x8 pa2, bf16x8 pa3) {
    const s16x4 l0 = tr_read<v_rd_off(D0, 0, 0)>(vb), h0 = tr_read<v_rd_off(D0, 0, 1)>(vb), l1 = tr_read<v_rd_off(D0, 1, 0)>(vb), h1 = tr_read<v_rd_off(D0, 1, 1)>(vb);
    const s16x4 l2 = tr_read<v_rd_off(D0, 2, 0)>(vb), h2 = tr_read<v_rd_off(D0, 2, 1)>(vb), l3 = tr_read<v_rd_off(D0, 3, 0)>(vb), h3 = tr_read<v_rd_off(D0, 3, 1)>(vb);
    asm volatile("s_waitcnt lgkmcnt(0)" ::: "memory"); DA_SBAR();
#define DA_PK(L, H) (bf16x8){L[0], L[1], L[2], L[3], H[0], H[1], H[2], H[3]}
    od = __builtin_amdgcn_mfma_f32_32x32x16_bf16(pa0, DA_PK(l0, h0), od, 0, 0, 0);
    od = __builtin_amdgcn_mfma_f32_32x32x16_bf16(pa1, DA_PK(l1, h1), od, 0, 0, 0);
    od = __builtin_amdgcn_mfma_f32_32x32x16_bf16(pa2, DA_PK(l2, h2), od, 0, 0, 0);
    od = __builtin_amdgcn_mfma_f32_32x32x16_bf16(pa3, DA_PK(l3, h3), od, 0, 0, 0);
#undef DA_PK
}
__device__ __forceinline__ void pv_d0(f32x16* o, int vb, bf16x8 pa0, bf16x8 pa1, bf16x8 pa2, bf16x8 pa3) {
    pv_one<0>(o[0], vb, pa0, pa1, pa2, pa3); pv_one<1>(o[1], vb, pa0, pa1, pa2, pa3); pv_one<2>(o[2], vb, pa0, pa1, pa2, pa3); pv_one<3>(o[3], vb, pa0, pa1, pa2, pa3);
}

#define DA_PKV(L, H) (bf16x8){L[0], L[1], L[2], L[3], H[0], H[1], H[2], H[3]}
#define DA_TRSET(D0, l0, h0, l1, h1, l2, h2, l3, h3) do { if (VAR == 3) { l0 = h0 = l1 = h1 = l2 = h2 = l3 = h3 = (s16x4){1, 2, 3, 4}; break; } l0 = tr_read<v_rd_off(D0, 0, 0)>(vb); h0 = tr_read<v_rd_off(D0, 0, 1)>(vb); l1 = tr_read<v_rd_off(D0, 1, 0)>(vb); h1 = tr_read<v_rd_off(D0, 1, 1)>(vb); \
    l2 = tr_read<v_rd_off(D0, 2, 0)>(vb); h2 = tr_read<v_rd_off(D0, 2, 1)>(vb); l3 = tr_read<v_rd_off(D0, 3, 0)>(vb); h3 = tr_read<v_rd_off(D0, 3, 1)>(vb); } while (0)
#define DA_EX2(P, I) do { if (VAR != 1) { P[I] = __builtin_amdgcn_exp2f(P[I]); P[I + 1] = __builtin_amdgcn_exp2f(P[I + 1]); } } while (0)
#define DA_MF(OD, A, B) do { if (VAR != 2) OD = __builtin_amdgcn_mfma_f32_32x32x16_bf16(A, B, OD, 0, 0, 0); else asm volatile("" :: "v"(B)); } while (0)
#define DA_BLK(OD, PA0, PA1, PA2, PA3, l0, h0, l1, h1, l2, h2, l3, h3, P, I) do { \
    DA_MF(OD, PA0, DA_PKV(l0, h0)); DA_EX2(P, I);     DA_SBAR(); \
    DA_MF(OD, PA1, DA_PKV(l1, h1)); DA_EX2(P, I + 2); DA_SBAR(); \
    DA_MF(OD, PA2, DA_PKV(l2, h2)); DA_EX2(P, I + 4); DA_SBAR(); \
    DA_MF(OD, PA3, DA_PKV(l3, h3)); DA_EX2(P, I + 6); DA_SBAR(); } while (0)
template <int VAR>
__device__ __forceinline__ void pv_fast(f32x16* o, int vb, bf16x8 pa0, bf16x8 pa1, bf16x8 pa2, bf16x8 pa3, f32x16& n0, f32x16& n1, float& l_reg) {
    s16x4 al0, ah0, al1, ah1, al2, ah2, al3, ah3, bl0, bh0, bl1, bh1, bl2, bh2, bl3, bh3;
    DA_TRSET(0, al0, ah0, al1, ah1, al2, ah2, al3, ah3);
    asm volatile("s_waitcnt lgkmcnt(0)" ::: "memory"); DA_SBAR();
    DA_TRSET(1, bl0, bh0, bl1, bh1, bl2, bh2, bl3, bh3); DA_SBAR();
    DA_BLK(o[0], pa0, pa1, pa2, pa3, al0, ah0, al1, ah1, al2, ah2, al3, ah3, n0, 0);
    asm volatile("s_waitcnt lgkmcnt(0)" ::: "memory"); DA_SBAR();
    DA_TRSET(2, al0, ah0, al1, ah1, al2, ah2, al3, ah3); DA_SBAR();
    DA_BLK(o[1], pa0, pa1, pa2, pa3, bl0, bh0, bl1, bh1, bl2, bh2, bl3, bh3, n0, 8);
    asm volatile("s_waitcnt lgkmcnt(0)" ::: "memory"); DA_SBAR();
    DA_TRSET(3, bl0, bh0, bl1, bh1, bl2, bh2, bl3, bh3); DA_SBAR();
    DA_BLK(o[2], pa0, pa1, pa2, pa3, al0, ah0, al1, ah1, al2, ah2, al3, ah3, n1, 0);
    asm volatile("s_waitcnt lgkmcnt(0)" ::: "memory"); DA_SBAR();
    DA_BLK(o[3], pa0, pa1, pa2, pa3, bl0, bh0, bl1, bh1, bl2, bh2, bl3, bh3, n1, 8);
    float ps = 0;
#pragma unroll
    for (int r = 0; r < 16; ++r) ps += n0[r];
#pragma unroll
    for (int r = 0; r < 16; ++r) ps += n1[r];
    l_reg += ps;
}
template <bool FAST, int VAR = 0>
__device__ __forceinline__ bool attn_unit(LAS char* lds, const bf16_t* proj, bf16_t* cat, int h, int qrow0, int nkeys, float lam, float oscale, const float* subln) {
    constexpr int LD = DA_IN;
    const int tid = opaque((int)threadIdx.x), wid = __builtin_amdgcn_readfirstlane(tid >> 6), lane = tid & 63, r32 = lane & 31, hi = lane >> 5, comp = wid >> 2, qw = wid & 3;
    LAS char* V_lds = lds; LAS char* K_lds = lds + 2 * SHM_V;
    LAS float* ws = (LAS float*)(lds + 2 * SHM_V + 2 * SHM_K) + wid * 64; LAS float* li_l = ws; LAS float* al_l = ws + 32;
    float m_reg = -1e30f, l_reg = 0; f32x16 o[4] = {}; bf16x8 qr[4];
    const bf16_t* Qw = proj + (size_t)(qrow0 + qw * 32 + r32) * LD + h * 128 + comp * 64 + hi * 8;
#pragma unroll
    for (int d0 = 0; d0 < 4; ++d0) qr[d0] = *reinterpret_cast<const bf16x8*>(Qw + d0 * 16);
    const bf16_t* Kh = proj + 1024 + h * 128; const bf16_t* Vh = proj + 2048 + h * 128;
    const int sr = tid >> 4, sc = (tid & 15) * 8, vst0 = v_st(sr, sc), vst1 = v_st(32 + sr, sc);
    const int vb0 = (int)(unsigned)(uintptr_t)V_lds + v_rd_base(lane);
    struct { bf16x8 vs0, vs1, ks0, ks1; } sr_[2];
#define DA_SLOAD(i, k0) do { if (VAR == 4) break; sr_[i].vs0 = *(const bf16x8*)(&Vh[(size_t)((k0) + sr) * LD + sc]); sr_[i].vs1 = *(const bf16x8*)(&Vh[(size_t)((k0) + 32 + sr) * LD + sc]); \
    sr_[i].ks0 = *(const bf16x8*)(&Kh[(size_t)((k0) + sr) * LD + sc]); sr_[i].ks1 = *(const bf16x8*)(&Kh[(size_t)((k0) + 32 + sr) * LD + sc]); } while (0)
#define DA_SWRITE(b, i) do { if (VAR == 4) break; *(LAS bf16x8*)(V_lds + (b) * SHM_V + vst0) = sr_[i].vs0; *(LAS bf16x8*)(V_lds + (b) * SHM_V + vst1) = sr_[i].vs1; const int kc = sc * 2; \
    *(LAS bf16x8*)(K_lds + (b) * SHM_K + DA_KSWZ(sr, kc)) = sr_[i].ks0; *(LAS bf16x8*)(K_lds + (b) * SHM_K + DA_KSWZ(32 + sr, kc)) = sr_[i].ks1; } while (0)
#define DA_SWAIT() asm volatile("s_waitcnt vmcnt(4)" ::: "memory")
#define DA_RESC(a) do { if (__any((a) < 1.f)) { if (hi == 0) al_l[r32] = (a); asm volatile("s_waitcnt lgkmcnt(0)" ::: "memory"); \
    _Pragma("unroll") for (int d = 0; d < 4; ++d) _Pragma("unroll") for (int r = 0; r < 16; ++r) o[d][r] *= al_l[crow(r, hi)]; } } while (0)
    f32x16 pA0, pA1, pB0, pB1; float alA, alB; bf16x8 pa0, pa1, pa2, pa3; const int NT = nkeys / KVBLK;
#define DA_PSM(P0, P1, AL) do { if (FAST) { partialSM_fast(P0, P1, l_reg); AL = 1.f; } else partialSM(P0, P1, m_reg, AL); } while (0)
#define DA_PVS(VB, P0, P1, AL) do { if (FAST) { pv_fast<VAR>(o, VB, pa0, pa1, pa2, pa3, P0, P1, l_reg); AL = 1.f; } else { pv_d0(o, VB, pa0, pa1, pa2, pa3); partialSM(P0, P1, m_reg, AL); } } while (0)
#define DA_FSM(P0, P1, AL) do { if (FAST) finishSM_fast(P0, P1, pa0, pa1, pa2, pa3); else finishSM(P0, P1, AL, l_reg, pa0, pa1, pa2, pa3); } while (0)
#define DA_RESCX(a) do { if (!FAST) { DA_RESC(a); } } while (0)
    DA_SLOAD(0, 0); asm volatile("s_waitcnt vmcnt(0)" ::: "memory"); DA_SWRITE(0, 0); __syncthreads();
    qkt(pA0, pA1, K_lds, qr, r32, hi, comp); DA_PSM(pA0, pA1, alA);
    DA_SLOAD(1, KVBLK); if (2 < NT) DA_SLOAD(0, 2 * KVBLK);
    DA_SWAIT(); DA_SWRITE(1, 1); __syncthreads();
#define DA_SYNC() do { if (VAR != 5) __syncthreads(); } while (0)
#define DA_QKT(P0, P1, KS) do { if (VAR != 6) qkt(P0, P1, KS, qr, r32, hi, comp); else { P0 = f32x16{}; P1 = f32x16{}; } } while (0)
    for (int j = 1; j + 1 < NT; j += 2) {
        DA_SBAR(); DA_QKT(pB0, pB1, K_lds + SHM_K);
        DA_FSM(pA0, pA1, alA); DA_SBAR();
        DA_SLOAD(1, (j + 2) * KVBLK); DA_SBAR();
        DA_PVS(vb0, pB0, pB1, alB);
        DA_SYNC(); DA_SWAIT(); DA_SWRITE(0, 0);
        DA_RESCX(alB); DA_SYNC();
        DA_SBAR(); DA_QKT(pA0, pA1, K_lds);
        DA_FSM(pB0, pB1, alB); DA_SBAR();
        { const int tn = (j + 3 < NT) ? (j + 3) : (NT - 1); DA_SLOAD(0, tn * KVBLK); } DA_SBAR();
        DA_PVS(vb0 + SHM_V, pA0, pA1, alA);
        DA_SYNC(); DA_SWAIT(); DA_SWRITE(1, 1);
        DA_RESCX(alA); DA_SYNC();
    }
    DA_SBAR(); qkt(pB0, pB1, K_lds + SHM_K, qr, r32, hi, comp);
    DA_FSM(pA0, pA1, alA); DA_SBAR();
    DA_PVS(vb0, pB0, pB1, alB);
    __syncthreads(); DA_RESCX(alB);
    DA_FSM(pB0, pB1, alB); DA_SBAR();
    pv_d0(o, vb0 + SHM_V, pa0, pa1, pa2, pa3);
#undef DA_PSM
#undef DA_FSM
#undef DA_PVS
#undef DA_SYNC
#undef DA_QKT
    if (FAST) { auto rr = __builtin_amdgcn_permlane32_swap(__float_as_uint(l_reg), __float_as_uint(l_reg), false, false); l_reg = __uint_as_float(rr[0]) + __uint_as_float(rr[1]); }
#undef DA_RESCX
    if (hi == 0) li_l[r32] = l_reg; asm volatile("s_waitcnt lgkmcnt(0)" ::: "memory");
    float rli[16];
#pragma unroll
    for (int r = 0; r < 16; ++r) rli[r] = __builtin_amdgcn_rcpf(li_l[crow(r, hi)]);
#pragma unroll
    for (int d0 = 0; d0 < 4; ++d0)
#pragma unroll
        for (int r = 0; r < 16; ++r) o[d0][r] *= rli[r];
    {   const int bad = (l_reg > 1.0e-30f && l_reg < 1.0e30f) ? 0 : 1;
        (void)bad; __syncthreads(); }
    LAS float* xb = (LAS float*)lds;
    if (comp == 1) {
#pragma unroll
        for (int d0 = 0; d0 < 4; ++d0)
#pragma unroll
            for (int r = 0; r < 16; ++r) xb[((qw * 64) + d0 * 16 + r) * 64 + lane] = o[d0][r];
    }
    __syncthreads();
    if (comp == 0) {
        float ssq[16];
#pragma unroll
        for (int r = 0; r < 16; ++r) ssq[r] = 0.f;
#pragma unroll
        for (int d0 = 0; d0 < 4; ++d0)
#pragma unroll
            for (int r = 0; r < 16; ++r) { const float x = o[d0][r] - lam * xb[((qw * 64) + d0 * 16 + r) * 64 + lane]; o[d0][r] = x; ssq[r] += x * x; }
#pragma unroll
        for (int r = 0; r < 16; ++r) {
#pragma unroll
            for (int off = 16; off >= 1; off >>= 1) ssq[r] += __shfl_xor(ssq[r], off);
            ssq[r] = rsqrtf(ssq[r] * (1.0f / 128.f) + 1e-5f) * oscale; }
        asm volatile("" ::: "memory");
        LAS char* stg = lds + qw * 16384;
#pragma unroll
        for (int d0 = 0; d0 < 4; ++d0) { const float g = subln[d0 * 32 + r32];
#pragma unroll
            for (int r = 0; r < 16; ++r) *(LAS bf16_t*)(stg + crow(r, hi) * 272 + (d0 * 32 + r32) * 2) = f2bf(o[d0][r] * ssq[r] * g); }
        asm volatile("s_waitcnt lgkmcnt(0)" ::: "memory");
        bf16_t* Ow = cat + (size_t)(qrow0 + qw * 32) * DA_W + h * 128;
#pragma unroll
        for (int q = 0; q < 8; ++q) { const int id = q * 64 + lane, row = id >> 4, c16 = id & 15; *(u32x4*)(Ow + (size_t)row * DA_W + c16 * 8) = *(const LAS u32x4*)(stg + row * 272 + c16 * 16); }
    }
    __syncthreads();
    return true;
#undef DA_SLOAD
#undef DA_SWRITE
#undef DA_SWAIT
#undef DA_RESC
}
}

__device__ __forceinline__ void phase_attn(const Ctx& c, int jj, bool with_ctx) {
    PREF P = *c.p; const bf16_t* proj = (const bf16_t*)(c.ws + WS_PROJ); bf16_t* cat = (bf16_t*)(c.ws + WS_CAT);
    const float lam = ((const float*)(c.ws + WS_MISC))[jj * 2 + 0], linit = ((const float*)(c.ws + WS_MISC))[jj * 2 + 1];
    const float* subln = P.in[24] + (size_t)jj * 128;
    const int nunits = 1024 + (with_ctx ? 16 : 0);
    unsigned failed = 0u; int it = 0;
#pragma unroll 1
    for (int L = c.bid; L < nunits; L += c.G, ++it) {
        int h, q0, nk;
        if (L < 1024) { h = (L + (L >> 8)) & 7; q0 = NC + (L >> 3) * 128; nk = NTOK; } else { const int i = L - 1024; h = i & 7; q0 = (i >> 3) * 128; nk = NC; }
        if (!da2::attn_unit_dma((LAS char*)c.lds, proj, cat, h, q0, nk, lam, 1.0f - linit, subln)) failed |= 1u << (it & 31);
    }
    failed = (unsigned)__builtin_amdgcn_readfirstlane((int)failed);
    if (failed) {
        it = 0;
#pragma unroll 1
        for (int L = c.bid; L < nunits; L += c.G, ++it) {
            if (!((failed >> (it & 31)) & 1u)) continue;
            int h, q0, nk;
            if (L < 1024) { h = (L + (L >> 8)) & 7; q0 = NC + (L >> 3) * 128; nk = NTOK; } else { const int i = L - 1024; h = i & 7; q0 = (i >> 3) * 128; nk = NC; }
            (void)da::attn_unit<false>((LAS char*)c.lds, proj, cat, h, q0, nk, lam, 1.0f - linit, subln);
        }
    }
}
__device__ __forceinline__ MoeTable moe_table(const Ctx& c, int layer, int ntok_l) {
    LAS int* tb = (LAS int*)(c.lds + LDS_MISC + 64); LAS int* cn = (LAS int*)(c.lds + LDS_MISC + 512);
    const unsigned* cg = (const unsigned*)(c.ws + WS_CTL) + CW_CNT + c.cnt_off + layer * 64;
    __syncthreads();
    if (c.tid == 0) { int t = 0;
        for (int e = 0; e < 65; ++e) { const int n = (e < 64) ? (int)cg[e] : ntok_l; cn[e] = n; tb[e] = t; t += (n + 255) >> 8; }
        tb[65] = t; }
    __syncthreads();
    MoeTable r; r.tb = tb; r.cn = cn; return r;
}

__device__ __forceinline__ void phase_cvt_experts(const Ctx& c, int layer) {
    PREF P = *c.p; unsigned char* ws = c.ws;
    const float* wg = P.in[27] + (size_t)layer * 64 * 1024 * 256; const float* wu = P.in[28] + (size_t)layer * 64 * 1024 * 256; const float* wd = P.in[29] + (size_t)layer * 64 * 256 * 1024;
    const float* sg = P.in[30] + (size_t)layer * 1024 * 256; const float* su = P.in[31] + (size_t)layer * 1024 * 256; const float* sd = P.in[32] + (size_t)layer * 256 * 1024;
    bf16_t* WGU = (bf16_t*)(ws + WS_WGU); bf16_t* WD = (bf16_t*)(ws + WS_WD);
    unsigned* ctr = (unsigned*)(ws + WS_CTL) + CW_CVTQ + c.cnt_off + layer;
    LAS int* qs = (LAS int*)(c.lds + LDS_MISC + 1024);
    const int NT_ = 65 * 96, CH = 4;
    for (;;) {
        __syncthreads();
        if (c.tid == 0) qs[0] = (int)__hip_atomic_fetch_add(ctr, (unsigned)CH, __ATOMIC_RELAXED, __HIP_MEMORY_SCOPE_AGENT);
        __syncthreads();
        const int u0 = qs[0]; if (u0 >= NT_) break;
        for (int u = u0; u < u0 + CH && u < NT_; ++u) {
            const int e = u / 96, r = u % 96, kind = r >> 5, q = r & 31;
            if (kind == 0) { const float* src = (e < 64) ? wg + (size_t)e * 1024 * 256 : sg; cvt_tile128(c, src, 256, (q >> 2) * 128, (q & 3) * 64, WGU + (size_t)e * 512 * 1024, 1024, RowGate()); }
            else if (kind == 1) { const float* src = (e < 64) ? wu + (size_t)e * 1024 * 256 : su; cvt_tile128(c, src, 256, (q >> 2) * 128, (q & 3) * 64, WGU + (size_t)e * 512 * 1024, 1024, RowUp()); }
            else { const float* src = (e < 64) ? wd + (size_t)e * 256 * 1024 : sd; cvt_tile128(c, src, 1024, (q >> 4) * 128, (q & 15) * 64, WD + (size_t)e * 1024 * 256, 256, RowDown()); }
        }
    }
}

__device__ __forceinline__ void phase_p6(const Ctx& c, int layer, int tok0) {
    PREF P = *c.p; unsigned char* ws = c.ws; const int tid = c.tid, lane = c.lane, w = c.wid;
    const int ntok_l = NTOK - tok0, tpb = (ntok_l + c.G - 1) / c.G;
    const int tb0 = tok0 + c.bid * tpb, tb1 = (tb0 + tpb < NTOK) ? tb0 + tpb : NTOK; const int nloc = (tb1 > tb0) ? tb1 - tb0 : 0;
    LAS float* lg = (LAS float*)c.lds;
    LAS int* che = (LAS int*)(c.lds + 81920); LAS float* chw = (LAS float*)(c.lds + 87040);
    LAS int* cntl = (LAS int*)(c.lds + 92160); LAS int* basel = (LAS int*)(c.lds + 92416);
    if (tid < 64) cntl[tid] = 0;
    const float* xres = (const float*)(ws + WS_XRES); bf16_t* hB = (bf16_t*)(ws + WS_H); bf16_t* hL = (bf16_t*)(ws + WS_HLO);
    const float* gain = P.in[7] + (size_t)layer * D; const float* modl = (const float*)(ws + WS_MOD) + (size_t)layer * 2 * 6144;
    const bf16_t* wrh = (const bf16_t*)(ws + WS_WR) + (size_t)(layer * 2 + 0) * 64 * 1024; const bf16_t* wrl = wrh + 64 * 1024;
    const float* rbias = P.in[26] + (size_t)layer * 64;
#ifndef DUP_TOK
#define DUP_TOK 1
#endif
#ifndef DUP_TOKA
#define DUP_TOKA 1
#endif
#ifndef DUP_TOKB
#define DUP_TOKB 1
#endif
    _Pragma("unroll 1") for (int rept_ = 0; rept_ < DUP_TOK; ++rept_) {
    _Pragma("unroll 1") for (int repa_ = 0; repa_ < DUP_TOKA; ++repa_) {
#pragma unroll 1
    for (int tl0 = w * 4; tl0 < nloc; tl0 += 32) {
        f32x4 v[4][4]; float ss[4];
#pragma unroll
        for (int t = 0; t < 4; ++t) { const int tl = (tl0 + t < nloc) ? tl0 + t : nloc - 1; const float* x = xres + (size_t)(tb0 + tl) * D; ss[t] = 0.f;
#pragma unroll
            for (int q = 0; q < 4; ++q) { v[t][q] = *(const f32x4*)(x + q * 256 + lane * 4); ss[t] += v[t][q][0] * v[t][q][0] + v[t][q][1] * v[t][q][1] + v[t][q][2] * v[t][q][2] + v[t][q][3] * v[t][q][3]; } }
        ss[0] = wave_sum(ss[0]); ss[1] = wave_sum(ss[1]); ss[2] = wave_sum(ss[2]); ss[3] = wave_sum(ss[3]);
#pragma unroll
        for (int t = 0; t < 4; ++t) { if (tl0 + t < nloc) { const int row = tb0 + tl0 + t; const float* m = modl + ((row < NC) ? 6144 : 0); const float rstd = rsqrtf(ss[t] * (1.0f / 1024.f) + EPS);
#pragma unroll
            for (int q = 0; q < 4; ++q) { const int col = q * 256 + lane * 4;
                const f32x4 g = *(const f32x4*)(gain + col), sc = *(const f32x4*)(m + 4 * 1024 + col), sh = *(const f32x4*)(m + 3 * 1024 + col);
                float o[4], lo_[4];
#pragma unroll
                for (int k = 0; k < 4; ++k) { o[k] = v[t][q][k] * rstd * g[k] * (1.0f + sc[k]) + sh[k]; lo_[k] = o[k] - bf2f(f2bf(o[k])); }
                u32x2 wv; wv.x = cvtpk(o[0], o[1]); wv.y = cvtpk(o[2], o[3]);
                *(u32x2*)(hB + (size_t)row * D + col) = wv;
                u32x2 wl; wl.x = cvtpk(lo_[0], lo_[1]); wl.y = cvtpk(lo_[2], lo_[3]);
                *(u32x2*)(hL + (size_t)row * D + col) = wl; } } }
    }
    asm volatile("s_waitcnt vmcnt(0)" ::: "memory");
    __syncthreads();
    }
    _Pragma("unroll 1") for (int repb_ = 0; repb_ < DUP_TOKB; ++repb_) {
    {
        const int etp = w & 1, kq = w >> 1, fr = lane & 15, fq = lane >> 4; const int nmt = (nloc + 15) >> 4;
        f32x4 acc[5][2];
#pragma unroll
        for (int mt = 0; mt < 5; ++mt) { acc[mt][0] = (f32x4){0.f, 0.f, 0.f, 0.f}; acc[mt][1] = (f32x4){0.f, 0.f, 0.f, 0.f}; }
        const bf16_t* bh = wrh + (size_t)(etp * 32 + fr) * 1024 + kq * 256 + fq * 8; const bf16_t* bl = wrl + (size_t)(etp * 32 + fr) * 1024 + kq * 256 + fq * 8;
        size_t arow[5];
#pragma unroll
        for (int mt = 0; mt < 5; ++mt) { int tl = mt * 16 + fr; tl = (tl < nloc) ? tl : (nloc > 0 ? nloc - 1 : 0); arow[mt] = (size_t)(tb0 + tl) * D + kq * 256 + fq * 8; }
#pragma unroll 2
        for (int ks = 0; ks < 8; ++ks) {
            const bf16x8 vbh0 = *(const bf16x8*)(bh + ks * 32), vbl0 = *(const bf16x8*)(bl + ks * 32);
            const bf16x8 vbh1 = *(const bf16x8*)(bh + 16 * 1024 + ks * 32), vbl1 = *(const bf16x8*)(bl + 16 * 1024 + ks * 32);
#pragma unroll
            for (int mt = 0; mt < 5; ++mt) { if (mt < nmt) {
                const bf16x8 ah = *(const bf16x8*)(hB + arow[mt] + ks * 32), al = *(const bf16x8*)(hL + arow[mt] + ks * 32);
                acc[mt][0] = __builtin_amdgcn_mfma_f32_16x16x32_bf16(ah, vbh0, acc[mt][0], 0, 0, 0);
                acc[mt][0] = __builtin_amdgcn_mfma_f32_16x16x32_bf16(ah, vbl0, acc[mt][0], 0, 0, 0);
                acc[mt][0] = __builtin_amdgcn_mfma_f32_16x16x32_bf16(al, vbh0, acc[mt][0], 0, 0, 0);
                acc[mt][1] = __builtin_amdgcn_mfma_f32_16x16x32_bf16(ah, vbh1, acc[mt][1], 0, 0, 0);
                acc[mt][1] = __builtin_amdgcn_mfma_f32_16x16x32_bf16(ah, vbl1, acc[mt][1], 0, 0, 0);
                acc[mt][1] = __builtin_amdgcn_mfma_f32_16x16x32_bf16(al, vbh1, acc[mt][1], 0, 0, 0); } } }
#pragma unroll
        for (int mt = 0; mt < 5; ++mt)
#pragma unroll
            for (int e2 = 0; e2 < 2; ++e2)
#pragma unroll
                for (int r = 0; r < 4; ++r) lg[(kq * 80 + mt * 16 + fq * 4 + r) * 64 + etp * 32 + e2 * 16 + fr] = acc[mt][e2][r];
    }
    __syncthreads();
    }
    }
#pragma unroll 1
    for (int tl = w; tl < nloc; tl += 8) {
        const float logit = (lg[tl * 64 + lane] + lg[(80 + tl) * 64 + lane]) + (lg[(160 + tl) * 64 + lane] + lg[(240 + tl) * 64 + lane]);
        const float score = sigmoidf_(logit), choice = score + rbias[lane];
        float m1 = choice;
#pragma unroll
        for (int off = 1; off <= 4; off <<= 1) m1 = fmaxf(m1, __shfl_xor(m1, off));
        const unsigned long long bm = __ballot(choice == m1); const unsigned gb = (unsigned)(bm >> (lane & 56)) & 0xffu;
        const bool isfirst = ((lane & 7) == (__builtin_ctz(gb) & 7));
        float m2 = isfirst ? -INFINITY : choice;
#pragma unroll
        for (int off = 1; off <= 4; off <<= 1) m2 = fmaxf(m2, __shfl_xor(m2, off));
        const float gs = m1 + m2; const int g = lane >> 3; int grank = 0;
#pragma unroll
        for (int g2 = 0; g2 < 8; ++g2) { const float o = __shfl(gs, g2 * 8); grank += (o > gs || (o == gs && g2 < g)) ? 1 : 0; }
        const bool gsel = grank < 4; const float mc = gsel ? choice : -INFINITY; int erank = 0;
#pragma unroll 8
        for (int e2 = 0; e2 < 64; ++e2) { const float o = __shfl(mc, e2); erank += (o > mc || (o == mc && e2 < lane)) ? 1 : 0; }
        const bool sel = gsel && erank < 8;
        const float sw = wave_sum(sel ? score : 0.f);
        if (sel) { che[tl * 8 + erank] = lane; chw[tl * 8 + erank] = score / (sw + 1e-20f) * 2.5f; atomicAdd((int*)&cntl[lane], 1); }
    }
    __syncthreads();
    if (tid < 64) { const int n = cntl[tid]; unsigned* cg = (unsigned*)(ws + WS_CTL) + CW_CNT + c.cnt_off + layer * 64;
        basel[tid] = n ? (int)__hip_atomic_fetch_add(cg + tid, (unsigned)n, __ATOMIC_RELAXED, __HIP_MEMORY_SCOPE_AGENT) : 0; cntl[tid] = 0; }
    __syncthreads();
    int* ltok = (int*)(ws + WS_LTOK); float* lw = (float*)(ws + WS_LW); int* slot = (int*)(ws + WS_SLOT);
    for (int idx = tid; idx < nloc * 8; idx += NTHREADS) { const int tl = idx >> 3, e = che[idx]; const int pos = basel[e] + atomicAdd((int*)&cntl[e], 1);
        ltok[(size_t)e * NTOK + pos] = tb0 + tl; lw[(size_t)e * NTOK + pos] = chw[idx]; slot[(size_t)(tb0 + tl) * 8 + (idx & 7)] = (e << 20) | pos; }
    __syncthreads();
}

__device__ __forceinline__ void phase_p9(const Ctx& c, int layer, int tok0, const MoeTable& t) {
    PREF P = *c.p; unsigned char* ws = c.ws; const int lane = c.lane;
    float* xres = (float*)(ws + WS_XRES); const unsigned char* Y = (const unsigned char*)(ws + WS_YSLOT); const int* slot = (const int*)(ws + WS_SLOT);
    const float* modl = (const float*)(ws + WS_MOD) + (size_t)layer * 2 * 6144;
    const bool fin = (layer == DEPTH - 1);
    const float* gain = fin ? P.in[33] : P.in[6] + (size_t)(layer + 1) * D; const float* modn = (const float*)(ws + WS_MOD) + (size_t)(layer + 1) * 2 * 6144;
    bf16_t* hA = (bf16_t*)(ws + WS_H);
    const size_t shrow0 = (size_t)t.tb[64] * 256;
    const int col0 = lane * 16;
    for (int row = tok0 + c.bid * 8 + c.wid; row < NTOK; row += c.G * 8) {
        const int sl = (lane < 8) ? slot[(size_t)row * 8 + lane] : 0;
        float acc[16];
#pragma unroll
        for (int k = 0; k < 16; ++k) acc[k] = 0.f;
        u32x4 yv[9];
#pragma unroll
        for (int k = 0; k < 9; ++k) { size_t yr;
            if (k < 8) { const int s = __shfl(sl, k); yr = (size_t)t.tb[s >> 20] * 256 + (s & 0xfffff); } else yr = shrow0 + (size_t)(row - tok0);
            yv[k] = *(const u32x4*)(Y + yr * 1024 + col0); }
#pragma unroll
        for (int k = 0; k < 9; ++k) { const unsigned w4[4] = {yv[k].x, yv[k].y, yv[k].z, yv[k].w};
#pragma unroll
            for (int q = 0; q < 4; ++q) { const f32x2 a = __builtin_amdgcn_cvt_pk_f32_fp8((int)w4[q], false), b = __builtin_amdgcn_cvt_pk_f32_fp8((int)w4[q], true);
                acc[q * 4 + 0] += a[0]; acc[q * 4 + 1] += a[1]; acc[q * 4 + 2] += b[0]; acc[q * 4 + 3] += b[1]; } }
        const float* m = modl + ((row < NC) ? 6144 : 0) + 5 * 1024; float* x = xres + (size_t)row * D; float xn[16]; float ss = 0.f;
#pragma unroll
        for (int q = 0; q < 4; ++q) { const int col = col0 + q * 4; const f32x4 xv = *(const f32x4*)(x + col), g = *(const f32x4*)(m + col); f32x4 o;
#pragma unroll
            for (int k = 0; k < 4; ++k) { o[k] = xv[k] + g[k] * acc[q * 4 + k]; xn[q * 4 + k] = o[k]; ss += o[k] * o[k]; }
            *(f32x4*)(x + col) = o; }
        ss = wave_sum(ss); const float rstd = rsqrtf(ss * (1.0f / 1024.f) + EPS);
        if (fin) {
            float* out = P.out + (size_t)(row - NC) * D;
#pragma unroll
            for (int q = 0; q < 4; ++q) { const int col = col0 + q * 4; const f32x4 g = *(const f32x4*)(gain + col); f32x4 o;
#pragma unroll
                for (int k = 0; k < 4; ++k) o[k] = xn[q * 4 + k] * rstd * g[k];
                *(f32x4*)(out + col) = o; }
        } else {
            const float* mn = modn + ((row < NC) ? 6144 : 0); float o[16];
#pragma unroll
            for (int q = 0; q < 4; ++q) { const int col = col0 + q * 4; const f32x4 g = *(const f32x4*)(gain + col), sc = *(const f32x4*)(mn + 1024 + col), sh = *(const f32x4*)(mn + col);
#pragma unroll
                for (int k = 0; k < 4; ++k) o[q * 4 + k] = xn[q * 4 + k] * rstd * g[k] * (1.0f + sc[k]) + sh[k]; }
            u32x4 w0, w1; w0.x = cvtpk(o[0], o[1]); w0.y = cvtpk(o[2], o[3]); w0.z = cvtpk(o[4], o[5]); w0.w = cvtpk(o[6], o[7]);
            w1.x = cvtpk(o[8], o[9]); w1.y = cvtpk(o[10], o[11]); w1.z = cvtpk(o[12], o[13]); w1.w = cvtpk(o[14], o[15]);
            *(u32x4*)(hA + (size_t)row * D + col0) = w0; *(u32x4*)(hA + (size_t)row * D + col0 + 8) = w1;
        }
    }
}
#ifndef DUP_INPROJ
#define DUP_INPROJ 1
#endif
#ifndef DUP_ATTN
#define DUP_ATTN 1
#endif
#ifndef DUP_UP
#define DUP_UP 1
#endif
#ifndef DUP_DOWN
#define DUP_DOWN 1
#endif
#ifndef DUP_F
#define DUP_F 1
#endif
#ifndef DUP_HYCONV
#define DUP_HYCONV 1
#endif
#ifndef DUP_R1
#define DUP_R1 1
#endif
#ifndef DUP_R3
#define DUP_R3 1
#endif
#ifndef DUP_MISC
#define DUP_MISC 1
#endif
#ifndef DUP_PR
#define DUP_PR 1
#endif
#ifndef DUP_CVT
#define DUP_CVT 1
#endif
#define REPEAT(n) _Pragma("unroll 1") for (int rep_ = 0; rep_ < (n); ++rep_)
constexpr int NPHASE = 38;
__global__ void __launch_bounds__(NTHREADS, 2) fwd_kernel(Params prm) {
    extern __shared__ __attribute__((aligned(16))) unsigned char lds_raw[];
    const KParams kp0 = (KParams)__builtin_amdgcn_kernarg_segment_ptr();
    Ctx c; c.p = kp0; c.lds = (LAS unsigned char*)lds_raw; c.tid = threadIdx.x; c.lane = c.tid & 63; c.wid = __builtin_amdgcn_readfirstlane(c.tid >> 6); c.G = gridDim.x; c.bid = blockIdx.x; c.ws = kp0->ws;
    volatile LAS unsigned* misc = (volatile LAS unsigned*)(c.lds + LDS_MISC);
    if (c.tid < 4) misc[c.tid] = 0u;
    __syncthreads();
#ifdef PROBE_STOP
    const int lo = 0; int hi = PROBE_STOP; int cnt_off = 256;
#else
    const int lo = kp0->ph_lo, hi = kp0->ph_hi; const int cnt_off = 0;
#endif
    XcdBarrier bar; bar.bar = (unsigned*)(c.ws + WS_CTL) + CW_BAR; bar.x = 0; bar.st = misc;
    if (kp0->ph_hi - kp0->ph_lo > 1) bar = xcd_barrier_post((unsigned*)(c.ws + WS_CTL) + CW_BAR, misc);
#define IN(k) ((lo <= (k) && (k) < hi) && ((c.tid = opaque((int)threadIdx.x)), (c.lane = c.tid & 63), (c.wid = __builtin_amdgcn_readfirstlane(c.tid >> 6)), (c.p = opaque_kp(kp0)), (c.ws = c.p->ws), (ws = c.ws), (c.G = opaque_s((int)gridDim.x)), (c.bid = opaque_s((int)blockIdx.x)), true))
#define SEAM(k) do { if ((lo <= (k)) && ((k) + 1 < hi)) { bar.bar = (unsigned*)(opaque_kp(kp0)->ws + WS_CTL) + CW_BAR; xcd_barrier(bar); } } while (0)
    unsigned char* ws = c.ws;
#ifdef PROBE_STOP
#pragma unroll 1
    for (int pass = 0; pass < 2; ++pass) {
    if (pass == 1) { xcd_barrier(bar); hi = NPHASE; cnt_off = 0; }
#endif
    c.cnt_off = cnt_off;
#ifdef PROBE_STOP
    c.pass = pass;
#else
    c.pass = 1;
#endif
    if (IN(0)) { REPEAT(DUP_PR) phase_pr0(c); } SEAM(0);
    if (IN(1)) { REPEAT(DUP_PR) phase_pr1(c); } SEAM(1);
#pragma unroll 1
    for (int jj = 0; jj < 2; ++jj) {
        const int pb = 2 + jj * 18;
        { const int layer = 2 * jj;
        if (IN(pb + 0)) { REPEAT(DUP_F) phase_f1(c, jj); } SEAM(pb + 0);
        if (IN(pb + 1)) { REPEAT(DUP_F) phase_f2(c); } SEAM(pb + 1);
        if (IN(pb + 2)) {
            DenseSched S; S.init(ws + WS_H, (const bf16_t*)(ws + WS_WAB_IN) + (size_t)jj * AB_IN * 1024, 1024, 65, 18, 0, c.G, c.bid);
            EpiAbIn E{(bf16_t*)(ws + WS_PROJ), (const f32x2*)(ws + WS_ROPE)};
            REPEAT(DUP_INPROJ) pg8::gemm_phase<EpiAbIn, DenseSched, false>(c.lds, 1024, S, E); } SEAM(pb + 2);
        if (IN(pb + 3)) { REPEAT(DUP_R1) phase_r1(c, jj); REPEAT(DUP_MISC) phase_hyprep(c, jj); } SEAM(pb + 3);
        if (IN(pb + 4)) { REPEAT(DUP_HYCONV) phase_hyconv(c, jj); REPEAT(DUP_MISC) phase_scan(c, jj); } SEAM(pb + 4);
        if (IN(pb + 5)) { REPEAT(DUP_R3) phase_r3(c, jj); REPEAT(DUP_MISC) { phase_hytrans(c); phase_hyctx(c, jj); } } SEAM(pb + 5);
        if (IN(pb + 6)) {
            DenseSched S; S.init(ws + WS_CAT, (const bf16_t*)(ws + WS_WAB_OUT) + (size_t)jj * 1024 * AB_CAT, AB_CAT, 65, 4, 0, c.G, c.bid);
            EpiResid E{(float*)(ws + WS_XRES), (const float*)(ws + WS_MOD) + (size_t)layer * 2 * 6144};
            pg8::gemm_phase<EpiResid, DenseSched, false>(c.lds, AB_CAT, S, E);
            phase_cvt_experts(c, layer); } SEAM(pb + 6);
        if (IN(pb + 7)) { phase_p6(c, layer, 0); } SEAM(pb + 7);
        if (IN(pb + 8)) { const MoeTable t = moe_table(c, layer, NTOK);
            MoeUpSched S; S.t = t; S.H = (const char*)(ws + WS_H); S.W = (const char*)(ws + WS_WGU); S.ltok = (const int*)(ws + WS_LTOK); S.tok0 = 0; S.G = c.G; S.c = c.bid; S.nwg = t.tb[65] * 2;
            EpiSwiglu E{(bf16_t*)(ws + WS_ACT), (const float*)(ws + WS_LW), t};
            REPEAT(DUP_UP) pg8::gemm_phase<EpiSwiglu, MoeUpSched, true>(c.lds, 1024, S, E); } SEAM(pb + 8);
        if (IN(pb + 9)) { const MoeTable t = moe_table(c, layer, NTOK);
            MoeDownSched S; S.t = t; S.ACT = (const char*)(ws + WS_ACT); S.W = (const char*)(ws + WS_WD); S.G = c.G; S.c = c.bid; S.nwg = t.tb[65] * 4;
            EpiDown E{(unsigned char*)(ws + WS_YSLOT), (const float*)(ws + WS_LW), t, 0};
#ifdef PROBE_DOWN_NOEPI
            { EpiDown E0 = E; E0.skip = 1; pg8::gemm_phase<EpiDown, MoeDownSched, false>(c.lds, 256, S, E0); }
#endif
            REPEAT(DUP_DOWN) pg8::gemm_phase<EpiDown, MoeDownSched, false>(c.lds, 256, S, E); } SEAM(pb + 9);
        if (IN(pb + 10)) { const MoeTable t = moe_table(c, layer, NTOK); phase_p9(c, layer, 0, t); } SEAM(pb + 10);
        }
        { const int layer = 2 * jj + 1; const bool with_ctx = layer < DEPTH - 1; const int tok0 = with_ctx ? 0 : NC; const int pm0 = with_ctx ? 0 : 1;
        if (IN(pb + 11)) {
            DenseSched S; S.init(ws + WS_H, (const bf16_t*)(ws + WS_WDA_IN) + (size_t)jj * DA_IN * 1024, 1024, 65, 12, 0, c.G, c.bid);
            EpiDaIn E{(bf16_t*)(ws + WS_PROJ), (const f32x2*)(ws + WS_ROPE) + (256 * 32 + 64 * 32)};
            REPEAT(DUP_INPROJ) pg8::gemm_phase<EpiDaIn, DenseSched, false>(c.lds, 1024, S, E); } SEAM(pb + 11);
        if (IN(pb + 12)) { REPEAT(DUP_ATTN) phase_attn(c, jj, with_ctx); } SEAM(pb + 12);
        if (IN(pb + 13)) {
            DenseSched S; S.init(ws + WS_CAT, (const bf16_t*)(ws + WS_WDA_OUT) + (size_t)jj * 1024 * 1024, 1024, 65, 4, pm0, c.G, c.bid);
            EpiResid E{(float*)(ws + WS_XRES), (const float*)(ws + WS_MOD) + (size_t)layer * 2 * 6144};
            pg8::gemm_phase<EpiResid, DenseSched, false>(c.lds, 1024, S, E);
            phase_cvt_experts(c, layer); } SEAM(pb + 13);
        if (IN(pb + 14)) { phase_p6(c, layer, tok0); } SEAM(pb + 14);
        if (IN(pb + 15)) { const MoeTable t = moe_table(c, layer, NTOK - tok0);
            MoeUpSched S; S.t = t; S.H = (const char*)(ws + WS_H); S.W = (const char*)(ws + WS_WGU); S.ltok = (const int*)(ws + WS_LTOK); S.tok0 = tok0; S.G = c.G; S.c = c.bid; S.nwg = t.tb[65] * 2;
            EpiSwiglu E{(bf16_t*)(ws + WS_ACT), (const float*)(ws + WS_LW), t};
            REPEAT(DUP_UP) pg8::gemm_phase<EpiSwiglu, MoeUpSched, true>(c.lds, 1024, S, E); } SEAM(pb + 15);
        if (IN(pb + 16)) { const MoeTable t = moe_table(c, layer, NTOK - tok0);
            MoeDownSched S; S.t = t; S.ACT = (const char*)(ws + WS_ACT); S.W = (const char*)(ws + WS_WD); S.G = c.G; S.c = c.bid; S.nwg = t.tb[65] * 4;
            EpiDown E{(unsigned char*)(ws + WS_YSLOT), (const float*)(ws + WS_LW), t, 0};
#ifdef PROBE_DOWN_NOEPI
            { EpiDown E0 = E; E0.skip = 1; pg8::gemm_phase<EpiDown, MoeDownSched, false>(c.lds, 256, S, E0); }
#endif
            REPEAT(DUP_DOWN) pg8::gemm_phase<EpiDown, MoeDownSched, false>(c.lds, 256, S, E); } SEAM(pb + 16);
        if (IN(pb + 17)) { const MoeTable t = moe_table(c, layer, NTOK - tok0); phase_p9(c, layer, tok0, t); } SEAM(pb + 17);
        }
    }
#ifdef PROBE_STOP
    }
#endif
#undef IN
#undef SEAM
}

#ifdef DBG_K
__global__ void dbg_dump(const unsigned* w, size_t nwords, float* out, int nout) {
    for (int i = blockIdx.x * blockDim.x + threadIdx.x; i < nout; i += gridDim.x * blockDim.x) { unsigned h = 0;
        for (size_t q = i; q < nwords; q += (size_t)nout) { unsigned x = w[q]; x ^= x >> 16; x *= 0x7feb352du; x ^= x >> 15; x *= 0x846ca68bu; x ^= x >> 16; h += x; }
        out[i] = (float)(h & 0xFFFFFu); }
}
#endif
#ifndef MK_SPLIT
#define MK_SPLIT 0
#endif
extern "C" void kernel_launch(void* const* d_in, const int* in_sizes, int n_in, void* d_out, int out_size, void* d_ws, size_t ws_size, hipStream_t stream) {
    static int grid = 0;
    if (grid == 0) {
        if (n_in != 34 || out_size != NX * D || ws_size < WS_END) { fprintf(stderr, "kernel_launch: unexpected shapes: n_in %d out %d ws %zu (need %zu)\n", n_in, out_size, ws_size, (size_t)WS_END); grid = -1; return; }
        int dev = 0, cus = 0, per_cu = 0;
        if (hipGetDevice(&dev) != hipSuccess || hipDeviceGetAttribute(&cus, hipDeviceAttributeMultiprocessorCount, dev) != hipSuccess) { grid = -1; return; }
        if (hipFuncSetAttribute((const void*)fwd_kernel, hipFuncAttributeMaxDynamicSharedMemorySize, LDS_BYTES) != hipSuccess) { fprintf(stderr, "kernel_launch: hipFuncSetAttribute failed\n"); grid = -1; return; }
        if (hipOccupancyMaxActiveBlocksPerMultiprocessor(&per_cu, (const void*)fwd_kernel, NTHREADS, LDS_BYTES) != hipSuccess || per_cu < 1) { fprintf(stderr, "kernel_launch: occupancy query says %d\n", per_cu); grid = -1; return; }
        grid = cus;
        if (grid > 256) grid = 256;
        grid &= ~7;
    }
    if (grid <= 0) return;
    (void)hipMemsetAsync((char*)d_ws + WS_CTL, 0, CTL_ZERO_BYTES, stream);
    Params p{};
    for (int i = 0; i < 34; ++i) p.in[i] = (const float*)d_in[i];
    p.out = (float*)d_out; p.ws = (unsigned char*)d_ws;
#ifdef DBG_K
    for (int k = 0; k <= DBG_K; ++k) { p.ph_lo = k; p.ph_hi = k + 1; hipLaunchKernelGGL(fwd_kernel, dim3(grid), dim3(NTHREADS), LDS_BYTES, stream, p); }
    hipLaunchKernelGGL(dbg_dump, dim3(1024), dim3(256), 0, stream, (const unsigned*)((const char*)d_ws + (size_t)(DBG_OFF)), (size_t)(DBG_BYTES) / 4, (float*)d_out, out_size);
#elif MK_SPLIT
    for (int k = 0; k < NPHASE; ++k) { p.ph_lo = k; p.ph_hi = k + 1; hipLaunchKernelGGL(fwd_kernel, dim3(grid), dim3(NTHREADS), LDS_BYTES, stream, p); }
#else
    p.ph_lo = 0; p.ph_hi = NPHASE;
    hipLaunchKernelGGL(fwd_kernel, dim3(grid), dim3(NTHREADS), LDS_BYTES, stream, p);
#endif
    const hipError_t le = hipPeekAtLastError();
    if (le != hipSuccess) fprintf(stderr, "kernel_launch: launch failed: %s\n", hipGetErrorName(le));
}
```
